# Optimizing an MI355X kernel written in HIP

```python
import math
import jax, jax.numpy as jnp
from jax import lax
import numpy as np

D_MODEL = 2048
BATCH = 2
SEQ = 4096
DEPTH = 2
DEC_BATCH = 8
DEC_SEQ = 1
PAST_LEN = 16384
PAGE_SIZE = 128

HEAD_DIM = 128
MIX_WIDTH = D_MODEL
N_MEM = 256
N_MEM_HEADS = 4
MEM_WIDTH = N_MEM_HEADS * HEAD_DIM
MIXER_WIDTH = MIX_WIDTH - MEM_WIDTH
CHUNK = 128
N_GROUPS_A = 4
GROUP_DIM_A = MIXER_WIDTH // N_GROUPS_A
SWA_PATTERN = ((128, 1), (512, 4), (2048, 16))
N_SWA_GROUPS = 3
HEADS_PER_GROUP = MIXER_WIDTH // (HEAD_DIM * N_SWA_GROUPS)
N_HEADS_B = HEADS_PER_GROUP * N_SWA_GROUPS
N_BUCKETS = 32
MAX_EXACT = N_BUCKETS // 2
MAX_DISTANCE = 2048
D_FF = -(-8 * D_MODEL // (3 * 256)) * 256
N_MIXERS = 2
N_GMLP_LAYERS = (DEPTH + 1) // 2
N_SWA_LAYERS = DEPTH // 2
EPS = 1e-6
NEG_INF = -1e30

kernel_name = 'hybrid_gmlp_dilated_swa_decode_step'


def rms_norm(x, g):
    xf = x.astype(jnp.float32)
    y = xf * lax.rsqrt(jnp.mean(xf * xf, axis=-1, keepdims=True) + EPS)
    return (y * g.astype(jnp.float32)).astype(x.dtype)


def t5_bucket(dist):
    nf = jnp.maximum(dist, MAX_EXACT).astype(jnp.float32)
    large = MAX_EXACT + (jnp.log(nf / MAX_EXACT) / math.log(MAX_DISTANCE / MAX_EXACT) * (N_BUCKETS - MAX_EXACT)).astype(jnp.int32)
    large = jnp.minimum(large, N_BUCKETS - 1)
    return jnp.where(dist < MAX_EXACT, dist, large)


def group_bias(rel_bias, g, dil, n_back):
    dist = jnp.arange(n_back + 1, dtype=jnp.int32) * dil
    b = rel_bias[t5_bucket(dist)][:, g * HEADS_PER_GROUP:(g + 1) * HEADS_PER_GROUP]
    return b.T.astype(jnp.float32)


def spatial_gating(z, g_v, w_s, b_s):
    B, T, _ = z.shape
    uv = jax.nn.gelu(z[..., :2 * MIXER_WIDTH])
    u, v = uv[..., :MIXER_WIDTH], uv[..., MIXER_WIDTH:]
    v = rms_norm(v, g_v)
    n_chunks = -(-T // CHUNK)
    vp = jnp.pad(v, ((0, 0), (0, n_chunks * CHUNK - T), (0, 0)))
    vp = vp.reshape(B, n_chunks, CHUNK, N_GROUPS_A, GROUP_DIM_A)
    w = w_s * jnp.tril(jnp.ones((CHUNK, CHUNK), w_s.dtype))
    s = jnp.einsum('gij,bnjgc->bnigc', w, vp) + b_s.T[None, None, :, :, None]
    s = s.reshape(B, n_chunks * CHUNK, MIXER_WIDTH)[:, :T]
    return u * s, v


def memory_kv(mem, g_mem, w_mem_kv):
    B = mem.shape[0]
    return (rms_norm(mem, g_mem) @ w_mem_kv).reshape(B, N_MEM, 2, N_MEM_HEADS, HEAD_DIM)


def memory_attention(q_cols, kv):
    B, T, _ = q_cols.shape
    q = q_cols.reshape(B, T, N_MEM_HEADS, HEAD_DIM)
    s = jnp.einsum('bthd,bmhd->bhtm', q, kv[:, :, 0]).astype(jnp.float32) * (HEAD_DIM ** -0.5)
    p = jax.nn.softmax(s, axis=-1).astype(q.dtype)
    return jnp.einsum('bhtm,bmhd->bthd', p, kv[:, :, 1]).reshape(B, T, MEM_WIDTH)


def swa_qkv(z):
    B, T, _ = z.shape
    qkv = z[..., :3 * MIXER_WIDTH].reshape(B, T, 3, N_HEADS_B, HEAD_DIM)
    return qkv[:, :, 0], qkv[:, :, 1], qkv[:, :, 2]


def dilated_attention_prompt(q, k, v, dil, n_back, bias_j):
    B, T, H, Dh = q.shape
    L = T // dil
    blk = n_back
    n_blk = -(-L // blk)
    Lp = n_blk * blk

    def to_sub(a):
        a = a.reshape(B, L, dil, H, Dh).transpose(0, 2, 1, 3, 4)
        return jnp.pad(a, ((0, 0), (0, 0), (0, Lp - L), (0, 0), (0, 0)))

    def band(a):
        a = jnp.pad(a, ((0, 0), (0, 0), (blk, 0), (0, 0), (0, 0))).reshape(B, dil, n_blk + 1, blk, H, Dh)
        return jnp.concatenate([a[:, :, :-1], a[:, :, 1:]], axis=3)

    qb = to_sub(q).reshape(B, dil, n_blk, blk, H, Dh)
    kb, vb = band(to_sub(k)), band(to_sub(v))
    qi = jnp.arange(blk)[:, None]
    kj = jnp.arange(2 * blk)[None, :]
    j = qi + blk - kj
    key_idx = jnp.arange(n_blk)[:, None, None] * blk - blk + kj[None]
    valid = (j >= 0) & (j <= n_back) & (key_idx >= 0)
    bias = bias_j[:, jnp.clip(j, 0, n_back)]
    s = jnp.einsum('brnqhd,brnkhd->brnhqk', qb, kb).astype(jnp.float32) * (Dh ** -0.5) + bias
    s = jnp.where(valid[None, None, :, None], s, NEG_INF)
    m = jnp.max(s, axis=-1, keepdims=True)
    p = jnp.exp(s - m)
    den = jnp.sum(p, axis=-1, keepdims=True)
    o = jnp.einsum('brnhqk,brnkhd->brnqhd', (p / den).astype(v.dtype), vb)
    lse = (m + jnp.log(den))[..., 0]
    o = o.reshape(B, dil, Lp, H, Dh)[:, :, :L].transpose(0, 2, 1, 3, 4).reshape(B, T, H, Dh)
    lse = lse.transpose(0, 1, 2, 4, 3).reshape(B, dil, Lp, H)[:, :, :L].transpose(0, 2, 1, 3).reshape(B, T, H)
    return o, lse


def dilated_attention_sample(q, k_all, v_all, n_buf, dil, n_back, bias_j):
    S = q.shape[1]
    idx = n_buf + jnp.arange(S)[:, None] - jnp.arange(n_back + 1)[None, :] * dil
    valid = idx >= 0
    idx = jnp.maximum(idx, 0)
    kg, vg = k_all[:, idx], v_all[:, idx]
    s = jnp.einsum('bshd,bsjhd->bhsj', q, kg).astype(jnp.float32) * (q.shape[-1] ** -0.5) + bias_j[None, :, None, :]
    s = jnp.where(valid[None, None], s, NEG_INF)
    lse = jax.nn.logsumexp(s, axis=-1)
    p = jnp.exp(s - lse[..., None]).astype(v_all.dtype)
    o = jnp.einsum('bhsj,bsjhd->bshd', p, vg)
    return o, lse.transpose(0, 2, 1)


def merge_groups(outs, lses):
    alpha = jax.nn.softmax(jnp.stack(lses, axis=0), axis=0)
    o = jnp.stack(outs, axis=0) * alpha[..., None].astype(outs[0].dtype)
    G, B, T, H, Dh = o.shape
    return o.transpose(1, 2, 0, 3, 4).reshape(B, T, G * H * Dh)


def swa_prompt(z, bias_groups):
    q, k, v = swa_qkv(z)
    T = z.shape[1]
    outs, lses, rows = [], [], []
    for g, (win, dil) in enumerate(SWA_PATTERN):
        hs = slice(g * HEADS_PER_GROUP, (g + 1) * HEADS_PER_GROUP)
        qg, kg, vg = q[:, :, hs], k[:, :, hs], v[:, :, hs]
        o, lse = dilated_attention_prompt(qg, kg, vg, dil, win // dil, bias_groups[g])
        outs.append(o)
        lses.append(lse)
        n_keep = min(win, T)
        rows.append(jnp.stack([kg, vg], axis=2)[:, T - n_keep:])
    return merge_groups(outs, lses), rows


def swa_sample(z, bufs, bias_groups):
    q, k, v = swa_qkv(z)
    outs, lses, rows = [], [], []
    for g, (win, dil) in enumerate(SWA_PATTERN):
        hs = slice(g * HEADS_PER_GROUP, (g + 1) * HEADS_PER_GROUP)
        qg, kg, vg = q[:, :, hs], k[:, :, hs], v[:, :, hs]
        buf = bufs[g]
        k_all = jnp.concatenate([buf[:, :, 0], kg], axis=1)
        v_all = jnp.concatenate([buf[:, :, 1], vg], axis=1)
        o, lse = dilated_attention_sample(qg, k_all, v_all, buf.shape[1], dil, win // dil, bias_groups[g])
        outs.append(o)
        lses.append(lse)
        rows.append(jnp.stack([kg, vg], axis=2))
    return merge_groups(outs, lses), rows


def mix_residual(x, mixer_out, q_mem, mem_kv, w_out, g_post):
    o = jnp.concatenate([mixer_out, memory_attention(q_mem, mem_kv)], axis=-1) @ w_out
    return x + rms_norm(o, g_post)


def ffn_residual(x, g_pre, g_post, w_up, w_down):
    h = rms_norm(x, g_pre) @ w_up
    return x + rms_norm((jax.nn.silu(h[..., :D_FF]) * h[..., D_FF:]) @ w_down, g_post)


def setup_inputs(seed: int = 0) -> dict:
    key = jax.random.key(seed)
    ks = jax.random.split(key, 24)
    f32 = jnp.float32

    def nrm(k, shape, scale):
        return jax.random.normal(k, shape, f32) * scale

    def gain(k, shape):
        return 1.0 + 0.05 * jax.random.normal(k, shape, f32)

    win_rows = [min(w, PAST_LEN) for w, _ in SWA_PATTERN]
    kv_tail = (2, HEADS_PER_GROUP, HEAD_DIM)
    return {
        'x_prompt': nrm(ks[0], (BATCH, SEQ, D_MODEL), 1.0),
        'x_sample': nrm(ks[1], (DEC_BATCH, DEC_SEQ, D_MODEL), 1.0),
        'mem_prompt': nrm(ks[2], (BATCH, N_MEM, D_MODEL), 1.0),
        'cache_mem_kv': nrm(ks[3], (DEPTH, DEC_BATCH, N_MEM, 2, N_MEM_HEADS, HEAD_DIM), 1.0),
        'cache_win128_kv': nrm(ks[4], (N_SWA_LAYERS, DEC_BATCH, win_rows[0]) + kv_tail, 1.0),
        'cache_win512_kv': nrm(ks[5], (N_SWA_LAYERS, DEC_BATCH, win_rows[1]) + kv_tail, 1.0),
        'cache_win2048_kv': nrm(ks[6], (N_SWA_LAYERS, DEC_BATCH, win_rows[2]) + kv_tail, 1.0),
        'rel_bias': nrm(ks[7], (N_BUCKETS, N_HEADS_B), 0.5),
        'norm_mix_pre': gain(ks[8], (DEPTH, D_MODEL)),
        'norm_mix_post': gain(ks[9], (DEPTH, D_MODEL)),
        'norm_ffn_pre': gain(ks[10], (DEPTH, D_MODEL)),
        'norm_ffn_post': gain(ks[11], (DEPTH, D_MODEL)),
        'norm_mem': gain(ks[12], (DEPTH, D_MODEL)),
        'w_mem_kv': nrm(ks[13], (DEPTH, D_MODEL, 2 * MEM_WIDTH), D_MODEL ** -0.5),
        'w_in_a': nrm(ks[14], (N_GMLP_LAYERS, D_MODEL, 2 * MIXER_WIDTH + MEM_WIDTH), D_MODEL ** -0.5),
        'norm_v_a': gain(ks[15], (N_GMLP_LAYERS, MIXER_WIDTH)),
        'w_spatial_a': nrm(ks[16], (N_GMLP_LAYERS, N_GROUPS_A, CHUNK, CHUNK), CHUNK ** -0.5),
        'b_spatial_a': 1.0 + 0.1 * jax.random.normal(ks[17], (N_GMLP_LAYERS, N_GROUPS_A, CHUNK), f32),
        'w_in_b': nrm(ks[18], (N_SWA_LAYERS, D_MODEL, 3 * MIXER_WIDTH + MEM_WIDTH), D_MODEL ** -0.5),
        'w_out': nrm(ks[19], (DEPTH, MIX_WIDTH, D_MODEL), MIX_WIDTH ** -0.5),
        'w_ffn_up': nrm(ks[20], (DEPTH, D_MODEL, 2 * D_FF), D_MODEL ** -0.5),
        'w_ffn_down': nrm(ks[21], (DEPTH, D_FF, D_MODEL), D_FF ** -0.5),
    }


def reference(x_prompt, x_sample, mem_prompt, cache_mem_kv, cache_win128_kv, cache_win512_kv,
              cache_win2048_kv, rel_bias, norm_mix_pre, norm_mix_post, norm_ffn_pre, norm_ffn_post,
              norm_mem, w_mem_kv, w_in_a, norm_v_a, w_spatial_a, b_spatial_a, w_in_b, w_out,
              w_ffn_up, w_ffn_down):
    bias_groups = [group_bias(rel_bias, g, dil, win // dil) for g, (win, dil) in enumerate(SWA_PATTERN)]
    win_caches = (cache_win128_kv, cache_win512_kv, cache_win2048_kv)
    yp, ys = x_prompt, x_sample
    mem_kv_p, chunk_v_s = [], []
    win_p = [[] for _ in SWA_PATTERN]
    win_s = [[] for _ in SWA_PATTERN]
    for i in range(DEPTH):
        li = i // N_MIXERS
        kv_p = memory_kv(mem_prompt, norm_mem[i], w_mem_kv[i])
        kv_s = cache_mem_kv[i]
        mem_kv_p.append(kv_p)
        hp = rms_norm(yp, norm_mix_pre[i])
        hs = rms_norm(ys, norm_mix_pre[i])
        if i % N_MIXERS == 0:
            zp = hp @ w_in_a[li]
            zs = hs @ w_in_a[li]
            mp, _ = spatial_gating(zp, norm_v_a[li], w_spatial_a[li], b_spatial_a[li])
            ms, v_rows = spatial_gating(zs, norm_v_a[li], w_spatial_a[li], b_spatial_a[li])
            chunk_v_s.append(v_rows)
            qp, qs = zp[..., 2 * MIXER_WIDTH:], zs[..., 2 * MIXER_WIDTH:]
        else:
            zp = hp @ w_in_b[li]
            zs = hs @ w_in_b[li]
            mp, rows_p = swa_prompt(zp, bias_groups)
            ms, rows_s = swa_sample(zs, [c[li] for c in win_caches], bias_groups)
            for g in range(N_SWA_GROUPS):
                win_p[g].append(rows_p[g])
                win_s[g].append(rows_s[g])
            qp, qs = zp[..., 3 * MIXER_WIDTH:], zs[..., 3 * MIXER_WIDTH:]
        yp = mix_residual(yp, mp, qp, kv_p, w_out[i], norm_mix_post[i])
        ys = mix_residual(ys, ms, qs, kv_s, w_out[i], norm_mix_post[i])
        yp = ffn_residual(yp, norm_ffn_pre[i], norm_ffn_post[i], w_ffn_up[i], w_ffn_down[i])
        ys = ffn_residual(ys, norm_ffn_pre[i], norm_ffn_post[i], w_ffn_up[i], w_ffn_down[i])
    new_mem_kv_prompt = jnp.stack(mem_kv_p, axis=0)
    new_chunk_v_sample = jnp.stack(chunk_v_s, axis=0)
    new_win128_kv_prompt = jnp.stack(win_p[0], axis=0)
    new_win512_kv_prompt = jnp.stack(win_p[1], axis=0)
    new_win2048_kv_prompt = jnp.stack(win_p[2], axis=0)
    new_win128_kv_sample = jnp.stack(win_s[0], axis=0)
    new_win512_kv_sample = jnp.stack(win_s[1], axis=0)
    new_win2048_kv_sample = jnp.stack(win_s[2], axis=0)
    return (yp, ys, new_mem_kv_prompt, new_chunk_v_sample,
            new_win128_kv_prompt, new_win512_kv_prompt, new_win2048_kv_prompt,
            new_win128_kv_sample, new_win512_kv_sample, new_win2048_kv_sample)
```

```cpp
#include <hip/hip_runtime.h>
#include <cstdio>
#include <cstdint>

#define LAS __attribute__((address_space(3)))
typedef unsigned short bf16_t;
typedef short bf16x8 __attribute__((ext_vector_type(8)));
typedef short s16x4 __attribute__((ext_vector_type(4)));
typedef float f32x4 __attribute__((ext_vector_type(4)));
typedef float f32x2 __attribute__((ext_vector_type(2)));
typedef unsigned u32x4 __attribute__((ext_vector_type(4)));
typedef unsigned u32x2 __attribute__((ext_vector_type(2)));

constexpr int DM = 2048, TP = 8192, TSMP = 8, TROWS = TP + 16, SEQ = 4096;
constexpr int MIXW = 1536, NA = 3584, NB = 5120, DFF = 5632, NUP = 11264, NKV = 1024;
constexpr int ZP = 5120;
constexpr float EPS = 1e-6f;
constexpr float LOG2E = 1.4426950408889634f, LN2 = 0.6931471805599453f;
constexpr float QSCALE = 0.08838834764831845f * 1.4426950408889634f;

constexpr size_t MiB = 1u << 20;
constexpr size_t WS_WMKV = 1 * MiB;
constexpr size_t WS_WINA = 9 * MiB;
constexpr size_t WS_WINB = 23 * MiB;
constexpr size_t WS_WOUT = 43 * MiB;
constexpr size_t WS_WUP = 59 * MiB;
constexpr size_t WS_WDN = 147 * MiB;
constexpr size_t WS_HN = 191 * MiB;
constexpr size_t WS_HM = 224 * MiB;
constexpr size_t WS_MKV = 228 * MiB;
constexpr size_t WS_Z = 230 * MiB;
constexpr size_t WS_ZS = 310 * MiB;
constexpr size_t WS_VSS = 311 * MiB;
constexpr size_t WS_MIX = 312 * MiB;
constexpr size_t WS_LSE = 345 * MiB;
constexpr size_t WS_RS = 345 * MiB + 512 * 1024;
constexpr size_t WS_O = 346 * MiB;
constexpr size_t WS_ACT = 379 * MiB;
constexpr size_t WS_END = 468 * MiB;

constexpr size_t OUT_Y = 0;
constexpr size_t OUT_MKV = 16793600;
constexpr size_t OUT_CHV = OUT_MKV + 1048576;
constexpr size_t OUT_W128P = OUT_CHV + 12288;
constexpr size_t OUT_W512P = OUT_W128P + 262144;
constexpr size_t OUT_W2048P = OUT_W512P + 1048576;
constexpr size_t OUT_W128S = OUT_W2048P + 4194304;
constexpr size_t OUT_W512S = OUT_W128S + 8192;
constexpr size_t OUT_W2048S = OUT_W512S + 8192;
constexpr size_t OUT_TOTAL = OUT_W2048S + 8192;

constexpr int LDS_BYTES = 147456;
constexpr int LDS_TAB = 131072;

__device__ __forceinline__ unsigned cvt_pk_bf16(float lo, float hi) { unsigned r; asm volatile("v_cvt_pk_bf16_f32 %0, %1, %2" : "=v"(r) : "v"(lo), "v"(hi)); return r; }
__device__ __forceinline__ float bf_lo(unsigned w) { return __uint_as_float(w << 16); }
__device__ __forceinline__ float bf_hi(unsigned w) { return __uint_as_float(w & 0xffff0000u); }
__device__ __forceinline__ float wave_sum(float v) {
#pragma unroll
    for (int o = 1; o < 64; o <<= 1) v += __shfl_xor(v, o);
    return v;
}
__device__ __forceinline__ float wave_max(float v) {
#pragma unroll
    for (int o = 1; o < 64; o <<= 1) v = fmaxf(v, __shfl_xor(v, o));
    return v;
}
__device__ __forceinline__ float gelu_tanh(float x) {
    const float t = x * x;
    const float u2 = x * (1.5957691216057308f + 0.07135481627260024f * t);
    const float e = __builtin_amdgcn_exp2f(-LOG2E * u2);
    return x * __builtin_amdgcn_rcpf(1.0f + e);
}
__device__ __forceinline__ float silu_f(float x) {
    const float e = __builtin_amdgcn_exp2f(-LOG2E * x);
    return x * __builtin_amdgcn_rcpf(1.0f + e);
}
__device__ __forceinline__ int t5_bucket(int d) {
    if (d < 16) return d;
    int b = 16;
    b += (d >= 22); b += (d >= 30); b += (d >= 40); b += (d >= 54); b += (d >= 73); b += (d >= 99); b += (d >= 134); b += (d >= 182);
    b += (d >= 246); b += (d >= 332); b += (d >= 450); b += (d >= 609); b += (d >= 825); b += (d >= 1117); b += (d >= 1513);
    return b;
}
__device__ __forceinline__ unsigned off_b(unsigned row, unsigned ch) { return 256u * row + 16u * (ch ^ (((row & 3) << 2) | ((row >> 2) & 3))); }
__device__ __forceinline__ unsigned tr16_addr(unsigned lane, unsigned c, unsigned ks, unsigned t) {
    const unsigned g = lane >> 4, q = (lane & 15) >> 2, p = lane & 3;
    return off_b(32 * ks + 8 * g + 4 * t + q, 2 * c + (p >> 1)) + 8 * (p & 1);
}
typedef short v4i16_t __attribute__((ext_vector_type(4)));
__device__ __forceinline__ s16x4 tr_read(LAS unsigned char* p) { return __builtin_bit_cast(s16x4, __builtin_amdgcn_ds_read_tr16_b64_v4i16((LAS v4i16_t*)p)); }

namespace pg8 {
constexpr int BM = 256, BK = 64, HALF = 128, HTB = HALF * BK * 2, STAGE_BYTES = 8 * HTB, NXCD = 8, WGM = 8;
__host__ __device__ __forceinline__ int lds_byte(int r, int c) { const int st = (r >> 4) * 2 + (c >> 5), rr = r & 15, cc = c & 31, ob = rr * 64 + cc * 2; return st * 1024 + (ob ^ (((ob >> 9) & 1) << 5)); }
__host__ __device__ __forceinline__ void stage_rc(int b, int& R, int& C) { const int st = b / 1024, sb = b % 1024, swz = sb ^ (((sb >> 9) & 1) << 5); R = (st >> 1) * 16 + swz / 64; C = (st & 1) * 32 + (swz % 64) / 2; }
__host__ __device__ __forceinline__ int perm32(int rho) { const int n = rho >> 4, i = rho & 15; return 8 * (i >> 2) + 4 * n + (i & 3); }

struct Unit { int pm, pn; };
struct Gemm { const bf16_t* A; const bf16_t* Bt; int M, N, K; };

struct StaticOrder {
    int nM, nN, nwg, G, c;
    __host__ __device__ void init(int M, int N, int G_, int c_) { nM = M / BM; nN = N / BM; nwg = nM * nN; G = G_; c = c_; }
    __host__ __device__ bool next(int i, Unit& u) const {
        const long L = (long)i * G + c; if (L >= nwg) return false;
        int wgid = (int)L; { const int q = nwg / NXCD, r = nwg % NXCD, xcd = wgid % NXCD, off = wgid / NXCD; wgid = (xcd < r ? xcd * (q + 1) : r * (q + 1) + (xcd - r) * q) + off; }
        const int nig = WGM * nN, gid = wgid / nig, fm = gid * WGM, gsz = (nM - fm) < WGM ? (nM - fm) : WGM;
        u.pm = fm + ((wgid % nig) % gsz); u.pn = (wgid % nig) / gsz; return true;
    }
};

template <class Epi, bool ALIGN_EPI, bool SP2>
__device__ __forceinline__ void gemm_phase(LAS unsigned char* lds, const Gemm g, const StaticOrder& S, const Epi& E) {
    int tid = threadIdx.x; asm volatile("" : "+v"(tid));
    const int wid = __builtin_amdgcn_readfirstlane(tid >> 6), lane = tid & 63, wr = wid >> 2, wc = wid & 3, fr = lane & 15, fq = lane >> 4;
    const int K = g.K, nt = K / BK;
    unsigned voffA[2], voffB[2];
#pragma unroll
    for (int i = 0; i < 2; ++i) { int R, C; stage_rc(tid * 16 + i * 8192, R, C); const int Rb = (R & ~31) + perm32(R & 31);
        voffA[i] = (unsigned)(R * K + C) * 2u; voffB[i] = (unsigned)(Rb * K + C) * 2u; }
    const size_t kstep = (size_t)(BK * 2);
    const size_t hstep = (size_t)HALF * K * 2;
    const size_t tstep = 2 * hstep;
    const unsigned ldsw = (unsigned)wid * 1024u;
    const int aoff = lds_byte(wr * 64 + fr, fq * 8), boff = lds_byte(wc * 32 + fr, fq * 8);
#define PG8_SA(b, h) (((b) * 2 + (h)) * HTB)
#define PG8_SB(b, h) ((4 + (b) * 2 + (h)) * HTB)
#define PG8_STAGE(bufoff, gbase, voff) do { _Pragma("unroll") for (int _i = 0; _i < 2; ++_i) \
        __builtin_amdgcn_global_load_lds((const unsigned*)((const char*)(gbase) + (voff)[_i]), (LAS unsigned*)(lds + (bufoff) + ldsw + _i * 8192), 16, 0, 0); } while (0)
#define PG8_LDA(dst, b, h) do { _Pragma("unroll") for (int m = 0; m < 4; ++m) _Pragma("unroll") for (int k = 0; k < 2; ++k) dst[m][k] = *(const LAS bf16x8*)(lds + PG8_SA(b, h) + aoff + m * 2048 + k * 1024); } while (0)
#define PG8_LDB(dst, b, h) do { _Pragma("unroll") for (int n = 0; n < 2; ++n) _Pragma("unroll") for (int k = 0; k < 2; ++k) dst[n][k] = *(const LAS bf16x8*)(lds + PG8_SB(b, h) + boff + n * 2048 + k * 1024); } while (0)
#define PG8_MMA(ai, bj, At, Bt) do { __builtin_amdgcn_s_setprio(1); _Pragma("unroll") for (int m = 0; m < 4; ++m) _Pragma("unroll") for (int n = 0; n < 2; ++n) _Pragma("unroll") for (int k = 0; k < 2; ++k) \
        acc[ai][bj][m][n] = __builtin_amdgcn_mfma_f32_16x16x32_bf16(Bt[n][k], At[m][k], acc[ai][bj][m][n], 0, 0, 0); __builtin_amdgcn_s_setprio(0); } while (0)
#define PG8_WAIT_V(n) asm volatile("s_waitcnt vmcnt(" #n ")" ::: "memory")
#define PG8_WAIT_L(n) asm volatile("s_waitcnt lgkmcnt(" #n ")" ::: "memory")
#define PG8_BAR __builtin_amdgcn_s_barrier()
#define PG8_SCHED __builtin_amdgcn_sched_barrier(0)
    Unit cur, nxt; int ui = 0;
    if (!S.next(0, cur)) return;
    f32x4 acc[2][2][4][2];
#pragma unroll
    for (int a = 0; a < 2; ++a)
#pragma unroll
        for (int b = 0; b < 2; ++b)
#pragma unroll
            for (int m = 0; m < 4; ++m)
#pragma unroll
                for (int n = 0; n < 2; ++n) acc[a][b][m][n] = (f32x4){0.f, 0.f, 0.f, 0.f};
    bf16x8 At[4][2], B0[2][2], B1[2][2];
    const char* cA = (const char*)g.A + (size_t)cur.pm * tstep; const char* cB = (const char*)g.Bt + (size_t)cur.pn * tstep;
    if constexpr (SP2) {
        PG8_STAGE(PG8_SB(0, 0), cB, voffB); PG8_STAGE(PG8_SB(0, 1), cB + hstep, voffB); PG8_STAGE(PG8_SA(0, 0), cA, voffA); PG8_STAGE(PG8_SA(0, 1), cA + hstep, voffA);
        if (wr == 1) PG8_BAR;
        PG8_WAIT_V(2); PG8_BAR;
        PG8_STAGE(PG8_SB(1, 0), cB + kstep, voffB); PG8_STAGE(PG8_SA(1, 0), cA + kstep, voffA); PG8_STAGE(PG8_SB(1, 1), cB + hstep + kstep, voffB);
        PG8_WAIT_V(6); PG8_BAR;
    } else {
        PG8_STAGE(PG8_SB(0, 0), cB, voffB); PG8_STAGE(PG8_SA(0, 0), cA, voffA); PG8_STAGE(PG8_SB(0, 1), cB + hstep, voffB); PG8_STAGE(PG8_SA(0, 1), cA + hstep, voffA);
        if (wr == 1) PG8_BAR;
        PG8_WAIT_V(4); PG8_BAR;
        PG8_STAGE(PG8_SB(1, 0), cB + kstep, voffB); PG8_STAGE(PG8_SA(1, 0), cA + kstep, voffA); PG8_STAGE(PG8_SB(1, 1), cB + hstep + kstep, voffB);
        PG8_WAIT_V(6); PG8_BAR;
    }
    for (;;) {
        const typename Epi::Pre pre = E.prefetch(cur, wr, fr);
        const bool has_next = S.next(ui + 1, nxt);
        const char* nA = has_next ? (const char*)g.A + (size_t)nxt.pm * tstep : cA; const char* nB = has_next ? (const char*)g.Bt + (size_t)nxt.pn * tstep : cB;
        for (int t = 0; t < nt; t += 2) {
            const bool last = (t == nt - 2);
            const char* a1 = cA + (size_t)(t + 1) * kstep;
            const char* a2 = last ? nA : cA + (size_t)(t + 2) * kstep; const char* b2 = last ? nB : cB + (size_t)(t + 2) * kstep;
            const char* a3 = a2 + kstep; const char* b3 = b2 + kstep;
            if constexpr (SP2) {
            PG8_LDB(B0, 0, 0); PG8_LDB(B1, 0, 1); PG8_SCHED; PG8_LDA(At, 0, 0); PG8_STAGE(PG8_SA(1, 1), a1 + hstep, voffA);
            PG8_WAIT_V(8); PG8_WAIT_L(0); PG8_BAR; PG8_MMA(0, 0, At, B0); PG8_MMA(0, 1, At, B1); PG8_BAR; PG8_SCHED;
            PG8_LDA(At, 0, 1); PG8_STAGE(PG8_SB(0, 0), b2, voffB); PG8_STAGE(PG8_SB(0, 1), b2 + hstep, voffB); PG8_STAGE(PG8_SA(0, 0), a2, voffA);
            PG8_WAIT_V(8); PG8_WAIT_L(0); PG8_BAR; PG8_MMA(1, 0, At, B0); PG8_MMA(1, 1, At, B1); PG8_BAR; PG8_SCHED;
            PG8_LDB(B0, 1, 0); PG8_LDB(B1, 1, 1); PG8_SCHED; PG8_LDA(At, 1, 0); PG8_STAGE(PG8_SA(0, 1), a2 + hstep, voffA);
            PG8_WAIT_V(8); PG8_WAIT_L(0); PG8_BAR; PG8_MMA(0, 0, At, B0); PG8_MMA(0, 1, At, B1); PG8_BAR; PG8_SCHED;
            PG8_LDA(At, 1, 1); PG8_STAGE(PG8_SB(1, 0), b3, voffB); PG8_STAGE(PG8_SB(1, 1), b3 + hstep, voffB); PG8_STAGE(PG8_SA(1, 0), a3, voffA);
            PG8_WAIT_V(8); PG8_WAIT_L(0); PG8_BAR; PG8_MMA(1, 0, At, B0); PG8_MMA(1, 1, At, B1); PG8_BAR; PG8_SCHED;
            } else {
            PG8_LDB(B0, 0, 0); PG8_SCHED; PG8_LDA(At, 0, 0); PG8_STAGE(PG8_SA(1, 1), a1 + hstep, voffA);
            PG8_WAIT_L(8); PG8_BAR; PG8_WAIT_L(0); PG8_MMA(0, 0, At, B0); PG8_BAR; PG8_SCHED;
            PG8_LDB(B1, 0, 1); PG8_STAGE(PG8_SB(0, 0), b2, voffB);
            PG8_BAR; PG8_WAIT_L(0); PG8_MMA(0, 1, At, B1); PG8_BAR;
            PG8_LDA(At, 0, 1); PG8_STAGE(PG8_SA(0, 0), a2, voffA);
            PG8_BAR; PG8_WAIT_L(0); PG8_MMA(1, 0, At, B0); PG8_BAR; PG8_SCHED;
            PG8_STAGE(PG8_SB(0, 1), b2 + hstep, voffB);
            PG8_WAIT_V(6); PG8_BAR; PG8_MMA(1, 1, At, B1); PG8_BAR;
            PG8_LDB(B0, 1, 0); PG8_SCHED; PG8_LDA(At, 1, 0); PG8_STAGE(PG8_SA(0, 1), a2 + hstep, voffA);
            PG8_WAIT_L(8); PG8_BAR; PG8_WAIT_L(0); PG8_MMA(0, 0, At, B0); PG8_BAR; PG8_SCHED;
            PG8_LDB(B1, 1, 1); PG8_STAGE(PG8_SB(1, 0), b3, voffB);
            PG8_BAR; PG8_WAIT_L(0); PG8_MMA(0, 1, At, B1); PG8_BAR;
            PG8_LDA(At, 1, 1); PG8_STAGE(PG8_SA(1, 0), a3, voffA);
            PG8_BAR; PG8_WAIT_L(0); PG8_MMA(1, 0, At, B0); PG8_BAR; PG8_SCHED;
            PG8_STAGE(PG8_SB(1, 1), b3 + hstep, voffB);
            PG8_WAIT_V(6); PG8_BAR; PG8_MMA(1, 1, At, B1); PG8_BAR;
            }
        }
        if constexpr (ALIGN_EPI) { if (wr == 0) PG8_BAR; }
        E(acc, cur, wr, wc, fr, fq, pre);
        if (!has_next) break;
#pragma unroll
        for (int a = 0; a < 2; ++a)
#pragma unroll
            for (int b = 0; b < 2; ++b)
#pragma unroll
                for (int m = 0; m < 4; ++m)
#pragma unroll
                    for (int n = 0; n < 2; ++n) acc[a][b][m][n] = (f32x4){0.f, 0.f, 0.f, 0.f};
        cur = nxt; cA = nA; cB = nB; ++ui;
        if constexpr (ALIGN_EPI) { if (wr == 1) PG8_BAR; }
    }
    PG8_WAIT_V(0);
    if constexpr (!ALIGN_EPI) { if (wr == 0) PG8_BAR; }
    PG8_BAR;
#undef PG8_SA
#undef PG8_SB
#undef PG8_STAGE
#undef PG8_LDA
#undef PG8_LDB
#undef PG8_MMA
#undef PG8_WAIT_V
#undef PG8_WAIT_L
#undef PG8_BAR
#undef PG8_SCHED
}

typedef f32x4 Acc[2][2][4][2];
struct PreRs { float r[2][4]; };
struct PreNone { };
__device__ __forceinline__ PreRs load_rs(const float* rs, const Unit& u, int wr, int fr) { PreRs p; const int row0 = u.pm * BM + wr * 64 + fr;
#pragma unroll
    for (int ai = 0; ai < 2; ++ai)
#pragma unroll
        for (int m = 0; m < 4; ++m) p.r[ai][m] = rs[row0 + ai * HALF + m * 16];
    return p; }
__device__ __forceinline__ u32x4 pack8(const f32x4 a, const f32x4 b) { u32x4 w; w.x = cvt_pk_bf16(a[0], a[1]); w.y = cvt_pk_bf16(a[2], a[3]); w.z = cvt_pk_bf16(b[0], b[1]); w.w = cvt_pk_bf16(b[2], b[3]); return w; }

struct EpiInA {
    bf16_t* Z; float* VSS; const float* rs;
    typedef PreRs Pre; __device__ __forceinline__ Pre prefetch(const Unit& u, int wr, int fr) const { return load_rs(rs, u, wr, fr); }
    __device__ __forceinline__ void operator()(const Acc& acc, const Unit& u, int wr, int wc, int fr, int fq, const Pre& pre) const {
        const int row0 = u.pm * BM + wr * 64 + fr, col0 = u.pn * BM + wc * 32 + 8 * fq;
        const bool act = u.pn < 12, isv = (u.pn >= 6) && act;
#pragma unroll
        for (int ai = 0; ai < 2; ++ai)
#pragma unroll
            for (int m = 0; m < 4; ++m) {
                const int row = row0 + ai * HALF + m * 16; bf16_t* rowp = Z + (size_t)row * ZP + col0; float ss = 0.f; const float rsr = pre.r[ai][m];
#pragma unroll
                for (int bj = 0; bj < 2; ++bj) { f32x4 v0 = acc[ai][bj][m][0] * rsr, v1 = acc[ai][bj][m][1] * rsr;
                    if (act) {
#pragma unroll
                        for (int e = 0; e < 4; ++e) { v0[e] = gelu_tanh(v0[e]); v1[e] = gelu_tanh(v1[e]); ss += v0[e] * v0[e] + v1[e] * v1[e]; }
                    } else { v0 = v0 * QSCALE; v1 = v1 * QSCALE; }
                    *(u32x4*)(rowp + bj * HALF) = pack8(v0, v1); }
                if (isv) { ss += __shfl_xor(ss, 16); ss += __shfl_xor(ss, 32); if (fq == 0) VSS[(size_t)row * 24 + (u.pn - 6) * 4 + wc] = ss; }
            }
    }
};
struct EpiMkv {
    float* outf; bf16_t* outb; const float* rs;
    typedef PreRs Pre; __device__ __forceinline__ Pre prefetch(const Unit& u, int wr, int fr) const { return load_rs(rs, u, wr, fr); }
    __device__ __forceinline__ void operator()(const Acc& acc, const Unit& u, int wr, int wc, int fr, int fq, const Pre& pre) const {
        const int row0 = u.pm * BM + wr * 64 + fr, col0 = u.pn * BM + wc * 32 + 8 * fq;
#pragma unroll
        for (int ai = 0; ai < 2; ++ai)
#pragma unroll
            for (int m = 0; m < 4; ++m) { const size_t off = (size_t)(row0 + ai * HALF + m * 16) * NKV + col0; const float rsr = pre.r[ai][m];
#pragma unroll
                for (int bj = 0; bj < 2; ++bj) { const f32x4 v0 = acc[ai][bj][m][0] * rsr, v1 = acc[ai][bj][m][1] * rsr;
                    *(f32x4*)(outf + off + bj * HALF) = v0; *(f32x4*)(outf + off + bj * HALF + 4) = v1; *(u32x4*)(outb + off + bj * HALF) = pack8(v0, v1); } }
    }
};
struct EpiPlain {
    bf16_t* O; int ldc;
    typedef PreNone Pre; __device__ __forceinline__ Pre prefetch(const Unit&, int, int) const { return Pre{}; }
    __device__ __forceinline__ void operator()(const Acc& acc, const Unit& u, int wr, int wc, int fr, int fq, const Pre&) const {
        const int row0 = u.pm * BM + wr * 64 + fr, col0 = u.pn * BM + wc * 32 + 8 * fq;
#pragma unroll
        for (int ai = 0; ai < 2; ++ai)
#pragma unroll
            for (int m = 0; m < 4; ++m) { bf16_t* rowp = O + (size_t)(row0 + ai * HALF + m * 16) * ldc + col0;
#pragma unroll
                for (int bj = 0; bj < 2; ++bj) *(u32x4*)(rowp + bj * HALF) = pack8(acc[ai][bj][m][0], acc[ai][bj][m][1]); }
    }
};
struct EpiSwiglu {
    bf16_t* ACT; const float* rs;
    typedef PreRs Pre; __device__ __forceinline__ Pre prefetch(const Unit& u, int wr, int fr) const { return load_rs(rs, u, wr, fr); }
    __device__ __forceinline__ void operator()(const Acc& acc, const Unit& u, int wr, int wc, int fr, int fq, const Pre& pre) const {
        const int row0 = u.pm * BM + wr * 64 + fr, col0 = u.pn * HALF + wc * 32 + 8 * fq;
#pragma unroll
        for (int ai = 0; ai < 2; ++ai)
#pragma unroll
            for (int m = 0; m < 4; ++m) { f32x4 v0, v1; const float rsr = pre.r[ai][m];
#pragma unroll
                for (int e = 0; e < 4; ++e) { v0[e] = silu_f(acc[ai][0][m][0][e] * rsr) * (acc[ai][1][m][0][e] * rsr); v1[e] = silu_f(acc[ai][0][m][1][e] * rsr) * (acc[ai][1][m][1][e] * rsr); }
                *(u32x4*)(ACT + (size_t)(row0 + ai * HALF + m * 16) * DFF + col0) = pack8(v0, v1); }
    }
};
struct EpiInB {
    bf16_t* Z; const float* rs;
    typedef PreRs Pre; __device__ __forceinline__ Pre prefetch(const Unit& u, int wr, int fr) const { return load_rs(rs, u, wr, fr); }
    __device__ __forceinline__ void operator()(const Acc& acc, const Unit& u, int wr, int wc, int fr, int fq, const Pre& pre) const {
        const int row0 = u.pm * BM + wr * 64 + fr, col0 = u.pn * BM + wc * 32 + 8 * fq;
        const float qs = ((u.pn < 6) || (u.pn >= 18)) ? QSCALE : 1.0f;
#pragma unroll
        for (int ai = 0; ai < 2; ++ai)
#pragma unroll
            for (int m = 0; m < 4; ++m) {
                const int row = row0 + ai * HALF + m * 16; bf16_t* rowp = Z + (size_t)row * ZP + col0; const float rsr = pre.r[ai][m] * qs;
#pragma unroll
                for (int bj = 0; bj < 2; ++bj) *(u32x4*)(rowp + bj * HALF) = pack8(acc[ai][bj][m][0] * rsr, acc[ai][bj][m][1] * rsr);
            }
    }
};
}

__device__ __forceinline__ unsigned f2bf(float f) { unsigned u = __builtin_bit_cast(unsigned, f); return (u + 0x7fffu + ((u >> 16) & 1u)) >> 16; }
__device__ __forceinline__ unsigned pk2(float lo, float hi) { return f2bf(lo) | (f2bf(hi) << 16); }
struct TItem { const float* src; bf16_t* dst; const float* gain; int N, K; };
__device__ __forceinline__ TItem t_make(const float* W, int K, int N, bf16_t* WT, bool upperm, const float* gain, int item) {
    const int nblk = N / 64, kb = item / nblk, nb = item % nblk, k0 = 64 * kb, n0 = 64 * nb;
    int s0 = n0;
    if (upperm) { const int pn = n0 >> 8, j = n0 & 255; s0 = (j < 128) ? (128 * pn + j) : (DFF + 128 * pn + (j - 128)); }
    TItem t; t.src = W + (size_t)k0 * N + s0; t.dst = WT + (size_t)n0 * K + k0; t.gain = gain != nullptr ? gain + k0 : nullptr; t.N = N; t.K = K; return t;
}
__device__ __forceinline__ void t_load(const TItem& t, int lane, f32x4 (&v)[16]) {
    const float* src = t.src + (size_t)(lane >> 4) * t.N + 4 * (lane & 15);
#pragma unroll
    for (int i = 0; i < 16; ++i) v[i] = __builtin_nontemporal_load((const f32x4*)(src + (size_t)(4 * i) * t.N));
}
__device__ __forceinline__ void t_store(const TItem& t, LAS float* scr, int lane, const f32x4 (&v)[16]) {
    const int lr = lane >> 4, lc = lane & 15;
#pragma unroll
    for (int i = 0; i < 16; ++i) { const int k = 4 * i + lr; const float gk = t.gain != nullptr ? t.gain[k] : 1.0f;
        *(LAS f32x4*)(scr + k * 64 + ((4 * lc) ^ (4 * (k >> 3)))) = v[i] * gk; }
    asm volatile("s_waitcnt lgkmcnt(0)" ::: "memory");
    const int c = lane & 7;
#pragma unroll
    for (int j = 0; j < 8; ++j) { const int n = (lane >> 3) + 8 * j; const LAS float* sp = scr + (8 * c) * 64 + (n ^ (4 * c));
        u32x4 o; o.x = cvt_pk_bf16(sp[0 * 64], sp[1 * 64]); o.y = cvt_pk_bf16(sp[2 * 64], sp[3 * 64]); o.z = cvt_pk_bf16(sp[4 * 64], sp[5 * 64]); o.w = cvt_pk_bf16(sp[6 * 64], sp[7 * 64]);
        __builtin_nontemporal_store(o, (u32x4*)(t.dst + (size_t)n * t.K + 8 * c)); }
    asm volatile("s_waitcnt lgkmcnt(0)" ::: "memory");
}
template <int MODE>
__device__ __forceinline__ void norm_row(const float* basef, bf16_t* yb, const bf16_t* o, const float* gpost, float* rs_out, float* yout, int lane) {
    f32x4 y[8];
    if (MODE == 0 || MODE == 1) {
#pragma unroll
        for (int j = 0; j < 8; ++j) y[j] = *(const f32x4*)(basef + 4 * (lane + 64 * j));
    } else {
#pragma unroll
        for (int j = 0; j < 8; ++j) { const u32x2 w = *(const u32x2*)(yb + 4 * (lane + 64 * j)); y[j] = (f32x4){bf_lo(w.x), bf_hi(w.x), bf_lo(w.y), bf_hi(w.y)}; }
    }
    if (MODE != 0) {
        f32x4 ov[8]; float ss = 0.f;
#pragma unroll
        for (int j = 0; j < 8; ++j) { const u32x2 w = *(const u32x2*)(o + 4 * (lane + 64 * j)); ov[j] = (f32x4){bf_lo(w.x), bf_hi(w.x), bf_lo(w.y), bf_hi(w.y)};
            ss += (ov[j][0] * ov[j][0] + ov[j][1] * ov[j][1]) + (ov[j][2] * ov[j][2] + ov[j][3] * ov[j][3]); }
        const float rstd = 1.0f / sqrtf(wave_sum(ss) * (1.0f / DM) + EPS);
#pragma unroll
        for (int j = 0; j < 8; ++j) { const f32x4 g = *(const f32x4*)(gpost + 4 * (lane + 64 * j)); y[j] = y[j] + ov[j] * rstd * g; }
    }
    if (MODE == 3) {
#pragma unroll
        for (int j = 0; j < 8; ++j) *(f32x4*)(yout + 4 * (lane + 64 * j)) = y[j];
    } else {
        float ss = 0.f;
#pragma unroll
        for (int j = 0; j < 8; ++j) { ss += (y[j][0] * y[j][0] + y[j][1] * y[j][1]) + (y[j][2] * y[j][2] + y[j][3] * y[j][3]);
            u32x2 w; w.x = cvt_pk_bf16(y[j][0], y[j][1]); w.y = cvt_pk_bf16(y[j][2], y[j][3]); *(u32x2*)(yb + 4 * (lane + 64 * j)) = w; }
        ss = wave_sum(ss);
        if (lane == 0) *rs_out = 1.0f / sqrtf(ss * (1.0f / DM) + EPS);
    }
}

struct KvDesc { const bf16_t* kbase; const bf16_t* vbase; long row0, rstep, pitch; int key_lo; };
__device__ __forceinline__ void kv_issue(const KvDesc& d, int tid, u32x4 (&kk)[8], u32x4 (&vv)[8]) {
    const int srow = tid >> 4, sch = tid & 15;
#pragma unroll
    for (int i = 0; i < 8; ++i) { const int row = srow + 32 * i, rowc = row < d.key_lo ? d.key_lo : row;
        const size_t e = (size_t)(d.row0 + (long)rowc * d.rstep) * d.pitch + sch * 8; kk[i] = *(const u32x4*)(d.kbase + e); vv[i] = *(const u32x4*)(d.vbase + e); }
}
__device__ __forceinline__ void kv_commit(LAS unsigned char* lds, int tid, int key_lo, const u32x4 (&kk)[8], const u32x4 (&vv)[8]) {
    const unsigned sb = off_b(tid >> 4, tid & 15); const int srow = tid >> 4; const u32x4 z = (u32x4){0u, 0u, 0u, 0u};
#pragma unroll
    for (int i = 0; i < 8; ++i) { const bool ok = (srow + 32 * i) >= key_lo; *(LAS u32x4*)(lds + sb + 8192 * i) = ok ? kk[i] : z; *(LAS u32x4*)(lds + 65536 + sb + 8192 * i) = ok ? vv[i] : z; }
}
template <bool BANDED>
__device__ __forceinline__ void attn_compute(LAS unsigned char* lds, int lane, int w, const bf16x8 (&qf)[4], int key_lo, bf16_t* orow, float* lsep, const LAS float* btab) {
    const int fr = lane & 15, fq = lane >> 4;
    LAS unsigned char* Kimg = lds; LAS unsigned char* Vimg = lds + 65536;
    constexpr int NBLK = BANDED ? 5 : 8;
    const int blk0 = BANDED ? (w >> 1) : 0;
    const int qi = 16 * w + fr;
    unsigned kb[2][4];
#pragma unroll
    for (int e = 0; e < 2; ++e)
#pragma unroll
        for (int kk = 0; kk < 4; ++kk) kb[e][kk] = off_b(8 * (fr >> 2) + 4 * e + (fr & 3), 4 * kk + fq);
    LAS unsigned char* Kb = Kimg + 8192 * blk0; LAS unsigned char* Vb = Vimg + 8192 * blk0;
    f32x4 s[2 * NBLK];
#pragma unroll
    for (int nt = 0; nt < 2 * NBLK; ++nt) s[nt] = (f32x4){0.f, 0.f, 0.f, 0.f};
    constexpr int TB = BANDED ? 2 * NBLK : NBLK;
#pragma unroll
    for (int t0 = 0; t0 < 2 * NBLK; t0 += TB)
#pragma unroll
        for (int kk = 0; kk < 4; ++kk) { bf16x8 kf[TB];
#pragma unroll
            for (int i = 0; i < TB; ++i) { const int nt = t0 + i; kf[i] = *(const LAS bf16x8*)(Kb + kb[nt & 1][kk] + 8192 * (nt >> 1)); }
            __builtin_amdgcn_sched_barrier(0);
#pragma unroll
            for (int i = 0; i < TB; ++i) s[t0 + i] = __builtin_amdgcn_mfma_f32_16x16x32_bf16(kf[i], qf[kk], s[t0 + i], 0, 0, 0);
            __builtin_amdgcn_sched_barrier(0); }
    float mx = -1e30f;
    const LAS float* bp = btab + (128 + 16 * (w & 1) + fr - 8 * fq + 32 - 135);
    const int cmin = BANDED ? (key_lo > 0 ? (128 + 16 * (w & 1) + fr - 8 * fq) - qi : -1000) : 0;
#pragma unroll
    for (int nt = 0; nt < 2 * NBLK; ++nt)
#pragma unroll
        for (int r = 0; r < 4; ++r) { float x = s[nt][r];
            if (BANDED) { const int c = 32 * (nt >> 1) + 4 * (nt & 1) + r; x = x + bp[135 - c]; x = (c >= cmin) ? x : -1e30f; s[nt][r] = x; }
            mx = fmaxf(mx, x); }
    mx = fmaxf(mx, __shfl_xor(mx, 16)); mx = fmaxf(mx, __shfl_xor(mx, 32));
    float l = 0.f;
#pragma unroll
    for (int nt = 0; nt < 2 * NBLK; ++nt)
#pragma unroll
        for (int r = 0; r < 4; ++r) { const float p = __builtin_amdgcn_exp2f(s[nt][r] - mx); s[nt][r] = p; l += p; }
    l += __shfl_xor(l, 16); l += __shfl_xor(l, 32);
    bf16x8 pf[NBLK];
#pragma unroll
    for (int ks = 0; ks < NBLK; ++ks) pf[ks] = __builtin_bit_cast(bf16x8, pg8::pack8(s[2 * ks], s[2 * ks + 1]));
    const float inv_l = 1.0f / l;
    unsigned vb[8][2];
#pragma unroll
    for (int ct = 0; ct < 8; ++ct) { vb[ct][0] = tr16_addr(lane, ct, 0, 0); vb[ct][1] = tr16_addr(lane, ct, 0, 1); }
    f32x4 oa[8];
#pragma unroll
    for (int ct = 0; ct < 8; ++ct) oa[ct] = (f32x4){0.f, 0.f, 0.f, 0.f};
#pragma unroll
    for (int ks = 0; ks < NBLK; ++ks) { s16x4 vlo[8], vhi[8];
#pragma unroll
        for (int ct = 0; ct < 8; ++ct) { vlo[ct] = tr_read(Vb + vb[ct][0] + 8192 * ks); vhi[ct] = tr_read(Vb + vb[ct][1] + 8192 * ks); }
        __builtin_amdgcn_sched_barrier(0);
#pragma unroll
        for (int ct = 0; ct < 8; ++ct) { const bf16x8 vf = (bf16x8){vlo[ct][0], vlo[ct][1], vlo[ct][2], vlo[ct][3], vhi[ct][0], vhi[ct][1], vhi[ct][2], vhi[ct][3]};
            oa[ct] = __builtin_amdgcn_mfma_f32_16x16x32_bf16(vf, pf[ks], oa[ct], 0, 0, 0); }
        __builtin_amdgcn_sched_barrier(0); }
#pragma unroll
    for (int ct = 0; ct < 8; ++ct) { u32x2 wv; wv.x = cvt_pk_bf16(oa[ct][0] * inv_l, oa[ct][1] * inv_l); wv.y = cvt_pk_bf16(oa[ct][2] * inv_l, oa[ct][3] * inv_l);
        *(u32x2*)(orow + 16 * ct) = wv; }
    if (lsep != nullptr && fq == 0) *lsep = (mx + __builtin_amdgcn_logf(l)) * LN2;
}
struct QoDesc { const bf16_t* qbase; long row0, rstep; bf16_t* obase; float* lsebase; int banded, dil, head; };

struct GateRegs { u32x4 v[2][6]; f32x4 wq[8]; f32x4 vs[3]; float gvl; };
__device__ __forceinline__ void gate_issue(int tid, int b, int chunk, int g, const bf16_t* Z, const float* VSS, const float* w_s, const float* g_v, GateRegs& R) {
    const int lane = tid & 63, w = __builtin_amdgcn_readfirstlane(tid >> 6), fr = lane & 15, fq = lane >> 4;
    const int tok0 = b * SEQ + chunk * 128;
    {
        const int r0 = tid >> 3, c0 = tid & 7; const bf16_t* gp = Z + (size_t)(tok0 + r0) * ZP + MIXW + g * 384 + c0 * 8;
#pragma unroll
        for (int i2 = 0; i2 < 2; ++i2)
#pragma unroll
            for (int i = 0; i < 6; ++i) R.v[i2][i] = *(const u32x4*)(gp + (size_t)i2 * 64 * ZP + 64 * i); }
    { const float* wp = w_s + (size_t)g * 16384 + (16 * w + fr) * 128 + 8 * fq;
#pragma unroll
      for (int kk = 0; kk < 4; ++kk) { R.wq[2 * kk] = *(const f32x4*)(wp + 32 * kk); R.wq[2 * kk + 1] = *(const f32x4*)(wp + 32 * kk + 4); } }
    { const float* p = VSS + (size_t)(tok0 + (tid & 127)) * 24 + 12 * ((tid >> 7) & 1);
#pragma unroll
      for (int i = 0; i < 3; ++i) R.vs[i] = *(const f32x4*)(p + 4 * i); }
    R.gvl = g_v[g * 384 + (tid < 384 ? tid : tid - 384)];
}
__device__ __forceinline__ void gate_run(LAS unsigned char* lds, int tid, int b, int chunk, int g, const GateRegs& R, const bf16_t* Z, const float* b_s, bf16_t* MIX) {
    const int lane = tid & 63, w = __builtin_amdgcn_readfirstlane(tid >> 6), fr = lane & 15, fq = lane >> 4;
    const int tok0 = b * SEQ + chunk * 128, i = 16 * w + fr;
    LAS float* rs = (LAS float*)(lds + LDS_TAB); LAS float* gvs = rs + 128;
    const size_t tokrow = (size_t)(tok0 + i);
    __syncthreads();
    const bf16_t* up = Z + tokrow * ZP + g * 384 + 4 * fq;
    u32x2 ucur[8];
    const float bs = b_s[g * 128 + i];
    {
        const int r0 = tid >> 3, c0 = tid & 7; const unsigned gsb0 = off_b(r0, c0), gsb1 = off_b(r0, c0 + 8);
#pragma unroll
        for (int i2 = 0; i2 < 2; ++i2)
#pragma unroll
            for (int k = 0; k < 6; ++k) *(LAS u32x4*)(lds + (k >> 1) * 32768 + ((k & 1) ? gsb1 : gsb0) + 16384 * i2) = R.v[i2][k]; }
    { float ssum = 0.f;
#pragma unroll
      for (int k = 0; k < 3; ++k) ssum += (R.vs[k][0] + R.vs[k][1]) + (R.vs[k][2] + R.vs[k][3]);
      if (tid < 256) rs[512 + tid] = ssum;
      if (tid < 384) gvs[tid] = R.gvl; }
    __syncthreads();
    if (tid < 128) rs[tid] = 1.0f / sqrtf((rs[512 + tid] + rs[512 + 128 + tid]) * (1.0f / MIXW) + EPS);
    __syncthreads();
    bf16x8 wf[4];
#pragma unroll
    for (int kk = 0; kk < 4; ++kk) { const int j0 = 32 * kk + 8 * fq;
        const f32x4 r0 = *(const LAS f32x4*)(rs + j0), r1 = *(const LAS f32x4*)(rs + j0 + 4);
        const f32x4 a = R.wq[2 * kk], c = R.wq[2 * kk + 1];
        float v[8] = {a[0] * r0[0], a[1] * r0[1], a[2] * r0[2], a[3] * r0[3], c[0] * r1[0], c[1] * r1[1], c[2] * r1[2], c[3] * r1[3]};
#pragma unroll
        for (int jj = 0; jj < 8; ++jj) v[jj] = (j0 + jj <= i) ? v[jj] : 0.f;
        u32x4 pk; pk.x = cvt_pk_bf16(v[0], v[1]); pk.y = cvt_pk_bf16(v[2], v[3]); pk.z = cvt_pk_bf16(v[4], v[5]); pk.w = cvt_pk_bf16(v[6], v[7]);
        wf[kk] = __builtin_bit_cast(bf16x8, pk); }
    unsigned vb[8][2];
#pragma unroll
    for (int c = 0; c < 8; ++c) { vb[c][0] = tr16_addr(lane, c, 0, 0); vb[c][1] = tr16_addr(lane, c, 0, 1); }
#pragma unroll
    for (int sub = 0; sub < 3; ++sub) { LAS unsigned char* img = lds + sub * 32768;
#pragma unroll
        for (int c = 0; c < 8; ++c) ucur[c] = *(const u32x2*)(up + sub * 128 + 16 * c);
#pragma unroll
        for (int c = 0; c < 8; ++c) { f32x4 a = (f32x4){0.f, 0.f, 0.f, 0.f};
#pragma unroll
            for (int kk = 0; kk < 4; ++kk) if (kk <= (w >> 1)) {
                const s16x4 lo = tr_read(img + vb[c][0] + 8192 * kk), hi = tr_read(img + vb[c][1] + 8192 * kk);
                const bf16x8 vf = (bf16x8){lo[0], lo[1], lo[2], lo[3], hi[0], hi[1], hi[2], hi[3]};
                a = __builtin_amdgcn_mfma_f32_16x16x32_bf16(vf, wf[kk], a, 0, 0, 0); }
            const int col = g * 384 + sub * 128 + 16 * c + 4 * fq;
            const f32x4 gv = *(const LAS f32x4*)(gvs + sub * 128 + 16 * c + 4 * fq);
            const u32x2 uw = ucur[c];
            const float o0 = bf_lo(uw.x) * (a[0] * gv[0] + bs), o1 = bf_hi(uw.x) * (a[1] * gv[1] + bs), o2 = bf_lo(uw.y) * (a[2] * gv[2] + bs), o3 = bf_hi(uw.y) * (a[3] * gv[3] + bs);
            u32x2 ov; ov.x = cvt_pk_bf16(o0, o1); ov.y = cvt_pk_bf16(o2, o3);
            *(u32x2*)(MIX + tokrow * DM + col) = ov; } }
}

template <int MODE, int K>
__device__ __forceinline__ void sample_gemv(LAS unsigned char* lds, const bf16_t* A, int a_pitch, const bf16_t* Wt, int N, int first, int stride,
                                            float* outf, bf16_t* outb, int ldb, float* win, const float* rs, const float* slse = nullptr) {
    int tid = threadIdx.x; asm volatile("" : "+v"(tid));
    const int lane = tid & 63, w = __builtin_amdgcn_readfirstlane(tid >> 6), fr = lane & 15, fq = lane >> 4;
    const int ntiles = (MODE == 2) ? N / 32 : N / 16;
    LAS float* red = (LAS float*)lds;
    constexpr int kw = K / 8;
    LAS float* atab = (LAS float*)(lds + LDS_TAB + 4096);
    if (slse != nullptr) {
        __syncthreads();
        if (tid < 128) { const int srow = tid >> 4, H = tid & 15; float al = 1.0f;
            if (H < 12) { const int hl = H & 3; const float l0 = slse[srow * 12 + hl], l1 = slse[srow * 12 + 4 + hl], l2 = slse[srow * 12 + 8 + hl], mm = fmaxf(l0, fmaxf(l1, l2));
                const float e0 = __expf(l0 - mm), e1 = __expf(l1 - mm), e2 = __expf(l2 - mm); al = (H < 4 ? e0 : (H < 8 ? e1 : e2)) / (e0 + e1 + e2); }
            atab[tid] = al; }
        __syncthreads();
    }
    for (int tile = first; tile < ntiles; tile += stride) {
        const int nrow0 = (MODE == 2) ? 256 * (tile >> 3) + 16 * (tile & 7) : 16 * tile;
        const bf16_t* ap = A + (size_t)(fr & 7) * a_pitch + w * kw + 8 * fq;
        const bf16_t* bp = Wt + (size_t)(nrow0 + fr) * K + w * kw + 8 * fq;
        f32x4 acc = (f32x4){0.f, 0.f, 0.f, 0.f}, acc2 = (f32x4){0.f, 0.f, 0.f, 0.f};
#pragma unroll
        for (int ks = 0; ks < kw / 32; ++ks) { bf16x8 a = *(const bf16x8*)(ap + 32 * ks); const bf16x8 b = *(const bf16x8*)(bp + 32 * ks);
            if (MODE == 1 && slse != nullptr) { const float al = atab[(fr & 7) * 16 + ((w * kw + 32 * ks + 8 * fq) >> 7)]; const u32x4 aw = __builtin_bit_cast(u32x4, a); u32x4 o;
                o.x = cvt_pk_bf16(bf_lo(aw.x) * al, bf_hi(aw.x) * al); o.y = cvt_pk_bf16(bf_lo(aw.y) * al, bf_hi(aw.y) * al);
                o.z = cvt_pk_bf16(bf_lo(aw.z) * al, bf_hi(aw.z) * al); o.w = cvt_pk_bf16(bf_lo(aw.w) * al, bf_hi(aw.w) * al); a = __builtin_bit_cast(bf16x8, o); }
            acc = __builtin_amdgcn_mfma_f32_16x16x32_bf16(b, a, acc, 0, 0, 0);
            if (MODE == 2) { const bf16x8 b2 = *(const bf16x8*)(bp + (size_t)128 * K + 32 * ks); acc2 = __builtin_amdgcn_mfma_f32_16x16x32_bf16(b2, a, acc2, 0, 0, 0); } }
        __syncthreads();
        *(LAS f32x4*)(red + (w * 16 + fr) * 16 + 4 * fq) = acc;
        if (MODE == 2) *(LAS f32x4*)(red + 2048 + (w * 16 + fr) * 16 + 4 * fq) = acc2;
        __syncthreads();
        if (tid < 128) { const int s = tid >> 4, c = tid & 15; float v = 0.f, v2 = 0.f;
#pragma unroll
            for (int ww = 0; ww < 8; ++ww) { v += red[(ww * 16 + s) * 16 + c]; if (MODE == 2) v2 += red[2048 + (ww * 16 + s) * 16 + c]; }
            if (rs != nullptr) { const float rsr = rs[s]; v *= rsr; v2 *= rsr; }
            if (MODE == 0) { const int n = nrow0 + c; outf[(size_t)s * ZP + n] = v;
                if (win != nullptr && n >= 1536 && n < 4608) { const int kv = n >= 3072 ? 1 : 0, cc = n - 1536 - 1536 * kv, grp = cc >> 9;
                    win[(size_t)grp * 8192 + (size_t)(s * 2 + kv) * 512 + (cc & 511)] = v; } }
            else if (MODE == 1) { outb[(size_t)s * ldb + nrow0 + c] = (bf16_t)f2bf(v); }
            else { outb[(size_t)s * ldb + 128 * (tile >> 3) + 16 * (tile & 7) + c] = (bf16_t)f2bf(silu_f(v) * v2); } }
    }
}

template <class KF, class VF>
__device__ __forceinline__ float sample_attend(LAS float* scr, const float* qv, int nkeys, KF kf, VF vf, const LAS float* btab, LAS float* o_out) {
    int tid = threadIdx.x; asm volatile("" : "+v"(tid));
    const int lane = tid & 63, w = __builtin_amdgcn_readfirstlane(tid >> 6);
    LAS float* sc = scr; LAS float* part = scr + 320; LAS float* stat = scr + 320 + 2048;
    {
        const int key = tid >> 1, half = tid & 1; float d = 0.f;
        if (key < nkeys) { const float* kp = kf(key) + 64 * half; const float* qp = qv + 64 * half; f32x4 k4[16];
#pragma unroll
            for (int i = 0; i < 16; ++i) k4[i] = *(const f32x4*)(kp + 4 * i);
#pragma unroll
            for (int i = 0; i < 16; ++i) { const f32x4 q4 = *(const f32x4*)(qp + 4 * i); d += (k4[i][0] * q4[0] + k4[i][1] * q4[1]) + (k4[i][2] * q4[2] + k4[i][3] * q4[3]); } }
        d += __shfl_xor(d, 1);
        if (half == 0 && key < nkeys) sc[key] = d * QSCALE + (btab != nullptr ? btab[key] : 0.f);
    }
    __syncthreads();
    if (w == 0) { float m = -1e30f; for (int j = lane; j < nkeys; j += 64) m = fmaxf(m, sc[j]); m = wave_max(m);
        float l = 0.f; for (int j = lane; j < nkeys; j += 64) { const float p = __builtin_amdgcn_exp2f(sc[j] - m); sc[j] = p; l += p; } l = wave_sum(l);
        if (lane == 0) { stat[0] = m; stat[1] = l; } }
    __syncthreads();
    {
        const int kg = tid >> 5, d4 = 4 * (tid & 31); f32x4 v4[16]; f32x4 a = (f32x4){0.f, 0.f, 0.f, 0.f};
#pragma unroll
        for (int i = 0; i < 16; ++i) { const int j = kg + 16 * i; v4[i] = (f32x4){0.f, 0.f, 0.f, 0.f}; if (j < nkeys) v4[i] = *(const f32x4*)(vf(j) + d4); }
#pragma unroll
        for (int i = 0; i < 16; ++i) { const int j = kg + 16 * i; const float pj = j < nkeys ? sc[j] : 0.f; a = a + v4[i] * pj; }
        *(LAS f32x4*)(part + kg * 128 + d4) = a; }
    __syncthreads();
    const float m = stat[0], l = stat[1];
    if (tid < 128) { float a = 0.f;
#pragma unroll
        for (int g = 0; g < 16; ++g) a += part[g * 128 + tid];
        o_out[tid] = a / l; }
    __syncthreads();
    return (m + __builtin_amdgcn_logf(l)) * LN2;
}

#define XB_TMO      128
#define XB_XCNT(j)  (256  + 64 * (j))
#define XB_XSUB(j)  (1280 + 64 * (j))
#define XB_XGEN(j)  (2304 + 64 * (j))
#define XB_TOP      3328
#define XB_TOPGEN   3392
#define XCD_BAR_WORDS 3456
#define XB_SPIN_CAP (1u << 18)
__device__ __forceinline__ unsigned xb_ld(unsigned* p)              { return __hip_atomic_load(p, __ATOMIC_RELAXED, __HIP_MEMORY_SCOPE_AGENT); }
__device__ __forceinline__ unsigned xb_add(unsigned* p, unsigned v) { return __hip_atomic_fetch_add(p, v, __ATOMIC_RELAXED, __HIP_MEMORY_SCOPE_AGENT); }
__device__ __forceinline__ unsigned xb_xcc_id() { return (unsigned)__builtin_amdgcn_s_getreg((3 << 11) | 20) & 0xFu; }
#define XB_SPIN(cond, bar) do { unsigned _sp = 0; while (cond) { __builtin_amdgcn_s_sleep(1); \
    if ((++_sp & 255u) == 0u) { if (xb_ld(&(bar)[XB_TMO])) break; if (_sp > XB_SPIN_CAP) { atomicAdd(&(bar)[XB_TMO], 1u); break; } } } } while (0)
struct XcdBarrier { unsigned* bar; unsigned x; volatile LAS unsigned* st; };
__device__ __forceinline__ XcdBarrier xcd_barrier_post(unsigned* bar, volatile LAS unsigned* st) {
    XcdBarrier b; b.bar = bar; b.x = xb_xcc_id(); b.st = st;
    if (threadIdx.x == 0) (void)xb_add(&bar[XB_XCNT(b.x)], 1u);
    return b;
}
__device__ __forceinline__ void xcd_barrier_complete(unsigned* bar, unsigned x, unsigned& nloc, unsigned& nx) {
    const unsigned G = gridDim.x * gridDim.y * gridDim.z;
    unsigned sum, cnt, mine, sp = 0u;
    for (;;) {
        sum = 0u; cnt = 0u; mine = 0u;
#pragma unroll
        for (unsigned j = 0; j < 16; ++j) { const unsigned c = xb_ld(&bar[XB_XCNT(j)]); sum += c; cnt += (c > 0u) ? 1u : 0u; mine = (j == x) ? c : mine; }
        if (sum == G) break;
        __builtin_amdgcn_s_sleep(1);
        if ((++sp & 255u) == 0u) { if (xb_ld(&bar[XB_TMO])) break; if (sp > XB_SPIN_CAP) { atomicAdd(&bar[XB_TMO], 1u); break; } }
    }
    nloc = mine > 0u ? mine : 1u; nx = cnt > 0u ? cnt : 1u;
}
__device__ __forceinline__ void xcd_barrier(const XcdBarrier& b) {
    asm volatile("s_waitcnt vmcnt(0)" ::: "memory");
    __syncthreads();
    if (threadIdx.x == 0) {
        unsigned* bar = b.bar;
        __builtin_amdgcn_s_waitcnt(0);
        unsigned nloc = b.st[0], nx = b.st[1];
        if (nloc == 0u) { xcd_barrier_complete(bar, b.x, nloc, nx); b.st[0] = nloc; b.st[1] = nx; }
        const unsigned old = xb_add(&bar[XB_XSUB(b.x)], 1u);
        const unsigned gen = old / nloc;
        if (old + 1u == (gen + 1u) * nloc) {
            __builtin_amdgcn_fence(__ATOMIC_RELEASE, "agent");
            asm volatile("s_waitcnt vmcnt(0)" ::: "memory");
            const unsigned og = xb_add(&bar[XB_TOP], 1u);
            const unsigned tg = og / nx;
            if (og + 1u == (tg + 1u) * nx) xb_add(&bar[XB_TOPGEN], 1u);
            else XB_SPIN(xb_ld(&bar[XB_TOPGEN]) == tg, bar);
            __builtin_amdgcn_fence(__ATOMIC_ACQUIRE, "agent");
            xb_add(&bar[XB_XGEN(b.x)], 1u);
            asm volatile("s_waitcnt vmcnt(0)" ::: "memory");
        } else {
            XB_SPIN(xb_ld(&bar[XB_XGEN(b.x)]) == gen, bar);
            __builtin_amdgcn_fence(__ATOMIC_ACQUIRE, "agent");
            asm volatile("s_waitcnt vmcnt(0)" ::: "memory");
        }
    }
    __syncthreads();
}

struct Args { const float* in[22]; float* out; unsigned char* ws; };
typedef const Args __attribute__((address_space(4)))* ArgsP;
__device__ __forceinline__ ArgsP args_ptr() { ArgsP p = (ArgsP)__builtin_amdgcn_kernarg_segment_ptr(); asm volatile("" : "+s"(p)); return p; }
#define WSP(T, off) ((T*)(A->ws + (off)))

constexpr int I_MKV = 32 * 16, I_INA = 32 * 56, I_INB = 32 * 80, I_OUT = 32 * 32, I_UP = 32 * 176, I_DN = 88 * 32, DN_P = 850, DN_A = 1170;
__device__ __forceinline__ int conv_count(int list) { return list == 0 ? 2 * I_MKV + I_INA + I_UP + DN_P : (list == 1 ? I_OUT + (DN_A - DN_P) : (list == 2 ? (I_DN - DN_A) + I_INB + I_OUT : (list == 3 ? I_UP : I_DN))); }
__device__ __forceinline__ TItem conv_item(ArgsP A, int list, int r) {
    const float* n_mix_pre = A->in[8]; const float* n_ffn_pre = A->in[10]; const float* n_mem = A->in[12]; const float* w_mem_kv = A->in[13]; const float* w_in_a = A->in[14];
    const float* w_in_b = A->in[18]; const float* w_out = A->in[19]; const float* w_up = A->in[20]; const float* w_dn = A->in[21];
    bf16_t* Wmkv = WSP(bf16_t, WS_WMKV); bf16_t* Wina = WSP(bf16_t, WS_WINA); bf16_t* Winb = WSP(bf16_t, WS_WINB); bf16_t* Wout = WSP(bf16_t, WS_WOUT);
    bf16_t* Wup = WSP(bf16_t, WS_WUP); bf16_t* Wdn = WSP(bf16_t, WS_WDN);
    if (list == 0) {
        if (r < 2 * I_MKV) { const int l = r / I_MKV; return t_make(w_mem_kv + (size_t)l * DM * NKV, DM, NKV, Wmkv + (size_t)l * NKV * DM, false, n_mem + l * DM, r % I_MKV); } r -= 2 * I_MKV;
        if (r < I_INA) return t_make(w_in_a, DM, NA, Wina, false, n_mix_pre, r); r -= I_INA;
        if (r < I_UP) return t_make(w_up, DM, NUP, Wup, true, n_ffn_pre, r); r -= I_UP;
        return t_make(w_dn, DFF, DM, Wdn, false, nullptr, r);
    } else if (list == 1) {
        if (r < I_OUT) return t_make(w_out, DM, DM, Wout, false, nullptr, r); r -= I_OUT;
        return t_make(w_dn, DFF, DM, Wdn, false, nullptr, DN_P + r);
    } else if (list == 2) {
        if (r < I_DN - DN_A) return t_make(w_dn, DFF, DM, Wdn, false, nullptr, DN_A + r); r -= I_DN - DN_A;
        if (r < I_INB) return t_make(w_in_b, DM, NB, Winb, false, n_mix_pre + DM, r); r -= I_INB;
        return t_make(w_out + (size_t)DM * DM, DM, DM, Wout + (size_t)DM * DM, false, nullptr, r);
    } else if (list == 3) {
        return t_make(w_up + (size_t)DM * NUP, DM, NUP, Wup + (size_t)NUP * DM, true, n_ffn_pre + DM, r);
    } else {
        return t_make(w_dn + (size_t)DFF * DM, DFF, DM, Wdn + (size_t)DM * DFF, false, nullptr, r);
    }
}
__device__ __forceinline__ void convert_list(LAS unsigned char* lds, ArgsP A, int list, int worker, int nworkers, int wave, int lane) {
    const int n = conv_count(list);
    LAS float* scr = (LAS float*)(lds + wave * 16384);
    int it = worker;
    if (it >= n) return;
    TItem cur = conv_item(A, list, it);
    f32x4 va[16], vb[16];
    t_load(cur, lane, va);
    for (;;) {
        const int itn = it + nworkers; const bool hn = itn < n;
        TItem nxt = cur;
        if (hn) { nxt = conv_item(A, list, itn); t_load(nxt, lane, vb); }
        t_store(cur, scr, lane, va);
        if (!hn) break;
#pragma unroll
        for (int i = 0; i < 16; ++i) va[i] = vb[i];
        cur = nxt; it = itn;
    }
}
__device__ __forceinline__ void convert_tail(LAS unsigned char* lds, ArgsP A, int list, int first_idle) {
    const int bid = blockIdx.x, G = gridDim.x;
    if (bid < first_idle || first_idle >= G) return;
    int tid = threadIdx.x; asm volatile("" : "+v"(tid));
    const int lane = tid & 63, wave = __builtin_amdgcn_readfirstlane(tid >> 6);
    __syncthreads();
    convert_list(lds, A, list, (bid - first_idle) * 8 + wave, (G - first_idle) * 8, wave, lane);
}
__device__ __forceinline__ void phase_prologue(LAS unsigned char* lds) {
    ArgsP A = args_ptr();
    int tid = threadIdx.x; asm volatile("" : "+v"(tid));
    const int lane = tid & 63, wave = __builtin_amdgcn_readfirstlane(tid >> 6), gw = blockIdx.x * 8 + wave, NGW = gridDim.x * 8;
    const float* x_prompt = A->in[0]; const float* x_sample = A->in[1]; const float* mem_prompt = A->in[2];
    bf16_t* YB = WSP(bf16_t, WS_HN); bf16_t* HM = WSP(bf16_t, WS_HM);
    float* RS = WSP(float, WS_RS); float* RSM = RS + 16384;
    convert_list(lds, A, 0, gw, NGW, wave, lane);
    if (gridDim.x != 256) { convert_list(lds, A, 1, gw, NGW, wave, lane); convert_list(lds, A, 2, gw, NGW, wave, lane); convert_list(lds, A, 3, gw, NGW, wave, lane); convert_list(lds, A, 4, gw, NGW, wave, lane); }
    for (int m = gw; m < 512 + TP + TSMP; m += NGW) {
        if (m < 512) norm_row<0>(mem_prompt + (size_t)m * DM, HM + (size_t)m * DM, nullptr, nullptr, RSM + m, nullptr, lane);
        else { const int r = m - 512; const float* xr = r < TP ? x_prompt + (size_t)r * DM : x_sample + (size_t)(r - TP) * DM;
            norm_row<0>(xr, YB + (size_t)r * DM, nullptr, nullptr, RS + r, nullptr, lane); }
    }
}

__device__ __forceinline__ void phase_in_a(LAS unsigned char* lds) {
    ArgsP A = args_ptr(); const int bid = blockIdx.x, G = gridDim.x;
    bf16_t* HN = WSP(bf16_t, WS_HN);
    { pg8::Gemm g{HN, WSP(bf16_t, WS_WINA), TP, NA, DM}; pg8::StaticOrder S; S.init(TP, NA, G, bid); pg8::EpiInA E{WSP(bf16_t, WS_Z), WSP(float, WS_VSS), WSP(float, WS_RS)};
      pg8::gemm_phase<pg8::EpiInA, true, true>(lds, g, S, E); }
#pragma unroll 1
    for (int l = 0; l < 2; ++l) { pg8::Gemm g{WSP(bf16_t, WS_HM), WSP(bf16_t, WS_WMKV) + (size_t)l * NKV * DM, 512, NKV, DM};
      pg8::StaticOrder S; S.init(512, NKV, G, (bid - 192 - 8 * l + 2 * G) % G);
      pg8::EpiMkv E{A->out + OUT_MKV + (size_t)l * 512 * NKV, WSP(bf16_t, WS_MKV) + (size_t)l * 512 * NKV, WSP(float, WS_RS) + 16384};
      pg8::gemm_phase<pg8::EpiMkv, true, true>(lds, g, S, E); }
    if (G == 256) { if (bid >= 208) sample_gemv<0, DM>(lds, HN + (size_t)TP * DM, DM, WSP(bf16_t, WS_WINA), NA, G - 1 - bid, 48, WSP(float, WS_ZS), nullptr, 0, nullptr, WSP(float, WS_RS) + TP); }
    else sample_gemv<0, DM>(lds, HN + (size_t)TP * DM, DM, WSP(bf16_t, WS_WINA), NA, G - 1 - bid, G, WSP(float, WS_ZS), nullptr, 0, nullptr, WSP(float, WS_RS) + TP);
    if (G == 256) convert_tail(lds, A, 1, 208);
}
__device__ __forceinline__ void phase_in_b(LAS unsigned char* lds) {
    ArgsP A = args_ptr(); const int bid = blockIdx.x, G = gridDim.x;
    bf16_t* HN = WSP(bf16_t, WS_HN); float* out = A->out;
    pg8::Gemm g{HN, WSP(bf16_t, WS_WINB), TP, NB, DM}; pg8::StaticOrder S; S.init(TP, NB, G, bid);
    pg8::EpiInB E{WSP(bf16_t, WS_Z), WSP(float, WS_RS)};
    pg8::gemm_phase<pg8::EpiInB, true, true>(lds, g, S, E);
    sample_gemv<0, DM>(lds, HN + (size_t)TP * DM, DM, WSP(bf16_t, WS_WINB), NB, G - 1 - bid, G, WSP(float, WS_ZS), nullptr, 0, out + OUT_W128S, WSP(float, WS_RS) + TP);
    if (G == 256) convert_tail(lds, A, 3, 128);
}
__device__ __forceinline__ void mem_unit_desc(ArgsP A, int v, int layer, KvDesc& kd, QoDesc& qd) {
    const int b = v >> 7, h = (v >> 5) & 3, qb = v & 31, qmoff = layer == 0 ? 3072 : 4608;
    const bf16_t* mkv = WSP(bf16_t, WS_MKV) + (size_t)layer * 512 * NKV + h * 128;
    kd.kbase = mkv; kd.vbase = mkv + 512; kd.row0 = (long)b * 256; kd.rstep = 1; kd.pitch = NKV; kd.key_lo = 0;
    qd.qbase = WSP(bf16_t, WS_Z) + qmoff + h * 128; qd.row0 = (long)b * SEQ + 128 * qb; qd.rstep = 1; qd.obase = WSP(bf16_t, WS_MIX) + MIXW + h * 128; qd.lsebase = nullptr;
    qd.banded = 0; qd.dil = 1; qd.head = 0;
}
__device__ __forceinline__ void swa_unit_desc(ArgsP A, int u, KvDesc& kd, QoDesc& qd) {
    const int b = u / 384, H = (u % 384) >> 5, idx = u & 31, g = H >> 2, dil = 1 << (2 * g), r = idx & (dil - 1), qb = idx >> (2 * g);
    const bf16_t* Z = WSP(bf16_t, WS_Z);
    kd.kbase = Z + MIXW + H * 128; kd.vbase = Z + 2 * MIXW + H * 128; kd.row0 = (long)b * SEQ + (long)(128 * qb - 128) * dil + r; kd.rstep = dil; kd.pitch = ZP; kd.key_lo = qb == 0 ? 128 : 0;
    qd.qbase = Z + H * 128; qd.row0 = (long)b * SEQ + (long)(128 * qb) * dil + r; qd.rstep = dil; qd.obase = WSP(bf16_t, WS_MIX) + H * 128; qd.lsebase = WSP(float, WS_LSE) + H;
    qd.banded = 1; qd.dil = dil; qd.head = H;
}
__device__ __forceinline__ void q_issue(const QoDesc& qd, int tid, bf16x8 (&qf)[4]) {
    const int lane = tid & 63, w = __builtin_amdgcn_readfirstlane(tid >> 6), fr = lane & 15, fq = lane >> 4;
    const long qrow = qd.row0 + (long)(16 * w + fr) * qd.rstep;
    const bf16_t* qp = qd.qbase + (size_t)qrow * ZP + 8 * fq;
#pragma unroll
    for (int k4 = 0; k4 < 4; ++k4) qf[k4] = *(const bf16x8*)(qp + 32 * k4);
}
__device__ __forceinline__ void build_bias_tables(LAS unsigned char* lds, int tid, const float* rel_bias) {
    LAS float* tab = (LAS float*)(lds + LDS_TAB);
    for (int i = tid; i < 12 * 192; i += 512) { const int H = i / 192, j = i % 192 - 32, dil = 1 << (2 * (H >> 2));
        tab[i] = (j >= 0 && j <= 128) ? rel_bias[t5_bucket(j * dil) * 12 + H] * LOG2E : -1e30f; }
}
__device__ __forceinline__ void attn_unit_run(LAS unsigned char* lds, int tid, const QoDesc& qd, int key_lo, u32x4 (&kk)[8], u32x4 (&vv)[8], bf16x8 (&qf)[4],
                                              const bool has_next, const KvDesc nxt, const QoDesc nxtq) {
    const int lane = tid & 63, w = __builtin_amdgcn_readfirstlane(tid >> 6), fr = lane & 15, fq = lane >> 4;
    __syncthreads();
    kv_commit(lds, tid, key_lo, kk, vv);
    bf16x8 qc[4];
#pragma unroll
    for (int k4 = 0; k4 < 4; ++k4) qc[k4] = qf[k4];
    if (has_next) { kv_issue(nxt, tid, kk, vv); q_issue(nxtq, tid, qf); }
    __syncthreads();
    const long qrow = qd.row0 + (long)(16 * w + fr) * qd.rstep;
    bf16_t* orow = qd.obase + (size_t)qrow * DM + 4 * fq;
    float* lsep = qd.lsebase != nullptr ? qd.lsebase + (size_t)qrow * 12 : nullptr;
    if (qd.banded) attn_compute<true>(lds, lane, w, qc, key_lo, orow, lsep, (const LAS float*)(lds + LDS_TAB) + qd.head * 192);
    else attn_compute<false>(lds, lane, w, qc, key_lo, orow, lsep, (const LAS float*)(lds + LDS_TAB));
}
__device__ __forceinline__ void sample_mem_attn(LAS unsigned char* lds, int layer) {
    ArgsP A = args_ptr(); const int bid = blockIdx.x, G = gridDim.x;
    int tid = threadIdx.x; asm volatile("" : "+v"(tid));
    const int qmoff = layer == 0 ? 3072 : 4608;
    for (int it = G - 1 - 96 - bid; it >= 0 && it < 32; it += G) {
        const int s = it >> 2, h = it & 3;
        LAS float* scr = (LAS float*)lds; LAS float* og = scr + 2560;
        __syncthreads();
        const float* cm = A->in[3] + (size_t)(layer * 8 + s) * 256 * 1024;
        auto kf = [=](int j) -> const float* { return cm + (size_t)j * 1024 + h * 128; };
        auto vf = [=](int j) -> const float* { return cm + (size_t)j * 1024 + 512 + h * 128; };
        (void)sample_attend(scr, WSP(float, WS_ZS) + (size_t)s * ZP + qmoff + h * 128, 256, kf, vf, (const LAS float*)nullptr, og);
        if (tid < 128) WSP(bf16_t, WS_MIX)[(size_t)(TP + s) * DM + MIXW + h * 128 + tid] = (bf16_t)f2bf(og[tid]);
        __syncthreads();
    }
}
__device__ __forceinline__ void phase_mix_a(LAS unsigned char* lds) {
    ArgsP A = args_ptr(); const int bid = blockIdx.x, G = gridDim.x;
    int tid = threadIdx.x; asm volatile("" : "+v"(tid));
    for (int u = bid; u < 256; u += G) {
        KvDesc kd; QoDesc qd; mem_unit_desc(A, u, 0, kd, qd);
        u32x4 kk[8], vv[8]; bf16x8 qf[4]; GateRegs R;
        gate_issue(tid, u >> 7, (u >> 2) & 31, u & 3, WSP(bf16_t, WS_Z), WSP(float, WS_VSS), A->in[16], A->in[15], R);
        kv_issue(kd, tid, kk, vv); q_issue(qd, tid, qf);
        gate_run(lds, tid, u >> 7, (u >> 2) & 31, u & 3, R, WSP(bf16_t, WS_Z), A->in[17], WSP(bf16_t, WS_MIX));
        attn_unit_run(lds, tid, qd, kd.key_lo, kk, vv, qf, false, kd, qd);
    }
    const int lane = tid & 63, wave = __builtin_amdgcn_readfirstlane(tid >> 6);
    const float* ZS = WSP(float, WS_ZS); const float* n_v_a = A->in[15]; const float* w_sp = A->in[16]; const float* b_sp = A->in[17]; bf16_t* MIX = WSP(bf16_t, WS_MIX); float* out = A->out;
    for (int it = G - 1 - bid; it < TSMP; it += G) {
        LAS float* red = (LAS float*)lds; const int s = it;
        __syncthreads();
        float vv[3], uu[3], ss = 0.f;
#pragma unroll
        for (int i = 0; i < 3; ++i) { const int c = tid + 512 * i; uu[i] = gelu_tanh(ZS[(size_t)s * ZP + c]); vv[i] = gelu_tanh(ZS[(size_t)s * ZP + MIXW + c]); ss += vv[i] * vv[i]; }
        ss = wave_sum(ss); if (lane == 0) red[wave] = ss;
        __syncthreads();
        float tot = 0.f;
#pragma unroll
        for (int i = 0; i < 8; ++i) tot += red[i];
        const float rstd = 1.0f / sqrtf(tot * (1.0f / MIXW) + EPS);
#pragma unroll
        for (int i = 0; i < 3; ++i) { const int c = tid + 512 * i, g = c / 384; const float vn = vv[i] * rstd * n_v_a[c];
            out[OUT_CHV + (size_t)s * MIXW + c] = vn;
            const float sg = w_sp[(size_t)g * 16384] * vn + b_sp[g * 128];
            MIX[(size_t)(TP + s) * DM + c] = (bf16_t)f2bf(uu[i] * sg); }
    }
    sample_mem_attn(lds, 0);
}
__device__ __forceinline__ void phase_mix_b1(LAS unsigned char* lds) {
    ArgsP A = args_ptr(); const int bid = blockIdx.x, G = gridDim.x;
    int tid = threadIdx.x; asm volatile("" : "+v"(tid));
    KvDesc kd{}, kn{}; QoDesc qd{}, qn{};
    u32x4 kk[8], vv[8]; bf16x8 qf[4];
    int u = bid;
    if (u < 1024) { if (u < 768) swa_unit_desc(A, u, kd, qd); else mem_unit_desc(A, u - 768, 1, kd, qd); kv_issue(kd, tid, kk, vv); q_issue(qd, tid, qf); }
    build_bias_tables(lds, tid, A->in[7]);
#pragma unroll 1
    for (; u < 1024; u += G) {
        const int un = u + G; const bool has_next = un < 1024;
        if (has_next) { if (un < 768) swa_unit_desc(A, un, kn, qn); else mem_unit_desc(A, un - 768, 1, kn, qn); }
        attn_unit_run(lds, tid, qd, kd.key_lo, kk, vv, qf, has_next, kn, qn);
        kd = kn; qd = qn;
    }
}
__device__ __forceinline__ void phase_mix_b2(LAS unsigned char* lds) {
    ArgsP A = args_ptr(); const int bid = blockIdx.x, G = gridDim.x;
    int tid = threadIdx.x; asm volatile("" : "+v"(tid));
    const int lane = tid & 63, wave = __builtin_amdgcn_readfirstlane(tid >> 6), gw = bid * 8 + wave, NGW = G * 8;
    bf16_t* MIX = WSP(bf16_t, WS_MIX); const float* LSE = WSP(float, WS_LSE);
    for (int row = gw; row < TP; row += NGW) {
        const float* lp = LSE + (size_t)row * 12;
#pragma unroll
        for (int i = 0; i < 3; ++i) { const int col = 8 * (lane + 64 * i), H = col >> 7, g = H >> 2, hl = H & 3;
            const float l0 = lp[hl], l1 = lp[4 + hl], l2 = lp[8 + hl], mm = fmaxf(l0, fmaxf(l1, l2));
            const float e0 = __expf(l0 - mm), e1 = __expf(l1 - mm), e2 = __expf(l2 - mm);
            const float al = (g == 0 ? e0 : (g == 1 ? e1 : e2)) / (e0 + e1 + e2);
            u32x4 wv = *(u32x4*)(MIX + (size_t)row * DM + col);
            wv.x = cvt_pk_bf16(bf_lo(wv.x) * al, bf_hi(wv.x) * al); wv.y = cvt_pk_bf16(bf_lo(wv.y) * al, bf_hi(wv.y) * al);
            wv.z = cvt_pk_bf16(bf_lo(wv.z) * al, bf_hi(wv.z) * al); wv.w = cvt_pk_bf16(bf_lo(wv.w) * al, bf_hi(wv.w) * al);
            *(u32x4*)(MIX + (size_t)row * DM + col) = wv; }
    }
    { const int nw = G > 128 ? G - 128 : G, wk = bid < nw ? bid : -1;
      if (wk >= 0) { const bf16_t* Z = WSP(bf16_t, WS_Z); float* o0 = A->out + OUT_W128P;
        for (int i = wk * 512 + tid; i < 688128; i += nw * 512) {
            const int g = i < 32768 ? 0 : (i < 163840 ? 1 : 2), ig = i - (g == 0 ? 0 : (g == 1 ? 32768 : 163840)), W = 128 << (2 * g);
            const int c8 = ig & 63, kv = (ig >> 6) & 1, tr = (ig >> 7) & (W - 1), b = (ig >> 7) / W;
            const u32x4 wv = *(const u32x4*)(Z + (size_t)(b * SEQ + (SEQ - W) + tr) * ZP + MIXW + kv * MIXW + g * 512 + c8 * 8);
            float* dst = o0 + (size_t)2048 * ((W - 128) / 3) + (size_t)ig * 8;
            *(f32x4*)dst = (f32x4){bf_lo(wv.x), bf_hi(wv.x), bf_lo(wv.y), bf_hi(wv.y)}; *(f32x4*)(dst + 4) = (f32x4){bf_lo(wv.z), bf_hi(wv.z), bf_lo(wv.w), bf_hi(wv.w)}; } } }
    const float* rel_bias = A->in[7]; const float* ZS = WSP(float, WS_ZS);
    for (int it = G - 1 - bid; it < 96; it += G) {
        const int s = it / 12, H = it % 12, g = H >> 2, hl = H & 3, dil = 1 << (2 * g), W = 128 << (2 * g);
        LAS float* scr = (LAS float*)lds; LAS float* btab = scr + 2400; LAS float* og = scr + 2560;
        __syncthreads();
        for (int j = tid; j <= 128; j += 512) btab[j] = rel_bias[t5_bucket(j * dil) * 12 + H] * LOG2E;
        __syncthreads();
        const float* cw = A->in[4 + g];
        const float* zrow = ZS + (size_t)s * ZP;
        auto kf = [=](int j) -> const float* { return j == 0 ? zrow + MIXW + H * 128 : cw + ((size_t)(s * W + (W - j * dil)) * 2 + 0) * 512 + hl * 128; };
        auto vf = [=](int j) -> const float* { return j == 0 ? zrow + 2 * MIXW + H * 128 : cw + ((size_t)(s * W + (W - j * dil)) * 2 + 1) * 512 + hl * 128; };
        const float lg = sample_attend(scr, zrow + H * 128, 129, kf, vf, btab, og);
        if (tid < 128) MIX[(size_t)(TP + s) * DM + H * 128 + tid] = (bf16_t)f2bf(og[tid]);
        if (tid == 0) WSP(float, WS_LSE)[(size_t)TP * 12 + s * 12 + H] = lg;
        __syncthreads();
    }
    sample_mem_attn(lds, 1);
}
__device__ __forceinline__ void phase_out(LAS unsigned char* lds, int layer) {
    ArgsP A = args_ptr(); const int bid = blockIdx.x, G = gridDim.x;
    bf16_t* MIX = WSP(bf16_t, WS_MIX); bf16_t* OB = WSP(bf16_t, WS_O); const bf16_t* W = WSP(bf16_t, WS_WOUT) + (size_t)layer * DM * DM;
    pg8::Gemm g{MIX, W, TP, DM, DM}; pg8::StaticOrder S; S.init(TP, DM, G, bid); pg8::EpiPlain E{OB, DM};
    pg8::gemm_phase<pg8::EpiPlain, false, true>(lds, g, S, E);
    sample_gemv<1, DM>(lds, MIX + (size_t)TP * DM, DM, W, DM, G - 1 - bid, G, nullptr, OB + (size_t)TP * DM, DM, nullptr, nullptr, layer == 1 ? WSP(float, WS_LSE) + (size_t)TP * 12 : nullptr);
}
__device__ __forceinline__ void phase_up(LAS unsigned char* lds, int layer) {
    ArgsP A = args_ptr(); const int bid = blockIdx.x, G = gridDim.x;
    bf16_t* HN = WSP(bf16_t, WS_HN); bf16_t* ACT = WSP(bf16_t, WS_ACT); const bf16_t* W = WSP(bf16_t, WS_WUP) + (size_t)layer * NUP * DM;
    pg8::Gemm g{HN, W, TP, NUP, DM}; pg8::StaticOrder S; S.init(TP, NUP, G, bid); pg8::EpiSwiglu E{ACT, WSP(float, WS_RS)};
    pg8::gemm_phase<pg8::EpiSwiglu, true, true>(lds, g, S, E);
    sample_gemv<2, DM>(lds, HN + (size_t)TP * DM, DM, W, NUP, G - 1 - bid, G, nullptr, ACT + (size_t)TP * DFF, DFF, nullptr, WSP(float, WS_RS) + TP);
    if (G == 256) convert_tail(lds, A, layer == 0 ? 2 : 4, 128);
}
__device__ __forceinline__ void phase_down(LAS unsigned char* lds, int layer) {
    ArgsP A = args_ptr(); const int bid = blockIdx.x, G = gridDim.x;
    bf16_t* ACT = WSP(bf16_t, WS_ACT); bf16_t* OB = WSP(bf16_t, WS_O); const bf16_t* W = WSP(bf16_t, WS_WDN) + (size_t)layer * DM * DFF;
    pg8::Gemm g{ACT, W, TP, DM, DFF}; pg8::StaticOrder S; S.init(TP, DM, G, bid); pg8::EpiPlain E{OB, DM};
    pg8::gemm_phase<pg8::EpiPlain, false, true>(lds, g, S, E);
    sample_gemv<1, DFF>(lds, ACT + (size_t)TP * DFF, DFF, W, DM, G - 1 - bid, G, nullptr, OB + (size_t)TP * DM, DM, nullptr, nullptr);
}
__device__ __forceinline__ void phase_norm(int which) {
    ArgsP A = args_ptr();
    int tid = threadIdx.x; asm volatile("" : "+v"(tid));
    const int lane = tid & 63, wave = __builtin_amdgcn_readfirstlane(tid >> 6), gw = blockIdx.x * 8 + wave, NGW = gridDim.x * 8;
    const int layer = which >> 1;
    float* Y = A->out + OUT_Y; const bf16_t* OB = WSP(bf16_t, WS_O); bf16_t* YB = WSP(bf16_t, WS_HN); float* RS = WSP(float, WS_RS);
    const float* gpost = ((which & 1) ? A->in[11] : A->in[9]) + layer * DM;
    const float* x_prompt = A->in[0]; const float* x_sample = A->in[1];
    for (int r = gw; r < TP + TSMP; r += NGW) {
        if (which == 0) { const float* base = r < TP ? x_prompt + (size_t)r * DM : x_sample + (size_t)(r - TP) * DM;
            norm_row<1>(base, YB + (size_t)r * DM, OB + (size_t)r * DM, gpost, RS + r, nullptr, lane); }
        else if (which == 3) norm_row<3>(nullptr, YB + (size_t)r * DM, OB + (size_t)r * DM, gpost, nullptr, Y + (size_t)r * DM, lane);
        else norm_row<2>(nullptr, YB + (size_t)r * DM, OB + (size_t)r * DM, gpost, RS + r, nullptr, lane);
    }
}

__global__ void __launch_bounds__(512, 2) fwd_megakernel(Args args) {
    extern __shared__ __attribute__((aligned(16))) unsigned char lds_raw[];
    LAS unsigned char* lds = (LAS unsigned char*)lds_raw;
    volatile LAS unsigned* bst = (volatile LAS unsigned*)(lds + LDS_BYTES - 64);
    if (threadIdx.x < 16) bst[threadIdx.x] = 0u;
    __syncthreads();
    const XcdBarrier bar = xcd_barrier_post((unsigned*)args.ws, bst);
#define GRID_SYNC() xcd_barrier(bar)
    phase_prologue(lds);
    GRID_SYNC();
    phase_in_a(lds);
    GRID_SYNC();
    phase_mix_a(lds);
    GRID_SYNC();
    phase_out(lds, 0);
    GRID_SYNC();
    phase_norm(0);
    GRID_SYNC();
    phase_up(lds, 0);
    GRID_SYNC();
    phase_down(lds, 0);
    GRID_SYNC();
    phase_norm(1);
    GRID_SYNC();
    phase_in_b(lds);
    GRID_SYNC();
    phase_mix_b1(lds);
    GRID_SYNC();
    phase_mix_b2(lds);
    GRID_SYNC();
    phase_out(lds, 1);
    GRID_SYNC();
    phase_norm(2);
    GRID_SYNC();
    phase_up(lds, 1);
    GRID_SYNC();
    phase_down(lds, 1);
    GRID_SYNC();
    phase_norm(3);
#undef GRID_SYNC
}

extern "C" void kernel_launch(void* const* d_in, const int* in_sizes, int n_in, void* d_out, int out_size, void* d_ws, size_t ws_size, hipStream_t stream) {
    static int grid = 0;
    if (grid == 0) {
        if (n_in != 22 || (size_t)out_size != OUT_TOTAL || ws_size < WS_END) { fprintf(stderr, "kernel_launch: unexpected shapes (n_in %d, out %d, ws %zu)\n", n_in, out_size, ws_size); grid = -1; return; }
        int dev = 0, cus = 0, per_cu = 0;
        if (hipGetDevice(&dev) != hipSuccess || hipDeviceGetAttribute(&cus, hipDeviceAttributeMultiprocessorCount, dev) != hipSuccess) { grid = -1; return; }
        if (hipFuncSetAttribute((const void*)fwd_megakernel, hipFuncAttributeMaxDynamicSharedMemorySize, LDS_BYTES) != hipSuccess) { fprintf(stderr, "kernel_launch: hipFuncSetAttribute failed\n"); grid = -1; return; }
        if (hipOccupancyMaxActiveBlocksPerMultiprocessor(&per_cu, (const void*)fwd_megakernel, 512, LDS_BYTES) != hipSuccess || per_cu < 1) { fprintf(stderr, "kernel_launch: occupancy query says %d\n", per_cu); (void)hipGetLastError(); per_cu = 1; }
        grid = cus;
    }
    if (grid < 0) return;
    if (hipMemsetAsync(d_ws, 0, 16384, stream) != hipSuccess) { fprintf(stderr, "kernel_launch: memset of the barrier words failed\n"); return; }
    Args a{};
    for (int i = 0; i < 22; ++i) a.in[i] = (const float*)d_in[i];
    a.out = (float*)d_out; a.ws = (unsigned char*)d_ws;
    void* kargs[] = {&a};
    hipError_t e = hipLaunchCooperativeKernel((const void*)fwd_megakernel, dim3(grid), dim3(512), kargs, LDS_BYTES, stream);
    if (e != hipSuccess) fprintf(stderr, "kernel_launch: cooperative launch failed: %s (grid %d)\n", hipGetErrorString(e), grid);
}
```

```cpp
#include <hip/hip_runtime.h>
#include <cstdio>
#include <cstdint>

#define LAS __attribute__((address_space(3)))
typedef unsigned short bf16_t;
typedef short bf16x8 __attribute__((ext_vector_type(8)));
typedef short s16x4 __attribute__((ext_vector_type(4)));
typedef float f32x4 __attribute__((ext_vector_type(4)));
typedef float f32x2 __attribute__((ext_vector_type(2)));
typedef unsigned u32x4 __attribute__((ext_vector_type(4)));
typedef unsigned u32x2 __attribute__((ext_vector_type(2)));

constexpr int DM = 2048, TP = 8192, TSMP = 8, TROWS = TP + 16, SEQ = 4096;
constexpr int MIXW = 1536, NA = 3584, NB = 5120, DFF = 5632, NUP = 11264, NKV = 1024;
constexpr int ZP = 5120;
constexpr float EPS = 1e-6f;
constexpr float LOG2E = 1.4426950408889634f, LN2 = 0.6931471805599453f;
constexpr float QSCALE = 0.08838834764831845f * 1.4426950408889634f;

constexpr size_t MiB = 1u << 20;
constexpr size_t WS_WMKV = 1 * MiB;
constexpr size_t WS_WINA = 9 * MiB;
constexpr size_t WS_WINB = 23 * MiB;
constexpr size_t WS_WOUT = 43 * MiB;
constexpr size_t WS_WUP = 59 * MiB;
constexpr size_t WS_WDN = 147 * MiB;
constexpr size_t WS_HN = 191 * MiB;
constexpr size_t WS_HM = 224 * MiB;
constexpr size_t WS_MKV = 228 * MiB;
constexpr size_t WS_Z = 230 * MiB;
constexpr size_t WS_ZS = 310 * MiB;
constexpr size_t WS_VSS = 311 * MiB;
constexpr size_t WS_MIX = 312 * MiB;
constexpr size_t WS_LSE = 345 * MiB;
constexpr size_t WS_RS = 345 * MiB + 512 * 1024;
constexpr size_t WS_O = 346 * MiB;
constexpr size_t WS_ACT = 379 * MiB;
constexpr size_t WS_END = 468 * MiB;

constexpr size_t OUT_Y = 0;
constexpr size_t OUT_MKV = 16793600;
constexpr size_t OUT_CHV = OUT_MKV + 1048576;
constexpr size_t OUT_W128P = OUT_CHV + 12288;
constexpr size_t OUT_W512P = OUT_W128P + 262144;
constexpr size_t OUT_W2048P = OUT_W512P + 1048576;
constexpr size_t OUT_W128S = OUT_W2048P + 4194304;
constexpr size_t OUT_W512S = OUT_W128S + 8192;
constexpr size_t OUT_W2048S = OUT_W512S + 8192;
constexpr size_t OUT_TOTAL = OUT_W2048S + 8192;

constexpr int LDS_BYTES = 147456;
constexpr int LDS_TAB = 131072;

__device__ __forceinline__ unsigned cvt_pk_bf16(float lo, float hi) { unsigned r; asm volatile("v_cvt_pk_bf16_f32 %0, %1, %2" : "=v"(r) : "v"(lo), "v"(hi)); return r; }
__device__ __forceinline__ float bf_lo(unsigned w) { return __uint_as_float(w << 16); }
__device__ __forceinline__ float bf_hi(unsigned w) { return __uint_as_float(w & 0xffff0000u); }
__device__ __forceinline__ float wave_sum(float v) {
#pragma unroll
    for (int o = 1; o < 64; o <<= 1) v += __shfl_xor(v, o);
    return v;
}
__device__ __forceinline__ float wave_max(float v) {
#pragma unroll
    for (int o = 1; o < 64; o <<= 1) v = fmaxf(v, __shfl_xor(v, o));
    return v;
}
__device__ __forceinline__ float gelu_tanh(float x) {
    const float t = x * x;
    const float u2 = x * (1.5957691216057308f + 0.07135481627260024f * t);
    const float e = __builtin_amdgcn_exp2f(-LOG2E * u2);
    return x * __builtin_amdgcn_rcpf(1.0f + e);
}
__device__ __forceinline__ float silu_f(float x) {
    const float e = __builtin_amdgcn_exp2f(-LOG2E * x);
    return x * __builtin_amdgcn_rcpf(1.0f + e);
}
__device__ __forceinline__ int t5_bucket(int d) {
    if (d < 16) return d;
    int b = 16;
    b += (d >= 22); b += (d >= 30); b += (d >= 40); b += (d >= 54); b += (d >= 73); b += (d >= 99); b += (d >= 134); b += (d >= 182);
    b += (d >= 246); b += (d >= 332); b += (d >= 450); b += (d >= 609); b += (d >= 825); b += (d >= 1117); b += (d >= 1513);
    return b;
}
__device__ __forceinline__ unsigned off_b(unsigned row, unsigned ch) { return 256u * row + 16u * (ch ^ (((row & 3) << 2) | ((row >> 2) & 3))); }
__device__ __forceinline__ unsigned tr16_addr(unsigned lane, unsigned c, unsigned ks, unsigned t) {
    const unsigned g = lane >> 4, q = (lane & 15) >> 2, p = lane & 3;
    return off_b(32 * ks + 8 * g + 4 * t + q, 2 * c + (p >> 1)) + 8 * (p & 1);
}
typedef short v4i16_t __attribute__((ext_vector_type(4)));
__device__ __forceinline__ s16x4 tr_read(LAS unsigned char* p) { return __builtin_bit_cast(s16x4, __builtin_amdgcn_ds_read_tr16_b64_v4i16((LAS v4i16_t*)p)); }

namespace pg8 {
constexpr int BM = 256, BK = 64, HALF = 128, HTB = HALF * BK * 2, STAGE_BYTES = 8 * HTB, NXCD = 8, WGM = 8;
__host__ __device__ __forceinline__ int lds_byte(int r, int c) { const int st = (r >> 4) * 2 + (c >> 5), rr = r & 15, cc = c & 31, ob = rr * 64 + cc * 2; return st * 1024 + (ob ^ (((ob >> 9) & 1) << 5)); }
__host__ __device__ __forceinline__ void stage_rc(int b, int& R, int& C) { const int st = b / 1024, sb = b % 1024, swz = sb ^ (((sb >> 9) & 1) << 5); R = (st >> 1) * 16 + swz / 64; C = (st & 1) * 32 + (swz % 64) / 2; }
__host__ __device__ __forceinline__ int perm32(int rho) { const int n = rho >> 4, i = rho & 15; return 8 * (i >> 2) + 4 * n + (i & 3); }

struct Unit { int pm, pn; };
struct Gemm { const bf16_t* A; const bf16_t* Bt; int M, N, K; };

struct StaticOrder {
    int nM, nN, nwg, G, c;
    __host__ __device__ void init(int M, int N, int G_, int c_) { nM = M / BM; nN = N / BM; nwg = nM * nN; G = G_; c = c_; }
    __host__ __device__ bool next(int i, Unit& u) const {
        const long L = (long)i * G + c; if (L >= nwg) return false;
        int wgid = (int)L; { const int q = nwg / NXCD, r = nwg % NXCD, xcd = wgid % NXCD, off = wgid / NXCD; wgid = (xcd < r ? xcd * (q + 1) : r * (q + 1) + (xcd - r) * q) + off; }
        const int nig = WGM * nN, gid = wgid / nig, fm = gid * WGM, gsz = (nM - fm) < WGM ? (nM - fm) : WGM;
        u.pm = fm + ((wgid % nig) % gsz); u.pn = (wgid % nig) / gsz; return true;
    }
};

template <class Epi, bool ALIGN_EPI, bool SP2>
__device__ __forceinline__ void gemm_phase(LAS unsigned char* lds, const Gemm g, const StaticOrder& S, const Epi& E) {
    int tid = threadIdx.x; asm volatile("" : "+v"(tid));
    const int wid = __builtin_amdgcn_readfirstlane(tid >> 6), lane = tid & 63, wr = wid >> 2, wc = wid & 3, fr = lane & 15, fq = lane >> 4;
    const int K = g.K, nt = K / BK;
    unsigned voffA[2], voffB[2];
#pragma unroll
    for (int i = 0; i < 2; ++i) { int R, C; stage_rc(tid * 16 + i * 8192, R, C); const int Rb = (R & ~31) + perm32(R & 31);
        voffA[i] = (unsigned)(R * K + C) * 2u; voffB[i] = (unsigned)(Rb * K + C) * 2u; }
    const size_t kstep = (size_t)(BK * 2);
    const size_t hstep = (size_t)HALF * K * 2;
    const size_t tstep = 2 * hstep;
    const unsigned ldsw = (unsigned)wid * 1024u;
    const int aoff = lds_byte(wr * 64 + fr, fq * 8), boff = lds_byte(wc * 32 + fr, fq * 8);
#define PG8_SA(b, h) (((b) * 2 + (h)) * HTB)
#define PG8_SB(b, h) ((4 + (b) * 2 + (h)) * HTB)
#define PG8_STAGE(bufoff, gbase, voff) do { _Pragma("unroll") for (int _i = 0; _i < 2; ++_i) \
        __builtin_amdgcn_global_load_lds((const unsigned*)((const char*)(gbase) + (voff)[_i]), (LAS unsigned*)(lds + (bufoff) + ldsw + _i * 8192), 16, 0, 0); } while (0)
#define PG8_LDA(dst, b, h) do { _Pragma("unroll") for (int m = 0; m < 4; ++m) _Pragma("unroll") for (int k = 0; k < 2; ++k) dst[m][k] = *(const LAS bf16x8*)(lds + PG8_SA(b, h) + aoff + m * 2048 + k * 1024); } while (0)
#define PG8_LDB(dst, b, h) do { _Pragma("unroll") for (int n = 0; n < 2; ++n) _Pragma("unroll") for (int k = 0; k < 2; ++k) dst[n][k] = *(const LAS bf16x8*)(lds + PG8_SB(b, h) + boff + n * 2048 + k * 1024); } while (0)
#define PG8_MMA(ai, bj, At, Bt) do { __builtin_amdgcn_s_setprio(1); _Pragma("unroll") for (int m = 0; m < 4; ++m) _Pragma("unroll") for (int n = 0; n < 2; ++n) _Pragma("unroll") for (int k = 0; k < 2; ++k) \
        acc[ai][bj][m][n] = __builtin_amdgcn_mfma_f32_16x16x32_bf16(Bt[n][k], At[m][k], acc[ai][bj][m][n], 0, 0, 0); __builtin_amdgcn_s_setprio(0); } while (0)
#define PG8_WAIT_V(n) asm volatile("s_waitcnt vmcnt(" #n ")" ::: "memory")
#define PG8_WAIT_L(n) asm volatile("s_waitcnt lgkmcnt(" #n ")" ::: "memory")
#define PG8_BAR __builtin_amdgcn_s_barrier()
#define PG8_SCHED __builtin_amdgcn_sched_barrier(0)
    Unit cur, nxt; int ui = 0;
    if (!S.next(0, cur)) return;
    f32x4 acc[2][2][4][2];
#pragma unroll
    for (int a = 0; a < 2; ++a)
#pragma unroll
        for (int b = 0; b < 2; ++b)
#pragma unroll
            for (int m = 0; m < 4; ++m)
#pragma unroll
                for (int n = 0; n < 2; ++n) acc[a][b][m][n] = (f32x4){0.f, 0.f, 0.f, 0.f};
    bf16x8 At[4][2], B0[2][2], B1[2][2];
    const char* cA = (const char*)g.A + (size_t)cur.pm * tstep; const char* cB = (const char*)g.Bt + (size_t)cur.pn * tstep;
    if constexpr (SP2) {
        PG8_STAGE(PG8_SB(0, 0), cB, voffB); PG8_STAGE(PG8_SB(0, 1), cB + hstep, voffB); PG8_STAGE(PG8_SA(0, 0), cA, voffA); PG8_STAGE(PG8_SA(0, 1), cA + hstep, voffA);
        if (wr == 1) PG8_BAR;
        PG8_WAIT_V(2); PG8_BAR;
        PG8_STAGE(PG8_SB(1, 0), cB + kstep, voffB); PG8_STAGE(PG8_SA(1, 0), cA + kstep, voffA); PG8_STAGE(PG8_SB(1, 1), cB + hstep + kstep, voffB);
        PG8_WAIT_V(6); PG8_BAR;
    } else {
        PG8_STAGE(PG8_SB(0, 0), cB, voffB); PG8_STAGE(PG8_SA(0, 0), cA, voffA); PG8_STAGE(PG8_SB(0, 1), cB + hstep, voffB); PG8_STAGE(PG8_SA(0, 1), cA + hstep, voffA);
        if (wr == 1) PG8_BAR;
        PG8_WAIT_V(4); PG8_BAR;
        PG8_STAGE(PG8_SB(1, 0), cB + kstep, voffB); PG8_STAGE(PG8_SA(1, 0), cA + kstep, voffA); PG8_STAGE(PG8_SB(1, 1), cB + hstep + kstep, voffB);
        PG8_WAIT_V(6); PG8_BAR;
    }
    for (;;) {
        const typename Epi::Pre pre = E.prefetch(cur, wr, fr);
        const bool has_next = S.next(ui + 1, nxt);
        const char* nA = has_next ? (const char*)g.A + (size_t)nxt.pm * tstep : cA; const char* nB = has_next ? (const char*)g.Bt + (size_t)nxt.pn * tstep : cB;
        for (int t = 0; t < nt; t += 2) {
            const bool last = (t == nt - 2);
            const char* a1 = cA + (size_t)(t + 1) * kstep;
            const char* a2 = last ? nA : cA + (size_t)(t + 2) * kstep; const char* b2 = last ? nB : cB + (size_t)(t + 2) * kstep;
            const char* a3 = a2 + kstep; const char* b3 = b2 + kstep;
            if constexpr (SP2) {
            PG8_LDB(B0, 0, 0); PG8_LDB(B1, 0, 1); PG8_SCHED; PG8_LDA(At, 0, 0); PG8_STAGE(PG8_SA(1, 1), a1 + hstep, voffA);
            PG8_WAIT_V(8); PG8_WAIT_L(0); PG8_BAR; PG8_MMA(0, 0, At, B0); PG8_MMA(0, 1, At, B1); PG8_BAR; PG8_SCHED;
            PG8_LDA(At, 0, 1); PG8_STAGE(PG8_SB(0, 0), b2, voffB); PG8_STAGE(PG8_SB(0, 1), b2 + hstep, voffB); PG8_STAGE(PG8_SA(0, 0), a2, voffA);
            PG8_WAIT_V(8); PG8_WAIT_L(0); PG8_BAR; PG8_MMA(1, 0, At, B0); PG8_MMA(1, 1, At, B1); PG8_BAR; PG8_SCHED;
            PG8_LDB(B0, 1, 0); PG8_LDB(B1, 1, 1); PG8_SCHED; PG8_LDA(At, 1, 0); PG8_STAGE(PG8_SA(0, 1), a2 + hstep, voffA);
            PG8_WAIT_V(8); PG8_WAIT_L(0); PG8_BAR; PG8_MMA(0, 0, At, B0); PG8_MMA(0, 1, At, B1); PG8_BAR; PG8_SCHED;
            PG8_LDA(At, 1, 1); PG8_STAGE(PG8_SB(1, 0), b3, voffB); PG8_STAGE(PG8_SB(1, 1), b3 + hstep, voffB); PG8_STAGE(PG8_SA(1, 0), a3, voffA);
            PG8_WAIT_V(8); PG8_WAIT_L(0); PG8_BAR; PG8_MMA(1, 0, At, B0); PG8_MMA(1, 1, At, B1); PG8_BAR; PG8_SCHED;
            } else {
            PG8_LDB(B0, 0, 0); PG8_SCHED; PG8_LDA(At, 0, 0); PG8_STAGE(PG8_SA(1, 1), a1 + hstep, voffA);
            PG8_WAIT_L(8); PG8_BAR; PG8_WAIT_L(0); PG8_MMA(0, 0, At, B0); PG8_BAR; PG8_SCHED;
            PG8_LDB(B1, 0, 1); PG8_STAGE(PG8_SB(0, 0), b2, voffB);
            PG8_BAR; PG8_WAIT_L(0); PG8_MMA(0, 1, At, B1); PG8_BAR;
            PG8_LDA(At, 0, 1); PG8_STAGE(PG8_SA(0, 0), a2, voffA);
            PG8_BAR; PG8_WAIT_L(0); PG8_MMA(1, 0, At, B0); PG8_BAR; PG8_SCHED;
            PG8_STAGE(PG8_SB(0, 1), b2 + hstep, voffB);
            PG8_WAIT_V(6); PG8_BAR; PG8_MMA(1, 1, At, B1); PG8_BAR;
            PG8_LDB(B0, 1, 0); PG8_SCHED; PG8_LDA(At, 1, 0); PG8_STAGE(PG8_SA(0, 1), a2 + hstep, voffA);
            PG8_WAIT_L(8); PG8_BAR; PG8_WAIT_L(0); PG8_MMA(0, 0, At, B0); PG8_BAR; PG8_SCHED;
            PG8_LDB(B1, 1, 1); PG8_STAGE(PG8_SB(1, 0), b3, voffB);
            PG8_BAR; PG8_WAIT_L(0); PG8_MMA(0, 1, At, B1); PG8_BAR;
            PG8_LDA(At, 1, 1); PG8_STAGE(PG8_SA(1, 0), a3, voffA);
            PG8_BAR; PG8_WAIT_L(0); PG8_MMA(1, 0, At, B0); PG8_BAR; PG8_SCHED;
            PG8_STAGE(PG8_SB(1, 1), b3 + hstep, voffB);
            PG8_WAIT_V(6); PG8_BAR; PG8_MMA(1, 1, At, B1); PG8_BAR;
            }
        }
        if constexpr (ALIGN_EPI) { if (wr == 0) PG8_BAR; }
        E(acc, cur, wr, wc, fr, fq, pre);
        if (!has_next) break;
#pragma unroll
        for (int a = 0; a < 2; ++a)
#pragma unroll
            for (int b = 0; b < 2; ++b)
#pragma unroll
                for (int m = 0; m < 4; ++m)
#pragma unroll
                    for (int n = 0; n < 2; ++n) acc[a][b][m][n] = (f32x4){0.f, 0.f, 0.f, 0.f};
        cur = nxt; cA = nA; cB = nB; ++ui;
        if constexpr (ALIGN_EPI) { if (wr == 1) PG8_BAR; }
    }
    PG8_WAIT_V(0);
    if constexpr (!ALIGN_EPI) { if (wr == 0) PG8_BAR; }
    PG8_BAR;
#undef PG8_SA
#undef PG8_SB
#undef PG8_STAGE
#undef PG8_LDA
#undef PG8_LDB
#undef PG8_MMA
#undef PG8_WAIT_V
#undef PG8_WAIT_L
#undef PG8_BAR
#undef PG8_SCHED
}

typedef f32x4 Acc[2][2][4][2];
struct PreRs { float r[2][4]; };
struct PreNone { };
__device__ __forceinline__ PreRs load_rs(const float* rs, const Unit& u, int wr, int fr) { PreRs p; const int row0 = u.pm * BM + wr * 64 + fr;
#pragma unroll
    for (int ai = 0; ai < 2; ++ai)
#pragma unroll
        for (int m = 0; m < 4; ++m) p.r[ai][m] = rs[row0 + ai * HALF + m * 16];
    return p; }
__device__ __forceinline__ u32x4 pack8(const f32x4 a, const f32x4 b) { u32x4 w; w.x = cvt_pk_bf16(a[0], a[1]); w.y = cvt_pk_bf16(a[2], a[3]); w.z = cvt_pk_bf16(b[0], b[1]); w.w = cvt_pk_bf16(b[2], b[3]); return w; }

struct EpiInA {
    bf16_t* Z; float* VSS; const float* rs;
    typedef PreRs Pre; __device__ __forceinline__ Pre prefetch(const Unit& u, int wr, int fr) const { return load_rs(rs, u, wr, fr); }
    __device__ __forceinline__ void operator()(const Acc& acc, const Unit& u, int wr, int wc, int fr, int fq, const Pre& pre) const {
        const int row0 = u.pm * BM + wr * 64 + fr, col0 = u.pn * BM + wc * 32 + 8 * fq;
        const bool act = u.pn < 12, isv = (u.pn >= 6) && act;
#pragma unroll
        for (int ai = 0; ai < 2; ++ai)
#pragma unroll
            for (int m = 0; m < 4; ++m) {
                const int row = row0 + ai * HALF + m * 16; bf16_t* rowp = Z + (size_t)row * ZP + col0; float ss = 0.f; const float rsr = pre.r[ai][m];
#pragma unroll
                for (int bj = 0; bj < 2; ++bj) { f32x4 v0 = acc[ai][bj][m][0] * rsr, v1 = acc[ai][bj][m][1] * rsr;
                    if (act) {
#pragma unroll
                        for (int e = 0; e < 4; ++e) { v0[e] = gelu_tanh(v0[e]); v1[e] = gelu_tanh(v1[e]); ss += v0[e] * v0[e] + v1[e] * v1[e]; }
                    } else { v0 = v0 * QSCALE; v1 = v1 * QSCALE; }
                    *(u32x4*)(rowp + bj * HALF) = pack8(v0, v1); }
                if (isv) { ss += __shfl_xor(ss, 16); ss += __shfl_xor(ss, 32); if (fq == 0) VSS[(size_t)row * 24 + (u.pn - 6) * 4 + wc] = ss; }
            }
    }
};
struct EpiMkv {
    float* outf; bf16_t* outb; const float* rs;
    typedef PreRs Pre; __device__ __forceinline__ Pre prefetch(const Unit& u, int wr, int fr) const { return load_rs(rs, u, wr, fr); }
    __device__ __forceinline__ void operator()(const Acc& acc, const Unit& u, int wr, int wc, int fr, int fq, const Pre& pre) const {
        const int row0 = u.pm * BM + wr * 64 + fr, col0 = u.pn * BM + wc * 32 + 8 * fq;
#pragma unroll
        for (int ai = 0; ai < 2; ++ai)
#pragma unroll
            for (int m = 0; m < 4; ++m) { const size_t off = (size_t)(row0 + ai * HALF + m * 16) * NKV + col0; const float rsr = pre.r[ai][m];
#pragma unroll
                for (int bj = 0; bj < 2; ++bj) { const f32x4 v0 = acc[ai][bj][m][0] * rsr, v1 = acc[ai][bj][m][1] * rsr;
                    *(f32x4*)(outf + off + bj * HALF) = v0; *(f32x4*)(outf + off + bj * HALF + 4) = v1; *(u32x4*)(outb + off + bj * HALF) = pack8(v0, v1); } }
    }
};
struct EpiPlain {
    bf16_t* O; int ldc;
    typedef PreNone Pre; __device__ __forceinline__ Pre prefetch(const Unit&, int, int) const { return Pre{}; }
    __device__ __forceinline__ void operator()(const Acc& acc, const Unit& u, int wr, int wc, int fr, int fq, const Pre&) const {
        const int row0 = u.pm * BM + wr * 64 + fr, col0 = u.pn * BM + wc * 32 + 8 * fq;
#pragma unroll
        for (int ai = 0; ai < 2; ++ai)
#pragma unroll
            for (int m = 0; m < 4; ++m) { bf16_t* rowp = O + (size_t)(row0 + ai * HALF + m * 16) * ldc + col0;
#pragma unroll
                for (int bj = 0; bj < 2; ++bj) *(u32x4*)(rowp + bj * HALF) = pack8(acc[ai][bj][m][0], acc[ai][bj][m][1]); }
    }
};
struct EpiSwiglu {
    bf16_t* ACT; const float* rs;
    typedef PreRs Pre; __device__ __forceinline__ Pre prefetch(const Unit& u, int wr, int fr) const { return load_rs(rs, u, wr, fr); }
    __device__ __forceinline__ void operator()(const Acc& acc, const Unit& u, int wr, int wc, int fr, int fq, const Pre& pre) const {
        const int row0 = u.pm * BM + wr * 64 + fr, col0 = u.pn * HALF + wc * 32 + 8 * fq;
#pragma unroll
        for (int ai = 0; ai < 2; ++ai)
#pragma unroll
            for (int m = 0; m < 4; ++m) { f32x4 v0, v1; const float rsr = pre.r[ai][m];
#pragma unroll
                for (int e = 0; e < 4; ++e) { v0[e] = silu_f(acc[ai][0][m][0][e] * rsr) * (acc[ai][1][m][0][e] * rsr); v1[e] = silu_f(acc[ai][0][m][1][e] * rsr) * (acc[ai][1][m][1][e] * rsr); }
                *(u32x4*)(ACT + (size_t)(row0 + ai * HALF + m * 16) * DFF + col0) = pack8(v0, v1); }
    }
};
struct EpiInB {
    bf16_t* Z; const float* rs;
    typedef PreRs Pre; __device__ __forceinline__ Pre prefetch(const Unit& u, int wr, int fr) const { return load_rs(rs, u, wr, fr); }
    __device__ __forceinline__ void operator()(const Acc& acc, const Unit& u, int wr, int wc, int fr, int fq, const Pre& pre) const {
        const int row0 = u.pm * BM + wr * 64 + fr, col0 = u.pn * BM + wc * 32 + 8 * fq;
        const float qs = ((u.pn < 6) || (u.pn >= 18)) ? QSCALE : 1.0f;
#pragma unroll
        for (int ai = 0; ai < 2; ++ai)
#pragma unroll
            for (int m = 0; m < 4; ++m) {
                const int row = row0 + ai * HALF + m * 16; bf16_t* rowp = Z + (size_t)row * ZP + col0; const float rsr = pre.r[ai][m] * qs;
#pragma unroll
                for (int bj = 0; bj < 2; ++bj) *(u32x4*)(rowp + bj * HALF) = pack8(acc[ai][bj][m][0] * rsr, acc[ai][bj][m][1] * rsr);
            }
    }
};
}

__device__ __forceinline__ unsigned f2bf(float f) { unsigned u = __builtin_bit_cast(unsigned, f); return (u + 0x7fffu + ((u >> 16) & 1u)) >> 16; }
__device__ __forceinline__ unsigned pk2(float lo, float hi) { return f2bf(lo) | (f2bf(hi) << 16); }
struct TItem { const float* src; bf16_t* dst; const float* gain; int N, K; };
__device__ __forceinline__ TItem t_make(const float* W, int K, int N, bf16_t* WT, bool upperm, const float* gain, int item) {
    const int nblk = N / 64, kb = item / nblk, nb = item % nblk, k0 = 64 * kb, n0 = 64 * nb;
    int s0 = n0;
    if (upperm) { const int pn = n0 >> 8, j = n0 & 255; s0 = (j < 128) ? (128 * pn + j) : (DFF + 128 * pn + (j - 128)); }
    TItem t; t.src = W + (size_t)k0 * N + s0; t.dst = WT + (size_t)n0 * K + k0; t.gain = gain != nullptr ? gain + k0 : nullptr; t.N = N; t.K = K; return t;
}
__device__ __forceinline__ void t_load(const TItem& t, int lane, f32x4 (&v)[16]) {
    const float* src = t.src + (size_t)(lane >> 4) * t.N + 4 * (lane & 15);
#pragma unroll
    for (int i = 0; i < 16; ++i) v[i] = __builtin_nontemporal_load((const f32x4*)(src + (size_t)(4 * i) * t.N));
}
__device__ __forceinline__ void t_store(const TItem& t, LAS float* scr, int lane, const f32x4 (&v)[16]) {
    const int lr = lane >> 4, lc = lane & 15;
#pragma unroll
    for (int i = 0; i < 16; ++i) { const int k = 4 * i + lr; const float gk = t.gain != nullptr ? t.gain[k] : 1.0f;
        *(LAS f32x4*)(scr + k * 64 + ((4 * lc) ^ (4 * (k >> 3)))) = v[i] * gk; }
    asm volatile("s_waitcnt lgkmcnt(0)" ::: "memory");
    const int c = lane & 7;
#pragma unroll
    for (int j = 0; j < 8; ++j) { const int n = (lane >> 3) + 8 * j; const LAS float* sp = scr + (8 * c) * 64 + (n ^ (4 * c));
        u32x4 o; o.x = cvt_pk_bf16(sp[0 * 64], sp[1 * 64]); o.y = cvt_pk_bf16(sp[2 * 64], sp[3 * 64]); o.z = cvt_pk_bf16(sp[4 * 64], sp[5 * 64]); o.w = cvt_pk_bf16(sp[6 * 64], sp[7 * 64]);
        __builtin_nontemporal_store(o, (u32x4*)(t.dst + (size_t)n * t.K + 8 * c)); }
    asm volatile("s_waitcnt lgkmcnt(0)" ::: "memory");
}
template <int MODE>
__device__ __forceinline__ void norm_row(const float* basef, bf16_t* yb, const bf16_t* o, const float* gpost, float* rs_out, float* yout, int lane) {
    f32x4 y[8];
    if (MODE == 0 || MODE == 1) {
#pragma unroll
        for (int j = 0; j < 8; ++j) y[j] = *(const f32x4*)(basef + 4 * (lane + 64 * j));
    } else {
#pragma unroll
        for (int j = 0; j < 8; ++j) { const u32x2 w = *(const u32x2*)(yb + 4 * (lane + 64 * j)); y[j] = (f32x4){bf_lo(w.x), bf_hi(w.x), bf_lo(w.y), bf_hi(w.y)}; }
    }
    if (MODE != 0) {
        f32x4 ov[8]; float ss = 0.f;
#pragma unroll
        for (int j = 0; j < 8; ++j) { const u32x2 w = *(const u32x2*)(o + 4 * (lane + 64 * j)); ov[j] = (f32x4){bf_lo(w.x), bf_hi(w.x), bf_lo(w.y), bf_hi(w.y)};
            ss += (ov[j][0] * ov[j][0] + ov[j][1] * ov[j][1]) + (ov[j][2] * ov[j][2] + ov[j][3] * ov[j][3]); }
        const float rstd = 1.0f / sqrtf(wave_sum(ss) * (1.0f / DM) + EPS);
#pragma unroll
        for (int j = 0; j < 8; ++j) { const f32x4 g = *(const f32x4*)(gpost + 4 * (lane + 64 * j)); y[j] = y[j] + ov[j] * rstd * g; }
    }
    if (MODE == 3) {
#pragma unroll
        for (int j = 0; j < 8; ++j) *(f32x4*)(yout + 4 * (lane + 64 * j)) = y[j];
    } else {
        float ss = 0.f;
#pragma unroll
        for (int j = 0; j < 8; ++j) { ss += (y[j][0] * y[j][0] + y[j][1] * y[j][1]) + (y[j][2] * y[j][2] + y[j][3] * y[j][3]);
            u32x2 w; w.x = cvt_pk_bf16(y[j][0], y[j][1]); w.y = cvt_pk_bf16(y[j][2], y[j][3]); *(u32x2*)(yb + 4 * (lane + 64 * j)) = w; }
        ss = wave_sum(ss);
        if (lane == 0) *rs_out = 1.0f / sqrtf(ss * (1.0f / DM) + EPS);
    }
}

struct KvDesc { const bf16_t* kbase; const bf16_t* vbase; long row0, rstep, pitch; int key_lo; };
__device__ __forceinline__ void kv_issue(const KvDesc& d, int tid, u32x4 (&kk)[8], u32x4 (&vv)[8]) {
    const int srow = tid >> 4, sch = tid & 15;
#pragma unroll
    for (int i = 0; i < 8; ++i) { const int row = srow + 32 * i, rowc = row < d.key_lo ? d.key_lo : row;
        const size_t e = (size_t)(d.row0 + (long)rowc * d.rstep) * d.pitch + sch * 8; kk[i] = *(const u32x4*)(d.kbase + e); vv[i] = *(const u32x4*)(d.vbase + e); }
}
__device__ __forceinline__ void kv_commit(LAS unsigned char* lds, int tid, int key_lo, const u32x4 (&kk)[8], const u32x4 (&vv)[8]) {
    const unsigned sb = off_b(tid >> 4, tid & 15); const int srow = tid >> 4; const u32x4 z = (u32x4){0u, 0u, 0u, 0u};
#pragma unroll
    for (int i = 0; i < 8; ++i) { const bool ok = (srow + 32 * i) >= key_lo; *(LAS u32x4*)(lds + sb + 8192 * i) = ok ? kk[i] : z; *(LAS u32x4*)(lds + 65536 + sb + 8192 * i) = ok ? vv[i] : z; }
}
template <bool BANDED>
__device__ __forceinline__ void attn_compute(LAS unsigned char* lds, int lane, int w, const bf16x8 (&qf)[4], int key_lo, bf16_t* orow, float* lsep, const LAS float* btab) {
    const int fr = lane & 15, fq = lane >> 4;
    LAS unsigned char* Kimg = lds; LAS unsigned char* Vimg = lds + 65536;
    constexpr int NBLK = BANDED ? 5 : 8;
    const int blk0 = BANDED ? (w >> 1) : 0;
    const int qi = 16 * w + fr;
    unsigned kb[2][4];
#pragma unroll
    for (int e = 0; e < 2; ++e)
#pragma unroll
        for (int kk = 0; kk < 4; ++kk) kb[e][kk] = off_b(8 * (fr >> 2) + 4 * e + (fr & 3), 4 * kk + fq);
    LAS unsigned char* Kb = Kimg + 8192 * blk0; LAS unsigned char* Vb = Vimg + 8192 * blk0;
    f32x4 s[2 * NBLK];
#pragma unroll
    for (int nt = 0; nt < 2 * NBLK; ++nt) s[nt] = (f32x4){0.f, 0.f, 0.f, 0.f};
    constexpr int TB = BANDED ? 2 * NBLK : NBLK;
#pragma unroll
    for (int t0 = 0; t0 < 2 * NBLK; t0 += TB)
#pragma unroll
        for (int kk = 0; kk < 4; ++kk) { bf16x8 kf[TB];
#pragma unroll
            for (int i = 0; i < TB; ++i) { const int nt = t0 + i; kf[i] = *(const LAS bf16x8*)(Kb + kb[nt & 1][kk] + 8192 * (nt >> 1)); }
            __builtin_amdgcn_sched_barrier(0);
#pragma unroll
            for (int i = 0; i < TB; ++i) s[t0 + i] = __builtin_amdgcn_mfma_f32_16x16x32_bf16(kf[i], qf[kk], s[t0 + i], 0, 0, 0);
            __builtin_amdgcn_sched_barrier(0); }
    float mx = -1e30f;
    const LAS float* bp = btab + (128 + 16 * (w & 1) + fr - 8 * fq + 32 - 135);
    const int cmin = BANDED ? (key_lo > 0 ? (128 + 16 * (w & 1) + fr - 8 * fq) - qi : -1000) : 0;
#pragma unroll
    for (int nt = 0; nt < 2 * NBLK; ++nt)
#pragma unroll
        for (int r = 0; r < 4; ++r) { float x = s[nt][r];
            if (BANDED) { const int c = 32 * (nt >> 1) + 4 * (nt & 1) + r; x = x + bp[135 - c]; x = (c >= cmin) ? x : -1e30f; s[nt][r] = x; }
            mx = fmaxf(mx, x); }
    mx = fmaxf(mx, __shfl_xor(mx, 16)); mx = fmaxf(mx, __shfl_xor(mx, 32));
    float l = 0.f;
#pragma unroll
    for (int nt = 0; nt < 2 * NBLK; ++nt)
#pragma unroll
        for (int r = 0; r < 4; ++r) { const float p = __builtin_amdgcn_exp2f(s[nt][r] - mx); s[nt][r] = p; l += p; }
    l += __shfl_xor(l, 16); l += __shfl_xor(l, 32);
    bf16x8 pf[NBLK];
#pragma unroll
    for (int ks = 0; ks < NBLK; ++ks) pf[ks] = __builtin_bit_cast(bf16x8, pg8::pack8(s[2 * ks], s[2 * ks + 1]));
    const float inv_l = 1.0f / l;
    unsigned vb[8][2];
#pragma unroll
    for (int ct = 0; ct < 8; ++ct) { vb[ct][0] = tr16_addr(lane, ct, 0, 0); vb[ct][1] = tr16_addr(lane, ct, 0, 1); }
    f32x4 oa[8];
#pragma unroll
    for (int ct = 0; ct < 8; ++ct) oa[ct] = (f32x4){0.f, 0.f, 0.f, 0.f};
#pragma unroll
    for (int ks = 0; ks < NBLK; ++ks) { s16x4 vlo[8], vhi[8];
#pragma unroll
        for (int ct = 0; ct < 8; ++ct) { vlo[ct] = tr_read(Vb + vb[ct][0] + 8192 * ks); vhi[ct] = tr_read(Vb + vb[ct][1] + 8192 * ks); }
        __builtin_amdgcn_sched_barrier(0);
#pragma unroll
        for (int ct = 0; ct < 8; ++ct) { const bf16x8 vf = (bf16x8){vlo[ct][0], vlo[ct][1], vlo[ct][2], vlo[ct][3], vhi[ct][0], vhi[ct][1], vhi[ct][2], vhi[ct][3]};
            oa[ct] = __builtin_amdgcn_mfma_f32_16x16x32_bf16(vf, pf[ks], oa[ct], 0, 0, 0); }
        __builtin_amdgcn_sched_barrier(0); }
#pragma unroll
    for (int ct = 0; ct < 8; ++ct) { u32x2 wv; wv.x = cvt_pk_bf16(oa[ct][0] * inv_l, oa[ct][1] * inv_l); wv.y = cvt_pk_bf16(oa[ct][2] * inv_l, oa[ct][3] * inv_l);
        *(u32x2*)(orow + 16 * ct) = wv; }
    if (lsep != nullptr && fq == 0) *lsep = (mx + __builtin_amdgcn_logf(l)) * LN2;
}
struct QoDesc { const bf16_t* qbase; long row0, rstep; bf16_t* obase; float* lsebase; int banded, dil, head; };

struct GateRegs { u32x4 v[2][6]; f32x4 wq[8]; f32x4 vs[3]; float gvl; };
__device__ __forceinline__ void gate_issue(int tid, int b, int chunk, int g, const bf16_t* Z, const float* VSS, const float* w_s, const float* g_v, GateRegs& R) {
    const int lane = tid & 63, w = __builtin_amdgcn_readfirstlane(tid >> 6), fr = lane & 15, fq = lane >> 4;
    const int tok0 = b * SEQ + chunk * 128;
    {
        const int r0 = tid >> 3, c0 = tid & 7; const bf16_t* gp = Z + (size_t)(tok0 + r0) * ZP + MIXW + g * 384 + c0 * 8;
#pragma unroll
        for (int i2 = 0; i2 < 2; ++i2)
#pragma unroll
            for (int i = 0; i < 6; ++i) R.v[i2][i] = *(const u32x4*)(gp + (size_t)i2 * 64 * ZP + 64 * i); }
    { const float* wp = w_s + (size_t)g * 16384 + (16 * w + fr) * 128 + 8 * fq;
#pragma unroll
      for (int kk = 0; kk < 4; ++kk) { R.wq[2 * kk] = *(const f32x4*)(wp + 32 * kk); R.wq[2 * kk + 1] = *(const f32x4*)(wp + 32 * kk + 4); } }
    { const float* p = VSS + (size_t)(tok0 + (tid & 127)) * 24 + 12 * ((tid >> 7) & 1);
#pragma unroll
      for (int i = 0; i < 3; ++i) R.vs[i] = *(const f32x4*)(p + 4 * i); }
    R.gvl = g_v[g * 384 + (tid < 384 ? tid : tid - 384)];
}
__device__ __forceinline__ void gate_run(LAS unsigned char* lds, int tid, int b, int chunk, int g, const GateRegs& R, const bf16_t* Z, const float* b_s, bf16_t* MIX) {
    const int lane = tid & 63, w = __builtin_amdgcn_readfirstlane(tid >> 6), fr = lane & 15, fq = lane >> 4;
    const int tok0 = b * SEQ + chunk * 128, i = 16 * w + fr;
    LAS float* rs = (LAS float*)(lds + LDS_TAB); LAS float* gvs = rs + 128;
    const size_t tokrow = (size_t)(tok0 + i);
    __syncthreads();
    const bf16_t* up = Z + tokrow * ZP + g * 384 + 4 * fq;
    u32x2 ucur[8];
    const float bs = b_s[g * 128 + i];
    {
        const int r0 = tid >> 3, c0 = tid & 7; const unsigned gsb0 = off_b(r0, c0), gsb1 = off_b(r0, c0 + 8);
#pragma unroll
        for (int i2 = 0; i2 < 2; ++i2)
#pragma unroll
            for (int k = 0; k < 6; ++k) *(LAS u32x4*)(lds + (k >> 1) * 32768 + ((k & 1) ? gsb1 : gsb0) + 16384 * i2) = R.v[i2][k]; }
    { float ssum = 0.f;
#pragma unroll
      for (int k = 0; k < 3; ++k) ssum += (R.vs[k][0] + R.vs[k][1]) + (R.vs[k][2] + R.vs[k][3]);
      if (tid < 256) rs[512 + tid] = ssum;
      if (tid < 384) gvs[tid] = R.gvl; }
    __syncthreads();
    if (tid < 128) rs[tid] = 1.0f / sqrtf((rs[512 + tid] + rs[512 + 128 + tid]) * (1.0f / MIXW) + EPS);
    __syncthreads();
    bf16x8 wf[4];
#pragma unroll
    for (int kk = 0; kk < 4; ++kk) { const int j0 = 32 * kk + 8 * fq;
        const f32x4 r0 = *(const LAS f32x4*)(rs + j0), r1 = *(const LAS f32x4*)(rs + j0 + 4);
        const f32x4 a = R.wq[2 * kk], c = R.wq[2 * kk + 1];
        float v[8] = {a[0] * r0[0], a[1] * r0[1], a[2] * r0[2], a[3] * r0[3], c[0] * r1[0], c[1] * r1[1], c[2] * r1[2], c[3] * r1[3]};
#pragma unroll
        for (int jj = 0; jj < 8; ++jj) v[jj] = (j0 + jj <= i) ? v[jj] : 0.f;
        u32x4 pk; pk.x = cvt_pk_bf16(v[0], v[1]); pk.y = cvt_pk_bf16(v[2], v[3]); pk.z = cvt_pk_bf16(v[4], v[5]); pk.w = cvt_pk_bf16(v[6], v[7]);
        wf[kk] = __builtin_bit_cast(bf16x8, pk); }
    unsigned vb[8][2];
#pragma unroll
    for (int c = 0; c < 8; ++c) { vb[c][0] = tr16_addr(lane, c, 0, 0); vb[c][1] = tr16_addr(lane, c, 0, 1); }
#pragma unroll
    for (int sub = 0; sub < 3; ++sub) { LAS unsigned char* img = lds + sub * 32768;
#pragma unroll
        for (int c = 0; c < 8; ++c) ucur[c] = *(const u32x2*)(up + sub * 128 + 16 * c);
#pragma unroll
        for (int c = 0; c < 8; ++c) { f32x4 a = (f32x4){0.f, 0.f, 0.f, 0.f};
#pragma unroll
            for (int kk = 0; kk < 4; ++kk) if (kk <= (w >> 1)) {
                const s16x4 lo = tr_read(img + vb[c][0] + 8192 * kk), hi = tr_read(img + vb[c][1] + 8192 * kk);
                const bf16x8 vf = (bf16x8){lo[0], lo[1], lo[2], lo[3], hi[0], hi[1], hi[2], hi[3]};
                a = __builtin_amdgcn_mfma_f32_16x16x32_bf16(vf, wf[kk], a, 0, 0, 0); }
            const int col = g * 384 + sub * 128 + 16 * c + 4 * fq;
            const f32x4 gv = *(const LAS f32x4*)(gvs + sub * 128 + 16 * c + 4 * fq);
            const u32x2 uw = ucur[c];
            const float o0 = bf_lo(uw.x) * (a[0] * gv[0] + bs), o1 = bf_hi(uw.x) * (a[1] * gv[1] + bs), o2 = bf_lo(uw.y) * (a[2] * gv[2] + bs), o3 = bf_hi(uw.y) * (a[3] * gv[3] + bs);
            u32x2 ov; ov.x = cvt_pk_bf16(o0, o1); ov.y = cvt_pk_bf16(o2, o3);
            *(u32x2*)(MIX + tokrow * DM + col) = ov; } }
}

template <int MODE, int K>
__device__ __forceinline__ void sample_gemv(LAS unsigned char* lds, const bf16_t* A, int a_pitch, const bf16_t* Wt, int N, int first, int stride,
                                            float* outf, bf16_t* outb, int ldb, float* win, const float* rs, const float* slse = nullptr) {
    int tid = threadIdx.x; asm volatile("" : "+v"(tid));
    const int lane = tid & 63, w = __builtin_amdgcn_readfirstlane(tid >> 6), fr = lane & 15, fq = lane >> 4;
    const int ntiles = (MODE == 2) ? N / 32 : N / 16;
    LAS float* red = (LAS float*)lds;
    constexpr int kw = K / 8;
    LAS float* atab = (LAS float*)(lds + LDS_TAB + 4096);
    if (slse != nullptr) {
        __syncthreads();
        if (tid < 128) { const int srow = tid >> 4, H = tid & 15; float al = 1.0f;
            if (H < 12) { const int hl = H & 3; const float l0 = slse[srow * 12 + hl], l1 = slse[srow * 12 + 4 + hl], l2 = slse[srow * 12 + 8 + hl], mm = fmaxf(l0, fmaxf(l1, l2));
                const float e0 = __expf(l0 - mm), e1 = __expf(l1 - mm), e2 = __expf(l2 - mm); al = (H < 4 ? e0 : (H < 8 ? e1 : e2)) / (e0 + e1 + e2); }
            atab[tid] = al; }
        __syncthreads();
    }
    for (int tile = first; tile < ntiles; tile += stride) {
        const int nrow0 = (MODE == 2) ? 256 * (tile >> 3) + 16 * (tile & 7) : 16 * tile;
        const bf16_t* ap = A + (size_t)(fr & 7) * a_pitch + w * kw + 8 * fq;
        const bf16_t* bp = Wt + (size_t)(nrow0 + fr) * K + w * kw + 8 * fq;
        f32x4 acc = (f32x4){0.f, 0.f, 0.f, 0.f}, acc2 = (f32x4){0.f, 0.f, 0.f, 0.f};
#pragma unroll
        for (int ks = 0; ks < kw / 32; ++ks) { bf16x8 a = *(const bf16x8*)(ap + 32 * ks); const bf16x8 b = *(const bf16x8*)(bp + 32 * ks);
            if (MODE == 1 && slse != nullptr) { const float al = atab[(fr & 7) * 16 + ((w * kw + 32 * ks + 8 * fq) >> 7)]; const u32x4 aw = __builtin_bit_cast(u32x4, a); u32x4 o;
                o.x = cvt_pk_bf16(bf_lo(aw.x) * al, bf_hi(aw.x) * al); o.y = cvt_pk_bf16(bf_lo(aw.y) * al, bf_hi(aw.y) * al);
                o.z = cvt_pk_bf16(bf_lo(aw.z) * al, bf_hi(aw.z) * al); o.w = cvt_pk_bf16(bf_lo(aw.w) * al, bf_hi(aw.w) * al); a = __builtin_bit_cast(bf16x8, o); }
            acc = __builtin_amdgcn_mfma_f32_16x16x32_bf16(b, a, acc, 0, 0, 0);
            if (MODE == 2) { const bf16x8 b2 = *(const bf16x8*)(bp + (size_t)128 * K + 32 * ks); acc2 = __builtin_amdgcn_mfma_f32_16x16x32_bf16(b2, a, acc2, 0, 0, 0); } }
        __syncthreads();
        *(LAS f32x4*)(red + (w * 16 + fr) * 16 + 4 * fq) = acc;
        if (MODE == 2) *(LAS f32x4*)(red + 2048 + (w * 16 + fr) * 16 + 4 * fq) = acc2;
        __syncthreads();
        if (tid < 128) { const int s = tid >> 4, c = tid & 15; float v = 0.f, v2 = 0.f;
#pragma unroll
            for (int ww = 0; ww < 8; ++ww) { v += red[(ww * 16 + s) * 16 + c]; if (MODE == 2) v2 += red[2048 + (ww * 16 + s) * 16 + c]; }
            if (rs != nullptr) { const float rsr = rs[s]; v *= rsr; v2 *= rsr; }
            if (MODE == 0) { const int n = nrow0 + c; outf[(size_t)s * ZP + n] = v;
                if (win != nullptr && n >= 1536 && n < 4608) { const int kv = n >= 3072 ? 1 : 0, cc = n - 1536 - 1536 * kv, grp = cc >> 9;
                    win[(size_t)grp * 8192 + (size_t)(s * 2 + kv) * 512 + (cc & 511)] = v; } }
            else if (MODE == 1) { outb[(size_t)s * ldb + nrow0 + c] = (bf16_t)f2bf(v); }
            else { outb[(size_t)s * ldb + 128 * (tile >> 3) + 16 * (tile & 7) + c] = (bf16_t)f2bf(silu_f(v) * v2); } }
    }
}

template <class KF, class VF>
__device__ __forceinline__ float sample_attend(LAS float* scr, const float* qv, int nkeys, KF kf, VF vf, const LAS float* btab, LAS float* o_out) {
    int tid = threadIdx.x; asm volatile("" : "+v"(tid));
    const int lane = tid & 63, w = __builtin_amdgcn_readfirstlane(tid >> 6);
    LAS float* sc = scr; LAS float* part = scr + 320; LAS float* stat = scr + 320 + 2048;
    {
        const int key = tid >> 1, half = tid & 1; float d = 0.f;
        if (key < nkeys) { const float* kp = kf(key) + 64 * half; const float* qp = qv + 64 * half; f32x4 k4[16];
#pragma unroll
            for (int i = 0; i < 16; ++i) k4[i] = *(const f32x4*)(kp + 4 * i);
#pragma unroll
            for (int i = 0; i < 16; ++i) { const f32x4 q4 = *(const f32x4*)(qp + 4 * i); d += (k4[i][0] * q4[0] + k4[i][1] * q4[1]) + (k4[i][2] * q4[2] + k4[i][3] * q4[3]); } }
        d += __shfl_xor(d, 1);
        if (half == 0 && key < nkeys) sc[key] = d * QSCALE + (btab != nullptr ? btab[key] : 0.f);
    }
    __syncthreads();
    if (w == 0) { float m = -1e30f; for (int j = lane; j < nkeys; j += 64) m = fmaxf(m, sc[j]); m = wave_max(m);
        float l = 0.f; for (int j = lane; j < nkeys; j += 64) { const float p = __builtin_amdgcn_exp2f(sc[j] - m); sc[j] = p; l += p; } l = wave_sum(l);
        if (lane == 0) { stat[0] = m; stat[1] = l; } }
    __syncthreads();
    {
        const int kg = tid >> 5, d4 = 4 * (tid & 31); f32x4 v4[16]; f32x4 a = (f32x4){0.f, 0.f, 0.f, 0.f};
#pragma unroll
        for (int i = 0; i < 16; ++i) { const int j = kg + 16 * i; v4[i] = (f32x4){0.f, 0.f, 0.f, 0.f}; if (j < nkeys) v4[i] = *(const f32x4*)(vf(j) + d4); }
#pragma unroll
        for (int i = 0; i < 16; ++i) { const int j = kg + 16 * i; const float pj = j < nkeys ? sc[j] : 0.f; a = a + v4[i] * pj; }
        *(LAS f32x4*)(part + kg * 128 + d4) = a; }
    __syncthreads();
    const float m = stat[0], l = stat[1];
    if (tid < 128) { float a = 0.f;
#pragma unroll
        for (int g = 0; g < 16; ++g) a += part[g * 128 + tid];
        o_out[tid] = a / l; }
    __syncthreads();
    return (m + __builtin_amdgcn_logf(l)) * LN2;
}

#define XB_TMO      128
#define XB_XCNT(j)  (256  + 64 * (j))
#define XB_XSUB(j)  (1280 + 64 * (j))
#define XB_XGEN(j)  (2304 + 64 * (j))
#define XB_TOP      3328
#define XB_TOPGEN   3392
#define XCD_BAR_WORDS 3456
#define XB_SPIN_CAP (1u << 18)
__device__ __forceinline__ unsigned xb_ld(unsigned* p)              { return __hip_atomic_load(p, __ATOMIC_RELAXED, __HIP_MEMORY_SCOPE_AGENT); }
__device__ __forceinline__ unsigned xb_add(unsigned* p, unsigned v) { return __hip_atomic_fetch_add(p, v, __ATOMIC_RELAXED, __HIP_MEMORY_SCOPE_AGENT); }
__device__ __forceinline__ unsigned xb_xcc_id() { return (unsigned)__builtin_amdgcn_s_getreg((3 << 11) | 20) & 0xFu; }
#define XB_SPIN(cond, bar) do { unsigned _sp = 0; while (cond) { __builtin_amdgcn_s_sleep(1); \
    if ((++_sp & 255u) == 0u) { if (xb_ld(&(bar)[XB_TMO])) break; if (_sp > XB_SPIN_CAP) { atomicAdd(&(bar)[XB_TMO], 1u); break; } } } } while (0)
struct XcdBarrier { unsigned* bar; unsigned x; volatile LAS unsigned* st; };
__device__ __forceinline__ XcdBarrier xcd_barrier_post(unsigned* bar, volatile LAS unsigned* st) {
    XcdBarrier b; b.bar = bar; b.x = xb_xcc_id(); b.st = st;
    if (threadIdx.x == 0) (void)xb_add(&bar[XB_XCNT(b.x)], 1u);
    return b;
}
__device__ __forceinline__ void xcd_barrier_complete(unsigned* bar, unsigned x, unsigned& nloc, unsigned& nx) {
    const unsigned G = gridDim.x * gridDim.y * gridDim.z;
    unsigned sum, cnt, mine, sp = 0u;
    for (;;) {
        sum = 0u; cnt = 0u; mine = 0u;
#pragma unroll
        for (unsigned j = 0; j < 16; ++j) { const unsigned c = xb_ld(&bar[XB_XCNT(j)]); sum += c; cnt += (c > 0u) ? 1u : 0u; mine = (j == x) ? c : mine; }
        if (sum == G) break;
        __builtin_amdgcn_s_sleep(1);
        if ((++sp & 255u) == 0u) { if (xb_ld(&bar[XB_TMO])) break; if (sp > XB_SPIN_CAP) { atomicAdd(&bar[XB_TMO], 1u); break; } }
    }
    nloc = mine > 0u ? mine : 1u; nx = cnt > 0u ? cnt : 1u;
}
__device__ __forceinline__ void xcd_barrier(const XcdBarrier& b) {
    asm volatile("s_waitcnt vmcnt(0)" ::: "memory");
    __syncthreads();
    if (threadIdx.x == 0) {
        unsigned* bar = b.bar;
        __builtin_amdgcn_s_waitcnt(0);
        unsigned nloc = b.st[0], nx = b.st[1];
        if (nloc == 0u) { xcd_barrier_complete(bar, b.x, nloc, nx); b.st[0] = nloc; b.st[1] = nx; }
        const unsigned old = xb_add(&bar[XB_XSUB(b.x)], 1u);
        const unsigned gen = old / nloc;
        if (old + 1u == (gen + 1u) * nloc) {
            __builtin_amdgcn_fence(__ATOMIC_RELEASE, "agent");
            asm volatile("s_waitcnt vmcnt(0)" ::: "memory");
            const unsigned og = xb_add(&bar[XB_TOP], 1u);
            const unsigned tg = og / nx;
            if (og + 1u == (tg + 1u) * nx) xb_add(&bar[XB_TOPGEN], 1u);
            else XB_SPIN(xb_ld(&bar[XB_TOPGEN]) == tg, bar);
            __builtin_amdgcn_fence(__ATOMIC_ACQUIRE, "agent");
            xb_add(&bar[XB_XGEN(b.x)], 1u);
            asm volatile("s_waitcnt vmcnt(0)" ::: "memory");
        } else {
            XB_SPIN(xb_ld(&bar[XB_XGEN(b.x)]) == gen, bar);
            __builtin_amdgcn_fence(__ATOMIC_ACQUIRE, "agent");
            asm volatile("s_waitcnt vmcnt(0)" ::: "memory");
        }
    }
    __syncthreads();
}

struct Args { const float* in[22]; float* out; unsigned char* ws; };
typedef const Args __attribute__((address_space(4)))* ArgsP;
__device__ __forceinline__ ArgsP args_ptr() { ArgsP p = (ArgsP)__builtin_amdgcn_kernarg_segment_ptr(); asm volatile("" : "+s"(p)); return p; }
#define WSP(T, off) ((T*)(A->ws + (off)))

constexpr int I_MKV = 32 * 16, I_INA = 32 * 56, I_INB = 32 * 80, I_OUT = 32 * 32, I_UP = 32 * 176, I_DN = 88 * 32, DN_P = 850, DN_A = 1170;
__device__ __forceinline__ int conv_count(int list) { return list == 0 ? 2 * I_MKV + I_INA + I_UP + DN_P : (list == 1 ? I_OUT + (DN_A - DN_P) : (list == 2 ? (I_DN - DN_A) + I_INB + I_OUT : (list == 3 ? I_UP : I_DN))); }
__device__ __forceinline__ TItem conv_item(ArgsP A, int list, int r) {
    const float* n_mix_pre = A->in[8]; const float* n_ffn_pre = A->in[10]; const float* n_mem = A->in[12]; const float* w_mem_kv = A->in[13]; const float* w_in_a = A->in[14];
    const float* w_in_b = A->in[18]; const float* w_out = A->in[19]; const float* w_up = A->in[20]; const float* w_dn = A->in[21];
    bf16_t* Wmkv = WSP(bf16_t, WS_WMKV); bf16_t* Wina = WSP(bf16_t, WS_WINA); bf16_t* Winb = WSP(bf16_t, WS_WINB); bf16_t* Wout = WSP(bf16_t, WS_WOUT);
    bf16_t* Wup = WSP(bf16_t, WS_WUP); bf16_t* Wdn = WSP(bf16_t, WS_WDN);
    if (list == 0) {
        if (r < 2 * I_MKV) { const int l = r / I_MKV; return t_make(w_mem_kv + (size_t)l * DM * NKV, DM, NKV, Wmkv + (size_t)l * NKV * DM, false, n_mem + l * DM, r % I_MKV); } r -= 2 * I_MKV;
        if (r < I_INA) return t_make(w_in_a, DM, NA, Wina, false, n_mix_pre, r); r -= I_INA;
        if (r < I_UP) return t_make(w_up, DM, NUP, Wup, true, n_ffn_pre, r); r -= I_UP;
        return t_make(w_dn, DFF, DM, Wdn, false, nullptr, r);
    } else if (list == 1) {
        if (r < I_OUT) return t_make(w_out, DM, DM, Wout, false, nullptr, r); r -= I_OUT;
        return t_make(w_dn, DFF, DM, Wdn, false, nullptr, DN_P + r);
    } else if (list == 2) {
        if (r < I_DN - DN_A) return t_make(w_dn, DFF, DM, Wdn, false, nullptr, DN_A + r); r -= I_DN - DN_A;
        if (r < I_INB) return t_make(w_in_b, DM, NB, Winb, false, n_mix_pre + DM, r); r -= I_INB;
        return t_make(w_out + (size_t)DM * DM, DM, DM, Wout + (size_t)DM * DM, false, nullptr, r);
    } else if (list == 3) {
        return t_make(w_up + (size_t)DM * NUP, DM, NUP, Wup + (size_t)NUP * DM, true, n_ffn_pre + DM, r);
    } else {
        return t_make(w_dn + (size_t)DFF * DM, DFF, DM, Wdn + (size_t)DM * DFF, false, nullptr, r);
    }
}
__device__ __forceinline__ void convert_list(LAS unsigned char* lds, ArgsP A, int list, int worker, int nworkers, int wave, int lane) {
    const int n = conv_count(list);
    LAS float* scr = (LAS float*)(lds + wave * 16384);
    int it = worker;
    if (it >= n) return;
    TItem cur = conv_item(A, list, it);
    f32x4 va[16], vb[16];
    t_load(cur, lane, va);
    for (;;) {
        const int itn = it + nworkers; const bool hn = itn < n;
        TItem nxt = cur;
        if (hn) { nxt = conv_item(A, list, itn); t_load(nxt, lane, vb); }
        t_store(cur, scr, lane, va);
        if (!hn) break;
#pragma unroll
        for (int i = 0; i < 16; ++i) va[i] = vb[i];
        cur = nxt; it = itn;
    }
}
__device__ __forceinline__ void convert_tail(LAS unsigned char* lds, ArgsP A, int list, int first_idle) {
    const int bid = blockIdx.x, G = gridDim.x;
    if (bid < first_idle || first_idle >= G) return;
    int tid = threadIdx.x; asm volatile("" : "+v"(tid));
    const int lane = tid & 63, wave = __builtin_amdgcn_readfirstlane(tid >> 6);
    __syncthreads();
    convert_list(lds, A, list, (bid - first_idle) * 8 + wave, (G - first_idle) * 8, wave, lane);
}
__device__ __forceinline__ void phase_prologue(LAS unsigned char* lds) {
    ArgsP A = args_ptr();
    int tid = threadIdx.x; asm volatile("" : "+v"(tid));
    const int lane = tid & 63, wave = __builtin_amdgcn_readfirstlane(tid >> 6), gw = blockIdx.x * 8 + wave, NGW = gridDim.x * 8;
    const float* x_prompt = A->in[0]; const float* x_sample = A->in[1]; const float* mem_prompt = A->in[2];
    bf16_t* YB = WSP(bf16_t, WS_HN); bf16_t* HM = WSP(bf16_t, WS_HM);
    float* RS = WSP(float, WS_RS); float* RSM = RS + 16384;
    convert_list(lds, A, 0, gw, NGW, wave, lane);
    if (gridDim.x != 256) { convert_list(lds, A, 1, gw, NGW, wave, lane); convert_list(lds, A, 2, gw, NGW, wave, lane); convert_list(lds, A, 3, gw, NGW, wave, lane); convert_list(lds, A, 4, gw, NGW, wave, lane); }
    for (int m = gw; m < 512 + TP + TSMP; m += NGW) {
        if (m < 512) norm_row<0>(mem_prompt + (size_t)m * DM, HM + (size_t)m * DM, nullptr, nullptr, RSM + m, nullptr, lane);
        else { const int r = m - 512; const float* xr = r < TP ? x_prompt + (size_t)r * DM : x_sample + (size_t)(r - TP) * DM;
            norm_row<0>(xr, YB + (size_t)r * DM, nullptr, nullptr, RS + r, nullptr, lane); }
    }
}

__device__ __forceinline__ void phase_in_a(LAS unsigned char* lds) {
    ArgsP A = args_ptr(); const int bid = blockIdx.x, G = gridDim.x;
    bf16_t* HN = WSP(bf16_t, WS_HN);
    { pg8::Gemm g{HN, WSP(bf16_t, WS_WINA), TP, NA, DM}; pg8::StaticOrder S; S.init(TP, NA, G, bid); pg8::EpiInA E{WSP(bf16_t, WS_Z), WSP(float, WS_VSS), WSP(float, WS_RS)};
      pg8::gemm_phase<pg8::EpiInA, true, true>(lds, g, S, E); }
#pragma unroll 1
    for (int l = 0; l < 2; ++l) { pg8::Gemm g{WSP(bf16_t, WS_HM), WSP(bf16_t, WS_WMKV) + (size_t)l * NKV * DM, 512, NKV, DM};
      pg8::StaticOrder S; S.init(512, NKV, G, (bid - 192 - 8 * l + 2 * G) % G);
      pg8::EpiMkv E{A->out + OUT_MKV + (size_t)l * 512 * NKV, WSP(bf16_t, WS_MKV) + (size_t)l * 512 * NKV, WSP(float, WS_RS) + 16384};
      pg8::gemm_phase<pg8::EpiMkv, true, true>(lds, g, S, E); }
    if (G == 256) { if (bid >= 208) sample_gemv<0, DM>(lds, HN + (size_t)TP * DM, DM, WSP(bf16_t, WS_WINA), NA, G - 1 - bid, 48, WSP(float, WS_ZS), nullptr, 0, nullptr, WSP(float, WS_RS) + TP); }
    else sample_gemv<0, DM>(lds, HN + (size_t)TP * DM, DM, WSP(bf16_t, WS_WINA), NA, G - 1 - bid, G, WSP(float, WS_ZS), nullptr, 0, nullptr, WSP(float, WS_RS) + TP);
    if (G == 256) convert_tail(lds, A, 1, 208);
}
__device__ __forceinline__ void phase_in_b(LAS unsigned char* lds) {
    ArgsP A = args_ptr(); const int bid = blockIdx.x, G = gridDim.x;
    bf16_t* HN = WSP(bf16_t, WS_HN); float* out = A->out;
    pg8::Gemm g{HN, WSP(bf16_t, WS_WINB), TP, NB, DM}; pg8::StaticOrder S; S.init(TP, NB, G, bid);
    pg8::EpiInB E{WSP(bf16_t, WS_Z), WSP(float, WS_RS)};
    pg8::gemm_phase<pg8::EpiInB, true, true>(lds, g, S, E);
    sample_gemv<0, DM>(lds, HN + (size_t)TP * DM, DM, WSP(bf16_t, WS_WINB), NB, G - 1 - bid, G, WSP(float, WS_ZS), nullptr, 0, out + OUT_W128S, WSP(float, WS_RS) + TP);
    if (G == 256) convert_tail(lds, A, 3, 128);
}
__device__ __forceinline__ void mem_unit_desc(ArgsP A, int v, int layer, KvDesc& kd, QoDesc& qd) {
    const int b = v >> 7, h = (v >> 5) & 3, qb = v & 31, qmoff = layer == 0 ? 3072 : 4608;
    const bf16_t* mkv = WSP(bf16_t, WS_MKV) + (size_t)layer * 512 * NKV + h * 128;
    kd.kbase = mkv; kd.vbase = mkv + 512; kd.row0 = (long)b * 256; kd.rstep = 1; kd.pitch = NKV; kd.key_lo = 0;
    qd.qbase = WSP(bf16_t, WS_Z) + qmoff + h * 128; qd.row0 = (long)b * SEQ + 128 * qb; qd.rstep = 1; qd.obase = WSP(bf16_t, WS_MIX) + MIXW + h * 128; qd.lsebase = nullptr;
    qd.banded = 0; qd.dil = 1; qd.head = 0;
}
__device__ __forceinline__ void swa_unit_desc(ArgsP A, int u, KvDesc& kd, QoDesc& qd) {
    const int b = u / 384, H = (u % 384) >> 5, idx = u & 31, g = H >> 2, dil = 1 << (2 * g), r = idx & (dil - 1), qb = idx >> (2 * g);
    const bf16_t* Z = WSP(bf16_t, WS_Z);
    kd.kbase = Z + MIXW + H * 128; kd.vbase = Z + 2 * MIXW + H * 128; kd.row0 = (long)b * SEQ + (long)(128 * qb - 128) * dil + r; kd.rstep = dil; kd.pitch = ZP; kd.key_lo = qb == 0 ? 128 : 0;
    qd.qbase = Z + H * 128; qd.row0 = (long)b * SEQ + (long)(128 * qb) * dil + r; qd.rstep = dil; qd.obase = WSP(bf16_t, WS_MIX) + H * 128; qd.lsebase = WSP(float, WS_LSE) + H;
    qd.banded = 1; qd.dil = dil; qd.head = H;
}
__device__ __forceinline__ void q_issue(const QoDesc& qd, int tid, bf16x8 (&qf)[4]) {
    const int lane = tid & 63, w = __builtin_amdgcn_readfirstlane(tid >> 6), fr = lane & 15, fq = lane >> 4;
    const long qrow = qd.row0 + (long)(16 * w + fr) * qd.rstep;
    const bf16_t* qp = qd.qbase + (size_t)qrow * ZP + 8 * fq;
#pragma unroll
    for (int k4 = 0; k4 < 4; ++k4) qf[k4] = *(const bf16x8*)(qp + 32 * k4);
}
__device__ __forceinline__ void build_bias_tables(LAS unsigned char* lds, int tid, const float* rel_bias) {
    LAS float* tab = (LAS float*)(lds + LDS_TAB);
    for (int i = tid; i < 12 * 192; i += 512) { const int H = i / 192, j = i % 192 - 32, dil = 1 << (2 * (H >> 2));
        tab[i] = (j >= 0 && j <= 128) ? rel_bias[t5_bucket(j * dil) * 12 + H] * LOG2E : -1e30f; }
}
__device__ __forceinline__ void attn_unit_run(LAS unsigned char* lds, int tid, const QoDesc& qd, int key_lo, u32x4 (&kk)[8], u32x4 (&vv)[8], bf16x8 (&qf)[4],
                                              const bool has_next, const KvDesc nxt, const QoDesc nxtq) {
    const int lane = tid & 63, w = __builtin_amdgcn_readfirstlane(tid >> 6), fr = lane & 15, fq = lane >> 4;
    __syncthreads();
    kv_commit(lds, tid, key_lo, kk, vv);
    bf16x8 qc[4];
#pragma unroll
    for (int k4 = 0; k4 < 4; ++k4) qc[k4] = qf[k4];
    if (has_next) { kv_issue(nxt, tid, kk, vv); q_issue(nxtq, tid, qf); }
    __syncthreads();
    const long qrow = qd.row0 + (long)(16 * w + fr) * qd.rstep;
    bf16_t* orow = qd.obase + (size_t)qrow * DM + 4 * fq;
    float* lsep = qd.lsebase != nullptr ? qd.lsebase + (size_t)qrow * 12 : nullptr;
    if (qd.banded) attn_compute<true>(lds, lane, w, qc, key_lo, orow, lsep, (const LAS float*)(lds + LDS_TAB) + qd.head * 192);
    else attn_compute<false>(lds, lane, w, qc, key_lo, orow, lsep, (const LAS float*)(lds + LDS_TAB));
}
__device__ __forceinline__ void sample_mem_attn(LAS unsigned char* lds, int layer) {
    ArgsP A = args_ptr(); const int bid = blockIdx.x, G = gridDim.x;
    int tid = threadIdx.x; asm volatile("" : "+v"(tid));
    const int qmoff = layer == 0 ? 3072 : 4608;
    for (int it = G - 1 - 96 - bid; it >= 0 && it < 32; it += G) {
        const int s = it >> 2, h = it & 3;
        LAS float* scr = (LAS float*)lds; LAS float* og = scr + 2560;
        __syncthreads();
        const float* cm = A->in[3] + (size_t)(layer * 8 + s) * 256 * 1024;
        auto kf = [=](int j) -> const float* { return cm + (size_t)j * 1024 + h * 128; };
        auto vf = [=](int j) -> const float* { return cm + (size_t)j * 1024 + 512 + h * 128; };
        (void)sample_attend(scr, WSP(float, WS_ZS) + (size_t)s * ZP + qmoff + h * 128, 256, kf, vf, (const LAS float*)nullptr, og);
        if (tid < 128) WSP(bf16_t, WS_MIX)[(size_t)(TP + s) * DM + MIXW + h * 128 + tid] = (bf16_t)f2bf(og[tid]);
        __syncthreads();
    }
}
__device__ __forceinline__ void phase_mix_a(LAS unsigned char* lds) {
    ArgsP A = args_ptr(); const int bid = blockIdx.x, G = gridDim.x;
    int tid = threadIdx.x; asm volatile("" : "+v"(tid));
    const int lane = tid & 63, wave = __builtin_amdgcn_readfirstlane(tid >> 6);
    const float* ZS = WSP(float, WS_ZS); const float* n_v_a = A->in[15]; const float* w_sp = A->in[16]; const float* b_sp = A->in[17]; bf16_t* MIX = WSP(bf16_t, WS_MIX); float* out = A->out;
    for (int it = G - 1 - bid; it < TSMP; it += G) {
        LAS float* red = (LAS float*)lds; const int s = it;
        __syncthreads();
        float vv[3], uu[3], ss = 0.f;
#pragma unroll
        for (int i = 0; i < 3; ++i) { const int c = tid + 512 * i; uu[i] = gelu_tanh(ZS[(size_t)s * ZP + c]); vv[i] = gelu_tanh(ZS[(size_t)s * ZP + MIXW + c]); ss += vv[i] * vv[i]; }
        ss = wave_sum(ss); if (lane == 0) red[wave] = ss;
        __syncthreads();
        float tot = 0.f;
#pragma unroll
        for (int i = 0; i < 8; ++i) tot += red[i];
        const float rstd = 1.0f / sqrtf(tot * (1.0f / MIXW) + EPS);
#pragma unroll
        for (int i = 0; i < 3; ++i) { const int c = tid + 512 * i, g = c / 384; const float vn = vv[i] * rstd * n_v_a[c];
            out[OUT_CHV + (size_t)s * MIXW + c] = vn;
            const float sg = w_sp[(size_t)g * 16384] * vn + b_sp[g * 128];
            MIX[(size_t)(TP + s) * DM + c] = (bf16_t)f2bf(uu[i] * sg); }
    }
    sample_mem_attn(lds, 0);
    __syncthreads();
    for (int u = bid; u < 256; u += G) {
        KvDesc kd; QoDesc qd; mem_unit_desc(A, u, 0, kd, qd);
        u32x4 kk[8], vv[8]; bf16x8 qf[4]; GateRegs R;
        gate_issue(tid, u >> 7, (u >> 2) & 31, u & 3, WSP(bf16_t, WS_Z), WSP(float, WS_VSS), A->in[16], A->in[15], R);
        kv_issue(kd, tid, kk, vv); q_issue(qd, tid, qf);
        gate_run(lds, tid, u >> 7, (u >> 2) & 31, u & 3, R, WSP(bf16_t, WS_Z), A->in[17], WSP(bf16_t, WS_MIX));
        attn_unit_run(lds, tid, qd, kd.key_lo, kk, vv, qf, false, kd, qd);
    }
}
__device__ __forceinline__ void phase_mix_b1(LAS unsigned char* lds) {
    ArgsP A = args_ptr(); const int bid = blockIdx.x, G = gridDim.x;
    int tid = threadIdx.x; asm volatile("" : "+v"(tid));
    KvDesc kd{}, kn{}; QoDesc qd{}, qn{};
    u32x4 kk[8], vv[8]; bf16x8 qf[4];
    int u = bid;
    if (u < 1024) { if (u < 768) swa_unit_desc(A, u, kd, qd); else mem_unit_desc(A, u - 768, 1, kd, qd); kv_issue(kd, tid, kk, vv); q_issue(qd, tid, qf); }
    build_bias_tables(lds, tid, A->in[7]);
#pragma unroll 1
    for (; u < 1024; u += G) {
        const int un = u + G; const bool has_next = un < 1024;
        if (has_next) { if (un < 768) swa_unit_desc(A, un, kn, qn); else mem_unit_desc(A, un - 768, 1, kn, qn); }
        attn_unit_run(lds, tid, qd, kd.key_lo, kk, vv, qf, has_next, kn, qn);
        kd = kn; qd = qn;
    }
}
__device__ __forceinline__ void phase_mix_b2(LAS unsigned char* lds) {
    ArgsP A = args_ptr(); const int bid = blockIdx.x, G = gridDim.x;
    int tid = threadIdx.x; asm volatile("" : "+v"(tid));
    const int lane = tid & 63, wave = __builtin_amdgcn_readfirstlane(tid >> 6), gw = bid * 8 + wave, NGW = G * 8;
    bf16_t* MIX = WSP(bf16_t, WS_MIX); const float* LSE = WSP(float, WS_LSE);
    for (int row = gw; row < TP; row += NGW) {
        const float* lp = LSE + (size_t)row * 12;
#pragma unroll
        for (int i = 0; i < 3; ++i) { const int col = 8 * (lane + 64 * i), H = col >> 7, g = H >> 2, hl = H & 3;
            const float l0 = lp[hl], l1 = lp[4 + hl], l2 = lp[8 + hl], mm = fmaxf(l0, fmaxf(l1, l2));
            const float e0 = __expf(l0 - mm), e1 = __expf(l1 - mm), e2 = __expf(l2 - mm);
            const float al = (g == 0 ? e0 : (g == 1 ? e1 : e2)) / (e0 + e1 + e2);
            u32x4 wv = *(u32x4*)(MIX + (size_t)row * DM + col);
            wv.x = cvt_pk_bf16(bf_lo(wv.x) * al, bf_hi(wv.x) * al); wv.y = cvt_pk_bf16(bf_lo(wv.y) * al, bf_hi(wv.y) * al);
            wv.z = cvt_pk_bf16(bf_lo(wv.z) * al, bf_hi(wv.z) * al); wv.w = cvt_pk_bf16(bf_lo(wv.w) * al, bf_hi(wv.w) * al);
            *(u32x4*)(MIX + (size_t)row * DM + col) = wv; }
    }
    { const int nw = G > 128 ? G - 128 : G, wk = bid < nw ? bid : -1;
      if (wk >= 0) { const bf16_t* Z = WSP(bf16_t, WS_Z); float* o0 = A->out + OUT_W128P;
        for (int i = wk * 512 + tid; i < 688128; i += nw * 512) {
            const int g = i < 32768 ? 0 : (i < 163840 ? 1 : 2), ig = i - (g == 0 ? 0 : (g == 1 ? 32768 : 163840)), W = 128 << (2 * g);
            const int c8 = ig & 63, kv = (ig >> 6) & 1, tr = (ig >> 7) & (W - 1), b = (ig >> 7) / W;
            const u32x4 wv = *(const u32x4*)(Z + (size_t)(b * SEQ + (SEQ - W) + tr) * ZP + MIXW + kv * MIXW + g * 512 + c8 * 8);
            float* dst = o0 + (size_t)2048 * ((W - 128) / 3) + (size_t)ig * 8;
            *(f32x4*)dst = (f32x4){bf_lo(wv.x), bf_hi(wv.x), bf_lo(wv.y), bf_hi(wv.y)}; *(f32x4*)(dst + 4) = (f32x4){bf_lo(wv.z), bf_hi(wv.z), bf_lo(wv.w), bf_hi(wv.w)}; } } }
    const float* rel_bias = A->in[7]; const float* ZS = WSP(float, WS_ZS);
    for (int it = G - 1 - bid; it < 96; it += G) {
        const int s = it / 12, H = it % 12, g = H >> 2, hl = H & 3, dil = 1 << (2 * g), W = 128 << (2 * g);
        LAS float* scr = (LAS float*)lds; LAS float* btab = scr + 2400; LAS float* og = scr + 2560;
        __syncthreads();
        for (int j = tid; j <= 128; j += 512) btab[j] = rel_bias[t5_bucket(j * dil) * 12 + H] * LOG2E;
        __syncthreads();
        const float* cw = A->in[4 + g];
        const float* zrow = ZS + (size_t)s * ZP;
        auto kf = [=](int j) -> const float* { return j == 0 ? zrow + MIXW + H * 128 : cw + ((size_t)(s * W + (W - j * dil)) * 2 + 0) * 512 + hl * 128; };
        auto vf = [=](int j) -> const float* { return j == 0 ? zrow + 2 * MIXW + H * 128 : cw + ((size_t)(s * W + (W - j * dil)) * 2 + 1) * 512 + hl * 128; };
        const float lg = sample_attend(scr, zrow + H * 128, 129, kf, vf, btab, og);
        if (tid < 128) MIX[(size_t)(TP + s) * DM + H * 128 + tid] = (bf16_t)f2bf(og[tid]);
        if (tid == 0) WSP(float, WS_LSE)[(size_t)TP * 12 + s * 12 + H] = lg;
        __syncthreads();
    }
    sample_mem_attn(lds, 1);
}
__device__ __forceinline__ void phase_out(LAS unsigned char* lds, int layer) {
    ArgsP A = args_ptr(); const int bid = blockIdx.x, G = gridDim.x;
    bf16_t* MIX = WSP(bf16_t, WS_MIX); bf16_t* OB = WSP(bf16_t, WS_O); const bf16_t* W = WSP(bf16_t, WS_WOUT) + (size_t)layer * DM * DM;
    pg8::Gemm g{MIX, W, TP, DM, DM}; pg8::StaticOrder S; S.init(TP, DM, G, bid); pg8::EpiPlain E{OB, DM};
    pg8::gemm_phase<pg8::EpiPlain, false, true>(lds, g, S, E);
    sample_gemv<1, DM>(lds, MIX + (size_t)TP * DM, DM, W, DM, G - 1 - bid, G, nullptr, OB + (size_t)TP * DM, DM, nullptr, nullptr, layer == 1 ? WSP(float, WS_LSE) + (size_t)TP * 12 : nullptr);
}
__device__ __forceinline__ void phase_up(LAS unsigned char* lds, int layer) {
    ArgsP A = args_ptr(); const int bid = blockIdx.x, G = gridDim.x;
    bf16_t* HN = WSP(bf16_t, WS_HN); bf16_t* ACT = WSP(bf16_t, WS_ACT); const bf16_t* W = WSP(bf16_t, WS_WUP) + (size_t)layer * NUP * DM;
    pg8::Gemm g{HN, W, TP, NUP, DM}; pg8::StaticOrder S; S.init(TP, NUP, G, bid); pg8::EpiSwiglu E{ACT, WSP(float, WS_RS)};
    pg8::gemm_phase<pg8::EpiSwiglu, true, true>(lds, g, S, E);
    sample_gemv<2, DM>(lds, HN + (size_t)TP * DM, DM, W, NUP, G - 1 - bid, G, nullptr, ACT + (size_t)TP * DFF, DFF, nullptr, WSP(float, WS_RS) + TP);
    if (G == 256) convert_tail(lds, A, layer == 0 ? 2 : 4, 128);
}
__device__ __forceinline__ void phase_down(LAS unsigned char* lds, int layer) {
    ArgsP A = args_ptr(); const int bid = blockIdx.x, G = gridDim.x;
    bf16_t* ACT = WSP(bf16_t, WS_ACT); bf16_t* OB = WSP(bf16_t, WS_O); const bf16_t* W = WSP(bf16_t, WS_WDN) + (size_t)layer * DM * DFF;
    pg8::Gemm g{ACT, W, TP, DM, DFF}; pg8::StaticOrder S; S.init(TP, DM, G, bid); pg8::EpiPlain E{OB, DM};
    pg8::gemm_phase<pg8::EpiPlain, false, true>(lds, g, S, E);
    sample_gemv<1, DFF>(lds, ACT + (size_t)TP * DFF, DFF, W, DM, G - 1 - bid, G, nullptr, OB + (size_t)TP * DM, DM, nullptr, nullptr);
}
__device__ __forceinline__ void phase_norm(int which) {
    ArgsP A = args_ptr();
    int tid = threadIdx.x; asm volatile("" : "+v"(tid));
    const int lane = tid & 63, wave = __builtin_amdgcn_readfirstlane(tid >> 6), gw = blockIdx.x * 8 + wave, NGW = gridDim.x * 8;
    const int layer = which >> 1;
    float* Y = A->out + OUT_Y; const bf16_t* OB = WSP(bf16_t, WS_O); bf16_t* YB = WSP(bf16_t, WS_HN); float* RS = WSP(float, WS_RS);
    const float* gpost = ((which & 1) ? A->in[11] : A->in[9]) + layer * DM;
    const float* x_prompt = A->in[0]; const float* x_sample = A->in[1];
    for (int r = gw; r < TP + TSMP; r += NGW) {
        if (which == 0) { const float* base = r < TP ? x_prompt + (size_t)r * DM : x_sample + (size_t)(r - TP) * DM;
            norm_row<1>(base, YB + (size_t)r * DM, OB + (size_t)r * DM, gpost, RS + r, nullptr, lane); }
        else if (which == 3) norm_row<3>(nullptr, YB + (size_t)r * DM, OB + (size_t)r * DM, gpost, nullptr, Y + (size_t)r * DM, lane);
        else norm_row<2>(nullptr, YB + (size_t)r * DM, OB + (size_t)r * DM, gpost, RS + r, nullptr, lane);
    }
}

__global__ void __launch_bounds__(512, 2) fwd_megakernel(Args args) {
    extern __shared__ __attribute__((aligned(16))) unsigned char lds_raw[];
    LAS unsigned char* lds = (LAS unsigned char*)lds_raw;
    volatile LAS unsigned* bst = (volatile LAS unsigned*)(lds + LDS_BYTES - 64);
    if (threadIdx.x < 16) bst[threadIdx.x] = 0u;
    __syncthreads();
    const XcdBarrier bar = xcd_barrier_post((unsigned*)args.ws, bst);
#define GRID_SYNC() xcd_barrier(bar)
    phase_prologue(lds);
    GRID_SYNC();
    phase_in_a(lds);
    GRID_SYNC();
    phase_mix_a(lds);
    GRID_SYNC();
    phase_out(lds, 0);
    GRID_SYNC();
    phase_norm(0);
    GRID_SYNC();
    phase_up(lds, 0);
    GRID_SYNC();
    phase_down(lds, 0);
    GRID_SYNC();
    phase_norm(1);
    GRID_SYNC();
    phase_in_b(lds);
    GRID_SYNC();
    phase_mix_b1(lds);
    GRID_SYNC();
    phase_mix_b2(lds);
    GRID_SYNC();
    phase_out(lds, 1);
    GRID_SYNC();
    phase_norm(2);
    GRID_SYNC();
    phase_up(lds, 1);
    GRID_SYNC();
    phase_down(lds, 1);
    GRID_SYNC();
    phase_norm(3);
#undef GRID_SYNC
}

extern "C" void kernel_launch(void* const* d_in, const int* in_sizes, int n_in, void* d_out, int out_size, void* d_ws, size_t ws_size, hipStream_t stream) {
    static int grid = 0;
    if (grid == 0) {
        if (n_in != 22 || (size_t)out_size != OUT_TOTAL || ws_size < WS_END) { fprintf(stderr, "kernel_launch: unexpected shapes (n_in %d, out %d, ws %zu)\n", n_in, out_size, ws_size); grid = -1; return; }
        int dev = 0, cus = 0, per_cu = 0;
        if (hipGetDevice(&dev) != hipSuccess || hipDeviceGetAttribute(&cus, hipDeviceAttributeMultiprocessorCount, dev) != hipSuccess) { grid = -1; return; }
        if (hipFuncSetAttribute((const void*)fwd_megakernel, hipFuncAttributeMaxDynamicSharedMemorySize, LDS_BYTES) != hipSuccess) { fprintf(stderr, "kernel_launch: hipFuncSetAttribute failed\n"); grid = -1; return; }
        if (hipOccupancyMaxActiveBlocksPerMultiprocessor(&per_cu, (const void*)fwd_megakernel, 512, LDS_BYTES) != hipSuccess || per_cu < 1) { fprintf(stderr, "kernel_launch: occupancy query says %d\n", per_cu); (void)hipGetLastError(); per_cu = 1; }
        grid = cus;
    }
    if (grid < 0) return;
    if (hipMemsetAsync(d_ws, 0, 16384, stream) != hipSuccess) { fprintf(stderr, "kernel_launch: memset of the barrier words failed\n"); return; }
    Args a{};
    for (int i = 0; i < 22; ++i) a.in[i] = (const float*)d_in[i];
    a.out = (float*)d_out; a.ws = (unsigned char*)d_ws;
    void* kargs[] = {&a};
    hipError_t e = hipLaunchCooperativeKernel((const void*)fwd_megakernel, dim3(grid), dim3(512), kargs, LDS_BYTES, stream);
    if (e != hipSuccess) fprintf(stderr, "kernel_launch: cooperative launch failed: %s (grid %d)\n", hipGetErrorString(e), grid);
}
```

```cpp
#include <hip/hip_runtime.h>
#include <cstdio>
#include <cstdint>

#define LAS __attribute__((address_space(3)))
typedef unsigned short bf16_t;
typedef short bf16x8 __attribute__((ext_vector_type(8)));
typedef short s16x4 __attribute__((ext_vector_type(4)));
typedef float f32x4 __attribute__((ext_vector_type(4)));
typedef float f32x2 __attribute__((ext_vector_type(2)));
typedef unsigned u32x4 __attribute__((ext_vector_type(4)));
typedef unsigned u32x2 __attribute__((ext_vector_type(2)));

constexpr int DM = 2048, TP = 8192, TSMP = 8, TROWS = TP + 16, SEQ = 4096;
constexpr int MIXW = 1536, NA = 3584, NB = 5120, DFF = 5632, NUP = 11264, NKV = 1024;
constexpr int ZP = 5120;
constexpr float EPS = 1e-6f;
constexpr float LOG2E = 1.4426950408889634f, LN2 = 0.6931471805599453f;
constexpr float QSCALE = 0.08838834764831845f * 1.4426950408889634f;

constexpr size_t MiB = 1u << 20;
constexpr size_t WS_WMKV = 1 * MiB;
constexpr size_t WS_WINA = 9 * MiB;
constexpr size_t WS_WINB = 23 * MiB;
constexpr size_t WS_WOUT = 43 * MiB;
constexpr size_t WS_WUP = 59 * MiB;
constexpr size_t WS_WDN = 147 * MiB;
constexpr size_t WS_HN = 191 * MiB;
constexpr size_t WS_HM = 224 * MiB;
constexpr size_t WS_MKV = 228 * MiB;
constexpr size_t WS_Z = 230 * MiB;
constexpr size_t WS_ZS = 310 * MiB;
constexpr size_t WS_VSS = 311 * MiB;
constexpr size_t WS_MIX = 312 * MiB;
constexpr size_t WS_LSE = 345 * MiB;
constexpr size_t WS_RS = 345 * MiB + 512 * 1024;
constexpr size_t WS_O = 346 * MiB;
constexpr size_t WS_ACT = 379 * MiB;
constexpr size_t WS_END = 468 * MiB;

constexpr size_t OUT_Y = 0;
constexpr size_t OUT_MKV = 16793600;
constexpr size_t OUT_CHV = OUT_MKV + 1048576;
constexpr size_t OUT_W128P = OUT_CHV + 12288;
constexpr size_t OUT_W512P = OUT_W128P + 262144;
constexpr size_t OUT_W2048P = OUT_W512P + 1048576;
constexpr size_t OUT_W128S = OUT_W2048P + 4194304;
constexpr size_t OUT_W512S = OUT_W128S + 8192;
constexpr size_t OUT_W2048S = OUT_W512S + 8192;
constexpr size_t OUT_TOTAL = OUT_W2048S + 8192;

constexpr int LDS_BYTES = 147456;
constexpr int LDS_TAB = 131072;

__device__ __forceinline__ unsigned cvt_pk_bf16(float lo, float hi) { unsigned r; asm volatile("v_cvt_pk_bf16_f32 %0, %1, %2" : "=v"(r) : "v"(lo), "v"(hi)); return r; }
__device__ __forceinline__ float bf_lo(unsigned w) { return __uint_as_float(w << 16); }
__device__ __forceinline__ float bf_hi(unsigned w) { return __uint_as_float(w & 0xffff0000u); }
__device__ __forceinline__ float wave_sum(float v) {
#pragma unroll
    for (int o = 1; o < 64; o <<= 1) v += __shfl_xor(v, o);
    return v;
}
__device__ __forceinline__ float wave_max(float v) {
#pragma unroll
    for (int o = 1; o < 64; o <<= 1) v = fmaxf(v, __shfl_xor(v, o));
    return v;
}
__device__ __forceinline__ float gelu_tanh(float x) {
    const float t = x * x;
    const float u2 = x * (1.5957691216057308f + 0.07135481627260024f * t);
    const float e = __builtin_amdgcn_exp2f(-LOG2E * u2);
    return x * __builtin_amdgcn_rcpf(1.0f + e);
}
__device__ __forceinline__ float silu_f(float x) {
    const float e = __builtin_amdgcn_exp2f(-LOG2E * x);
    return x * __builtin_amdgcn_rcpf(1.0f + e);
}
__device__ __forceinline__ int t5_bucket(int d) {
    if (d < 16) return d;
    int b = 16;
    b += (d >= 22); b += (d >= 30); b += (d >= 40); b += (d >= 54); b += (d >= 73); b += (d >= 99); b += (d >= 134); b += (d >= 182);
    b += (d >= 246); b += (d >= 332); b += (d >= 450); b += (d >= 609); b += (d >= 825); b += (d >= 1117); b += (d >= 1513);
    return b;
}
__device__ __forceinline__ unsigned off_b(unsigned row, unsigned ch) { return 256u * row + 16u * (ch ^ (((row & 3) << 2) | ((row >> 2) & 3))); }
__device__ __forceinline__ unsigned tr16_addr(unsigned lane, unsigned c, unsigned ks, unsigned t) {
    const unsigned g = lane >> 4, q = (lane & 15) >> 2, p = lane & 3;
    return off_b(32 * ks + 8 * g + 4 * t + q, 2 * c + (p >> 1)) + 8 * (p & 1);
}
typedef short v4i16_t __attribute__((ext_vector_type(4)));
__device__ __forceinline__ s16x4 tr_read(LAS unsigned char* p) { return __builtin_bit_cast(s16x4, __builtin_amdgcn_ds_read_tr16_b64_v4i16((LAS v4i16_t*)p)); }

namespace pg8 {
constexpr int BM = 256, BK = 64, HALF = 128, HTB = HALF * BK * 2, STAGE_BYTES = 8 * HTB, NXCD = 8, WGM = 8;
__host__ __device__ __forceinline__ int lds_byte(int r, int c) { const int st = (r >> 4) * 2 + (c >> 5), rr = r & 15, cc = c & 31, ob = rr * 64 + cc * 2; return st * 1024 + (ob ^ (((ob >> 9) & 1) << 5)); }
__host__ __device__ __forceinline__ void stage_rc(int b, int& R, int& C) { const int st = b / 1024, sb = b % 1024, swz = sb ^ (((sb >> 9) & 1) << 5); R = (st >> 1) * 16 + swz / 64; C = (st & 1) * 32 + (swz % 64) / 2; }
__host__ __device__ __forceinline__ int perm32(int rho) { const int n = rho >> 4, i = rho & 15; return 8 * (i >> 2) + 4 * n + (i & 3); }

struct Unit { int pm, pn; };
struct Gemm { const bf16_t* A; const bf16_t* Bt; int M, N, K; };

struct StaticOrder {
    int nM, nN, nwg, G, c;
    __host__ __device__ void init(int M, int N, int G_, int c_) { nM = M / BM; nN = N / BM; nwg = nM * nN; G = G_; c = c_; }
    __host__ __device__ bool next(int i, Unit& u) const {
        const long L = (long)i * G + c; if (L >= nwg) return false;
        int wgid = (int)L; { const int q = nwg / NXCD, r = nwg % NXCD, xcd = wgid % NXCD, off = wgid / NXCD; wgid = (xcd < r ? xcd * (q + 1) : r * (q + 1) + (xcd - r) * q) + off; }
        const int nig = WGM * nN, gid = wgid / nig, fm = gid * WGM, gsz = (nM - fm) < WGM ? (nM - fm) : WGM;
        u.pm = fm + ((wgid % nig) % gsz); u.pn = (wgid % nig) / gsz; return true;
    }
};

template <class Epi, bool ALIGN_EPI, bool SP2>
__device__ __forceinline__ void gemm_phase(LAS unsigned char* lds, const Gemm g, const StaticOrder& S, const Epi& E) {
    int tid = threadIdx.x; asm volatile("" : "+v"(tid));
    const int wid = __builtin_amdgcn_readfirstlane(tid >> 6), lane = tid & 63, wr = wid >> 2, wc = wid & 3, fr = lane & 15, fq = lane >> 4;
    const int K = g.K, nt = K / BK;
    unsigned voffA[2], voffB[2];
#pragma unroll
    for (int i = 0; i < 2; ++i) { int R, C; stage_rc(tid * 16 + i * 8192, R, C); const int Rb = (R & ~31) + perm32(R & 31);
        voffA[i] = (unsigned)(R * K + C) * 2u; voffB[i] = (unsigned)(Rb * K + C) * 2u; }
    const size_t kstep = (size_t)(BK * 2);
    const size_t hstep = (size_t)HALF * K * 2;
    const size_t tstep = 2 * hstep;
    const unsigned ldsw = (unsigned)wid * 1024u;
    const int aoff = lds_byte(wr * 64 + fr, fq * 8), boff = lds_byte(wc * 32 + fr, fq * 8);
#define PG8_SA(b, h) (((b) * 2 + (h)) * HTB)
#define PG8_SB(b, h) ((4 + (b) * 2 + (h)) * HTB)
#define PG8_STAGE(bufoff, gbase, voff) do { _Pragma("unroll") for (int _i = 0; _i < 2; ++_i) \
        __builtin_amdgcn_global_load_lds((const unsigned*)((const char*)(gbase) + (voff)[_i]), (LAS unsigned*)(lds + (bufoff) + ldsw + _i * 8192), 16, 0, 0); } while (0)
#define PG8_LDA(dst, b, h) do { _Pragma("unroll") for (int m = 0; m < 4; ++m) _Pragma("unroll") for (int k = 0; k < 2; ++k) dst[m][k] = *(const LAS bf16x8*)(lds + PG8_SA(b, h) + aoff + m * 2048 + k * 1024); } while (0)
#define PG8_LDB(dst, b, h) do { _Pragma("unroll") for (int n = 0; n < 2; ++n) _Pragma("unroll") for (int k = 0; k < 2; ++k) dst[n][k] = *(const LAS bf16x8*)(lds + PG8_SB(b, h) + boff + n * 2048 + k * 1024); } while (0)
#define PG8_MMA(ai, bj, At, Bt) do { __builtin_amdgcn_s_setprio(1); _Pragma("unroll") for (int m = 0; m < 4; ++m) _Pragma("unroll") for (int n = 0; n < 2; ++n) _Pragma("unroll") for (int k = 0; k < 2; ++k) \
        acc[ai][bj][m][n] = __builtin_amdgcn_mfma_f32_16x16x32_bf16(Bt[n][k], At[m][k], acc[ai][bj][m][n], 0, 0, 0); __builtin_amdgcn_s_setprio(0); } while (0)
#define PG8_WAIT_V(n) asm volatile("s_waitcnt vmcnt(" #n ")" ::: "memory")
#define PG8_WAIT_L(n) asm volatile("s_waitcnt lgkmcnt(" #n ")" ::: "memory")
#define PG8_BAR __builtin_amdgcn_s_barrier()
#define PG8_SCHED __builtin_amdgcn_sched_barrier(0)
    Unit cur, nxt; int ui = 0;
    if (!S.next(0, cur)) return;
    f32x4 acc[2][2][4][2];
#pragma unroll
    for (int a = 0; a < 2; ++a)
#pragma unroll
        for (int b = 0; b < 2; ++b)
#pragma unroll
            for (int m = 0; m < 4; ++m)
#pragma unroll
                for (int n = 0; n < 2; ++n) acc[a][b][m][n] = (f32x4){0.f, 0.f, 0.f, 0.f};
    bf16x8 At[4][2], B0[2][2], B1[2][2];
    const char* cA = (const char*)g.A + (size_t)cur.pm * tstep; const char* cB = (const char*)g.Bt + (size_t)cur.pn * tstep;
    if constexpr (SP2) {
        PG8_STAGE(PG8_SB(0, 0), cB, voffB); PG8_STAGE(PG8_SB(0, 1), cB + hstep, voffB); PG8_STAGE(PG8_SA(0, 0), cA, voffA); PG8_STAGE(PG8_SA(0, 1), cA + hstep, voffA);
        if (wr == 1) PG8_BAR;
        PG8_WAIT_V(2); PG8_BAR;
        PG8_STAGE(PG8_SB(1, 0), cB + kstep, voffB); PG8_STAGE(PG8_SA(1, 0), cA + kstep, voffA); PG8_STAGE(PG8_SB(1, 1), cB + hstep + kstep, voffB);
        PG8_WAIT_V(6); PG8_BAR;
    } else {
        PG8_STAGE(PG8_SB(0, 0), cB, voffB); PG8_STAGE(PG8_SA(0, 0), cA, voffA); PG8_STAGE(PG8_SB(0, 1), cB + hstep, voffB); PG8_STAGE(PG8_SA(0, 1), cA + hstep, voffA);
        if (wr == 1) PG8_BAR;
        PG8_WAIT_V(4); PG8_BAR;
        PG8_STAGE(PG8_SB(1, 0), cB + kstep, voffB); PG8_STAGE(PG8_SA(1, 0), cA + kstep, voffA); PG8_STAGE(PG8_SB(1, 1), cB + hstep + kstep, voffB);
        PG8_WAIT_V(6); PG8_BAR;
    }
    for (;;) {
        const typename Epi::Pre pre = E.prefetch(cur, wr, fr);
        const bool has_next = S.next(ui + 1, nxt);
        const char* nA = has_next ? (const char*)g.A + (size_t)nxt.pm * tstep : cA; const char* nB = has_next ? (const char*)g.Bt + (size_t)nxt.pn * tstep : cB;
        for (int t = 0; t < nt; t += 2) {
            const bool last = (t == nt - 2);
            const char* a1 = cA + (size_t)(t + 1) * kstep;
            const char* a2 = last ? nA : cA + (size_t)(t + 2) * kstep; const char* b2 = last ? nB : cB + (size_t)(t + 2) * kstep;
            const char* a3 = a2 + kstep; const char* b3 = b2 + kstep;
            if constexpr (SP2) {
            PG8_LDB(B0, 0, 0); PG8_LDB(B1, 0, 1); PG8_SCHED; PG8_LDA(At, 0, 0); PG8_STAGE(PG8_SA(1, 1), a1 + hstep, voffA);
            PG8_WAIT_V(8); PG8_WAIT_L(0); PG8_BAR; PG8_MMA(0, 0, At, B0); PG8_MMA(0, 1, At, B1); PG8_BAR; PG8_SCHED;
            PG8_LDA(At, 0, 1); PG8_STAGE(PG8_SB(0, 0), b2, voffB); PG8_STAGE(PG8_SB(0, 1), b2 + hstep, voffB); PG8_STAGE(PG8_SA(0, 0), a2, voffA);
            PG8_WAIT_V(8); PG8_WAIT_L(0); PG8_BAR; PG8_MMA(1, 0, At, B0); PG8_MMA(1, 1, At, B1); PG8_BAR; PG8_SCHED;
            PG8_LDB(B0, 1, 0); PG8_LDB(B1, 1, 1); PG8_SCHED; PG8_LDA(At, 1, 0); PG8_STAGE(PG8_SA(0, 1), a2 + hstep, voffA);
            PG8_WAIT_V(8); PG8_WAIT_L(0); PG8_BAR; PG8_MMA(0, 0, At, B0); PG8_MMA(0, 1, At, B1); PG8_BAR; PG8_SCHED;
            PG8_LDA(At, 1, 1); PG8_STAGE(PG8_SB(1, 0), b3, voffB); PG8_STAGE(PG8_SB(1, 1), b3 + hstep, voffB); PG8_STAGE(PG8_SA(1, 0), a3, voffA);
            PG8_WAIT_V(8); PG8_WAIT_L(0); PG8_BAR; PG8_MMA(1, 0, At, B0); PG8_MMA(1, 1, At, B1); PG8_BAR; PG8_SCHED;
            } else {
            PG8_LDB(B0, 0, 0); PG8_SCHED; PG8_LDA(At, 0, 0); PG8_STAGE(PG8_SA(1, 1), a1 + hstep, voffA);
            PG8_WAIT_L(8); PG8_BAR; PG8_WAIT_L(0); PG8_MMA(0, 0, At, B0); PG8_BAR; PG8_SCHED;
            PG8_LDB(B1, 0, 1); PG8_STAGE(PG8_SB(0, 0), b2, voffB);
            PG8_BAR; PG8_WAIT_L(0); PG8_MMA(0, 1, At, B1); PG8_BAR;
            PG8_LDA(At, 0, 1); PG8_STAGE(PG8_SA(0, 0), a2, voffA);
            PG8_BAR; PG8_WAIT_L(0); PG8_MMA(1, 0, At, B0); PG8_BAR; PG8_SCHED;
            PG8_STAGE(PG8_SB(0, 1), b2 + hstep, voffB);
            PG8_WAIT_V(6); PG8_BAR; PG8_MMA(1, 1, At, B1); PG8_BAR;
            PG8_LDB(B0, 1, 0); PG8_SCHED; PG8_LDA(At, 1, 0); PG8_STAGE(PG8_SA(0, 1), a2 + hstep, voffA);
            PG8_WAIT_L(8); PG8_BAR; PG8_WAIT_L(0); PG8_MMA(0, 0, At, B0); PG8_BAR; PG8_SCHED;
            PG8_LDB(B1, 1, 1); PG8_STAGE(PG8_SB(1, 0), b3, voffB);
            PG8_BAR; PG8_WAIT_L(0); PG8_MMA(0, 1, At, B1); PG8_BAR;
            PG8_LDA(At, 1, 1); PG8_STAGE(PG8_SA(1, 0), a3, voffA);
            PG8_BAR; PG8_WAIT_L(0); PG8_MMA(1, 0, At, B0); PG8_BAR; PG8_SCHED;
            PG8_STAGE(PG8_SB(1, 1), b3 + hstep, voffB);
            PG8_WAIT_V(6); PG8_BAR; PG8_MMA(1, 1, At, B1); PG8_BAR;
            }
        }
        if constexpr (ALIGN_EPI) { if (wr == 0) PG8_BAR; }
        E(acc, cur, wr, wc, fr, fq, pre);
        if (!has_next) break;
#pragma unroll
        for (int a = 0; a < 2; ++a)
#pragma unroll
            for (int b = 0; b < 2; ++b)
#pragma unroll
                for (int m = 0; m < 4; ++m)
#pragma unroll
                    for (int n = 0; n < 2; ++n) acc[a][b][m][n] = (f32x4){0.f, 0.f, 0.f, 0.f};
        cur = nxt; cA = nA; cB = nB; ++ui;
        if constexpr (ALIGN_EPI) { if (wr == 1) PG8_BAR; }
    }
    PG8_WAIT_V(0);
    if constexpr (!ALIGN_EPI) { if (wr == 0) PG8_BAR; }
    PG8_BAR;
#undef PG8_SA
#undef PG8_SB
#undef PG8_STAGE
#undef PG8_LDA
#undef PG8_LDB
#undef PG8_MMA
#undef PG8_WAIT_V
#undef PG8_WAIT_L
#undef PG8_BAR
#undef PG8_SCHED
}

typedef f32x4 Acc[2][2][4][2];
struct PreRs { float r[2][4]; };
struct PreNone { };
__device__ __forceinline__ PreRs load_rs(const float* rs, const Unit& u, int wr, int fr) { PreRs p; const int row0 = u.pm * BM + wr * 64 + fr;
#pragma unroll
    for (int ai = 0; ai < 2; ++ai)
#pragma unroll
        for (int m = 0; m < 4; ++m) p.r[ai][m] = rs[row0 + ai * HALF + m * 16];
    return p; }
__device__ __forceinline__ u32x4 pack8(const f32x4 a, const f32x4 b) { u32x4 w; w.x = cvt_pk_bf16(a[0], a[1]); w.y = cvt_pk_bf16(a[2], a[3]); w.z = cvt_pk_bf16(b[0], b[1]); w.w = cvt_pk_bf16(b[2], b[3]); return w; }

struct EpiInA {
    bf16_t* Z; float* VSS; const float* rs;
    typedef PreRs Pre; __device__ __forceinline__ Pre prefetch(const Unit& u, int wr, int fr) const { return load_rs(rs, u, wr, fr); }
    __device__ __forceinline__ void operator()(const Acc& acc, const Unit& u, int wr, int wc, int fr, int fq, const Pre& pre) const {
        const int row0 = u.pm * BM + wr * 64 + fr, col0 = u.pn * BM + wc * 32 + 8 * fq;
        const bool act = u.pn < 12, isv = (u.pn >= 6) && act;
#pragma unroll
        for (int ai = 0; ai < 2; ++ai)
#pragma unroll
            for (int m = 0; m < 4; ++m) {
                const int row = row0 + ai * HALF + m * 16; bf16_t* rowp = Z + (size_t)row * ZP + col0; float ss = 0.f; const float rsr = pre.r[ai][m];
#pragma unroll
                for (int bj = 0; bj < 2; ++bj) { f32x4 v0 = acc[ai][bj][m][0] * rsr, v1 = acc[ai][bj][m][1] * rsr;
                    if (act) {
#pragma unroll
                        for (int e = 0; e < 4; ++e) { v0[e] = gelu_tanh(v0[e]); v1[e] = gelu_tanh(v1[e]); ss += v0[e] * v0[e] + v1[e] * v1[e]; }
                    } else { v0 = v0 * QSCALE; v1 = v1 * QSCALE; }
                    *(u32x4*)(rowp + bj * HALF) = pack8(v0, v1); }
                if (isv) { ss += __shfl_xor(ss, 16); ss += __shfl_xor(ss, 32); if (fq == 0) VSS[(size_t)row * 24 + (u.pn - 6) * 4 + wc] = ss; }
            }
    }
};
struct EpiMkv {
    float* outf; bf16_t* outb; const float* rs;
    typedef PreRs Pre; __device__ __forceinline__ Pre prefetch(const Unit& u, int wr, int fr) const { return load_rs(rs, u, wr, fr); }
    __device__ __forceinline__ void operator()(const Acc& acc, const Unit& u, int wr, int wc, int fr, int fq, const Pre& pre) const {
        const int row0 = u.pm * BM + wr * 64 + fr, col0 = u.pn * BM + wc * 32 + 8 * fq;
#pragma unroll
        for (int ai = 0; ai < 2; ++ai)
#pragma unroll
            for (int m = 0; m < 4; ++m) { const size_t off = (size_t)(row0 + ai * HALF + m * 16) * NKV + col0; const float rsr = pre.r[ai][m];
#pragma unroll
                for (int bj = 0; bj < 2; ++bj) { const f32x4 v0 = acc[ai][bj][m][0] * rsr, v1 = acc[ai][bj][m][1] * rsr;
                    *(f32x4*)(outf + off + bj * HALF) = v0; *(f32x4*)(outf + off + bj * HALF + 4) = v1; *(u32x4*)(outb + off + bj * HALF) = pack8(v0, v1); } }
    }
};
struct EpiPlain {
    bf16_t* O; int ldc;
    typedef PreNone Pre; __device__ __forceinline__ Pre prefetch(const Unit&, int, int) const { return Pre{}; }
    __device__ __forceinline__ void operator()(const Acc& acc, const Unit& u, int wr, int wc, int fr, int fq, const Pre&) const {
        const int row0 = u.pm * BM + wr * 64 + fr, col0 = u.pn * BM + wc * 32 + 8 * fq;
#pragma unroll
        for (int ai = 0; ai < 2; ++ai)
#pragma unroll
            for (int m = 0; m < 4; ++m) { bf16_t* rowp = O + (size_t)(row0 + ai * HALF + m * 16) * ldc + col0;
#pragma unroll
                for (int bj = 0; bj < 2; ++bj) *(u32x4*)(rowp + bj * HALF) = pack8(acc[ai][bj][m][0], acc[ai][bj][m][1]); }
    }
};
struct EpiSwiglu {
    bf16_t* ACT; const float* rs;
    typedef PreRs Pre; __device__ __forceinline__ Pre prefetch(const Unit& u, int wr, int fr) const { return load_rs(rs, u, wr, fr); }
    __device__ __forceinline__ void operator()(const Acc& acc, const Unit& u, int wr, int wc, int fr, int fq, const Pre& pre) const {
        const int row0 = u.pm * BM + wr * 64 + fr, col0 = u.pn * HALF + wc * 32 + 8 * fq;
#pragma unroll
        for (int ai = 0; ai < 2; ++ai)
#pragma unroll
            for (int m = 0; m < 4; ++m) { f32x4 v0, v1; const float rsr = pre.r[ai][m];
#pragma unroll
                for (int e = 0; e < 4; ++e) { v0[e] = silu_f(acc[ai][0][m][0][e] * rsr) * (acc[ai][1][m][0][e] * rsr); v1[e] = silu_f(acc[ai][0][m][1][e] * rsr) * (acc[ai][1][m][1][e] * rsr); }
                *(u32x4*)(ACT + (size_t)(row0 + ai * HALF + m * 16) * DFF + col0) = pack8(v0, v1); }
    }
};
struct EpiInB {
    bf16_t* Z; const float* rs;
    typedef PreRs Pre; __device__ __forceinline__ Pre prefetch(const Unit& u, int wr, int fr) const { return load_rs(rs, u, wr, fr); }
    __device__ __forceinline__ void operator()(const Acc& acc, const Unit& u, int wr, int wc, int fr, int fq, const Pre& pre) const {
        const int row0 = u.pm * BM + wr * 64 + fr, col0 = u.pn * BM + wc * 32 + 8 * fq;
        const float qs = ((u.pn < 6) || (u.pn >= 18)) ? QSCALE : 1.0f;
#pragma unroll
        for (int ai = 0; ai < 2; ++ai)
#pragma unroll
            for (int m = 0; m < 4; ++m) {
                const int row = row0 + ai * HALF + m * 16; bf16_t* rowp = Z + (size_t)row * ZP + col0; const float rsr = pre.r[ai][m] * qs;
#pragma unroll
                for (int bj = 0; bj < 2; ++bj) *(u32x4*)(rowp + bj * HALF) = pack8(acc[ai][bj][m][0] * rsr, acc[ai][bj][m][1] * rsr);
            }
    }
};
}

__device__ __forceinline__ unsigned f2bf(float f) { unsigned u = __builtin_bit_cast(unsigned, f); return (u + 0x7fffu + ((u >> 16) & 1u)) >> 16; }
__device__ __forceinline__ unsigned pk2(float lo, float hi) { return f2bf(lo) | (f2bf(hi) << 16); }
struct TItem { const float* src; bf16_t* dst; const float* gain; int N, K; };
__device__ __forceinline__ TItem t_make(const float* W, int K, int N, bf16_t* WT, bool upperm, const float* gain, int item) {
    const int nblk = N / 64, kb = item / nblk, nb = item % nblk, k0 = 64 * kb, n0 = 64 * nb;
    int s0 = n0;
    if (upperm) { const int pn = n0 >> 8, j = n0 & 255; s0 = (j < 128) ? (128 * pn + j) : (DFF + 128 * pn + (j - 128)); }
    TItem t; t.src = W + (size_t)k0 * N + s0; t.dst = WT + (size_t)n0 * K + k0; t.gain = gain != nullptr ? gain + k0 : nullptr; t.N = N; t.K = K; return t;
}
__device__ __forceinline__ void t_load(const TItem& t, int lane, f32x4 (&v)[16]) {
    const float* src = t.src + (size_t)(lane >> 4) * t.N + 4 * (lane & 15);
#pragma unroll
    for (int i = 0; i < 16; ++i) v[i] = __builtin_nontemporal_load((const f32x4*)(src + (size_t)(4 * i) * t.N));
}
__device__ __forceinline__ void t_store(const TItem& t, LAS float* scr, int lane, const f32x4 (&v)[16]) {
    const int lr = lane >> 4, lc = lane & 15;
#pragma unroll
    for (int i = 0; i < 16; ++i) { const int k = 4 * i + lr; const float gk = t.gain != nullptr ? t.gain[k] : 1.0f;
        *(LAS f32x4*)(scr + k * 64 + ((4 * lc) ^ (4 * (k >> 3)))) = v[i] * gk; }
    asm volatile("s_waitcnt lgkmcnt(0)" ::: "memory");
    const int c = lane & 7;
#pragma unroll
    for (int j = 0; j < 8; ++j) { const int n = (lane >> 3) + 8 * j; const LAS float* sp = scr + (8 * c) * 64 + (n ^ (4 * c));
        u32x4 o; o.x = cvt_pk_bf16(sp[0 * 64], sp[1 * 64]); o.y = cvt_pk_bf16(sp[2 * 64], sp[3 * 64]); o.z = cvt_pk_bf16(sp[4 * 64], sp[5 * 64]); o.w = cvt_pk_bf16(sp[6 * 64], sp[7 * 64]);
        __builtin_nontemporal_store(o, (u32x4*)(t.dst + (size_t)n * t.K + 8 * c)); }
    asm volatile("s_waitcnt lgkmcnt(0)" ::: "memory");
}
template <int MODE>
__device__ __forceinline__ void norm_row(const float* basef, bf16_t* yb, const bf16_t* o, const float* gpost, float* rs_out, float* yout, int lane) {
    f32x4 y[8];
    if (MODE == 0 || MODE == 1) {
#pragma unroll
        for (int j = 0; j < 8; ++j) y[j] = *(const f32x4*)(basef + 4 * (lane + 64 * j));
    } else {
#pragma unroll
        for (int j = 0; j < 8; ++j) { const u32x2 w = *(const u32x2*)(yb + 4 * (lane + 64 * j)); y[j] = (f32x4){bf_lo(w.x), bf_hi(w.x), bf_lo(w.y), bf_hi(w.y)}; }
    }
    if (MODE != 0) {
        f32x4 ov[8]; float ss = 0.f;
#pragma unroll
        for (int j = 0; j < 8; ++j) { const u32x2 w = *(const u32x2*)(o + 4 * (lane + 64 * j)); ov[j] = (f32x4){bf_lo(w.x), bf_hi(w.x), bf_lo(w.y), bf_hi(w.y)};
            ss += (ov[j][0] * ov[j][0] + ov[j][1] * ov[j][1]) + (ov[j][2] * ov[j][2] + ov[j][3] * ov[j][3]); }
        const float rstd = 1.0f / sqrtf(wave_sum(ss) * (1.0f / DM) + EPS);
#pragma unroll
        for (int j = 0; j < 8; ++j) { const f32x4 g = *(const f32x4*)(gpost + 4 * (lane + 64 * j)); y[j] = y[j] + ov[j] * rstd * g; }
    }
    if (MODE == 3) {
#pragma unroll
        for (int j = 0; j < 8; ++j) *(f32x4*)(yout + 4 * (lane + 64 * j)) = y[j];
    } else {
        float ss = 0.f;
#pragma unroll
        for (int j = 0; j < 8; ++j) { ss += (y[j][0] * y[j][0] + y[j][1] * y[j][1]) + (y[j][2] * y[j][2] + y[j][3] * y[j][3]);
            u32x2 w; w.x = cvt_pk_bf16(y[j][0], y[j][1]); w.y = cvt_pk_bf16(y[j][2], y[j][3]); *(u32x2*)(yb + 4 * (lane + 64 * j)) = w; }
        ss = wave_sum(ss);
        if (lane == 0) *rs_out = 1.0f / sqrtf(ss * (1.0f / DM) + EPS);
    }
}

struct KvDesc { const bf16_t* kbase; const bf16_t* vbase; long row0, rstep, pitch; int key_lo; };
__device__ __forceinline__ void kv_issue(const KvDesc& d, int tid, u32x4 (&kk)[8], u32x4 (&vv)[8]) {
    const int srow = tid >> 4, sch = tid & 15;
#pragma unroll
    for (int i = 0; i < 8; ++i) { const int row = srow + 32 * i, rowc = row < d.key_lo ? d.key_lo : row;
        const size_t e = (size_t)(d.row0 + (long)rowc * d.rstep) * d.pitch + sch * 8; kk[i] = *(const u32x4*)(d.kbase + e); vv[i] = *(const u32x4*)(d.vbase + e); }
}
__device__ __forceinline__ void kv_commit(LAS unsigned char* lds, int tid, int key_lo, const u32x4 (&kk)[8], const u32x4 (&vv)[8]) {
    const unsigned sb = off_b(tid >> 4, tid & 15); const int srow = tid >> 4; const u32x4 z = (u32x4){0u, 0u, 0u, 0u};
#pragma unroll
    for (int i = 0; i < 8; ++i) { const bool ok = (srow + 32 * i) >= key_lo; *(LAS u32x4*)(lds + sb + 8192 * i) = ok ? kk[i] : z; *(LAS u32x4*)(lds + 65536 + sb + 8192 * i) = ok ? vv[i] : z; }
}
template <bool BANDED>
__device__ __forceinline__ void attn_compute(LAS unsigned char* lds, int lane, int w, const bf16x8 (&qf)[4], int key_lo, bf16_t* orow, float* lsep, const LAS float* btab) {
    const int fr = lane & 15, fq = lane >> 4;
    LAS unsigned char* Kimg = lds; LAS unsigned char* Vimg = lds + 65536;
    constexpr int NBLK = BANDED ? 5 : 8;
    const int blk0 = BANDED ? (w >> 1) : 0;
    const int qi = 16 * w + fr;
    unsigned kb[2][4];
#pragma unroll
    for (int e = 0; e < 2; ++e)
#pragma unroll
        for (int kk = 0; kk < 4; ++kk) kb[e][kk] = off_b(8 * (fr >> 2) + 4 * e + (fr & 3), 4 * kk + fq);
    LAS unsigned char* Kb = Kimg + 8192 * blk0; LAS unsigned char* Vb = Vimg + 8192 * blk0;
    f32x4 s[2 * NBLK];
#pragma unroll
    for (int nt = 0; nt < 2 * NBLK; ++nt) s[nt] = (f32x4){0.f, 0.f, 0.f, 0.f};
    constexpr int TB = BANDED ? 2 * NBLK : NBLK;
#pragma unroll
    for (int t0 = 0; t0 < 2 * NBLK; t0 += TB)
#pragma unroll
        for (int kk = 0; kk < 4; ++kk) { bf16x8 kf[TB];
#pragma unroll
            for (int i = 0; i < TB; ++i) { const int nt = t0 + i; kf[i] = *(const LAS bf16x8*)(Kb + kb[nt & 1][kk] + 8192 * (nt >> 1)); }
            __builtin_amdgcn_sched_barrier(0);
#pragma unroll
            for (int i = 0; i < TB; ++i) s[t0 + i] = __builtin_amdgcn_mfma_f32_16x16x32_bf16(kf[i], qf[kk], s[t0 + i], 0, 0, 0);
            __builtin_amdgcn_sched_barrier(0); }
    float mx = -1e30f;
    const LAS float* bp = btab + (128 + 16 * (w & 1) + fr - 8 * fq + 32 - 135);
    const int cmin = BANDED ? (key_lo > 0 ? (128 + 16 * (w & 1) + fr - 8 * fq) - qi : -1000) : 0;
#pragma unroll
    for (int nt = 0; nt < 2 * NBLK; ++nt)
#pragma unroll
        for (int r = 0; r < 4; ++r) { float x = s[nt][r];
            if (BANDED) { const int c = 32 * (nt >> 1) + 4 * (nt & 1) + r; x = x + bp[135 - c]; x = (c >= cmin) ? x : -1e30f; s[nt][r] = x; }
            mx = fmaxf(mx, x); }
    mx = fmaxf(mx, __shfl_xor(mx, 16)); mx = fmaxf(mx, __shfl_xor(mx, 32));
    float l = 0.f;
#pragma unroll
    for (int nt = 0; nt < 2 * NBLK; ++nt)
#pragma unroll
        for (int r = 0; r < 4; ++r) { const float p = __builtin_amdgcn_exp2f(s[nt][r] - mx); s[nt][r] = p; l += p; }
    l += __shfl_xor(l, 16); l += __shfl_xor(l, 32);
    bf16x8 pf[NBLK];
#pragma unroll
    for (int ks = 0; ks < NBLK; ++ks) pf[ks] = __builtin_bit_cast(bf16x8, pg8::pack8(s[2 * ks], s[2 * ks + 1]));
    const float inv_l = 1.0f / l;
    unsigned vb[8][2];
#pragma unroll
    for (int ct = 0; ct < 8; ++ct) { vb[ct][0] = tr16_addr(lane, ct, 0, 0); vb[ct][1] = tr16_addr(lane, ct, 0, 1); }
    f32x4 oa[8];
#pragma unroll
    for (int ct = 0; ct < 8; ++ct) oa[ct] = (f32x4){0.f, 0.f, 0.f, 0.f};
#pragma unroll
    for (int ks = 0; ks < NBLK; ++ks) { s16x4 vlo[8], vhi[8];
#pragma unroll
        for (int ct = 0; ct < 8; ++ct) { vlo[ct] = tr_read(Vb + vb[ct][0] + 8192 * ks); vhi[ct] = tr_read(Vb + vb[ct][1] + 8192 * ks); }
        __builtin_amdgcn_sched_barrier(0);
#pragma unroll
        for (int ct = 0; ct < 8; ++ct) { const bf16x8 vf = (bf16x8){vlo[ct][0], vlo[ct][1], vlo[ct][2], vlo[ct][3], vhi[ct][0], vhi[ct][1], vhi[ct][2], vhi[ct][3]};
            oa[ct] = __builtin_amdgcn_mfma_f32_16x16x32_bf16(vf, pf[ks], oa[ct], 0, 0, 0); }
        __builtin_amdgcn_sched_barrier(0); }
#pragma unroll
    for (int ct = 0; ct < 8; ++ct) { u32x2 wv; wv.x = cvt_pk_bf16(oa[ct][0] * inv_l, oa[ct][1] * inv_l); wv.y = cvt_pk_bf16(oa[ct][2] * inv_l, oa[ct][3] * inv_l);
        *(u32x2*)(orow + 16 * ct) = wv; }
    if (lsep != nullptr && fq == 0) *lsep = (mx + __builtin_amdgcn_logf(l)) * LN2;
}
struct QoDesc { const bf16_t* qbase; long row0, rstep; bf16_t* obase; float* lsebase; int banded, dil, head; };

struct GateRegs { u32x4 v[2][6]; f32x4 wq[8]; f32x4 vs[3]; float gvl; };
__device__ __forceinline__ void gate_issue(int tid, int b, int chunk, int g, const bf16_t* Z, const float* VSS, const float* w_s, const float* g_v, GateRegs& R) {
    const int lane = tid & 63, w = __builtin_amdgcn_readfirstlane(tid >> 6), fr = lane & 15, fq = lane >> 4;
    const int tok0 = b * SEQ + chunk * 128;
    {
        const int r0 = tid >> 3, c0 = tid & 7; const bf16_t* gp = Z + (size_t)(tok0 + r0) * ZP + MIXW + g * 384 + c0 * 8;
#pragma unroll
        for (int i2 = 0; i2 < 2; ++i2)
#pragma unroll
            for (int i = 0; i < 6; ++i) R.v[i2][i] = *(const u32x4*)(gp + (size_t)i2 * 64 * ZP + 64 * i); }
    { const float* wp = w_s + (size_t)g * 16384 + (16 * w + fr) * 128 + 8 * fq;
#pragma unroll
      for (int kk = 0; kk < 4; ++kk) { R.wq[2 * kk] = *(const f32x4*)(wp + 32 * kk); R.wq[2 * kk + 1] = *(const f32x4*)(wp + 32 * kk + 4); } }
    { const float* p = VSS + (size_t)(tok0 + (tid & 127)) * 24 + 12 * ((tid >> 7) & 1);
#pragma unroll
      for (int i = 0; i < 3; ++i) R.vs[i] = *(const f32x4*)(p + 4 * i); }
    R.gvl = g_v[g * 384 + (tid < 384 ? tid : tid - 384)];
}
__device__ __forceinline__ void gate_run(LAS unsigned char* lds, int tid, int b, int chunk, int g, const GateRegs& R, const bf16_t* Z, const float* b_s, bf16_t* MIX) {
    const int lane = tid & 63, w = __builtin_amdgcn_readfirstlane(tid >> 6), fr = lane & 15, fq = lane >> 4;
    const int tok0 = b * SEQ + chunk * 128, i = 16 * w + fr;
    LAS float* rs = (LAS float*)(lds + LDS_TAB); LAS float* gvs = rs + 128;
    const size_t tokrow = (size_t)(tok0 + i);
    __syncthreads();
    const bf16_t* up = Z + tokrow * ZP + g * 384 + 4 * fq;
    u32x2 ucur[8];
    const float bs = b_s[g * 128 + i];
    {
        const int r0 = tid >> 3, c0 = tid & 7; const unsigned gsb0 = off_b(r0, c0), gsb1 = off_b(r0, c0 + 8);
#pragma unroll
        for (int i2 = 0; i2 < 2; ++i2)
#pragma unroll
            for (int k = 0; k < 6; ++k) *(LAS u32x4*)(lds + (k >> 1) * 32768 + ((k & 1) ? gsb1 : gsb0) + 16384 * i2) = R.v[i2][k]; }
    { float ssum = 0.f;
#pragma unroll
      for (int k = 0; k < 3; ++k) ssum += (R.vs[k][0] + R.vs[k][1]) + (R.vs[k][2] + R.vs[k][3]);
      if (tid < 256) rs[512 + tid] = ssum;
      if (tid < 384) gvs[tid] = R.gvl; }
    __syncthreads();
    if (tid < 128) rs[tid] = 1.0f / sqrtf((rs[512 + tid] + rs[512 + 128 + tid]) * (1.0f / MIXW) + EPS);
    __syncthreads();
    bf16x8 wf[4];
#pragma unroll
    for (int kk = 0; kk < 4; ++kk) { const int j0 = 32 * kk + 8 * fq;
        const f32x4 r0 = *(const LAS f32x4*)(rs + j0), r1 = *(const LAS f32x4*)(rs + j0 + 4);
        const f32x4 a = R.wq[2 * kk], c = R.wq[2 * kk + 1];
        float v[8] = {a[0] * r0[0], a[1] * r0[1], a[2] * r0[2], a[3] * r0[3], c[0] * r1[0], c[1] * r1[1], c[2] * r1[2], c[3] * r1[3]};
#pragma unroll
        for (int jj = 0; jj < 8; ++jj) v[jj] = (j0 + jj <= i) ? v[jj] : 0.f;
        u32x4 pk; pk.x = cvt_pk_bf16(v[0], v[1]); pk.y = cvt_pk_bf16(v[2], v[3]); pk.z = cvt_pk_bf16(v[4], v[5]); pk.w = cvt_pk_bf16(v[6], v[7]);
        wf[kk] = __builtin_bit_cast(bf16x8, pk); }
    unsigned vb[8][2];
#pragma unroll
    for (int c = 0; c < 8; ++c) { vb[c][0] = tr16_addr(lane, c, 0, 0); vb[c][1] = tr16_addr(lane, c, 0, 1); }
#pragma unroll
    for (int sub = 0; sub < 3; ++sub) { LAS unsigned char* img = lds + sub * 32768;
#pragma unroll
        for (int c = 0; c < 8; ++c) ucur[c] = *(const u32x2*)(up + sub * 128 + 16 * c);
#pragma unroll
        for (int c = 0; c < 8; ++c) { f32x4 a = (f32x4){0.f, 0.f, 0.f, 0.f};
#pragma unroll
            for (int kk = 0; kk < 4; ++kk) if (kk <= (w >> 1)) {
                const s16x4 lo = tr_read(img + vb[c][0] + 8192 * kk), hi = tr_read(img + vb[c][1] + 8192 * kk);
                const bf16x8 vf = (bf16x8){lo[0], lo[1], lo[2], lo[3], hi[0], hi[1], hi[2], hi[3]};
                a = __builtin_amdgcn_mfma_f32_16x16x32_bf16(vf, wf[kk], a, 0, 0, 0); }
            const int col = g * 384 + sub * 128 + 16 * c + 4 * fq;
            const f32x4 gv = *(const LAS f32x4*)(gvs + sub * 128 + 16 * c + 4 * fq);
            const u32x2 uw = ucur[c];
            const float o0 = bf_lo(uw.x) * (a[0] * gv[0] + bs), o1 = bf_hi(uw.x) * (a[1] * gv[1] + bs), o2 = bf_lo(uw.y) * (a[2] * gv[2] + bs), o3 = bf_hi(uw.y) * (a[3] * gv[3] + bs);
            u32x2 ov; ov.x = cvt_pk_bf16(o0, o1); ov.y = cvt_pk_bf16(o2, o3);
            *(u32x2*)(MIX + tokrow * DM + col) = ov; } }
}

template <int MODE, int K>
__device__ __forceinline__ void sample_gemv(LAS unsigned char* lds, const bf16_t* A, int a_pitch, const bf16_t* Wt, int N, int first, int stride,
                                            float* outf, bf16_t* outb, int ldb, float* win, const float* rs, const float* slse = nullptr) {
    int tid = threadIdx.x; asm volatile("" : "+v"(tid));
    const int lane = tid & 63, w = __builtin_amdgcn_readfirstlane(tid >> 6), fr = lane & 15, fq = lane >> 4;
    const int ntiles = (MODE == 2) ? N / 32 : N / 16;
    LAS float* red = (LAS float*)lds;
    constexpr int kw = K / 8;
    LAS float* atab = (LAS float*)(lds + LDS_TAB + 4096);
    if (slse != nullptr) {
        __syncthreads();
        if (tid < 128) { const int srow = tid >> 4, H = tid & 15; float al = 1.0f;
            if (H < 12) { const int hl = H & 3; const float l0 = slse[srow * 12 + hl], l1 = slse[srow * 12 + 4 + hl], l2 = slse[srow * 12 + 8 + hl], mm = fmaxf(l0, fmaxf(l1, l2));
                const float e0 = __expf(l0 - mm), e1 = __expf(l1 - mm), e2 = __expf(l2 - mm); al = (H < 4 ? e0 : (H < 8 ? e1 : e2)) / (e0 + e1 + e2); }
            atab[tid] = al; }
        __syncthreads();
    }
    for (int tile = first; tile < ntiles; tile += stride) {
        const int nrow0 = (MODE == 2) ? 256 * (tile >> 3) + 16 * (tile & 7) : 16 * tile;
        const bf16_t* ap = A + (size_t)(fr & 7) * a_pitch + w * kw + 8 * fq;
        const bf16_t* bp = Wt + (size_t)(nrow0 + fr) * K + w * kw + 8 * fq;
        f32x4 acc = (f32x4){0.f, 0.f, 0.f, 0.f}, acc2 = (f32x4){0.f, 0.f, 0.f, 0.f};
#pragma unroll
        for (int ks = 0; ks < kw / 32; ++ks) { bf16x8 a = *(const bf16x8*)(ap + 32 * ks); const bf16x8 b = *(const bf16x8*)(bp + 32 * ks);
            if (MODE == 1 && slse != nullptr) { const float al = atab[(fr & 7) * 16 + ((w * kw + 32 * ks + 8 * fq) >> 7)]; const u32x4 aw = __builtin_bit_cast(u32x4, a); u32x4 o;
                o.x = cvt_pk_bf16(bf_lo(aw.x) * al, bf_hi(aw.x) * al); o.y = cvt_pk_bf16(bf_lo(aw.y) * al, bf_hi(aw.y) * al);
                o.z = cvt_pk_bf16(bf_lo(aw.z) * al, bf_hi(aw.z) * al); o.w = cvt_pk_bf16(bf_lo(aw.w) * al, bf_hi(aw.w) * al); a = __builtin_bit_cast(bf16x8, o); }
            acc = __builtin_amdgcn_mfma_f32_16x16x32_bf16(b, a, acc, 0, 0, 0);
            if (MODE == 2) { const bf16x8 b2 = *(const bf16x8*)(bp + (size_t)128 * K + 32 * ks); acc2 = __builtin_amdgcn_mfma_f32_16x16x32_bf16(b2, a, acc2, 0, 0, 0); } }
        __syncthreads();
        *(LAS f32x4*)(red + (w * 16 + fr) * 16 + 4 * fq) = acc;
        if (MODE == 2) *(LAS f32x4*)(red + 2048 + (w * 16 + fr) * 16 + 4 * fq) = acc2;
        __syncthreads();
        if (tid < 128) { const int s = tid >> 4, c = tid & 15; float v = 0.f, v2 = 0.f;
#pragma unroll
            for (int ww = 0; ww < 8; ++ww) { v += red[(ww * 16 + s) * 16 + c]; if (MODE == 2) v2 += red[2048 + (ww * 16 + s) * 16 + c]; }
            if (rs != nullptr) { const float rsr = rs[s]; v *= rsr; v2 *= rsr; }
            if (MODE == 0) { const int n = nrow0 + c; outf[(size_t)s * ZP + n] = v;
                if (win != nullptr && n >= 1536 && n < 4608) { const int kv = n >= 3072 ? 1 : 0, cc = n - 1536 - 1536 * kv, grp = cc >> 9;
                    win[(size_t)grp * 8192 + (size_t)(s * 2 + kv) * 512 + (cc & 511)] = v; } }
            else if (MODE == 1) { outb[(size_t)s * ldb + nrow0 + c] = (bf16_t)f2bf(v); }
            else { outb[(size_t)s * ldb + 128 * (tile >> 3) + 16 * (tile & 7) + c] = (bf16_t)f2bf(silu_f(v) * v2); } }
    }
}

template <class KF, class VF>
__device__ __forceinline__ float sample_attend(LAS float* scr, const float* qv, int nkeys, KF kf, VF vf, const LAS float* btab, LAS float* o_out) {
    int tid = threadIdx.x; asm volatile("" : "+v"(tid));
    const int lane = tid & 63, w = __builtin_amdgcn_readfirstlane(tid >> 6);
    LAS float* sc = scr; LAS float* part = scr + 320; LAS float* stat = scr + 320 + 2048;
    {
        const int key = tid >> 1, half = tid & 1; float d = 0.f;
        if (key < nkeys) { const float* kp = kf(key) + 64 * half; const float* qp = qv + 64 * half; f32x4 k4[16];
#pragma unroll
            for (int i = 0; i < 16; ++i) k4[i] = *(const f32x4*)(kp + 4 * i);
#pragma unroll
            for (int i = 0; i < 16; ++i) { const f32x4 q4 = *(const f32x4*)(qp + 4 * i); d += (k4[i][0] * q4[0] + k4[i][1] * q4[1]) + (k4[i][2] * q4[2] + k4[i][3] * q4[3]); } }
        d += __shfl_xor(d, 1);
        if (half == 0 && key < nkeys) sc[key] = d * QSCALE + (btab != nullptr ? btab[key] : 0.f);
    }
    __syncthreads();
    if (w == 0) { float m = -1e30f; for (int j = lane; j < nkeys; j += 64) m = fmaxf(m, sc[j]); m = wave_max(m);
        float l = 0.f; for (int j = lane; j < nkeys; j += 64) { const float p = __builtin_amdgcn_exp2f(sc[j] - m); sc[j] = p; l += p; } l = wave_sum(l);
        if (lane == 0) { stat[0] = m; stat[1] = l; } }
    __syncthreads();
    {
        const int kg = tid >> 5, d4 = 4 * (tid & 31); f32x4 v4[16]; f32x4 a = (f32x4){0.f, 0.f, 0.f, 0.f};
#pragma unroll
        for (int i = 0; i < 16; ++i) { const int j = kg + 16 * i; v4[i] = (f32x4){0.f, 0.f, 0.f, 0.f}; if (j < nkeys) v4[i] = *(const f32x4*)(vf(j) + d4); }
#pragma unroll
        for (int i = 0; i < 16; ++i) { const int j = kg + 16 * i; const float pj = j < nkeys ? sc[j] : 0.f; a = a + v4[i] * pj; }
        *(LAS f32x4*)(part + kg * 128 + d4) = a; }
    __syncthreads();
    const float m = stat[0], l = stat[1];
    if (tid < 128) { float a = 0.f;
#pragma unroll
        for (int g = 0; g < 16; ++g) a += part[g * 128 + tid];
        o_out[tid] = a / l; }
    __syncthreads();
    return (m + __builtin_amdgcn_logf(l)) * LN2;
}

#define XB_TMO      128
#define XB_XCNT(j)  (256  + 64 * (j))
#define XB_XSUB(j)  (1280 + 64 * (j))
#define XB_XGEN(j)  (2304 + 64 * (j))
#define XB_TOP      3328
#define XB_TOPGEN   3392
#define XCD_BAR_WORDS 3456
#define XB_SPIN_CAP (1u << 18)
__device__ __forceinline__ unsigned xb_ld(unsigned* p)              { return __hip_atomic_load(p, __ATOMIC_RELAXED, __HIP_MEMORY_SCOPE_AGENT); }
__device__ __forceinline__ unsigned xb_add(unsigned* p, unsigned v) { return __hip_atomic_fetch_add(p, v, __ATOMIC_RELAXED, __HIP_MEMORY_SCOPE_AGENT); }
__device__ __forceinline__ unsigned xb_xcc_id() { return (unsigned)__builtin_amdgcn_s_getreg((3 << 11) | 20) & 0xFu; }
#define XB_SPIN(cond, bar) do { unsigned _sp = 0; while (cond) { __builtin_amdgcn_s_sleep(1); \
    if ((++_sp & 255u) == 0u) { if (xb_ld(&(bar)[XB_TMO])) break; if (_sp > XB_SPIN_CAP) { atomicAdd(&(bar)[XB_TMO], 1u); break; } } } } while (0)
struct XcdBarrier { unsigned* bar; unsigned x; volatile LAS unsigned* st; };
__device__ __forceinline__ XcdBarrier xcd_barrier_post(unsigned* bar, volatile LAS unsigned* st) {
    XcdBarrier b; b.bar = bar; b.x = xb_xcc_id(); b.st = st;
    if (threadIdx.x == 0) (void)xb_add(&bar[XB_XCNT(b.x)], 1u);
    return b;
}
__device__ __forceinline__ void xcd_barrier_complete(unsigned* bar, unsigned x, unsigned& nloc, unsigned& nx) {
    const unsigned G = gridDim.x * gridDim.y * gridDim.z;
    unsigned sum, cnt, mine, sp = 0u;
    for (;;) {
        sum = 0u; cnt = 0u; mine = 0u;
#pragma unroll
        for (unsigned j = 0; j < 16; ++j) { const unsigned c = xb_ld(&bar[XB_XCNT(j)]); sum += c; cnt += (c > 0u) ? 1u : 0u; mine = (j == x) ? c : mine; }
        if (sum == G) break;
        __builtin_amdgcn_s_sleep(1);
        if ((++sp & 255u) == 0u) { if (xb_ld(&bar[XB_TMO])) break; if (sp > XB_SPIN_CAP) { atomicAdd(&bar[XB_TMO], 1u); break; } }
    }
    nloc = mine > 0u ? mine : 1u; nx = cnt > 0u ? cnt : 1u;
}
__device__ __forceinline__ void xcd_barrier(const XcdBarrier& b) {
    asm volatile("s_waitcnt vmcnt(0)" ::: "memory");
    __syncthreads();
    if (threadIdx.x == 0) {
        unsigned* bar = b.bar;
        __builtin_amdgcn_s_waitcnt(0);
        unsigned nloc = b.st[0], nx = b.st[1];
        if (nloc == 0u) { xcd_barrier_complete(bar, b.x, nloc, nx); b.st[0] = nloc; b.st[1] = nx; }
        const unsigned old = xb_add(&bar[XB_XSUB(b.x)], 1u);
        const unsigned gen = old / nloc;
        if (old + 1u == (gen + 1u) * nloc) {
            __builtin_amdgcn_fence(__ATOMIC_RELEASE, "agent");
            asm volatile("s_waitcnt vmcnt(0)" ::: "memory");
            const unsigned og = xb_add(&bar[XB_TOP], 1u);
            const unsigned tg = og / nx;
            if (og + 1u == (tg + 1u) * nx) xb_add(&bar[XB_TOPGEN], 1u);
            else XB_SPIN(xb_ld(&bar[XB_TOPGEN]) == tg, bar);
            __builtin_amdgcn_fence(__ATOMIC_ACQUIRE, "agent");
            xb_add(&bar[XB_XGEN(b.x)], 1u);
            asm volatile("s_waitcnt vmcnt(0)" ::: "memory");
        } else {
            XB_SPIN(xb_ld(&bar[XB_XGEN(b.x)]) == gen, bar);
            __builtin_amdgcn_fence(__ATOMIC_ACQUIRE, "agent");
            asm volatile("s_waitcnt vmcnt(0)" ::: "memory");
        }
    }
    __syncthreads();
}

struct Args { const float* in[22]; float* out; unsigned char* ws; };
typedef const Args __attribute__((address_space(4)))* ArgsP;
__device__ __forceinline__ ArgsP args_ptr() { ArgsP p = (ArgsP)__builtin_amdgcn_kernarg_segment_ptr(); asm volatile("" : "+s"(p)); return p; }
#define WSP(T, off) ((T*)(A->ws + (off)))

constexpr int I_MKV = 32 * 16, I_INA = 32 * 56, I_INB = 32 * 80, I_OUT = 32 * 32, I_UP = 32 * 176, I_DN = 88 * 32, DN_P = 850, DN_A = 1170;
__device__ __forceinline__ int conv_count(int list) { return list == 0 ? 2 * I_MKV + I_INA + I_UP + DN_P : (list == 1 ? I_OUT + (DN_A - DN_P) : (list == 2 ? (I_DN - DN_A) + I_INB + I_OUT : (list == 3 ? I_UP : I_DN))); }
__device__ __forceinline__ TItem conv_item(ArgsP A, int list, int r) {
    const float* n_mix_pre = A->in[8]; const float* n_ffn_pre = A->in[10]; const float* n_mem = A->in[12]; const float* w_mem_kv = A->in[13]; const float* w_in_a = A->in[14];
    const float* w_in_b = A->in[18]; const float* w_out = A->in[19]; const float* w_up = A->in[20]; const float* w_dn = A->in[21];
    bf16_t* Wmkv = WSP(bf16_t, WS_WMKV); bf16_t* Wina = WSP(bf16_t, WS_WINA); bf16_t* Winb = WSP(bf16_t, WS_WINB); bf16_t* Wout = WSP(bf16_t, WS_WOUT);
    bf16_t* Wup = WSP(bf16_t, WS_WUP); bf16_t* Wdn = WSP(bf16_t, WS_WDN);
    if (list == 0) {
        if (r < 2 * I_MKV) { const int l = r / I_MKV; return t_make(w_mem_kv + (size_t)l * DM * NKV, DM, NKV, Wmkv + (size_t)l * NKV * DM, false, n_mem + l * DM, r % I_MKV); } r -= 2 * I_MKV;
        if (r < I_INA) return t_make(w_in_a, DM, NA, Wina, false, n_mix_pre, r); r -= I_INA;
        if (r < I_UP) return t_make(w_up, DM, NUP, Wup, true, n_ffn_pre, r); r -= I_UP;
        return t_make(w_dn, DFF, DM, Wdn, false, nullptr, r);
    } else if (list == 1) {
        if (r < I_OUT) return t_make(w_out, DM, DM, Wout, false, nullptr, r); r -= I_OUT;
        return t_make(w_dn, DFF, DM, Wdn, false, nullptr, DN_P + r);
    } else if (list == 2) {
        if (r < I_DN - DN_A) return t_make(w_dn, DFF, DM, Wdn, false, nullptr, DN_A + r); r -= I_DN - DN_A;
        if (r < I_INB) return t_make(w_in_b, DM, NB, Winb, false, n_mix_pre + DM, r); r -= I_INB;
        return t_make(w_out + (size_t)DM * DM, DM, DM, Wout + (size_t)DM * DM, false, nullptr, r);
    } else if (list == 3) {
        return t_make(w_up + (size_t)DM * NUP, DM, NUP, Wup + (size_t)NUP * DM, true, n_ffn_pre + DM, r);
    } else {
        return t_make(w_dn + (size_t)DFF * DM, DFF, DM, Wdn + (size_t)DM * DFF, false, nullptr, r);
    }
}
__device__ __forceinline__ void convert_list(LAS unsigned char* lds, ArgsP A, int list, int worker, int nworkers, int wave, int lane) {
    const int n = conv_count(list);
    LAS float* scr = (LAS float*)(lds + wave * 16384);
    int it = worker;
    if (it >= n) return;
    TItem cur = conv_item(A, list, it);
    f32x4 va[16], vb[16];
    t_load(cur, lane, va);
    for (;;) {
        const int itn = it + nworkers; const bool hn = itn < n;
        TItem nxt = cur;
        if (hn) { nxt = conv_item(A, list, itn); t_load(nxt, lane, vb); }
        t_store(cur, scr, lane, va);
        if (!hn) break;
#pragma unroll
        for (int i = 0; i < 16; ++i) va[i] = vb[i];
        cur = nxt; it = itn;
    }
}
__device__ __forceinline__ void convert_tail(LAS unsigned char* lds, ArgsP A, int list, int first_idle) {
    const int bid = blockIdx.x, G = gridDim.x;
    if (bid < first_idle || first_idle >= G) return;
    int tid = threadIdx.x; asm volatile("" : "+v"(tid));
    const int lane = tid & 63, wave = __builtin_amdgcn_readfirstlane(tid >> 6);
    __syncthreads();
    convert_list(lds, A, list, (bid - first_idle) * 8 + wave, (G - first_idle) * 8, wave, lane);
}
__device__ __forceinline__ void phase_prologue(LAS unsigned char* lds) {
    ArgsP A = args_ptr();
    int tid = threadIdx.x; asm volatile("" : "+v"(tid));
    const int lane = tid & 63, wave = __builtin_amdgcn_readfirstlane(tid >> 6), gw = blockIdx.x * 8 + wave, NGW = gridDim.x * 8;
    const float* x_prompt = A->in[0]; const float* x_sample = A->in[1]; const float* mem_prompt = A->in[2];
    bf16_t* YB = WSP(bf16_t, WS_HN); bf16_t* HM = WSP(bf16_t, WS_HM);
    float* RS = WSP(float, WS_RS); float* RSM = RS + 16384;
    convert_list(lds, A, 0, gw, NGW, wave, lane);
    if (gridDim.x != 256) { convert_list(lds, A, 1, gw, NGW, wave, lane); convert_list(lds, A, 2, gw, NGW, wave, lane); convert_list(lds, A, 3, gw, NGW, wave, lane); convert_list(lds, A, 4, gw, NGW, wave, lane); }
    for (int m = gw; m < 512 + TP + TSMP; m += NGW) {
        if (m < 512) norm_row<0>(mem_prompt + (size_t)m * DM, HM + (size_t)m * DM, nullptr, nullptr, RSM + m, nullptr, lane);
        else { const int r = m - 512; const float* xr = r < TP ? x_prompt + (size_t)r * DM : x_sample + (size_t)(r - TP) * DM;
            norm_row<0>(xr, YB + (size_t)r * DM, nullptr, nullptr, RS + r, nullptr, lane); }
    }
}

__device__ __forceinline__ void phase_in_a(LAS unsigned char* lds) {
    ArgsP A = args_ptr(); const int bid = blockIdx.x, G = gridDim.x;
    bf16_t* HN = WSP(bf16_t, WS_HN);
    { pg8::Gemm g{HN, WSP(bf16_t, WS_WINA), TP, NA, DM}; pg8::StaticOrder S; S.init(TP, NA, G, bid); pg8::EpiInA E{WSP(bf16_t, WS_Z), WSP(float, WS_VSS), WSP(float, WS_RS)};
      pg8::gemm_phase<pg8::EpiInA, true, true>(lds, g, S, E); }
#pragma unroll 1
    for (int l = 0; l < 2; ++l) { pg8::Gemm g{WSP(bf16_t, WS_HM), WSP(bf16_t, WS_WMKV) + (size_t)l * NKV * DM, 512, NKV, DM};
      pg8::StaticOrder S; S.init(512, NKV, G, (bid - 192 - 8 * l + 2 * G) % G);
      pg8::EpiMkv E{A->out + OUT_MKV + (size_t)l * 512 * NKV, WSP(bf16_t, WS_MKV) + (size_t)l * 512 * NKV, WSP(float, WS_RS) + 16384};
      pg8::gemm_phase<pg8::EpiMkv, true, true>(lds, g, S, E); }
    if (G == 256) { if (bid >= 208) sample_gemv<0, DM>(lds, HN + (size_t)TP * DM, DM, WSP(bf16_t, WS_WINA), NA, G - 1 - bid, 48, WSP(float, WS_ZS), nullptr, 0, nullptr, WSP(float, WS_RS) + TP); }
    else sample_gemv<0, DM>(lds, HN + (size_t)TP * DM, DM, WSP(bf16_t, WS_WINA), NA, G - 1 - bid, G, WSP(float, WS_ZS), nullptr, 0, nullptr, WSP(float, WS_RS) + TP);
    if (G == 256) convert_tail(lds, A, 1, 208);
}
__device__ __forceinline__ void phase_in_b(LAS unsigned char* lds) {
    ArgsP A = args_ptr(); const int bid = blockIdx.x, G = gridDim.x;
    bf16_t* HN = WSP(bf16_t, WS_HN); float* out = A->out;
    pg8::Gemm g{HN, WSP(bf16_t, WS_WINB), TP, NB, DM}; pg8::StaticOrder S; S.init(TP, NB, G, bid);
    pg8::EpiInB E{WSP(bf16_t, WS_Z), WSP(float, WS_RS)};
    pg8::gemm_phase<pg8::EpiInB, true, true>(lds, g, S, E);
    sample_gemv<0, DM>(lds, HN + (size_t)TP * DM, DM, WSP(bf16_t, WS_WINB), NB, G - 1 - bid, G, WSP(float, WS_ZS), nullptr, 0, out + OUT_W128S, WSP(float, WS_RS) + TP);
    if (G == 256) convert_tail(lds, A, 3, 128);
}
__device__ __forceinline__ void mem_unit_desc(ArgsP A, int v, int layer, KvDesc& kd, QoDesc& qd) {
    const int b = v >> 7, h = (v >> 5) & 3, qb = v & 31, qmoff = layer == 0 ? 3072 : 4608;
    const bf16_t* mkv = WSP(bf16_t, WS_MKV) + (size_t)layer * 512 * NKV + h * 128;
    kd.kbase = mkv; kd.vbase = mkv + 512; kd.row0 = (long)b * 256; kd.rstep = 1; kd.pitch = NKV; kd.key_lo = 0;
    qd.qbase = WSP(bf16_t, WS_Z) + qmoff + h * 128; qd.row0 = (long)b * SEQ + 128 * qb; qd.rstep = 1; qd.obase = WSP(bf16_t, WS_MIX) + MIXW + h * 128; qd.lsebase = nullptr;
    qd.banded = 0; qd.dil = 1; qd.head = 0;
}
__device__ __forceinline__ void swa_unit_desc(ArgsP A, int u, KvDesc& kd, QoDesc& qd) {
    const int b = u / 384, H = (u % 384) >> 5, idx = u & 31, g = H >> 2, dil = 1 << (2 * g), r = idx & (dil - 1), qb = idx >> (2 * g);
    const bf16_t* Z = WSP(bf16_t, WS_Z);
    kd.kbase = Z + MIXW + H * 128; kd.vbase = Z + 2 * MIXW + H * 128; kd.row0 = (long)b * SEQ + (long)(128 * qb - 128) * dil + r; kd.rstep = dil; kd.pitch = ZP; kd.key_lo = qb == 0 ? 128 : 0;
    qd.qbase = Z + H * 128; qd.row0 = (long)b * SEQ + (long)(128 * qb) * dil + r; qd.rstep = dil; qd.obase = WSP(bf16_t, WS_MIX) + H * 128; qd.lsebase = WSP(float, WS_LSE) + H;
    qd.banded = 1; qd.dil = dil; qd.head = H;
}
__device__ __forceinline__ void q_issue(const QoDesc& qd, int tid, bf16x8 (&qf)[4]) {
    const int lane = tid & 63, w = __builtin_amdgcn_readfirstlane(tid >> 6), fr = lane & 15, fq = lane >> 4;
    const long qrow = qd.row0 + (long)(16 * w + fr) * qd.rstep;
    const bf16_t* qp = qd.qbase + (size_t)qrow * ZP + 8 * fq;
#pragma unroll
    for (int k4 = 0; k4 < 4; ++k4) qf[k4] = *(const bf16x8*)(qp + 32 * k4);
}
__device__ __forceinline__ void build_bias_tables(LAS unsigned char* lds, int tid, const float* rel_bias) {
    LAS float* tab = (LAS float*)(lds + LDS_TAB);
    for (int i = tid; i < 12 * 192; i += 512) { const int H = i / 192, j = i % 192 - 32, dil = 1 << (2 * (H >> 2));
        tab[i] = (j >= 0 && j <= 128) ? rel_bias[t5_bucket(j * dil) * 12 + H] * LOG2E : -1e30f; }
}
__device__ __forceinline__ void attn_unit_run(LAS unsigned char* lds, int tid, const QoDesc& qd, int key_lo, u32x4 (&kk)[8], u32x4 (&vv)[8], bf16x8 (&qf)[4],
                                              const bool has_next, const KvDesc nxt, const QoDesc nxtq) {
    const int lane = tid & 63, w = __builtin_amdgcn_readfirstlane(tid >> 6), fr = lane & 15, fq = lane >> 4;
    __syncthreads();
    kv_commit(lds, tid, key_lo, kk, vv);
    bf16x8 qc[4];
#pragma unroll
    for (int k4 = 0; k4 < 4; ++k4) qc[k4] = qf[k4];
    if (has_next) { kv_issue(nxt, tid, kk, vv); q_issue(nxtq, tid, qf); }
    __syncthreads();
    const long qrow = qd.row0 + (long)(16 * w + fr) * qd.rstep;
    bf16_t* orow = qd.obase + (size_t)qrow * DM + 4 * fq;
    float* lsep = qd.lsebase != nullptr ? qd.lsebase + (size_t)qrow * 12 : nullptr;
    if (qd.banded) attn_compute<true>(lds, lane, w, qc, key_lo, orow, lsep, (const LAS float*)(lds + LDS_TAB) + qd.head * 192);
    else attn_compute<false>(lds, lane, w, qc, key_lo, orow, lsep, (const LAS float*)(lds + LDS_TAB));
}
__device__ __forceinline__ void sample_mem_attn(LAS unsigned char* lds, int layer) {
    ArgsP A = args_ptr(); const int bid = blockIdx.x, G = gridDim.x;
    int tid = threadIdx.x; asm volatile("" : "+v"(tid));
    const int qmoff = layer == 0 ? 3072 : 4608;
    for (int it = G - 1 - 96 - bid; it >= 0 && it < 32; it += G) {
        const int s = it >> 2, h = it & 3;
        LAS float* scr = (LAS float*)lds; LAS float* og = scr + 2560;
        __syncthreads();
        const float* cm = A->in[3] + (size_t)(layer * 8 + s) * 256 * 1024;
        auto kf = [=](int j) -> const float* { return cm + (size_t)j * 1024 + h * 128; };
        auto vf = [=](int j) -> const float* { return cm + (size_t)j * 1024 + 512 + h * 128; };
        (void)sample_attend(scr, WSP(float, WS_ZS) + (size_t)s * ZP + qmoff + h * 128, 256, kf, vf, (const LAS float*)nullptr, og);
        if (tid < 128) WSP(bf16_t, WS_MIX)[(size_t)(TP + s) * DM + MIXW + h * 128 + tid] = (bf16_t)f2bf(og[tid]);
        __syncthreads();
    }
}
__device__ __forceinline__ void phase_mix_a(LAS unsigned char* lds) {
    ArgsP A = args_ptr(); const int bid = blockIdx.x, G = gridDim.x;
    int tid = threadIdx.x; asm volatile("" : "+v"(tid));
    const int lane = tid & 63, wave = __builtin_amdgcn_readfirstlane(tid >> 6);
    const float* ZS = WSP(float, WS_ZS); const float* n_v_a = A->in[15]; const float* w_sp = A->in[16]; const float* b_sp = A->in[17]; bf16_t* MIX = WSP(bf16_t, WS_MIX); float* out = A->out;
    for (int it = G - 1 - bid; it < TSMP; it += G) {
        LAS float* red = (LAS float*)lds; const int s = it;
        __syncthreads();
        float vv[3], uu[3], ss = 0.f;
#pragma unroll
        for (int i = 0; i < 3; ++i) { const int c = tid + 512 * i; uu[i] = gelu_tanh(ZS[(size_t)s * ZP + c]); vv[i] = gelu_tanh(ZS[(size_t)s * ZP + MIXW + c]); ss += vv[i] * vv[i]; }
        ss = wave_sum(ss); if (lane == 0) red[wave] = ss;
        __syncthreads();
        float tot = 0.f;
#pragma unroll
        for (int i = 0; i < 8; ++i) tot += red[i];
        const float rstd = 1.0f / sqrtf(tot * (1.0f / MIXW) + EPS);
#pragma unroll
        for (int i = 0; i < 3; ++i) { const int c = tid + 512 * i, g = c / 384; const float vn = vv[i] * rstd * n_v_a[c];
            out[OUT_CHV + (size_t)s * MIXW + c] = vn;
            const float sg = w_sp[(size_t)g * 16384] * vn + b_sp[g * 128];
            MIX[(size_t)(TP + s) * DM + c] = (bf16_t)f2bf(uu[i] * sg); }
    }
    sample_mem_attn(lds, 0);
    __syncthreads();
    for (int u = bid; u < 256; u += G) {
        KvDesc kd; QoDesc qd; mem_unit_desc(A, u, 0, kd, qd);
        u32x4 kk[8], vv[8]; bf16x8 qf[4]; GateRegs R;
        gate_issue(tid, u >> 7, (u >> 2) & 31, u & 3, WSP(bf16_t, WS_Z), WSP(float, WS_VSS), A->in[16], A->in[15], R);
        kv_issue(kd, tid, kk, vv); q_issue(qd, tid, qf);
        gate_run(lds, tid, u >> 7, (u >> 2) & 31, u & 3, R, WSP(bf16_t, WS_Z), A->in[17], WSP(bf16_t, WS_MIX));
        attn_unit_run(lds, tid, qd, kd.key_lo, kk, vv, qf, false, kd, qd);
    }
}
__device__ __forceinline__ void phase_mix_b1(LAS unsigned char* lds) {
    ArgsP A = args_ptr(); const int bid = blockIdx.x, G = gridDim.x;
    int tid = threadIdx.x; asm volatile("" : "+v"(tid));
    KvDesc kd{}, kn{}; QoDesc qd{}, qn{};
    u32x4 kk[8], vv[8]; bf16x8 qf[4];
    int u = bid;
    if (u < 1024) { if (u < 768) swa_unit_desc(A, u, kd, qd); else mem_unit_desc(A, u - 768, 1, kd, qd); kv_issue(kd, tid, kk, vv); q_issue(qd, tid, qf); }
    build_bias_tables(lds, tid, A->in[7]);
#pragma unroll 1
    for (; u < 1024; u += G) {
        const int un = u + G; const bool has_next = un < 1024;
        if (has_next) { if (un < 768) swa_unit_desc(A, un, kn, qn); else mem_unit_desc(A, un - 768, 1, kn, qn); }
        attn_unit_run(lds, tid, qd, kd.key_lo, kk, vv, qf, has_next, kn, qn);
        kd = kn; qd = qn;
    }
}
__device__ __forceinline__ void phase_mix_b2(LAS unsigned char* lds) {
    ArgsP A = args_ptr(); const int bid = blockIdx.x, G = gridDim.x;
    int tid = threadIdx.x; asm volatile("" : "+v"(tid));
    const int lane = tid & 63, wave = __builtin_amdgcn_readfirstlane(tid >> 6), gw = bid * 8 + wave, NGW = G * 8;
    bf16_t* MIX = WSP(bf16_t, WS_MIX); const float* LSE = WSP(float, WS_LSE);
    for (int row = gw; row < TP; row += NGW) {
        const float* lp = LSE + (size_t)row * 12;
#pragma unroll
        for (int i = 0; i < 3; ++i) { const int col = 8 * (lane + 64 * i), H = col >> 7, g = H >> 2, hl = H & 3;
            const float l0 = lp[hl], l1 = lp[4 + hl], l2 = lp[8 + hl], mm = fmaxf(l0, fmaxf(l1, l2));
            const float e0 = __expf(l0 - mm), e1 = __expf(l1 - mm), e2 = __expf(l2 - mm);
            const float al = (g == 0 ? e0 : (g == 1 ? e1 : e2)) / (e0 + e1 + e2);
            u32x4 wv = *(u32x4*)(MIX + (size_t)row * DM + col);
            wv.x = cvt_pk_bf16(bf_lo(wv.x) * al, bf_hi(wv.x) * al); wv.y = cvt_pk_bf16(bf_lo(wv.y) * al, bf_hi(wv.y) * al);
            wv.z = cvt_pk_bf16(bf_lo(wv.z) * al, bf_hi(wv.z) * al); wv.w = cvt_pk_bf16(bf_lo(wv.w) * al, bf_hi(wv.w) * al);
            *(u32x4*)(MIX + (size_t)row * DM + col) = wv; }
    }
    { const int nw = G > 128 ? G - 128 : G, wk = bid < nw ? bid : -1;
      if (wk >= 0) { const bf16_t* Z = WSP(bf16_t, WS_Z); float* o0 = A->out + OUT_W128P;
        for (int i = wk * 512 + tid; i < 688128; i += nw * 512) {
            const int g = i < 32768 ? 0 : (i < 163840 ? 1 : 2), ig = i - (g == 0 ? 0 : (g == 1 ? 32768 : 163840)), W = 128 << (2 * g);
            const int c8 = ig & 63, kv = (ig >> 6) & 1, tr = (ig >> 7) & (W - 1), b = (ig >> 7) / W;
            const u32x4 wv = *(const u32x4*)(Z + (size_t)(b * SEQ + (SEQ - W) + tr) * ZP + MIXW + kv * MIXW + g * 512 + c8 * 8);
            float* dst = o0 + (size_t)2048 * ((W - 128) / 3) + (size_t)ig * 8;
            *(f32x4*)dst = (f32x4){bf_lo(wv.x), bf_hi(wv.x), bf_lo(wv.y), bf_hi(wv.y)}; *(f32x4*)(dst + 4) = (f32x4){bf_lo(wv.z), bf_hi(wv.z), bf_lo(wv.w), bf_hi(wv.w)}; } } }
    const float* rel_bias = A->in[7]; const float* ZS = WSP(float, WS_ZS);
    for (int it = G - 1 - bid; it < 96; it += G) {
        const int s = it / 12, H = it % 12, g = H >> 2, hl = H & 3, dil = 1 << (2 * g), W = 128 << (2 * g);
        LAS float* scr = (LAS float*)lds; LAS float* btab = scr + 2400; LAS float* og = scr + 2560;
        __syncthreads();
        for (int j = tid; j <= 128; j += 512) btab[j] = rel_bias[t5_bucket(j * dil) * 12 + H] * LOG2E;
        __syncthreads();
        const float* cw = A->in[4 + g];
        const float* zrow = ZS + (size_t)s * ZP;
        auto kf = [=](int j) -> const float* { return j == 0 ? zrow + MIXW + H * 128 : cw + ((size_t)(s * W + (W - j * dil)) * 2 + 0) * 512 + hl * 128; };
        auto vf = [=](int j) -> const float* { return j == 0 ? zrow + 2 * MIXW + H * 128 : cw + ((size_t)(s * W + (W - j * dil)) * 2 + 1) * 512 + hl * 128; };
        const float lg = sample_attend(scr, zrow + H * 128, 129, kf, vf, btab, og);
        if (tid < 128) MIX[(size_t)(TP + s) * DM + H * 128 + tid] = (bf16_t)f2bf(og[tid]);
        if (tid == 0) WSP(float, WS_LSE)[(size_t)TP * 12 + s * 12 + H] = lg;
        __syncthreads();
    }
    sample_mem_attn(lds, 1);
}
__device__ __forceinline__ void phase_out(LAS unsigned char* lds, int layer) {
    ArgsP A = args_ptr(); const int bid = blockIdx.x, G = gridDim.x;
    bf16_t* MIX = WSP(bf16_t, WS_MIX); bf16_t* OB = WSP(bf16_t, WS_O); const bf16_t* W = WSP(bf16_t, WS_WOUT) + (size_t)layer * DM * DM;
    pg8::Gemm g{MIX, W, TP, DM, DM}; pg8::StaticOrder S; S.init(TP, DM, G, bid); pg8::EpiPlain E{OB, DM};
    pg8::gemm_phase<pg8::EpiPlain, false, true>(lds, g, S, E);
    sample_gemv<1, DM>(lds, MIX + (size_t)TP * DM, DM, W, DM, G - 1 - bid, G, nullptr, OB + (size_t)TP * DM, DM, nullptr, nullptr, layer == 1 ? WSP(float, WS_LSE) + (size_t)TP * 12 : nullptr);
}
__device__ __forceinline__ void phase_up(LAS unsigned char* lds, int layer) {
    ArgsP A = args_ptr(); const int bid = blockIdx.x, G = gridDim.x;
    bf16_t* HN = WSP(bf16_t, WS_HN); bf16_t* ACT = WSP(bf16_t, WS_ACT); const bf16_t* W = WSP(bf16_t, WS_WUP) + (size_t)layer * NUP * DM;
    pg8::Gemm g{HN, W, TP, NUP, DM}; pg8::StaticOrder S; S.init(TP, NUP, G, bid); pg8::EpiSwiglu E{ACT, WSP(float, WS_RS)};
    pg8::gemm_phase<pg8::EpiSwiglu, true, true>(lds, g, S, E);
    sample_gemv<2, DM>(lds, HN + (size_t)TP * DM, DM, W, NUP, G - 1 - bid, G, nullptr, ACT + (size_t)TP * DFF, DFF, nullptr, WSP(float, WS_RS) + TP);
    if (G == 256) convert_tail(lds, A, layer == 0 ? 2 : 4, 128);
}
__device__ __forceinline__ void phase_down(LAS unsigned char* lds, int layer) {
    ArgsP A = args_ptr(); const int bid = blockIdx.x, G = gridDim.x;
    bf16_t* ACT = WSP(bf16_t, WS_ACT); bf16_t* OB = WSP(bf16_t, WS_O); const bf16_t* W = WSP(bf16_t, WS_WDN) + (size_t)layer * DM * DFF;
    pg8::Gemm g{ACT, W, TP, DM, DFF}; pg8::StaticOrder S; S.init(TP, DM, G, bid); pg8::EpiPlain E{OB, DM};
    pg8::gemm_phase<pg8::EpiPlain, false, true>(lds, g, S, E);
    sample_gemv<1, DFF>(lds, ACT + (size_t)TP * DFF, DFF, W, DM, G - 1 - bid, G, nullptr, OB + (size_t)TP * DM, DM, nullptr, nullptr);
}
__device__ __forceinline__ void phase_norm(int which) {
    ArgsP A = args_ptr();
    int tid = threadIdx.x; asm volatile("" : "+v"(tid));
    const int lane = tid & 63, wave = __builtin_amdgcn_readfirstlane(tid >> 6), gw = blockIdx.x * 8 + wave, NGW = gridDim.x * 8;
    const int layer = which >> 1;
    float* Y = A->out + OUT_Y; const bf16_t* OB = WSP(bf16_t, WS_O); bf16_t* YB = WSP(bf16_t, WS_HN); float* RS = WSP(float, WS_RS);
    const float* gpost = ((which & 1) ? A->in[11] : A->in[9]) + layer * DM;
    for (int r = gw; r < TP + TSMP; r += NGW) {
        if (which == 3) norm_row<3>(nullptr, YB + (size_t)r * DM, OB + (size_t)r * DM, gpost, nullptr, Y + (size_t)r * DM, lane);
        else norm_row<2>(nullptr, YB + (size_t)r * DM, OB + (size_t)r * DM, gpost, RS + r, nullptr, lane);
    }
}

__global__ void __launch_bounds__(512, 2) fwd_megakernel(Args args) {
    extern __shared__ __attribute__((aligned(16))) unsigned char lds_raw[];
    LAS unsigned char* lds = (LAS unsigned char*)lds_raw;
    volatile LAS unsigned* bst = (volatile LAS unsigned*)(lds + LDS_BYTES - 64);
    if (threadIdx.x < 16) bst[threadIdx.x] = 0u;
    __syncthreads();
    const XcdBarrier bar = xcd_barrier_post((unsigned*)args.ws, bst);
#define GRID_SYNC() xcd_barrier(bar)
    phase_prologue(lds);
    GRID_SYNC();
    phase_in_a(lds);
    GRID_SYNC();
    phase_mix_a(lds);
    GRID_SYNC();
    phase_out(lds, 0);
    GRID_SYNC();
    phase_norm(0);
    GRID_SYNC();
    phase_up(lds, 0);
    GRID_SYNC();
    phase_down(lds, 0);
    GRID_SYNC();
    phase_norm(1);
    GRID_SYNC();
    phase_in_b(lds);
    GRID_SYNC();
    phase_mix_b1(lds);
    GRID_SYNC();
    phase_mix_b2(lds);
    GRID_SYNC();
    phase_out(lds, 1);
    GRID_SYNC();
    phase_norm(2);
    GRID_SYNC();
    phase_up(lds, 1);
    GRID_SYNC();
    phase_down(lds, 1);
    GRID_SYNC();
    phase_norm(3);
#undef GRID_SYNC
}

extern "C" void kernel_launch(void* const* d_in, const int* in_sizes, int n_in, void* d_out, int out_size, void* d_ws, size_t ws_size, hipStream_t stream) {
    static int grid = 0;
    if (grid == 0) {
        if (n_in != 22 || (size_t)out_size != OUT_TOTAL || ws_size < WS_END) { fprintf(stderr, "kernel_launch: unexpected shapes (n_in %d, out %d, ws %zu)\n", n_in, out_size, ws_size); grid = -1; return; }
        int dev = 0, cus = 0, per_cu = 0;
        if (hipGetDevice(&dev) != hipSuccess || hipDeviceGetAttribute(&cus, hipDeviceAttributeMultiprocessorCount, dev) != hipSuccess) { grid = -1; return; }
        if (hipFuncSetAttribute((const void*)fwd_megakernel, hipFuncAttributeMaxDynamicSharedMemorySize, LDS_BYTES) != hipSuccess) { fprintf(stderr, "kernel_launch: hipFuncSetAttribute failed\n"); grid = -1; return; }
        if (hipOccupancyMaxActiveBlocksPerMultiprocessor(&per_cu, (const void*)fwd_megakernel, 512, LDS_BYTES) != hipSuccess || per_cu < 1) { fprintf(stderr, "kernel_launch: occupancy query says %d\n", per_cu); (void)hipGetLastError(); per_cu = 1; }
        grid = cus;
    }
    if (grid < 0) return;
    if (hipMemsetAsync(d_ws, 0, 16384, stream) != hipSuccess) { fprintf(stderr, "kernel_launch: memset of the barrier words failed\n"); return; }
    Args a{};
    for (int i = 0; i < 22; ++i) a.in[i] = (const float*)d_in[i];
    a.out = (float*)d_out; a.ws = (unsigned char*)d_ws;
    void* kargs[] = {&a};
    hipError_t e = hipLaunchCooperativeKernel((const void*)fwd_megakernel, dim3(grid), dim3(512), kargs, LDS_BYTES, stream);
    if (e != hipSuccess) fprintf(stderr, "kernel_launch: cooperative launch failed: %s (grid %d)\n", hipGetErrorString(e), grid);
}
```

```cpp
#include <hip/hip_runtime.h>
#include <cstdio>
#include <cstdint>

#define LAS __attribute__((address_space(3)))
typedef unsigned short bf16_t;
typedef short bf16x8 __attribute__((ext_vector_type(8)));
typedef short s16x4 __attribute__((ext_vector_type(4)));
typedef float f32x4 __attribute__((ext_vector_type(4)));
typedef float f32x2 __attribute__((ext_vector_type(2)));
typedef unsigned u32x4 __attribute__((ext_vector_type(4)));
typedef unsigned u32x2 __attribute__((ext_vector_type(2)));

constexpr int DM = 2048, TP = 8192, TSMP = 8, TROWS = TP + 16, SEQ = 4096;
constexpr int MIXW = 1536, NA = 3584, NB = 5120, DFF = 5632, NUP = 11264, NKV = 1024;
constexpr int ZP = 5120;
constexpr float EPS = 1e-6f;
constexpr float LOG2E = 1.4426950408889634f, LN2 = 0.6931471805599453f;
constexpr float QSCALE = 0.08838834764831845f * 1.4426950408889634f;

constexpr size_t MiB = 1u << 20;
constexpr size_t WS_WMKV = 1 * MiB;
constexpr size_t WS_WINA = 9 * MiB;
constexpr size_t WS_WINB = 23 * MiB;
constexpr size_t WS_WOUT = 43 * MiB;
constexpr size_t WS_WUP = 59 * MiB;
constexpr size_t WS_WDN = 147 * MiB;
constexpr size_t WS_HN = 191 * MiB;
constexpr size_t WS_HM = 224 * MiB;
constexpr size_t WS_MKV = 228 * MiB;
constexpr size_t WS_Z = 230 * MiB;
constexpr size_t WS_ZS = 310 * MiB;
constexpr size_t WS_VSS = 311 * MiB;
constexpr size_t WS_MIX = 312 * MiB;
constexpr size_t WS_LSE = 345 * MiB;
constexpr size_t WS_RS = 345 * MiB + 512 * 1024;
constexpr size_t WS_O = 346 * MiB;
constexpr size_t WS_ACT = 379 * MiB;
constexpr size_t WS_END = 468 * MiB;

constexpr size_t OUT_Y = 0;
constexpr size_t OUT_MKV = 16793600;
constexpr size_t OUT_CHV = OUT_MKV + 1048576;
constexpr size_t OUT_W128P = OUT_CHV + 12288;
constexpr size_t OUT_W512P = OUT_W128P + 262144;
constexpr size_t OUT_W2048P = OUT_W512P + 1048576;
constexpr size_t OUT_W128S = OUT_W2048P + 4194304;
constexpr size_t OUT_W512S = OUT_W128S + 8192;
constexpr size_t OUT_W2048S = OUT_W512S + 8192;
constexpr size_t OUT_TOTAL = OUT_W2048S + 8192;

constexpr int LDS_BYTES = 147456;
constexpr int LDS_TAB = 131072;

__device__ __forceinline__ unsigned cvt_pk_bf16(float lo, float hi) { unsigned r; asm volatile("v_cvt_pk_bf16_f32 %0, %1, %2" : "=v"(r) : "v"(lo), "v"(hi)); return r; }
__device__ __forceinline__ float bf_lo(unsigned w) { return __uint_as_float(w << 16); }
__device__ __forceinline__ float bf_hi(unsigned w) { return __uint_as_float(w & 0xffff0000u); }
__device__ __forceinline__ float wave_sum(float v) {
#pragma unroll
    for (int o = 1; o < 64; o <<= 1) v += __shfl_xor(v, o);
    return v;
}
__device__ __forceinline__ float wave_max(float v) {
#pragma unroll
    for (int o = 1; o < 64; o <<= 1) v = fmaxf(v, __shfl_xor(v, o));
    return v;
}
__device__ __forceinline__ float gelu_tanh(float x) {
    const float t = x * x;
    const float u2 = x * (1.5957691216057308f + 0.07135481627260024f * t);
    const float e = __builtin_amdgcn_exp2f(-LOG2E * u2);
    return x * __builtin_amdgcn_rcpf(1.0f + e);
}
__device__ __forceinline__ float silu_f(float x) {
    const float e = __builtin_amdgcn_exp2f(-LOG2E * x);
    return x * __builtin_amdgcn_rcpf(1.0f + e);
}
__device__ __forceinline__ int t5_bucket(int d) {
    if (d < 16) return d;
    int b = 16;
    b += (d >= 22); b += (d >= 30); b += (d >= 40); b += (d >= 54); b += (d >= 73); b += (d >= 99); b += (d >= 134); b += (d >= 182);
    b += (d >= 246); b += (d >= 332); b += (d >= 450); b += (d >= 609); b += (d >= 825); b += (d >= 1117); b += (d >= 1513);
    return b;
}
__device__ __forceinline__ unsigned off_b(unsigned row, unsigned ch) { return 256u * row + 16u * (ch ^ (((row & 3) << 2) | ((row >> 2) & 3))); }
__device__ __forceinline__ unsigned tr16_addr(unsigned lane, unsigned c, unsigned ks, unsigned t) {
    const unsigned g = lane >> 4, q = (lane & 15) >> 2, p = lane & 3;
    return off_b(32 * ks + 8 * g + 4 * t + q, 2 * c + (p >> 1)) + 8 * (p & 1);
}
typedef short v4i16_t __attribute__((ext_vector_type(4)));
__device__ __forceinline__ s16x4 tr_read(LAS unsigned char* p) { return __builtin_bit_cast(s16x4, __builtin_amdgcn_ds_read_tr16_b64_v4i16((LAS v4i16_t*)p)); }

namespace pg8 {
constexpr int BM = 256, BK = 64, HALF = 128, HTB = HALF * BK * 2, STAGE_BYTES = 8 * HTB, NXCD = 8, WGM = 8;
__host__ __device__ __forceinline__ int lds_byte(int r, int c) { const int st = (r >> 4) * 2 + (c >> 5), rr = r & 15, cc = c & 31, ob = rr * 64 + cc * 2; return st * 1024 + (ob ^ (((ob >> 9) & 1) << 5)); }
__host__ __device__ __forceinline__ void stage_rc(int b, int& R, int& C) { const int st = b / 1024, sb = b % 1024, swz = sb ^ (((sb >> 9) & 1) << 5); R = (st >> 1) * 16 + swz / 64; C = (st & 1) * 32 + (swz % 64) / 2; }
__host__ __device__ __forceinline__ int perm32(int rho) { const int n = rho >> 4, i = rho & 15; return 8 * (i >> 2) + 4 * n + (i & 3); }

struct Unit { int pm, pn; };
struct Gemm { const bf16_t* A; const bf16_t* Bt; int M, N, K; };

struct StaticOrder {
    int nM, nN, nwg, G, c;
    __host__ __device__ void init(int M, int N, int G_, int c_) { nM = M / BM; nN = N / BM; nwg = nM * nN; G = G_; c = c_; }
    __host__ __device__ bool next(int i, Unit& u) const {
        const long L = (long)i * G + c; if (L >= nwg) return false;
        int wgid = (int)L; { const int q = nwg / NXCD, r = nwg % NXCD, xcd = wgid % NXCD, off = wgid / NXCD; wgid = (xcd < r ? xcd * (q + 1) : r * (q + 1) + (xcd - r) * q) + off; }
        const int nig = WGM * nN, gid = wgid / nig, fm = gid * WGM, gsz = (nM - fm) < WGM ? (nM - fm) : WGM;
        u.pm = fm + ((wgid % nig) % gsz); u.pn = (wgid % nig) / gsz; return true;
    }
};

template <class Epi, bool ALIGN_EPI, bool SP2>
__device__ __forceinline__ void gemm_phase(LAS unsigned char* lds, const Gemm g, const StaticOrder& S, const Epi& E) {
    int tid = threadIdx.x; asm volatile("" : "+v"(tid));
    const int wid = __builtin_amdgcn_readfirstlane(tid >> 6), lane = tid & 63, wr = wid >> 2, wc = wid & 3, fr = lane & 15, fq = lane >> 4;
    const int K = g.K, nt = K / BK;
    unsigned voffA[2], voffB[2];
#pragma unroll
    for (int i = 0; i < 2; ++i) { int R, C; stage_rc(tid * 16 + i * 8192, R, C); const int Rb = (R & ~31) + perm32(R & 31);
        voffA[i] = (unsigned)(R * K + C) * 2u; voffB[i] = (unsigned)(Rb * K + C) * 2u; }
    const size_t kstep = (size_t)(BK * 2);
    const size_t hstep = (size_t)HALF * K * 2;
    const size_t tstep = 2 * hstep;
    const unsigned ldsw = (unsigned)wid * 1024u;
    const int aoff = lds_byte(wr * 64 + fr, fq * 8), boff = lds_byte(wc * 32 + fr, fq * 8);
#define PG8_SA(b, h) (((b) * 2 + (h)) * HTB)
#define PG8_SB(b, h) ((4 + (b) * 2 + (h)) * HTB)
#define PG8_STAGE(bufoff, gbase, voff) do { _Pragma("unroll") for (int _i = 0; _i < 2; ++_i) \
        __builtin_amdgcn_global_load_lds((const unsigned*)((const char*)(gbase) + (voff)[_i]), (LAS unsigned*)(lds + (bufoff) + ldsw + _i * 8192), 16, 0, 0); } while (0)
#define PG8_LDA(dst, b, h) do { _Pragma("unroll") for (int m = 0; m < 4; ++m) _Pragma("unroll") for (int k = 0; k < 2; ++k) dst[m][k] = *(const LAS bf16x8*)(lds + PG8_SA(b, h) + aoff + m * 2048 + k * 1024); } while (0)
#define PG8_LDB(dst, b, h) do { _Pragma("unroll") for (int n = 0; n < 2; ++n) _Pragma("unroll") for (int k = 0; k < 2; ++k) dst[n][k] = *(const LAS bf16x8*)(lds + PG8_SB(b, h) + boff + n * 2048 + k * 1024); } while (0)
#define PG8_MMA(ai, bj, At, Bt) do { __builtin_amdgcn_s_setprio(1); _Pragma("unroll") for (int m = 0; m < 4; ++m) _Pragma("unroll") for (int n = 0; n < 2; ++n) _Pragma("unroll") for (int k = 0; k < 2; ++k) \
        acc[ai][bj][m][n] = __builtin_amdgcn_mfma_f32_16x16x32_bf16(Bt[n][k], At[m][k], acc[ai][bj][m][n], 0, 0, 0); __builtin_amdgcn_s_setprio(0); } while (0)
#define PG8_WAIT_V(n) asm volatile("s_waitcnt vmcnt(" #n ")" ::: "memory")
#define PG8_WAIT_L(n) asm volatile("s_waitcnt lgkmcnt(" #n ")" ::: "memory")
#define PG8_BAR __builtin_amdgcn_s_barrier()
#define PG8_SCHED __builtin_amdgcn_sched_barrier(0)
    Unit cur, nxt; int ui = 0;
    if (!S.next(0, cur)) return;
    f32x4 acc[2][2][4][2];
#pragma unroll
    for (int a = 0; a < 2; ++a)
#pragma unroll
        for (int b = 0; b < 2; ++b)
#pragma unroll
            for (int m = 0; m < 4; ++m)
#pragma unroll
                for (int n = 0; n < 2; ++n) acc[a][b][m][n] = (f32x4){0.f, 0.f, 0.f, 0.f};
    bf16x8 At[4][2], B0[2][2], B1[2][2];
    const char* cA = (const char*)g.A + (size_t)cur.pm * tstep; const char* cB = (const char*)g.Bt + (size_t)cur.pn * tstep;
    if constexpr (SP2) {
        PG8_STAGE(PG8_SB(0, 0), cB, voffB); PG8_STAGE(PG8_SB(0, 1), cB + hstep, voffB); PG8_STAGE(PG8_SA(0, 0), cA, voffA); PG8_STAGE(PG8_SA(0, 1), cA + hstep, voffA);
        if (wr == 1) PG8_BAR;
        PG8_WAIT_V(2); PG8_BAR;
        PG8_STAGE(PG8_SB(1, 0), cB + kstep, voffB); PG8_STAGE(PG8_SA(1, 0), cA + kstep, voffA); PG8_STAGE(PG8_SB(1, 1), cB + hstep + kstep, voffB);
        PG8_WAIT_V(6); PG8_BAR;
    } else {
        PG8_STAGE(PG8_SB(0, 0), cB, voffB); PG8_STAGE(PG8_SA(0, 0), cA, voffA); PG8_STAGE(PG8_SB(0, 1), cB + hstep, voffB); PG8_STAGE(PG8_SA(0, 1), cA + hstep, voffA);
        if (wr == 1) PG8_BAR;
        PG8_WAIT_V(4); PG8_BAR;
        PG8_STAGE(PG8_SB(1, 0), cB + kstep, voffB); PG8_STAGE(PG8_SA(1, 0), cA + kstep, voffA); PG8_STAGE(PG8_SB(1, 1), cB + hstep + kstep, voffB);
        PG8_WAIT_V(6); PG8_BAR;
    }
    for (;;) {
        const typename Epi::Pre pre = E.prefetch(cur, wr, fr);
        const bool has_next = S.next(ui + 1, nxt);
        const char* nA = has_next ? (const char*)g.A + (size_t)nxt.pm * tstep : cA; const char* nB = has_next ? (const char*)g.Bt + (size_t)nxt.pn * tstep : cB;
        for (int t = 0; t < nt; t += 2) {
            const bool last = (t == nt - 2);
            const char* a1 = cA + (size_t)(t + 1) * kstep;
            const char* a2 = last ? nA : cA + (size_t)(t + 2) * kstep; const char* b2 = last ? nB : cB + (size_t)(t + 2) * kstep;
            const char* a3 = a2 + kstep; const char* b3 = b2 + kstep;
            if constexpr (SP2) {
            PG8_LDB(B0, 0, 0); PG8_LDB(B1, 0, 1); PG8_SCHED; PG8_LDA(At, 0, 0); PG8_STAGE(PG8_SA(1, 1), a1 + hstep, voffA);
            PG8_WAIT_V(8); PG8_WAIT_L(0); PG8_BAR; PG8_MMA(0, 0, At, B0); PG8_MMA(0, 1, At, B1); PG8_BAR; PG8_SCHED;
            PG8_LDA(At, 0, 1); PG8_STAGE(PG8_SB(0, 0), b2, voffB); PG8_STAGE(PG8_SB(0, 1), b2 + hstep, voffB); PG8_STAGE(PG8_SA(0, 0), a2, voffA);
            PG8_WAIT_V(8); PG8_WAIT_L(0); PG8_BAR; PG8_MMA(1, 0, At, B0); PG8_MMA(1, 1, At, B1); PG8_BAR; PG8_SCHED;
            PG8_LDB(B0, 1, 0); PG8_LDB(B1, 1, 1); PG8_SCHED; PG8_LDA(At, 1, 0); PG8_STAGE(PG8_SA(0, 1), a2 + hstep, voffA);
            PG8_WAIT_V(8); PG8_WAIT_L(0); PG8_BAR; PG8_MMA(0, 0, At, B0); PG8_MMA(0, 1, At, B1); PG8_BAR; PG8_SCHED;
            PG8_LDA(At, 1, 1); PG8_STAGE(PG8_SB(1, 0), b3, voffB); PG8_STAGE(PG8_SB(1, 1), b3 + hstep, voffB); PG8_STAGE(PG8_SA(1, 0), a3, voffA);
            PG8_WAIT_V(8); PG8_WAIT_L(0); PG8_BAR; PG8_MMA(1, 0, At, B0); PG8_MMA(1, 1, At, B1); PG8_BAR; PG8_SCHED;
            } else {
            PG8_LDB(B0, 0, 0); PG8_SCHED; PG8_LDA(At, 0, 0); PG8_STAGE(PG8_SA(1, 1), a1 + hstep, voffA);
            PG8_WAIT_L(8); PG8_BAR; PG8_WAIT_L(0); PG8_MMA(0, 0, At, B0); PG8_BAR; PG8_SCHED;
            PG8_LDB(B1, 0, 1); PG8_STAGE(PG8_SB(0, 0), b2, voffB);
            PG8_BAR; PG8_WAIT_L(0); PG8_MMA(0, 1, At, B1); PG8_BAR;
            PG8_LDA(At, 0, 1); PG8_STAGE(PG8_SA(0, 0), a2, voffA);
            PG8_BAR; PG8_WAIT_L(0); PG8_MMA(1, 0, At, B0); PG8_BAR; PG8_SCHED;
            PG8_STAGE(PG8_SB(0, 1), b2 + hstep, voffB);
            PG8_WAIT_V(6); PG8_BAR; PG8_MMA(1, 1, At, B1); PG8_BAR;
            PG8_LDB(B0, 1, 0); PG8_SCHED; PG8_LDA(At, 1, 0); PG8_STAGE(PG8_SA(0, 1), a2 + hstep, voffA);
            PG8_WAIT_L(8); PG8_BAR; PG8_WAIT_L(0); PG8_MMA(0, 0, At, B0); PG8_BAR; PG8_SCHED;
            PG8_LDB(B1, 1, 1); PG8_STAGE(PG8_SB(1, 0), b3, voffB);
            PG8_BAR; PG8_WAIT_L(0); PG8_MMA(0, 1, At, B1); PG8_BAR;
            PG8_LDA(At, 1, 1); PG8_STAGE(PG8_SA(1, 0), a3, voffA);
            PG8_BAR; PG8_WAIT_L(0); PG8_MMA(1, 0, At, B0); PG8_BAR; PG8_SCHED;
            PG8_STAGE(PG8_SB(1, 1), b3 + hstep, voffB);
            PG8_WAIT_V(6); PG8_BAR; PG8_MMA(1, 1, At, B1); PG8_BAR;
            }
        }
        if constexpr (ALIGN_EPI) { if (wr == 0) PG8_BAR; }
        E(acc, cur, wr, wc, fr, fq, pre);
        if (!has_next) break;
#pragma unroll
        for (int a = 0; a < 2; ++a)
#pragma unroll
            for (int b = 0; b < 2; ++b)
#pragma unroll
                for (int m = 0; m < 4; ++m)
#pragma unroll
                    for (int n = 0; n < 2; ++n) acc[a][b][m][n] = (f32x4){0.f, 0.f, 0.f, 0.f};
        cur = nxt; cA = nA; cB = nB; ++ui;
        if constexpr (ALIGN_EPI) { if (wr == 1) PG8_BAR; }
    }
    PG8_WAIT_V(0);
    if constexpr (!ALIGN_EPI) { if (wr == 0) PG8_BAR; }
    PG8_BAR;
#undef PG8_SA
#undef PG8_SB
#undef PG8_STAGE
#undef PG8_LDA
#undef PG8_LDB
#undef PG8_MMA
#undef PG8_WAIT_V
#undef PG8_WAIT_L
#undef PG8_BAR
#undef PG8_SCHED
}

typedef f32x4 Acc[2][2][4][2];
struct PreRs { float r[2][4]; };
struct PreNone { };
__device__ __forceinline__ PreRs load_rs(const float* rs, const Unit& u, int wr, int fr) { PreRs p; const int row0 = u.pm * BM + wr * 64 + fr;
#pragma unroll
    for (int ai = 0; ai < 2; ++ai)
#pragma unroll
        for (int m = 0; m < 4; ++m) p.r[ai][m] = rs[row0 + ai * HALF + m * 16];
    return p; }
__device__ __forceinline__ u32x4 pack8(const f32x4 a, const f32x4 b) { u32x4 w; w.x = cvt_pk_bf16(a[0], a[1]); w.y = cvt_pk_bf16(a[2], a[3]); w.z = cvt_pk_bf16(b[0], b[1]); w.w = cvt_pk_bf16(b[2], b[3]); return w; }

struct EpiInA {
    bf16_t* Z; float* VSS; const float* rs;
    typedef PreRs Pre; __device__ __forceinline__ Pre prefetch(const Unit& u, int wr, int fr) const { return load_rs(rs, u, wr, fr); }
    __device__ __forceinline__ void operator()(const Acc& acc, const Unit& u, int wr, int wc, int fr, int fq, const Pre& pre) const {
        const int row0 = u.pm * BM + wr * 64 + fr, col0 = u.pn * BM + wc * 32 + 8 * fq;
        const bool act = u.pn < 12, isv = (u.pn >= 6) && act;
#pragma unroll
        for (int ai = 0; ai < 2; ++ai)
#pragma unroll
            for (int m = 0; m < 4; ++m) {
                const int row = row0 + ai * HALF + m * 16; bf16_t* rowp = Z + (size_t)row * ZP + col0; float ss = 0.f; const float rsr = pre.r[ai][m];
#pragma unroll
                for (int bj = 0; bj < 2; ++bj) { f32x4 v0 = acc[ai][bj][m][0] * rsr, v1 = acc[ai][bj][m][1] * rsr;
                    if (act) {
#pragma unroll
                        for (int e = 0; e < 4; ++e) { v0[e] = gelu_tanh(v0[e]); v1[e] = gelu_tanh(v1[e]); ss += v0[e] * v0[e] + v1[e] * v1[e]; }
                    } else { v0 = v0 * QSCALE; v1 = v1 * QSCALE; }
                    *(u32x4*)(rowp + bj * HALF) = pack8(v0, v1); }
                if (isv) { ss += __shfl_xor(ss, 16); ss += __shfl_xor(ss, 32); if (fq == 0) VSS[(size_t)row * 24 + (u.pn - 6) * 4 + wc] = ss; }
            }
    }
};
struct EpiMkv {
    float* outf; bf16_t* outb; const float* rs;
    typedef PreRs Pre; __device__ __forceinline__ Pre prefetch(const Unit& u, int wr, int fr) const { return load_rs(rs, u, wr, fr); }
    __device__ __forceinline__ void operator()(const Acc& acc, const Unit& u, int wr, int wc, int fr, int fq, const Pre& pre) const {
        const int row0 = u.pm * BM + wr * 64 + fr, col0 = u.pn * BM + wc * 32 + 8 * fq;
#pragma unroll
        for (int ai = 0; ai < 2; ++ai)
#pragma unroll
            for (int m = 0; m < 4; ++m) { const size_t off = (size_t)(row0 + ai * HALF + m * 16) * NKV + col0; const float rsr = pre.r[ai][m];
#pragma unroll
                for (int bj = 0; bj < 2; ++bj) { const f32x4 v0 = acc[ai][bj][m][0] * rsr, v1 = acc[ai][bj][m][1] * rsr;
                    *(f32x4*)(outf + off + bj * HALF) = v0; *(f32x4*)(outf + off + bj * HALF + 4) = v1; *(u32x4*)(outb + off + bj * HALF) = pack8(v0, v1); } }
    }
};
struct EpiPlain {
    bf16_t* O; int ldc;
    typedef PreNone Pre; __device__ __forceinline__ Pre prefetch(const Unit&, int, int) const { return Pre{}; }
    __device__ __forceinline__ void operator()(const Acc& acc, const Unit& u, int wr, int wc, int fr, int fq, const Pre&) const {
        const int row0 = u.pm * BM + wr * 64 + fr, col0 = u.pn * BM + wc * 32 + 8 * fq;
#pragma unroll
        for (int ai = 0; ai < 2; ++ai)
#pragma unroll
            for (int m = 0; m < 4; ++m) { bf16_t* rowp = O + (size_t)(row0 + ai * HALF + m * 16) * ldc + col0;
#pragma unroll
                for (int bj = 0; bj < 2; ++bj) *(u32x4*)(rowp + bj * HALF) = pack8(acc[ai][bj][m][0], acc[ai][bj][m][1]); }
    }
};
struct EpiSwiglu {
    bf16_t* ACT; const float* rs;
    typedef PreRs Pre; __device__ __forceinline__ Pre prefetch(const Unit& u, int wr, int fr) const { return load_rs(rs, u, wr, fr); }
    __device__ __forceinline__ void operator()(const Acc& acc, const Unit& u, int wr, int wc, int fr, int fq, const Pre& pre) const {
        const int row0 = u.pm * BM + wr * 64 + fr, col0 = u.pn * HALF + wc * 32 + 8 * fq;
#pragma unroll
        for (int ai = 0; ai < 2; ++ai)
#pragma unroll
            for (int m = 0; m < 4; ++m) { f32x4 v0, v1; const float rsr = pre.r[ai][m];
#pragma unroll
                for (int e = 0; e < 4; ++e) { v0[e] = silu_f(acc[ai][0][m][0][e] * rsr) * (acc[ai][1][m][0][e] * rsr); v1[e] = silu_f(acc[ai][0][m][1][e] * rsr) * (acc[ai][1][m][1][e] * rsr); }
                *(u32x4*)(ACT + (size_t)(row0 + ai * HALF + m * 16) * DFF + col0) = pack8(v0, v1); }
    }
};
struct EpiInB {
    bf16_t* Z; const float* rs;
    typedef PreRs Pre; __device__ __forceinline__ Pre prefetch(const Unit& u, int wr, int fr) const { return load_rs(rs, u, wr, fr); }
    __device__ __forceinline__ void operator()(const Acc& acc, const Unit& u, int wr, int wc, int fr, int fq, const Pre& pre) const {
        const int row0 = u.pm * BM + wr * 64 + fr, col0 = u.pn * BM + wc * 32 + 8 * fq;
        const float qs = ((u.pn < 6) || (u.pn >= 18)) ? QSCALE : 1.0f;
#pragma unroll
        for (int ai = 0; ai < 2; ++ai)
#pragma unroll
            for (int m = 0; m < 4; ++m) {
                const int row = row0 + ai * HALF + m * 16; bf16_t* rowp = Z + (size_t)row * ZP + col0; const float rsr = pre.r[ai][m] * qs;
#pragma unroll
                for (int bj = 0; bj < 2; ++bj) *(u32x4*)(rowp + bj * HALF) = pack8(acc[ai][bj][m][0] * rsr, acc[ai][bj][m][1] * rsr);
            }
    }
};
}

__device__ __forceinline__ unsigned f2bf(float f) { unsigned u = __builtin_bit_cast(unsigned, f); return (u + 0x7fffu + ((u >> 16) & 1u)) >> 16; }
__device__ __forceinline__ unsigned pk2(float lo, float hi) { return f2bf(lo) | (f2bf(hi) << 16); }
struct TItem { const float* src; bf16_t* dst; const float* gain; int N, K; };
__device__ __forceinline__ TItem t_make(const float* W, int K, int N, bf16_t* WT, bool upperm, const float* gain, int item) {
    const int nblk = N / 64, kb = item / nblk, nb = item % nblk, k0 = 64 * kb, n0 = 64 * nb;
    int s0 = n0;
    if (upperm) { const int pn = n0 >> 8, j = n0 & 255; s0 = (j < 128) ? (128 * pn + j) : (DFF + 128 * pn + (j - 128)); }
    TItem t; t.src = W + (size_t)k0 * N + s0; t.dst = WT + (size_t)n0 * K + k0; t.gain = gain != nullptr ? gain + k0 : nullptr; t.N = N; t.K = K; return t;
}
__device__ __forceinline__ void t_load(const TItem& t, int lane, f32x4 (&v)[16]) {
    const float* src = t.src + (size_t)(lane >> 4) * t.N + 4 * (lane & 15);
#pragma unroll
    for (int i = 0; i < 16; ++i) v[i] = __builtin_nontemporal_load((const f32x4*)(src + (size_t)(4 * i) * t.N));
}
__device__ __forceinline__ void t_store(const TItem& t, LAS float* scr, int lane, const f32x4 (&v)[16]) {
    const int lr = lane >> 4, lc = lane & 15;
#pragma unroll
    for (int i = 0; i < 16; ++i) { const int k = 4 * i + lr; const float gk = t.gain != nullptr ? t.gain[k] : 1.0f;
        *(LAS f32x4*)(scr + k * 64 + ((4 * lc) ^ (4 * (k >> 3)))) = v[i] * gk; }
    asm volatile("s_waitcnt lgkmcnt(0)" ::: "memory");
    const int c = lane & 7;
#pragma unroll
    for (int j = 0; j < 8; ++j) { const int n = (lane >> 3) + 8 * j; const LAS float* sp = scr + (8 * c) * 64 + (n ^ (4 * c));
        u32x4 o; o.x = cvt_pk_bf16(sp[0 * 64], sp[1 * 64]); o.y = cvt_pk_bf16(sp[2 * 64], sp[3 * 64]); o.z = cvt_pk_bf16(sp[4 * 64], sp[5 * 64]); o.w = cvt_pk_bf16(sp[6 * 64], sp[7 * 64]);
        __builtin_nontemporal_store(o, (u32x4*)(t.dst + (size_t)n * t.K + 8 * c)); }
    asm volatile("s_waitcnt lgkmcnt(0)" ::: "memory");
}
template <int MODE>
__device__ __forceinline__ void norm_row(const float* basef, bf16_t* yb, const bf16_t* o, const float* gpost, float* rs_out, float* yout, int lane) {
    f32x4 y[8];
    if (MODE == 0 || MODE == 1) {
#pragma unroll
        for (int j = 0; j < 8; ++j) y[j] = *(const f32x4*)(basef + 4 * (lane + 64 * j));
    } else {
#pragma unroll
        for (int j = 0; j < 8; ++j) { const u32x2 w = *(const u32x2*)(yb + 4 * (lane + 64 * j)); y[j] = (f32x4){bf_lo(w.x), bf_hi(w.x), bf_lo(w.y), bf_hi(w.y)}; }
    }
    if (MODE != 0) {
        f32x4 ov[8]; float ss = 0.f;
#pragma unroll
        for (int j = 0; j < 8; ++j) { const u32x2 w = *(const u32x2*)(o + 4 * (lane + 64 * j)); ov[j] = (f32x4){bf_lo(w.x), bf_hi(w.x), bf_lo(w.y), bf_hi(w.y)};
            ss += (ov[j][0] * ov[j][0] + ov[j][1] * ov[j][1]) + (ov[j][2] * ov[j][2] + ov[j][3] * ov[j][3]); }
        const float rstd = 1.0f / sqrtf(wave_sum(ss) * (1.0f / DM) + EPS);
#pragma unroll
        for (int j = 0; j < 8; ++j) { const f32x4 g = *(const f32x4*)(gpost + 4 * (lane + 64 * j)); y[j] = y[j] + ov[j] * rstd * g; }
    }
    if (MODE == 3) {
#pragma unroll
        for (int j = 0; j < 8; ++j) *(f32x4*)(yout + 4 * (lane + 64 * j)) = y[j];
    } else {
        float ss = 0.f;
#pragma unroll
        for (int j = 0; j < 8; ++j) { ss += (y[j][0] * y[j][0] + y[j][1] * y[j][1]) + (y[j][2] * y[j][2] + y[j][3] * y[j][3]);
            u32x2 w; w.x = cvt_pk_bf16(y[j][0], y[j][1]); w.y = cvt_pk_bf16(y[j][2], y[j][3]); *(u32x2*)(yb + 4 * (lane + 64 * j)) = w; }
        ss = wave_sum(ss);
        if (lane == 0) *rs_out = 1.0f / sqrtf(ss * (1.0f / DM) + EPS);
    }
}

struct KvDesc { const bf16_t* kbase; const bf16_t* vbase; long row0, rstep, pitch; int key_lo; };
__device__ __forceinline__ void kv_issue(const KvDesc& d, int tid, u32x4 (&kk)[8], u32x4 (&vv)[8]) {
    const int srow = tid >> 4, sch = tid & 15;
#pragma unroll
    for (int i = 0; i < 8; ++i) { const int row = srow + 32 * i, rowc = row < d.key_lo ? d.key_lo : row;
        const size_t e = (size_t)(d.row0 + (long)rowc * d.rstep) * d.pitch + sch * 8; kk[i] = *(const u32x4*)(d.kbase + e); vv[i] = *(const u32x4*)(d.vbase + e); }
}
__device__ __forceinline__ void kv_commit(LAS unsigned char* lds, int tid, int key_lo, const u32x4 (&kk)[8], const u32x4 (&vv)[8]) {
    const unsigned sb = off_b(tid >> 4, tid & 15); const int srow = tid >> 4; const u32x4 z = (u32x4){0u, 0u, 0u, 0u};
#pragma unroll
    for (int i = 0; i < 8; ++i) { const bool ok = (srow + 32 * i) >= key_lo; *(LAS u32x4*)(lds + sb + 8192 * i) = ok ? kk[i] : z; *(LAS u32x4*)(lds + 65536 + sb + 8192 * i) = ok ? vv[i] : z; }
}
template <bool BANDED>
__device__ __forceinline__ void attn_compute(LAS unsigned char* lds, int lane, int w, const bf16x8 (&qf)[4], int key_lo, bf16_t* orow, float* lsep, const LAS float* btab) {
    const int fr = lane & 15, fq = lane >> 4;
    LAS unsigned char* Kimg = lds; LAS unsigned char* Vimg = lds + 65536;
    constexpr int NBLK = BANDED ? 5 : 8;
    const int blk0 = BANDED ? (w >> 1) : 0;
    const int qi = 16 * w + fr;
    unsigned kb[2][4];
#pragma unroll
    for (int e = 0; e < 2; ++e)
#pragma unroll
        for (int kk = 0; kk < 4; ++kk) kb[e][kk] = off_b(8 * (fr >> 2) + 4 * e + (fr & 3), 4 * kk + fq);
    LAS unsigned char* Kb = Kimg + 8192 * blk0; LAS unsigned char* Vb = Vimg + 8192 * blk0;
    f32x4 s[2 * NBLK];
#pragma unroll
    for (int nt = 0; nt < 2 * NBLK; ++nt) s[nt] = (f32x4){0.f, 0.f, 0.f, 0.f};
    constexpr int TB = BANDED ? 2 * NBLK : NBLK;
#pragma unroll
    for (int t0 = 0; t0 < 2 * NBLK; t0 += TB)
#pragma unroll
        for (int kk = 0; kk < 4; ++kk) { bf16x8 kf[TB];
#pragma unroll
            for (int i = 0; i < TB; ++i) { const int nt = t0 + i; kf[i] = *(const LAS bf16x8*)(Kb + kb[nt & 1][kk] + 8192 * (nt >> 1)); }
            __builtin_amdgcn_sched_barrier(0);
#pragma unroll
            for (int i = 0; i < TB; ++i) s[t0 + i] = __builtin_amdgcn_mfma_f32_16x16x32_bf16(kf[i], qf[kk], s[t0 + i], 0, 0, 0);
            __builtin_amdgcn_sched_barrier(0); }
    float mx = -1e30f;
    const LAS float* bp = btab + (128 + 16 * (w & 1) + fr - 8 * fq + 32 - 135);
    const int cmin = BANDED ? (key_lo > 0 ? (128 + 16 * (w & 1) + fr - 8 * fq) - qi : -1000) : 0;
#pragma unroll
    for (int nt = 0; nt < 2 * NBLK; ++nt)
#pragma unroll
        for (int r = 0; r < 4; ++r) { float x = s[nt][r];
            if (BANDED) { const int c = 32 * (nt >> 1) + 4 * (nt & 1) + r; x = x + bp[135 - c]; x = (c >= cmin) ? x : -1e30f; s[nt][r] = x; }
            mx = fmaxf(mx, x); }
    mx = fmaxf(mx, __shfl_xor(mx, 16)); mx = fmaxf(mx, __shfl_xor(mx, 32));
    float l = 0.f;
#pragma unroll
    for (int nt = 0; nt < 2 * NBLK; ++nt)
#pragma unroll
        for (int r = 0; r < 4; ++r) { const float p = __builtin_amdgcn_exp2f(s[nt][r] - mx); s[nt][r] = p; l += p; }
    l += __shfl_xor(l, 16); l += __shfl_xor(l, 32);
    bf16x8 pf[NBLK];
#pragma unroll
    for (int ks = 0; ks < NBLK; ++ks) pf[ks] = __builtin_bit_cast(bf16x8, pg8::pack8(s[2 * ks], s[2 * ks + 1]));
    const float inv_l = 1.0f / l;
    unsigned vb[8][2];
#pragma unroll
    for (int ct = 0; ct < 8; ++ct) { vb[ct][0] = tr16_addr(lane, ct, 0, 0); vb[ct][1] = tr16_addr(lane, ct, 0, 1); }
    f32x4 oa[8];
#pragma unroll
    for (int ct = 0; ct < 8; ++ct) oa[ct] = (f32x4){0.f, 0.f, 0.f, 0.f};
#pragma unroll
    for (int ks = 0; ks < NBLK; ++ks) { s16x4 vlo[8], vhi[8];
#pragma unroll
        for (int ct = 0; ct < 8; ++ct) { vlo[ct] = tr_read(Vb + vb[ct][0] + 8192 * ks); vhi[ct] = tr_read(Vb + vb[ct][1] + 8192 * ks); }
        __builtin_amdgcn_sched_barrier(0);
#pragma unroll
        for (int ct = 0; ct < 8; ++ct) { const bf16x8 vf = (bf16x8){vlo[ct][0], vlo[ct][1], vlo[ct][2], vlo[ct][3], vhi[ct][0], vhi[ct][1], vhi[ct][2], vhi[ct][3]};
            oa[ct] = __builtin_amdgcn_mfma_f32_16x16x32_bf16(vf, pf[ks], oa[ct], 0, 0, 0); }
        __builtin_amdgcn_sched_barrier(0); }
#pragma unroll
    for (int ct = 0; ct < 8; ++ct) { u32x2 wv; wv.x = cvt_pk_bf16(oa[ct][0] * inv_l, oa[ct][1] * inv_l); wv.y = cvt_pk_bf16(oa[ct][2] * inv_l, oa[ct][3] * inv_l);
        *(u32x2*)(orow + 16 * ct) = wv; }
    if (lsep != nullptr && fq == 0) *lsep = (mx + __builtin_amdgcn_logf(l)) * LN2;
}
struct QoDesc { const bf16_t* qbase; long row0, rstep; bf16_t* obase; float* lsebase; int banded, dil, head; };

struct GateRegs { u32x4 v[2][6]; f32x4 wq[8]; f32x4 vs[3]; float gvl; };
__device__ __forceinline__ void gate_issue(int tid, int b, int chunk, int g, const bf16_t* Z, const float* VSS, const float* w_s, const float* g_v, GateRegs& R) {
    const int lane = tid & 63, w = __builtin_amdgcn_readfirstlane(tid >> 6), fr = lane & 15, fq = lane >> 4;
    const int tok0 = b * SEQ + chunk * 128;
    {
        const int r0 = tid >> 3, c0 = tid & 7; const bf16_t* gp = Z + (size_t)(tok0 + r0) * ZP + MIXW + g * 384 + c0 * 8;
#pragma unroll
        for (int i2 = 0; i2 < 2; ++i2)
#pragma unroll
            for (int i = 0; i < 6; ++i) R.v[i2][i] = *(const u32x4*)(gp + (size_t)i2 * 64 * ZP + 64 * i); }
    { const float* wp = w_s + (size_t)g * 16384 + (16 * w + fr) * 128 + 8 * fq;
#pragma unroll
      for (int kk = 0; kk < 4; ++kk) { R.wq[2 * kk] = *(const f32x4*)(wp + 32 * kk); R.wq[2 * kk + 1] = *(const f32x4*)(wp + 32 * kk + 4); } }
    { const float* p = VSS + (size_t)(tok0 + (tid & 127)) * 24 + 12 * ((tid >> 7) & 1);
#pragma unroll
      for (int i = 0; i < 3; ++i) R.vs[i] = *(const f32x4*)(p + 4 * i); }
    R.gvl = g_v[g * 384 + (tid < 384 ? tid : tid - 384)];
}
__device__ __forceinline__ void gate_run(LAS unsigned char* lds, int tid, int b, int chunk, int g, const GateRegs& R, const bf16_t* Z, const float* b_s, bf16_t* MIX) {
    const int lane = tid & 63, w = __builtin_amdgcn_readfirstlane(tid >> 6), fr = lane & 15, fq = lane >> 4;
    const int tok0 = b * SEQ + chunk * 128, i = 16 * w + fr;
    LAS float* rs = (LAS float*)(lds + LDS_TAB); LAS float* gvs = rs + 128;
    const size_t tokrow = (size_t)(tok0 + i);
    __syncthreads();
    const bf16_t* up = Z + tokrow * ZP + g * 384 + 4 * fq;
    u32x2 ucur[8];
    const float bs = b_s[g * 128 + i];
    {
        const int r0 = tid >> 3, c0 = tid & 7; const unsigned gsb0 = off_b(r0, c0), gsb1 = off_b(r0, c0 + 8);
#pragma unroll
        for (int i2 = 0; i2 < 2; ++i2)
#pragma unroll
            for (int k = 0; k < 6; ++k) *(LAS u32x4*)(lds + (k >> 1) * 32768 + ((k & 1) ? gsb1 : gsb0) + 16384 * i2) = R.v[i2][k]; }
    { float ssum = 0.f;
#pragma unroll
      for (int k = 0; k < 3; ++k) ssum += (R.vs[k][0] + R.vs[k][1]) + (R.vs[k][2] + R.vs[k][3]);
      if (tid < 256) rs[512 + tid] = ssum;
      if (tid < 384) gvs[tid] = R.gvl; }
    __syncthreads();
    if (tid < 128) rs[tid] = 1.0f / sqrtf((rs[512 + tid] + rs[512 + 128 + tid]) * (1.0f / MIXW) + EPS);
    __syncthreads();
    bf16x8 wf[4];
#pragma unroll
    for (int kk = 0; kk < 4; ++kk) { const int j0 = 32 * kk + 8 * fq;
        const f32x4 r0 = *(const LAS f32x4*)(rs + j0), r1 = *(const LAS f32x4*)(rs + j0 + 4);
        const f32x4 a = R.wq[2 * kk], c = R.wq[2 * kk + 1];
        float v[8] = {a[0] * r0[0], a[1] * r0[1], a[2] * r0[2], a[3] * r0[3], c[0] * r1[0], c[1] * r1[1], c[2] * r1[2], c[3] * r1[3]};
#pragma unroll
        for (int jj = 0; jj < 8; ++jj) v[jj] = (j0 + jj <= i) ? v[jj] : 0.f;
        u32x4 pk; pk.x = cvt_pk_bf16(v[0], v[1]); pk.y = cvt_pk_bf16(v[2], v[3]); pk.z = cvt_pk_bf16(v[4], v[5]); pk.w = cvt_pk_bf16(v[6], v[7]);
        wf[kk] = __builtin_bit_cast(bf16x8, pk); }
    unsigned vb[8][2];
#pragma unroll
    for (int c = 0; c < 8; ++c) { vb[c][0] = tr16_addr(lane, c, 0, 0); vb[c][1] = tr16_addr(lane, c, 0, 1); }
#pragma unroll
    for (int sub = 0; sub < 3; ++sub) { LAS unsigned char* img = lds + sub * 32768;
#pragma unroll
        for (int c = 0; c < 8; ++c) ucur[c] = *(const u32x2*)(up + sub * 128 + 16 * c);
#pragma unroll
        for (int c = 0; c < 8; ++c) { f32x4 a = (f32x4){0.f, 0.f, 0.f, 0.f};
#pragma unroll
            for (int kk = 0; kk < 4; ++kk) if (kk <= (w >> 1)) {
                const s16x4 lo = tr_read(img + vb[c][0] + 8192 * kk), hi = tr_read(img + vb[c][1] + 8192 * kk);
                const bf16x8 vf = (bf16x8){lo[0], lo[1], lo[2], lo[3], hi[0], hi[1], hi[2], hi[3]};
                a = __builtin_amdgcn_mfma_f32_16x16x32_bf16(vf, wf[kk], a, 0, 0, 0); }
            const int col = g * 384 + sub * 128 + 16 * c + 4 * fq;
            const f32x4 gv = *(const LAS f32x4*)(gvs + sub * 128 + 16 * c + 4 * fq);
            const u32x2 uw = ucur[c];
            const float o0 = bf_lo(uw.x) * (a[0] * gv[0] + bs), o1 = bf_hi(uw.x) * (a[1] * gv[1] + bs), o2 = bf_lo(uw.y) * (a[2] * gv[2] + bs), o3 = bf_hi(uw.y) * (a[3] * gv[3] + bs);
            u32x2 ov; ov.x = cvt_pk_bf16(o0, o1); ov.y = cvt_pk_bf16(o2, o3);
            *(u32x2*)(MIX + tokrow * DM + col) = ov; } }
}

template <int MODE, int K>
__device__ __forceinline__ void sample_gemv(LAS unsigned char* lds, const bf16_t* A, int a_pitch, const bf16_t* Wt, int N, int first, int stride,
                                            float* outf, bf16_t* outb, int ldb, float* win, const float* rs, const float* slse = nullptr) {
    int tid = threadIdx.x; asm volatile("" : "+v"(tid));
    const int lane = tid & 63, w = __builtin_amdgcn_readfirstlane(tid >> 6), fr = lane & 15, fq = lane >> 4;
    const int ntiles = (MODE == 2) ? N / 32 : N / 16;
    LAS float* red = (LAS float*)lds;
    constexpr int kw = K / 8;
    LAS float* atab = (LAS float*)(lds + LDS_TAB + 4096);
    if (slse != nullptr) {
        __syncthreads();
        if (tid < 128) { const int srow = tid >> 4, H = tid & 15; float al = 1.0f;
            if (H < 12) { const int hl = H & 3; const float l0 = slse[srow * 12 + hl], l1 = slse[srow * 12 + 4 + hl], l2 = slse[srow * 12 + 8 + hl], mm = fmaxf(l0, fmaxf(l1, l2));
                const float e0 = __expf(l0 - mm), e1 = __expf(l1 - mm), e2 = __expf(l2 - mm); al = (H < 4 ? e0 : (H < 8 ? e1 : e2)) / (e0 + e1 + e2); }
            atab[tid] = al; }
        __syncthreads();
    }
    for (int tile = first; tile < ntiles; tile += stride) {
        const int nrow0 = (MODE == 2) ? 256 * (tile >> 3) + 16 * (tile & 7) : 16 * tile;
        const bf16_t* ap = A + (size_t)(fr & 7) * a_pitch + w * kw + 8 * fq;
        const bf16_t* bp = Wt + (size_t)(nrow0 + fr) * K + w * kw + 8 * fq;
        f32x4 acc = (f32x4){0.f, 0.f, 0.f, 0.f}, acc2 = (f32x4){0.f, 0.f, 0.f, 0.f};
#pragma unroll
        for (int ks = 0; ks < kw / 32; ++ks) { bf16x8 a = *(const bf16x8*)(ap + 32 * ks); const bf16x8 b = *(const bf16x8*)(bp + 32 * ks);
            if (MODE == 1 && slse != nullptr) { const float al = atab[(fr & 7) * 16 + ((w * kw + 32 * ks + 8 * fq) >> 7)]; const u32x4 aw = __builtin_bit_cast(u32x4, a); u32x4 o;
                o.x = cvt_pk_bf16(bf_lo(aw.x) * al, bf_hi(aw.x) * al); o.y = cvt_pk_bf16(bf_lo(aw.y) * al, bf_hi(aw.y) * al);
                o.z = cvt_pk_bf16(bf_lo(aw.z) * al, bf_hi(aw.z) * al); o.w = cvt_pk_bf16(bf_lo(aw.w) * al, bf_hi(aw.w) * al); a = __builtin_bit_cast(bf16x8, o); }
            acc = __builtin_amdgcn_mfma_f32_16x16x32_bf16(b, a, acc, 0, 0, 0);
            if (MODE == 2) { const bf16x8 b2 = *(const bf16x8*)(bp + (size_t)128 * K + 32 * ks); acc2 = __builtin_amdgcn_mfma_f32_16x16x32_bf16(b2, a, acc2, 0, 0, 0); } }
        __syncthreads();
        *(LAS f32x4*)(red + (w * 16 + fr) * 16 + 4 * fq) = acc;
        if (MODE == 2) *(LAS f32x4*)(red + 2048 + (w * 16 + fr) * 16 + 4 * fq) = acc2;
        __syncthreads();
        if (tid < 128) { const int s = tid >> 4, c = tid & 15; float v = 0.f, v2 = 0.f;
#pragma unroll
            for (int ww = 0; ww < 8; ++ww) { v += red[(ww * 16 + s) * 16 + c]; if (MODE == 2) v2 += red[2048 + (ww * 16 + s) * 16 + c]; }
            if (rs != nullptr) { const float rsr = rs[s]; v *= rsr; v2 *= rsr; }
            if (MODE == 0) { const int n = nrow0 + c; outf[(size_t)s * ZP + n] = v;
                if (win != nullptr && n >= 1536 && n < 4608) { const int kv = n >= 3072 ? 1 : 0, cc = n - 1536 - 1536 * kv, grp = cc >> 9;
                    win[(size_t)grp * 8192 + (size_t)(s * 2 + kv) * 512 + (cc & 511)] = v; } }
            else if (MODE == 1) { outb[(size_t)s * ldb + nrow0 + c] = (bf16_t)f2bf(v); }
            else { outb[(size_t)s * ldb + 128 * (tile >> 3) + 16 * (tile & 7) + c] = (bf16_t)f2bf(silu_f(v) * v2); } }
    }
}

template <class KF, class VF>
__device__ __forceinline__ float sample_attend(LAS float* scr, const float* qv, int nkeys, KF kf, VF vf, const LAS float* btab, LAS float* o_out) {
    int tid = threadIdx.x; asm volatile("" : "+v"(tid));
    const int lane = tid & 63, w = __builtin_amdgcn_readfirstlane(tid >> 6);
    LAS float* sc = scr; LAS float* part = scr + 320; LAS float* stat = scr + 320 + 2048;
    {
        const int key = tid >> 1, half = tid & 1; float d = 0.f;
        if (key < nkeys) { const float* kp = kf(key) + 64 * half; const float* qp = qv + 64 * half; f32x4 k4[16];
#pragma unroll
            for (int i = 0; i < 16; ++i) k4[i] = *(const f32x4*)(kp + 4 * i);
#pragma unroll
            for (int i = 0; i < 16; ++i) { const f32x4 q4 = *(const f32x4*)(qp + 4 * i); d += (k4[i][0] * q4[0] + k4[i][1] * q4[1]) + (k4[i][2] * q4[2] + k4[i][3] * q4[3]); } }
        d += __shfl_xor(d, 1);
        if (half == 0 && key < nkeys) sc[key] = d * QSCALE + (btab != nullptr ? btab[key] : 0.f);
    }
    __syncthreads();
    if (w == 0) { float m = -1e30f; for (int j = lane; j < nkeys; j += 64) m = fmaxf(m, sc[j]); m = wave_max(m);
        float l = 0.f; for (int j = lane; j < nkeys; j += 64) { const float p = __builtin_amdgcn_exp2f(sc[j] - m); sc[j] = p; l += p; } l = wave_sum(l);
        if (lane == 0) { stat[0] = m; stat[1] = l; } }
    __syncthreads();
    {
        const int kg = tid >> 5, d4 = 4 * (tid & 31); f32x4 v4[16]; f32x4 a = (f32x4){0.f, 0.f, 0.f, 0.f};
#pragma unroll
        for (int i = 0; i < 16; ++i) { const int j = kg + 16 * i; v4[i] = (f32x4){0.f, 0.f, 0.f, 0.f}; if (j < nkeys) v4[i] = *(const f32x4*)(vf(j) + d4); }
#pragma unroll
        for (int i = 0; i < 16; ++i) { const int j = kg + 16 * i; const float pj = j < nkeys ? sc[j] : 0.f; a = a + v4[i] * pj; }
        *(LAS f32x4*)(part + kg * 128 + d4) = a; }
    __syncthreads();
    const float m = stat[0], l = stat[1];
    if (tid < 128) { float a = 0.f;
#pragma unroll
        for (int g = 0; g < 16; ++g) a += part[g * 128 + tid];
        o_out[tid] = a / l; }
    __syncthreads();
    return (m + __builtin_amdgcn_logf(l)) * LN2;
}

#define XB_TMO      128
#define XB_XCNT(j)  (256  + 64 * (j))
#define XB_XSUB(j)  (1280 + 64 * (j))
#define XB_XGEN(j)  (2304 + 64 * (j))
#define XB_TOP      3328
#define XB_TOPGEN   3392
#define XCD_BAR_WORDS 3456
#define XB_SPIN_CAP (1u << 18)
__device__ __forceinline__ unsigned xb_ld(unsigned* p)              { return __hip_atomic_load(p, __ATOMIC_RELAXED, __HIP_MEMORY_SCOPE_AGENT); }
__device__ __forceinline__ unsigned xb_add(unsigned* p, unsigned v) { return __hip_atomic_fetch_add(p, v, __ATOMIC_RELAXED, __HIP_MEMORY_SCOPE_AGENT); }
__device__ __forceinline__ unsigned xb_xcc_id() { return (unsigned)__builtin_amdgcn_s_getreg((3 << 11) | 20) & 0xFu; }
#define XB_SPIN(cond, bar) do { unsigned _sp = 0; while (cond) { __builtin_amdgcn_s_sleep(1); \
    if ((++_sp & 255u) == 0u) { if (xb_ld(&(bar)[XB_TMO])) break; if (_sp > XB_SPIN_CAP) { atomicAdd(&(bar)[XB_TMO], 1u); break; } } } } while (0)
struct XcdBarrier { unsigned* bar; unsigned x; volatile LAS unsigned* st; };
__device__ __forceinline__ XcdBarrier xcd_barrier_post(unsigned* bar, volatile LAS unsigned* st) {
    XcdBarrier b; b.bar = bar; b.x = xb_xcc_id(); b.st = st;
    if (threadIdx.x == 0) (void)xb_add(&bar[XB_XCNT(b.x)], 1u);
    return b;
}
__device__ __forceinline__ void xcd_barrier_complete(unsigned* bar, unsigned x, unsigned& nloc, unsigned& nx) {
    const unsigned G = gridDim.x * gridDim.y * gridDim.z;
    unsigned sum, cnt, mine, sp = 0u;
    for (;;) {
        sum = 0u; cnt = 0u; mine = 0u;
#pragma unroll
        for (unsigned j = 0; j < 16; ++j) { const unsigned c = xb_ld(&bar[XB_XCNT(j)]); sum += c; cnt += (c > 0u) ? 1u : 0u; mine = (j == x) ? c : mine; }
        if (sum == G) break;
        __builtin_amdgcn_s_sleep(1);
        if ((++sp & 255u) == 0u) { if (xb_ld(&bar[XB_TMO])) break; if (sp > XB_SPIN_CAP) { atomicAdd(&bar[XB_TMO], 1u); break; } }
    }
    nloc = mine > 0u ? mine : 1u; nx = cnt > 0u ? cnt : 1u;
}
__device__ __forceinline__ void xcd_barrier(const XcdBarrier& b) {
    asm volatile("s_waitcnt vmcnt(0)" ::: "memory");
    __syncthreads();
    if (threadIdx.x == 0) {
        unsigned* bar = b.bar;
        __builtin_amdgcn_s_waitcnt(0);
        unsigned nloc = b.st[0], nx = b.st[1];
        if (nloc == 0u) { xcd_barrier_complete(bar, b.x, nloc, nx); b.st[0] = nloc; b.st[1] = nx; }
        const unsigned old = xb_add(&bar[XB_XSUB(b.x)], 1u);
        const unsigned gen = old / nloc;
        if (old + 1u == (gen + 1u) * nloc) {
            __builtin_amdgcn_fence(__ATOMIC_RELEASE, "agent");
            asm volatile("s_waitcnt vmcnt(0)" ::: "memory");
            const unsigned og = xb_add(&bar[XB_TOP], 1u);
            const unsigned tg = og / nx;
            if (og + 1u == (tg + 1u) * nx) xb_add(&bar[XB_TOPGEN], 1u);
            else XB_SPIN(xb_ld(&bar[XB_TOPGEN]) == tg, bar);
            __builtin_amdgcn_fence(__ATOMIC_ACQUIRE, "agent");
            xb_add(&bar[XB_XGEN(b.x)], 1u);
            asm volatile("s_waitcnt vmcnt(0)" ::: "memory");
        } else {
            XB_SPIN(xb_ld(&bar[XB_XGEN(b.x)]) == gen, bar);
            __builtin_amdgcn_fence(__ATOMIC_ACQUIRE, "agent");
            asm volatile("s_waitcnt vmcnt(0)" ::: "memory");
        }
    }
    __syncthreads();
}

struct Args { const float* in[22]; float* out; unsigned char* ws; };
typedef const Args __attribute__((address_space(4)))* ArgsP;
__device__ __forceinline__ ArgsP args_ptr() { ArgsP p = (ArgsP)__builtin_amdgcn_kernarg_segment_ptr(); asm volatile("" : "+s"(p)); return p; }
#define WSP(T, off) ((T*)(A->ws + (off)))

constexpr int I_MKV = 32 * 16, I_INA = 32 * 56, I_INB = 32 * 80, I_OUT = 32 * 32, I_UP = 32 * 176, I_DN = 88 * 32, DN_P = 850, DN_A = 1170;
__device__ __forceinline__ int conv_count(int list) { return list == 0 ? 2 * I_MKV + I_INA + I_UP + DN_P : (list == 1 ? I_OUT + (DN_A - DN_P) : (list == 2 ? (I_DN - DN_A) + I_INB + I_OUT : (list == 3 ? I_UP : I_DN))); }
__device__ __forceinline__ TItem conv_item(ArgsP A, int list, int r) {
    const float* n_mix_pre = A->in[8]; const float* n_ffn_pre = A->in[10]; const float* n_mem = A->in[12]; const float* w_mem_kv = A->in[13]; const float* w_in_a = A->in[14];
    const float* w_in_b = A->in[18]; const float* w_out = A->in[19]; const float* w_up = A->in[20]; const float* w_dn = A->in[21];
    bf16_t* Wmkv = WSP(bf16_t, WS_WMKV); bf16_t* Wina = WSP(bf16_t, WS_WINA); bf16_t* Winb = WSP(bf16_t, WS_WINB); bf16_t* Wout = WSP(bf16_t, WS_WOUT);
    bf16_t* Wup = WSP(bf16_t, WS_WUP); bf16_t* Wdn = WSP(bf16_t, WS_WDN);
    if (list == 0) {
        if (r < 2 * I_MKV) { const int l = r / I_MKV; return t_make(w_mem_kv + (size_t)l * DM * NKV, DM, NKV, Wmkv + (size_t)l * NKV * DM, false, n_mem + l * DM, r % I_MKV); } r -= 2 * I_MKV;
        if (r < I_INA) return t_make(w_in_a, DM, NA, Wina, false, n_mix_pre, r); r -= I_INA;
        if (r < I_UP) return t_make(w_up, DM, NUP, Wup, true, n_ffn_pre, r); r -= I_UP;
        return t_make(w_dn, DFF, DM, Wdn, false, nullptr, r);
    } else if (list == 1) {
        if (r < I_OUT) return t_make(w_out, DM, DM, Wout, false, nullptr, r); r -= I_OUT;
        return t_make(w_dn, DFF, DM, Wdn, false, nullptr, DN_P + r);
    } else if (list == 2) {
        if (r < I_DN - DN_A) return t_make(w_dn, DFF, DM, Wdn, false, nullptr, DN_A + r); r -= I_DN - DN_A;
        if (r < I_INB) return t_make(w_in_b, DM, NB, Winb, false, n_mix_pre + DM, r); r -= I_INB;
        return t_make(w_out + (size_t)DM * DM, DM, DM, Wout + (size_t)DM * DM, false, nullptr, r);
    } else if (list == 3) {
        return t_make(w_up + (size_t)DM * NUP, DM, NUP, Wup + (size_t)NUP * DM, true, n_ffn_pre + DM, r);
    } else {
        return t_make(w_dn + (size_t)DFF * DM, DFF, DM, Wdn + (size_t)DM * DFF, false, nullptr, r);
    }
}
__device__ __forceinline__ void convert_list(LAS unsigned char* lds, ArgsP A, int list, int worker, int nworkers, int wave, int lane) {
    const int n = conv_count(list);
    LAS float* scr = (LAS float*)(lds + wave * 16384);
    int it = worker;
    if (it >= n) return;
    TItem cur = conv_item(A, list, it);
    f32x4 va[16], vb[16];
    t_load(cur, lane, va);
    for (;;) {
        const int itn = it + nworkers; const bool hn = itn < n;
        TItem nxt = cur;
        if (hn) { nxt = conv_item(A, list, itn); t_load(nxt, lane, vb); }
        t_store(cur, scr, lane, va);
        if (!hn) break;
#pragma unroll
        for (int i = 0; i < 16; ++i) va[i] = vb[i];
        cur = nxt; it = itn;
    }
}
__device__ __forceinline__ void convert_tail(LAS unsigned char* lds, ArgsP A, int list, int first_idle) {
    const int bid = blockIdx.x, G = gridDim.x;
    if (bid < first_idle || first_idle >= G) return;
    int tid = threadIdx.x; asm volatile("" : "+v"(tid));
    const int lane = tid & 63, wave = __builtin_amdgcn_readfirstlane(tid >> 6);
    __syncthreads();
    convert_list(lds, A, list, (bid - first_idle) * 8 + wave, (G - first_idle) * 8, wave, lane);
}
__device__ __forceinline__ void phase_prologue(LAS unsigned char* lds) {
    ArgsP A = args_ptr();
    int tid = threadIdx.x; asm volatile("" : "+v"(tid));
    const int lane = tid & 63, wave = __builtin_amdgcn_readfirstlane(tid >> 6), gw = blockIdx.x * 8 + wave, NGW = gridDim.x * 8;
    const float* x_prompt = A->in[0]; const float* x_sample = A->in[1]; const float* mem_prompt = A->in[2];
    bf16_t* YB = WSP(bf16_t, WS_HN); bf16_t* HM = WSP(bf16_t, WS_HM);
    float* RS = WSP(float, WS_RS); float* RSM = RS + 16384;
    convert_list(lds, A, 0, gw, NGW, wave, lane);
    if (gridDim.x != 256) { convert_list(lds, A, 1, gw, NGW, wave, lane); convert_list(lds, A, 2, gw, NGW, wave, lane); convert_list(lds, A, 3, gw, NGW, wave, lane); convert_list(lds, A, 4, gw, NGW, wave, lane); }
    for (int m = gw; m < 512 + TP + TSMP; m += NGW) {
        if (m < 512) norm_row<0>(mem_prompt + (size_t)m * DM, HM + (size_t)m * DM, nullptr, nullptr, RSM + m, nullptr, lane);
        else { const int r = m - 512; const float* xr = r < TP ? x_prompt + (size_t)r * DM : x_sample + (size_t)(r - TP) * DM;
            norm_row<0>(xr, YB + (size_t)r * DM, nullptr, nullptr, RS + r, nullptr, lane); }
    }
}

__device__ __forceinline__ void phase_in_a(LAS unsigned char* lds) {
    ArgsP A = args_ptr(); const int bid = blockIdx.x, G = gridDim.x;
    bf16_t* HN = WSP(bf16_t, WS_HN);
    { pg8::Gemm g{HN, WSP(bf16_t, WS_WINA), TP, NA, DM}; pg8::StaticOrder S; S.init(TP, NA, G, bid); pg8::EpiInA E{WSP(bf16_t, WS_Z), WSP(float, WS_VSS), WSP(float, WS_RS)};
      pg8::gemm_phase<pg8::EpiInA, true, true>(lds, g, S, E); }
#pragma unroll 1
    for (int l = 0; l < 2; ++l) { pg8::Gemm g{WSP(bf16_t, WS_HM), WSP(bf16_t, WS_WMKV) + (size_t)l * NKV * DM, 512, NKV, DM};
      pg8::StaticOrder S; S.init(512, NKV, G, (bid - 192 - 8 * l + 2 * G) % G);
      pg8::EpiMkv E{A->out + OUT_MKV + (size_t)l * 512 * NKV, WSP(bf16_t, WS_MKV) + (size_t)l * 512 * NKV, WSP(float, WS_RS) + 16384};
      pg8::gemm_phase<pg8::EpiMkv, true, true>(lds, g, S, E); }
    if (G == 256) { if (bid >= 208) sample_gemv<0, DM>(lds, HN + (size_t)TP * DM, DM, WSP(bf16_t, WS_WINA), NA, G - 1 - bid, 48, WSP(float, WS_ZS), nullptr, 0, nullptr, WSP(float, WS_RS) + TP); }
    else sample_gemv<0, DM>(lds, HN + (size_t)TP * DM, DM, WSP(bf16_t, WS_WINA), NA, G - 1 - bid, G, WSP(float, WS_ZS), nullptr, 0, nullptr, WSP(float, WS_RS) + TP);
    if (G == 256) convert_tail(lds, A, 1, 208);
}
__device__ __forceinline__ void phase_in_b(LAS unsigned char* lds) {
    ArgsP A = args_ptr(); const int bid = blockIdx.x, G = gridDim.x;
    bf16_t* HN = WSP(bf16_t, WS_HN); float* out = A->out;
    pg8::Gemm g{HN, WSP(bf16_t, WS_WINB), TP, NB, DM}; pg8::StaticOrder S; S.init(TP, NB, G, bid);
    pg8::EpiInB E{WSP(bf16_t, WS_Z), WSP(float, WS_RS)};
    pg8::gemm_phase<pg8::EpiInB, true, true>(lds, g, S, E);
    sample_gemv<0, DM>(lds, HN + (size_t)TP * DM, DM, WSP(bf16_t, WS_WINB), NB, G - 1 - bid, G, WSP(float, WS_ZS), nullptr, 0, out + OUT_W128S, WSP(float, WS_RS) + TP);
    if (G == 256) convert_tail(lds, A, 3, 128);
}
__device__ __forceinline__ void mem_unit_desc(ArgsP A, int v, int layer, KvDesc& kd, QoDesc& qd) {
    const int b = v >> 7, h = (v >> 5) & 3, qb = v & 31, qmoff = layer == 0 ? 3072 : 4608;
    const bf16_t* mkv = WSP(bf16_t, WS_MKV) + (size_t)layer * 512 * NKV + h * 128;
    kd.kbase = mkv; kd.vbase = mkv + 512; kd.row0 = (long)b * 256; kd.rstep = 1; kd.pitch = NKV; kd.key_lo = 0;
    qd.qbase = WSP(bf16_t, WS_Z) + qmoff + h * 128; qd.row0 = (long)b * SEQ + 128 * qb; qd.rstep = 1; qd.obase = WSP(bf16_t, WS_MIX) + MIXW + h * 128; qd.lsebase = nullptr;
    qd.banded = 0; qd.dil = 1; qd.head = 0;
}
__device__ __forceinline__ void swa_unit_desc(ArgsP A, int u, KvDesc& kd, QoDesc& qd) {
    const int b = u / 384, H = (u % 384) >> 5, idx = u & 31, g = H >> 2, dil = 1 << (2 * g), r = idx & (dil - 1), qb = idx >> (2 * g);
    const bf16_t* Z = WSP(bf16_t, WS_Z);
    kd.kbase = Z + MIXW + H * 128; kd.vbase = Z + 2 * MIXW + H * 128; kd.row0 = (long)b * SEQ + (long)(128 * qb - 128) * dil + r; kd.rstep = dil; kd.pitch = ZP; kd.key_lo = qb == 0 ? 128 : 0;
    qd.qbase = Z + H * 128; qd.row0 = (long)b * SEQ + (long)(128 * qb) * dil + r; qd.rstep = dil; qd.obase = WSP(bf16_t, WS_MIX) + H * 128; qd.lsebase = WSP(float, WS_LSE) + H;
    qd.banded = 1; qd.dil = dil; qd.head = H;
}
__device__ __forceinline__ void q_issue(const QoDesc& qd, int tid, bf16x8 (&qf)[4]) {
    const int lane = tid & 63, w = __builtin_amdgcn_readfirstlane(tid >> 6), fr = lane & 15, fq = lane >> 4;
    const long qrow = qd.row0 + (long)(16 * w + fr) * qd.rstep;
    const bf16_t* qp = qd.qbase + (size_t)qrow * ZP + 8 * fq;
#pragma unroll
    for (int k4 = 0; k4 < 4; ++k4) qf[k4] = *(const bf16x8*)(qp + 32 * k4);
}
__device__ __forceinline__ void build_bias_tables(LAS unsigned char* lds, int tid, const float* rel_bias) {
    LAS float* tab = (LAS float*)(lds + LDS_TAB);
    for (int i = tid; i < 12 * 192; i += 512) { const int H = i / 192, j = i % 192 - 32, dil = 1 << (2 * (H >> 2));
        tab[i] = (j >= 0 && j <= 128) ? rel_bias[t5_bucket(j * dil) * 12 + H] * LOG2E : -1e30f; }
}
__device__ __forceinline__ void attn_unit_run(LAS unsigned char* lds, int tid, const QoDesc& qd, int key_lo, u32x4 (&kk)[8], u32x4 (&vv)[8], bf16x8 (&qf)[4],
                                              const bool has_next, const KvDesc nxt, const QoDesc nxtq) {
    const int lane = tid & 63, w = __builtin_amdgcn_readfirstlane(tid >> 6), fr = lane & 15, fq = lane >> 4;
    __syncthreads();
    kv_commit(lds, tid, key_lo, kk, vv);
    bf16x8 qc[4];
#pragma unroll
    for (int k4 = 0; k4 < 4; ++k4) qc[k4] = qf[k4];
    if (has_next) { kv_issue(nxt, tid, kk, vv); q_issue(nxtq, tid, qf); }
    __syncthreads();
    const long qrow = qd.row0 + (long)(16 * w + fr) * qd.rstep;
    bf16_t* orow = qd.obase + (size_t)qrow * DM + 4 * fq;
    float* lsep = qd.lsebase != nullptr ? qd.lsebase + (size_t)qrow * 12 : nullptr;
    if (qd.banded) attn_compute<true>(lds, lane, w, qc, key_lo, orow, lsep, (const LAS float*)(lds + LDS_TAB) + qd.head * 192);
    else attn_compute<false>(lds, lane, w, qc, key_lo, orow, lsep, (const LAS float*)(lds + LDS_TAB));
}
__device__ __forceinline__ void sample_mem_attn(LAS unsigned char* lds, int layer) {
    ArgsP A = args_ptr(); const int bid = blockIdx.x, G = gridDim.x;
    int tid = threadIdx.x; asm volatile("" : "+v"(tid));
    const int qmoff = layer == 0 ? 3072 : 4608;
    for (int it = G - 1 - 96 - bid; it >= 0 && it < 32; it += G) {
        const int s = it >> 2, h = it & 3;
        LAS float* scr = (LAS float*)lds; LAS float* og = scr + 2560;
        __syncthreads();
        const float* cm = A->in[3] + (size_t)(layer * 8 + s) * 256 * 1024;
        auto kf = [=](int j) -> const float* { return cm + (size_t)j * 1024 + h * 128; };
        auto vf = [=](int j) -> const float* { return cm + (size_t)j * 1024 + 512 + h * 128; };
        (void)sample_attend(scr, WSP(float, WS_ZS) + (size_t)s * ZP + qmoff + h * 128, 256, kf, vf, (const LAS float*)nullptr, og);
        if (tid < 128) WSP(bf16_t, WS_MIX)[(size_t)(TP + s) * DM + MIXW + h * 128 + tid] = (bf16_t)f2bf(og[tid]);
        __syncthreads();
    }
}
__device__ __forceinline__ void phase_mix_a(LAS unsigned char* lds) {
    ArgsP A = args_ptr(); const int bid = blockIdx.x, G = gridDim.x;
    int tid = threadIdx.x; asm volatile("" : "+v"(tid));
    const int lane = tid & 63, wave = __builtin_amdgcn_readfirstlane(tid >> 6);
    const float* ZS = WSP(float, WS_ZS); const float* n_v_a = A->in[15]; const float* w_sp = A->in[16]; const float* b_sp = A->in[17]; bf16_t* MIX = WSP(bf16_t, WS_MIX); float* out = A->out;
    for (int it = G - 1 - bid; it < TSMP; it += G) {
        LAS float* red = (LAS float*)lds; const int s = it;
        __syncthreads();
        float vv[3], uu[3], ss = 0.f;
#pragma unroll
        for (int i = 0; i < 3; ++i) { const int c = tid + 512 * i; uu[i] = gelu_tanh(ZS[(size_t)s * ZP + c]); vv[i] = gelu_tanh(ZS[(size_t)s * ZP + MIXW + c]); ss += vv[i] * vv[i]; }
        ss = wave_sum(ss); if (lane == 0) red[wave] = ss;
        __syncthreads();
        float tot = 0.f;
#pragma unroll
        for (int i = 0; i < 8; ++i) tot += red[i];
        const float rstd = 1.0f / sqrtf(tot * (1.0f / MIXW) + EPS);
#pragma unroll
        for (int i = 0; i < 3; ++i) { const int c = tid + 512 * i, g = c / 384; const float vn = vv[i] * rstd * n_v_a[c];
            out[OUT_CHV + (size_t)s * MIXW + c] = vn;
            const float sg = w_sp[(size_t)g * 16384] * vn + b_sp[g * 128];
            MIX[(size_t)(TP + s) * DM + c] = (bf16_t)f2bf(uu[i] * sg); }
    }
    sample_mem_attn(lds, 0);
    __syncthreads();
    for (int u = bid; u < 256; u += G) {
        KvDesc kd; QoDesc qd; mem_unit_desc(A, u, 0, kd, qd);
        u32x4 kk[8], vv[8]; bf16x8 qf[4]; GateRegs R;
        gate_issue(tid, u >> 7, (u >> 2) & 31, u & 3, WSP(bf16_t, WS_Z), WSP(float, WS_VSS), A->in[16], A->in[15], R);
        kv_issue(kd, tid, kk, vv); q_issue(qd, tid, qf);
        gate_run(lds, tid, u >> 7, (u >> 2) & 31, u & 3, R, WSP(bf16_t, WS_Z), A->in[17], WSP(bf16_t, WS_MIX));
        attn_unit_run(lds, tid, qd, kd.key_lo, kk, vv, qf, false, kd, qd);
    }
}
__device__ __forceinline__ void phase_mix_b1(LAS unsigned char* lds) {
    ArgsP A = args_ptr(); const int bid = blockIdx.x, G = gridDim.x;
    int tid = threadIdx.x; asm volatile("" : "+v"(tid));
    KvDesc kd{}, kn{}; QoDesc qd{}, qn{};
    u32x4 kk[8], vv[8]; bf16x8 qf[4];
    int u = bid;
    if (u < 1024) { if (u < 768) swa_unit_desc(A, u, kd, qd); else mem_unit_desc(A, u - 768, 1, kd, qd); kv_issue(kd, tid, kk, vv); q_issue(qd, tid, qf); }
    build_bias_tables(lds, tid, A->in[7]);
#pragma unroll 1
    for (; u < 1024; u += G) {
        const int un = u + G; const bool has_next = un < 1024;
        if (has_next) { if (un < 768) swa_unit_desc(A, un, kn, qn); else mem_unit_desc(A, un - 768, 1, kn, qn); }
        attn_unit_run(lds, tid, qd, kd.key_lo, kk, vv, qf, has_next, kn, qn);
        kd = kn; qd = qn;
    }
}
__device__ __forceinline__ void phase_mix_b2(LAS unsigned char* lds) {
    ArgsP A = args_ptr(); const int bid = blockIdx.x, G = gridDim.x;
    int tid = threadIdx.x; asm volatile("" : "+v"(tid));
    const int lane = tid & 63, wave = __builtin_amdgcn_readfirstlane(tid >> 6), gw = bid * 8 + wave, NGW = G * 8;
    bf16_t* MIX = WSP(bf16_t, WS_MIX); const float* LSE = WSP(float, WS_LSE);
    for (int row = gw; row < TP; row += NGW) {
        const float* lp = LSE + (size_t)row * 12;
#pragma unroll
        for (int i = 0; i < 3; ++i) { const int col = 8 * (lane + 64 * i), H = col >> 7, g = H >> 2, hl = H & 3;
            const float l0 = lp[hl], l1 = lp[4 + hl], l2 = lp[8 + hl], mm = fmaxf(l0, fmaxf(l1, l2));
            const float e0 = __expf(l0 - mm), e1 = __expf(l1 - mm), e2 = __expf(l2 - mm);
            const float al = (g == 0 ? e0 : (g == 1 ? e1 : e2)) / (e0 + e1 + e2);
            u32x4 wv = *(u32x4*)(MIX + (size_t)row * DM + col);
            wv.x = cvt_pk_bf16(bf_lo(wv.x) * al, bf_hi(wv.x) * al); wv.y = cvt_pk_bf16(bf_lo(wv.y) * al, bf_hi(wv.y) * al);
            wv.z = cvt_pk_bf16(bf_lo(wv.z) * al, bf_hi(wv.z) * al); wv.w = cvt_pk_bf16(bf_lo(wv.w) * al, bf_hi(wv.w) * al);
            *(u32x4*)(MIX + (size_t)row * DM + col) = wv; }
    }
    { const int nw = G > 128 ? G - 128 : G, wk = bid < nw ? bid : -1;
      if (wk >= 0) { const bf16_t* Z = WSP(bf16_t, WS_Z); float* o0 = A->out + OUT_W128P;
        for (int i = wk * 512 + tid; i < 688128; i += nw * 512) {
            const int g = i < 32768 ? 0 : (i < 163840 ? 1 : 2), ig = i - (g == 0 ? 0 : (g == 1 ? 32768 : 163840)), W = 128 << (2 * g);
            const int c8 = ig & 63, kv = (ig >> 6) & 1, tr = (ig >> 7) & (W - 1), b = (ig >> 7) / W;
            const u32x4 wv = *(const u32x4*)(Z + (size_t)(b * SEQ + (SEQ - W) + tr) * ZP + MIXW + kv * MIXW + g * 512 + c8 * 8);
            float* dst = o0 + (size_t)2048 * ((W - 128) / 3) + (size_t)ig * 8;
            *(f32x4*)dst = (f32x4){bf_lo(wv.x), bf_hi(wv.x), bf_lo(wv.y), bf_hi(wv.y)}; *(f32x4*)(dst + 4) = (f32x4){bf_lo(wv.z), bf_hi(wv.z), bf_lo(wv.w), bf_hi(wv.w)}; } } }
    const float* rel_bias = A->in[7]; const float* ZS = WSP(float, WS_ZS);
    for (int it = G - 1 - bid; it < 96; it += G) {
        const int s = it / 12, H = it % 12, g = H >> 2, hl = H & 3, dil = 1 << (2 * g), W = 128 << (2 * g);
        LAS float* scr = (LAS float*)lds; LAS float* btab = scr + 2400; LAS float* og = scr + 2560;
        __syncthreads();
        for (int j = tid; j <= 128; j += 512) btab[j] = rel_bias[t5_bucket(j * dil) * 12 + H] * LOG2E;
        __syncthreads();
        const float* cw = A->in[4 + g];
        const float* zrow = ZS + (size_t)s * ZP;
        auto kf = [=](int j) -> const float* { return j == 0 ? zrow + MIXW + H * 128 : cw + ((size_t)(s * W + (W - j * dil)) * 2 + 0) * 512 + hl * 128; };
        auto vf = [=](int j) -> const float* { return j == 0 ? zrow + 2 * MIXW + H * 128 : cw + ((size_t)(s * W + (W - j * dil)) * 2 + 1) * 512 + hl * 128; };
        const float lg = sample_attend(scr, zrow + H * 128, 129, kf, vf, btab, og);
        if (tid < 128) MIX[(size_t)(TP + s) * DM + H * 128 + tid] = (bf16_t)f2bf(og[tid]);
        if (tid == 0) WSP(float, WS_LSE)[(size_t)TP * 12 + s * 12 + H] = lg;
        __syncthreads();
    }
    sample_mem_attn(lds, 1);
}
__device__ __forceinline__ void phase_out(LAS unsigned char* lds, int layer) {
    ArgsP A = args_ptr(); const int bid = blockIdx.x, G = gridDim.x;
    bf16_t* MIX = WSP(bf16_t, WS_MIX); bf16_t* OB = WSP(bf16_t, WS_O); const bf16_t* W = WSP(bf16_t, WS_WOUT) + (size_t)layer * DM * DM;
    pg8::Gemm g{MIX, W, TP, DM, DM}; pg8::StaticOrder S; S.init(TP, DM, G, bid); pg8::EpiPlain E{OB, DM};
    pg8::gemm_phase<pg8::EpiPlain, false, true>(lds, g, S, E);
    sample_gemv<1, DM>(lds, MIX + (size_t)TP * DM, DM, W, DM, G - 1 - bid, G, nullptr, OB + (size_t)TP * DM, DM, nullptr, nullptr, layer == 1 ? WSP(float, WS_LSE) + (size_t)TP * 12 : nullptr);
}
__device__ __forceinline__ void phase_up(LAS unsigned char* lds, int layer) {
    ArgsP A = args_ptr(); const int bid = blockIdx.x, G = gridDim.x;
    bf16_t* HN = WSP(bf16_t, WS_HN); bf16_t* ACT = WSP(bf16_t, WS_ACT); const bf16_t* W = WSP(bf16_t, WS_WUP) + (size_t)layer * NUP * DM;
    pg8::Gemm g{HN, W, TP, NUP, DM}; pg8::StaticOrder S; S.init(TP, NUP, G, bid); pg8::EpiSwiglu E{ACT, WSP(float, WS_RS)};
    pg8::gemm_phase<pg8::EpiSwiglu, true, true>(lds, g, S, E);
    if (G == 256 && layer == 1) { if (bid >= 128) sample_gemv<2, DM>(lds, HN + (size_t)TP * DM, DM, W, NUP, G - 1 - bid, 128, nullptr, ACT + (size_t)TP * DFF, DFF, nullptr, WSP(float, WS_RS) + TP); }
    else sample_gemv<2, DM>(lds, HN + (size_t)TP * DM, DM, W, NUP, G - 1 - bid, G, nullptr, ACT + (size_t)TP * DFF, DFF, nullptr, WSP(float, WS_RS) + TP);
    if (G == 256) convert_tail(lds, A, layer == 0 ? 2 : 4, 128);
}
__device__ __forceinline__ void phase_down(LAS unsigned char* lds, int layer) {
    ArgsP A = args_ptr(); const int bid = blockIdx.x, G = gridDim.x;
    bf16_t* ACT = WSP(bf16_t, WS_ACT); bf16_t* OB = WSP(bf16_t, WS_O); const bf16_t* W = WSP(bf16_t, WS_WDN) + (size_t)layer * DM * DFF;
    pg8::Gemm g{ACT, W, TP, DM, DFF}; pg8::StaticOrder S; S.init(TP, DM, G, bid); pg8::EpiPlain E{OB, DM};
    pg8::gemm_phase<pg8::EpiPlain, false, true>(lds, g, S, E);
    sample_gemv<1, DFF>(lds, ACT + (size_t)TP * DFF, DFF, W, DM, G - 1 - bid, G, nullptr, OB + (size_t)TP * DM, DM, nullptr, nullptr);
}
__device__ __forceinline__ void phase_norm(int which) {
    ArgsP A = args_ptr();
    int tid = threadIdx.x; asm volatile("" : "+v"(tid));
    const int lane = tid & 63, wave = __builtin_amdgcn_readfirstlane(tid >> 6), gw = blockIdx.x * 8 + wave, NGW = gridDim.x * 8;
    const int layer = which >> 1;
    float* Y = A->out + OUT_Y; const bf16_t* OB = WSP(bf16_t, WS_O); bf16_t* YB = WSP(bf16_t, WS_HN); float* RS = WSP(float, WS_RS);
    const float* gpost = ((which & 1) ? A->in[11] : A->in[9]) + layer * DM;
    for (int r = gw; r < TP + TSMP; r += NGW) {
        if (which == 3) norm_row<3>(nullptr, YB + (size_t)r * DM, OB + (size_t)r * DM, gpost, nullptr, Y + (size_t)r * DM, lane);
        else norm_row<2>(nullptr, YB + (size_t)r * DM, OB + (size_t)r * DM, gpost, RS + r, nullptr, lane);
    }
}

__global__ void __launch_bounds__(512, 2) fwd_megakernel(Args args) {
    extern __shared__ __attribute__((aligned(16))) unsigned char lds_raw[];
    LAS unsigned char* lds = (LAS unsigned char*)lds_raw;
    volatile LAS unsigned* bst = (volatile LAS unsigned*)(lds + LDS_BYTES - 64);
    if (threadIdx.x < 16) bst[threadIdx.x] = 0u;
    __syncthreads();
    const XcdBarrier bar = xcd_barrier_post((unsigned*)args.ws, bst);
#define GRID_SYNC() xcd_barrier(bar)
    phase_prologue(lds);
    GRID_SYNC();
    phase_in_a(lds);
    GRID_SYNC();
    phase_mix_a(lds);
    GRID_SYNC();
    phase_out(lds, 0);
    GRID_SYNC();
    phase_norm(0);
    GRID_SYNC();
    phase_up(lds, 0);
    GRID_SYNC();
    phase_down(lds, 0);
    GRID_SYNC();
    phase_norm(1);
    GRID_SYNC();
    phase_in_b(lds);
    GRID_SYNC();
    phase_mix_b1(lds);
    GRID_SYNC();
    phase_mix_b2(lds);
    GRID_SYNC();
    phase_out(lds, 1);
    GRID_SYNC();
    phase_norm(2);
    GRID_SYNC();
    phase_up(lds, 1);
    GRID_SYNC();
    phase_down(lds, 1);
    GRID_SYNC();
    phase_norm(3);
#undef GRID_SYNC
}

extern "C" void kernel_launch(void* const* d_in, const int* in_sizes, int n_in, void* d_out, int out_size, void* d_ws, size_t ws_size, hipStream_t stream) {
    static int grid = 0;
    if (grid == 0) {
        if (n_in != 22 || (size_t)out_size != OUT_TOTAL || ws_size < WS_END) { fprintf(stderr, "kernel_launch: unexpected shapes (n_in %d, out %d, ws %zu)\n", n_in, out_size, ws_size); grid = -1; return; }
        int dev = 0, cus = 0, per_cu = 0;
        if (hipGetDevice(&dev) != hipSuccess || hipDeviceGetAttribute(&cus, hipDeviceAttributeMultiprocessorCount, dev) != hipSuccess) { grid = -1; return; }
        if (hipFuncSetAttribute((const void*)fwd_megakernel, hipFuncAttributeMaxDynamicSharedMemorySize, LDS_BYTES) != hipSuccess) { fprintf(stderr, "kernel_launch: hipFuncSetAttribute failed\n"); grid = -1; return; }
        if (hipOccupancyMaxActiveBlocksPerMultiprocessor(&per_cu, (const void*)fwd_megakernel, 512, LDS_BYTES) != hipSuccess || per_cu < 1) { fprintf(stderr, "kernel_launch: occupancy query says %d\n", per_cu); (void)hipGetLastError(); per_cu = 1; }
        grid = cus;
    }
    if (grid < 0) return;
    if (hipMemsetAsync(d_ws, 0, 16384, stream) != hipSuccess) { fprintf(stderr, "kernel_launch: memset of the barrier words failed\n"); return; }
    Args a{};
    for (int i = 0; i < 22; ++i) a.in[i] = (const float*)d_in[i];
    a.out = (float*)d_out; a.ws = (unsigned char*)d_ws;
    void* kargs[] = {&a};
    hipError_t e = hipLaunchCooperativeKernel((const void*)fwd_megakernel, dim3(grid), dim3(512), kargs, LDS_BYTES, stream);
    if (e != hipSuccess) fprintf(stderr, "kernel_launch: cooperative launch failed: %s (grid %d)\n", hipGetErrorString(e), grid);
}
```

```cpp
#include <hip/hip_runtime.h>
#include <cstdio>
#include <cstdint>

#define LAS __attribute__((address_space(3)))
typedef unsigned short bf16_t;
typedef short bf16x8 __attribute__((ext_vector_type(8)));
typedef short s16x4 __attribute__((ext_vector_type(4)));
typedef float f32x4 __attribute__((ext_vector_type(4)));
typedef float f32x2 __attribute__((ext_vector_type(2)));
typedef unsigned u32x4 __attribute__((ext_vector_type(4)));
typedef unsigned u32x2 __attribute__((ext_vector_type(2)));

constexpr int DM = 2048, TP = 8192, TSMP = 8, TROWS = TP + 16, SEQ = 4096;
constexpr int MIXW = 1536, NA = 3584, NB = 5120, DFF = 5632, NUP = 11264, NKV = 1024;
constexpr int ZP = 5120;
constexpr float EPS = 1e-6f;
constexpr float LOG2E = 1.4426950408889634f, LN2 = 0.6931471805599453f;
constexpr float QSCALE = 0.08838834764831845f * 1.4426950408889634f;

constexpr size_t MiB = 1u << 20;
constexpr size_t WS_WMKV = 1 * MiB;
constexpr size_t WS_WINA = 9 * MiB;
constexpr size_t WS_WINB = 23 * MiB;
constexpr size_t WS_WOUT = 43 * MiB;
constexpr size_t WS_WUP = 59 * MiB;
constexpr size_t WS_WDN = 147 * MiB;
constexpr size_t WS_HN = 191 * MiB;
constexpr size_t WS_HM = 224 * MiB;
constexpr size_t WS_MKV = 228 * MiB;
constexpr size_t WS_Z = 230 * MiB;
constexpr size_t WS_ZS = 310 * MiB;
constexpr size_t WS_VSS = 311 * MiB;
constexpr size_t WS_MIX = 312 * MiB;
constexpr size_t WS_LSE = 345 * MiB;
constexpr size_t WS_RS = 345 * MiB + 512 * 1024;
constexpr size_t WS_O = 346 * MiB;
constexpr size_t WS_ACT = 379 * MiB;
constexpr size_t WS_END = 468 * MiB;

constexpr size_t OUT_Y = 0;
constexpr size_t OUT_MKV = 16793600;
constexpr size_t OUT_CHV = OUT_MKV + 1048576;
constexpr size_t OUT_W128P = OUT_CHV + 12288;
constexpr size_t OUT_W512P = OUT_W128P + 262144;
constexpr size_t OUT_W2048P = OUT_W512P + 1048576;
constexpr size_t OUT_W128S = OUT_W2048P + 4194304;
constexpr size_t OUT_W512S = OUT_W128S + 8192;
constexpr size_t OUT_W2048S = OUT_W512S + 8192;
constexpr size_t OUT_TOTAL = OUT_W2048S + 8192;

constexpr int LDS_BYTES = 147456;
constexpr int LDS_TAB = 131072;

__device__ __forceinline__ unsigned cvt_pk_bf16(float lo, float hi) { unsigned r; asm volatile("v_cvt_pk_bf16_f32 %0, %1, %2" : "=v"(r) : "v"(lo), "v"(hi)); return r; }
__device__ __forceinline__ float bf_lo(unsigned w) { return __uint_as_float(w << 16); }
__device__ __forceinline__ float bf_hi(unsigned w) { return __uint_as_float(w & 0xffff0000u); }
__device__ __forceinline__ float wave_sum(float v) {
#pragma unroll
    for (int o = 1; o < 64; o <<= 1) v += __shfl_xor(v, o);
    return v;
}
__device__ __forceinline__ float wave_max(float v) {
#pragma unroll
    for (int o = 1; o < 64; o <<= 1) v = fmaxf(v, __shfl_xor(v, o));
    return v;
}
__device__ __forceinline__ float gelu_tanh(float x) {
    const float t = x * x;
    const float u2 = x * (1.5957691216057308f + 0.07135481627260024f * t);
    const float e = __builtin_amdgcn_exp2f(-LOG2E * u2);
    return x * __builtin_amdgcn_rcpf(1.0f + e);
}
__device__ __forceinline__ float silu_f(float x) {
    const float e = __builtin_amdgcn_exp2f(-LOG2E * x);
    return x * __builtin_amdgcn_rcpf(1.0f + e);
}
__device__ __forceinline__ int t5_bucket(int d) {
    if (d < 16) return d;
    int b = 16;
    b += (d >= 22); b += (d >= 30); b += (d >= 40); b += (d >= 54); b += (d >= 73); b += (d >= 99); b += (d >= 134); b += (d >= 182);
    b += (d >= 246); b += (d >= 332); b += (d >= 450); b += (d >= 609); b += (d >= 825); b += (d >= 1117); b += (d >= 1513);
    return b;
}
__device__ __forceinline__ unsigned off_b(unsigned row, unsigned ch) { return 256u * row + 16u * (ch ^ (((row & 3) << 2) | ((row >> 2) & 3))); }
__device__ __forceinline__ unsigned tr16_addr(unsigned lane, unsigned c, unsigned ks, unsigned t) {
    const unsigned g = lane >> 4, q = (lane & 15) >> 2, p = lane & 3;
    return off_b(32 * ks + 8 * g + 4 * t + q, 2 * c + (p >> 1)) + 8 * (p & 1);
}
typedef short v4i16_t __attribute__((ext_vector_type(4)));
__device__ __forceinline__ s16x4 tr_read(LAS unsigned char* p) { return __builtin_bit_cast(s16x4, __builtin_amdgcn_ds_read_tr16_b64_v4i16((LAS v4i16_t*)p)); }

namespace pg8 {
constexpr int BM = 256, BK = 64, HALF = 128, HTB = HALF * BK * 2, STAGE_BYTES = 8 * HTB, NXCD = 8, WGM = 8;
__host__ __device__ __forceinline__ int lds_byte(int r, int c) { const int st = (r >> 4) * 2 + (c >> 5), rr = r & 15, cc = c & 31, ob = rr * 64 + cc * 2; return st * 1024 + (ob ^ (((ob >> 9) & 1) << 5)); }
__host__ __device__ __forceinline__ void stage_rc(int b, int& R, int& C) { const int st = b / 1024, sb = b % 1024, swz = sb ^ (((sb >> 9) & 1) << 5); R = (st >> 1) * 16 + swz / 64; C = (st & 1) * 32 + (swz % 64) / 2; }
__host__ __device__ __forceinline__ int perm32(int rho) { const int n = rho >> 4, i = rho & 15; return 8 * (i >> 2) + 4 * n + (i & 3); }

struct Unit { int pm, pn; };
struct Gemm { const bf16_t* A; const bf16_t* Bt; int M, N, K; };

struct StaticOrder {
    int nM, nN, nwg, G, c;
    __host__ __device__ void init(int M, int N, int G_, int c_) { nM = M / BM; nN = N / BM; nwg = nM * nN; G = G_; c = c_; }
    __host__ __device__ bool next(int i, Unit& u) const {
        const long L = (long)i * G + c; if (L >= nwg) return false;
        int wgid = (int)L; { const int q = nwg / NXCD, r = nwg % NXCD, xcd = wgid % NXCD, off = wgid / NXCD; wgid = (xcd < r ? xcd * (q + 1) : r * (q + 1) + (xcd - r) * q) + off; }
        const int nig = WGM * nN, gid = wgid / nig, fm = gid * WGM, gsz = (nM - fm) < WGM ? (nM - fm) : WGM;
        u.pm = fm + ((wgid % nig) % gsz); u.pn = (wgid % nig) / gsz; return true;
    }
};

template <class Epi, bool ALIGN_EPI, bool SP2>
__device__ __forceinline__ void gemm_phase(LAS unsigned char* lds, const Gemm g, const StaticOrder& S, const Epi& E) {
    int tid = threadIdx.x; asm volatile("" : "+v"(tid));
    const int wid = __builtin_amdgcn_readfirstlane(tid >> 6), lane = tid & 63, wr = wid >> 2, wc = wid & 3, fr = lane & 15, fq = lane >> 4;
    const int K = g.K, nt = K / BK;
    unsigned voffA[2], voffB[2];
#pragma unroll
    for (int i = 0; i < 2; ++i) { int R, C; stage_rc(tid * 16 + i * 8192, R, C); const int Rb = (R & ~31) + perm32(R & 31);
        voffA[i] = (unsigned)(R * K + C) * 2u; voffB[i] = (unsigned)(Rb * K + C) * 2u; }
    const size_t kstep = (size_t)(BK * 2);
    const size_t hstep = (size_t)HALF * K * 2;
    const size_t tstep = 2 * hstep;
    const unsigned ldsw = (unsigned)wid * 1024u;
    const int aoff = lds_byte(wr * 64 + fr, fq * 8), boff = lds_byte(wc * 32 + fr, fq * 8);
#define PG8_SA(b, h) (((b) * 2 + (h)) * HTB)
#define PG8_SB(b, h) ((4 + (b) * 2 + (h)) * HTB)
#define PG8_STAGE(bufoff, gbase, voff) do { _Pragma("unroll") for (int _i = 0; _i < 2; ++_i) \
        __builtin_amdgcn_global_load_lds((const unsigned*)((const char*)(gbase) + (voff)[_i]), (LAS unsigned*)(lds + (bufoff) + ldsw + _i * 8192), 16, 0, 0); } while (0)
#define PG8_LDA(dst, b, h) do { _Pragma("unroll") for (int m = 0; m < 4; ++m) _Pragma("unroll") for (int k = 0; k < 2; ++k) dst[m][k] = *(const LAS bf16x8*)(lds + PG8_SA(b, h) + aoff + m * 2048 + k * 1024); } while (0)
#define PG8_LDB(dst, b, h) do { _Pragma("unroll") for (int n = 0; n < 2; ++n) _Pragma("unroll") for (int k = 0; k < 2; ++k) dst[n][k] = *(const LAS bf16x8*)(lds + PG8_SB(b, h) + boff + n * 2048 + k * 1024); } while (0)
#define PG8_MMA(ai, bj, At, Bt) do { __builtin_amdgcn_s_setprio(1); _Pragma("unroll") for (int m = 0; m < 4; ++m) _Pragma("unroll") for (int n = 0; n < 2; ++n) _Pragma("unroll") for (int k = 0; k < 2; ++k) \
        acc[ai][bj][m][n] = __builtin_amdgcn_mfma_f32_16x16x32_bf16(Bt[n][k], At[m][k], acc[ai][bj][m][n], 0, 0, 0); __builtin_amdgcn_s_setprio(0); } while (0)
#define PG8_WAIT_V(n) asm volatile("s_waitcnt vmcnt(" #n ")" ::: "memory")
#define PG8_WAIT_L(n) asm volatile("s_waitcnt lgkmcnt(" #n ")" ::: "memory")
#define PG8_BAR __builtin_amdgcn_s_barrier()
#define PG8_SCHED __builtin_amdgcn_sched_barrier(0)
    Unit cur, nxt; int ui = 0;
    if (!S.next(0, cur)) return;
    f32x4 acc[2][2][4][2];
#pragma unroll
    for (int a = 0; a < 2; ++a)
#pragma unroll
        for (int b = 0; b < 2; ++b)
#pragma unroll
            for (int m = 0; m < 4; ++m)
#pragma unroll
                for (int n = 0; n < 2; ++n) acc[a][b][m][n] = (f32x4){0.f, 0.f, 0.f, 0.f};
    bf16x8 At[4][2], B0[2][2], B1[2][2];
    const char* cA = (const char*)g.A + (size_t)cur.pm * tstep; const char* cB = (const char*)g.Bt + (size_t)cur.pn * tstep;
    if constexpr (SP2) {
        PG8_STAGE(PG8_SB(0, 0), cB, voffB); PG8_STAGE(PG8_SB(0, 1), cB + hstep, voffB); PG8_STAGE(PG8_SA(0, 0), cA, voffA); PG8_STAGE(PG8_SA(0, 1), cA + hstep, voffA);
        if (wr == 1) PG8_BAR;
        PG8_WAIT_V(2); PG8_BAR;
        PG8_STAGE(PG8_SB(1, 0), cB + kstep, voffB); PG8_STAGE(PG8_SA(1, 0), cA + kstep, voffA); PG8_STAGE(PG8_SB(1, 1), cB + hstep + kstep, voffB);
        PG8_WAIT_V(6); PG8_BAR;
    } else {
        PG8_STAGE(PG8_SB(0, 0), cB, voffB); PG8_STAGE(PG8_SA(0, 0), cA, voffA); PG8_STAGE(PG8_SB(0, 1), cB + hstep, voffB); PG8_STAGE(PG8_SA(0, 1), cA + hstep, voffA);
        if (wr == 1) PG8_BAR;
        PG8_WAIT_V(4); PG8_BAR;
        PG8_STAGE(PG8_SB(1, 0), cB + kstep, voffB); PG8_STAGE(PG8_SA(1, 0), cA + kstep, voffA); PG8_STAGE(PG8_SB(1, 1), cB + hstep + kstep, voffB);
        PG8_WAIT_V(6); PG8_BAR;
    }
    for (;;) {
        const typename Epi::Pre pre = E.prefetch(cur, wr, fr);
        const bool has_next = S.next(ui + 1, nxt);
        const char* nA = has_next ? (const char*)g.A + (size_t)nxt.pm * tstep : cA; const char* nB = has_next ? (const char*)g.Bt + (size_t)nxt.pn * tstep : cB;
        for (int t = 0; t < nt; t += 2) {
            const bool last = (t == nt - 2);
            const char* a1 = cA + (size_t)(t + 1) * kstep;
            const char* a2 = last ? nA : cA + (size_t)(t + 2) * kstep; const char* b2 = last ? nB : cB + (size_t)(t + 2) * kstep;
            const char* a3 = a2 + kstep; const char* b3 = b2 + kstep;
            if constexpr (SP2) {
            PG8_LDB(B0, 0, 0); PG8_LDB(B1, 0, 1); PG8_SCHED; PG8_LDA(At, 0, 0); PG8_STAGE(PG8_SA(1, 1), a1 + hstep, voffA);
            PG8_WAIT_V(8); PG8_WAIT_L(0); PG8_BAR; PG8_MMA(0, 0, At, B0); PG8_MMA(0, 1, At, B1); PG8_BAR; PG8_SCHED;
            PG8_LDA(At, 0, 1); PG8_STAGE(PG8_SB(0, 0), b2, voffB); PG8_STAGE(PG8_SB(0, 1), b2 + hstep, voffB); PG8_STAGE(PG8_SA(0, 0), a2, voffA);
            PG8_WAIT_V(8); PG8_WAIT_L(0); PG8_BAR; PG8_MMA(1, 0, At, B0); PG8_MMA(1, 1, At, B1); PG8_BAR; PG8_SCHED;
            PG8_LDB(B0, 1, 0); PG8_LDB(B1, 1, 1); PG8_SCHED; PG8_LDA(At, 1, 0); PG8_STAGE(PG8_SA(0, 1), a2 + hstep, voffA);
            PG8_WAIT_V(8); PG8_WAIT_L(0); PG8_BAR; PG8_MMA(0, 0, At, B0); PG8_MMA(0, 1, At, B1); PG8_BAR; PG8_SCHED;
            PG8_LDA(At, 1, 1); PG8_STAGE(PG8_SB(1, 0), b3, voffB); PG8_STAGE(PG8_SB(1, 1), b3 + hstep, voffB); PG8_STAGE(PG8_SA(1, 0), a3, voffA);
            PG8_WAIT_V(8); PG8_WAIT_L(0); PG8_BAR; PG8_MMA(1, 0, At, B0); PG8_MMA(1, 1, At, B1); PG8_BAR; PG8_SCHED;
            } else {
            PG8_LDB(B0, 0, 0); PG8_SCHED; PG8_LDA(At, 0, 0); PG8_STAGE(PG8_SA(1, 1), a1 + hstep, voffA);
            PG8_WAIT_L(8); PG8_BAR; PG8_WAIT_L(0); PG8_MMA(0, 0, At, B0); PG8_BAR; PG8_SCHED;
            PG8_LDB(B1, 0, 1); PG8_STAGE(PG8_SB(0, 0), b2, voffB);
            PG8_BAR; PG8_WAIT_L(0); PG8_MMA(0, 1, At, B1); PG8_BAR;
            PG8_LDA(At, 0, 1); PG8_STAGE(PG8_SA(0, 0), a2, voffA);
            PG8_BAR; PG8_WAIT_L(0); PG8_MMA(1, 0, At, B0); PG8_BAR; PG8_SCHED;
            PG8_STAGE(PG8_SB(0, 1), b2 + hstep, voffB);
            PG8_WAIT_V(6); PG8_BAR; PG8_MMA(1, 1, At, B1); PG8_BAR;
            PG8_LDB(B0, 1, 0); PG8_SCHED; PG8_LDA(At, 1, 0); PG8_STAGE(PG8_SA(0, 1), a2 + hstep, voffA);
            PG8_WAIT_L(8); PG8_BAR; PG8_WAIT_L(0); PG8_MMA(0, 0, At, B0); PG8_BAR; PG8_SCHED;
            PG8_LDB(B1, 1, 1); PG8_STAGE(PG8_SB(1, 0), b3, voffB);
            PG8_BAR; PG8_WAIT_L(0); PG8_MMA(0, 1, At, B1); PG8_BAR;
            PG8_LDA(At, 1, 1); PG8_STAGE(PG8_SA(1, 0), a3, voffA);
            PG8_BAR; PG8_WAIT_L(0); PG8_MMA(1, 0, At, B0); PG8_BAR; PG8_SCHED;
            PG8_STAGE(PG8_SB(1, 1), b3 + hstep, voffB);
            PG8_WAIT_V(6); PG8_BAR; PG8_MMA(1, 1, At, B1); PG8_BAR;
            }
        }
        if constexpr (ALIGN_EPI) { if (wr == 0) PG8_BAR; }
        E(acc, cur, wr, wc, fr, fq, pre);
        if (!has_next) break;
#pragma unroll
        for (int a = 0; a < 2; ++a)
#pragma unroll
            for (int b = 0; b < 2; ++b)
#pragma unroll
                for (int m = 0; m < 4; ++m)
#pragma unroll
                    for (int n = 0; n < 2; ++n) acc[a][b][m][n] = (f32x4){0.f, 0.f, 0.f, 0.f};
        cur = nxt; cA = nA; cB = nB; ++ui;
        if constexpr (ALIGN_EPI) { if (wr == 1) PG8_BAR; }
    }
    PG8_WAIT_V(0);
    if constexpr (!ALIGN_EPI) { if (wr == 0) PG8_BAR; }
    PG8_BAR;
#undef PG8_SA
#undef PG8_SB
#undef PG8_STAGE
#undef PG8_LDA
#undef PG8_LDB
#undef PG8_MMA
#undef PG8_WAIT_V
#undef PG8_WAIT_L
#undef PG8_BAR
#undef PG8_SCHED
}

typedef f32x4 Acc[2][2][4][2];
struct PreRs { float r[2][4]; };
struct PreNone { };
__device__ __forceinline__ PreRs load_rs(const float* rs, const Unit& u, int wr, int fr) { PreRs p; const int row0 = u.pm * BM + wr * 64 + fr;
#pragma unroll
    for (int ai = 0; ai < 2; ++ai)
#pragma unroll
        for (int m = 0; m < 4; ++m) p.r[ai][m] = rs[row0 + ai * HALF + m * 16];
    return p; }
__device__ __forceinline__ u32x4 pack8(const f32x4 a, const f32x4 b) { u32x4 w; w.x = cvt_pk_bf16(a[0], a[1]); w.y = cvt_pk_bf16(a[2], a[3]); w.z = cvt_pk_bf16(b[0], b[1]); w.w = cvt_pk_bf16(b[2], b[3]); return w; }

struct EpiInA {
    bf16_t* Z; float* VSS; const float* rs;
    typedef PreRs Pre; __device__ __forceinline__ Pre prefetch(const Unit& u, int wr, int fr) const { return load_rs(rs, u, wr, fr); }
    __device__ __forceinline__ void operator()(const Acc& acc, const Unit& u, int wr, int wc, int fr, int fq, const Pre& pre) const {
        const int row0 = u.pm * BM + wr * 64 + fr, col0 = u.pn * BM + wc * 32 + 8 * fq;
        const bool act = u.pn < 12, isv = (u.pn >= 6) && act;
#pragma unroll
        for (int ai = 0; ai < 2; ++ai)
#pragma unroll
            for (int m = 0; m < 4; ++m) {
                const int row = row0 + ai * HALF + m * 16; bf16_t* rowp = Z + (size_t)row * ZP + col0; float ss = 0.f; const float rsr = pre.r[ai][m];
#pragma unroll
                for (int bj = 0; bj < 2; ++bj) { f32x4 v0 = acc[ai][bj][m][0] * rsr, v1 = acc[ai][bj][m][1] * rsr;
                    if (act) {
#pragma unroll
                        for (int e = 0; e < 4; ++e) { v0[e] = gelu_tanh(v0[e]); v1[e] = gelu_tanh(v1[e]); ss += v0[e] * v0[e] + v1[e] * v1[e]; }
                    } else { v0 = v0 * QSCALE; v1 = v1 * QSCALE; }
                    *(u32x4*)(rowp + bj * HALF) = pack8(v0, v1); }
                if (isv) { ss += __shfl_xor(ss, 16); ss += __shfl_xor(ss, 32); if (fq == 0) VSS[(size_t)row * 24 + (u.pn - 6) * 4 + wc] = ss; }
            }
    }
};
struct EpiMkv {
    float* outf; bf16_t* outb; const float* rs;
    typedef PreRs Pre; __device__ __forceinline__ Pre prefetch(const Unit& u, int wr, int fr) const { return load_rs(rs, u, wr, fr); }
    __device__ __forceinline__ void operator()(const Acc& acc, const Unit& u, int wr, int wc, int fr, int fq, const Pre& pre) const {
        const int row0 = u.pm * BM + wr * 64 + fr, col0 = u.pn * BM + wc * 32 + 8 * fq;
#pragma unroll
        for (int ai = 0; ai < 2; ++ai)
#pragma unroll
            for (int m = 0; m < 4; ++m) { const size_t off = (size_t)(row0 + ai * HALF + m * 16) * NKV + col0; const float rsr = pre.r[ai][m];
#pragma unroll
                for (int bj = 0; bj < 2; ++bj) { const f32x4 v0 = acc[ai][bj][m][0] * rsr, v1 = acc[ai][bj][m][1] * rsr;
                    *(f32x4*)(outf + off + bj * HALF) = v0; *(f32x4*)(outf + off + bj * HALF + 4) = v1; *(u32x4*)(outb + off + bj * HALF) = pack8(v0, v1); } }
    }
};
struct EpiPlain {
    bf16_t* O; int ldc;
    typedef PreNone Pre; __device__ __forceinline__ Pre prefetch(const Unit&, int, int) const { return Pre{}; }
    __device__ __forceinline__ void operator()(const Acc& acc, const Unit& u, int wr, int wc, int fr, int fq, const Pre&) const {
        const int row0 = u.pm * BM + wr * 64 + fr, col0 = u.pn * BM + wc * 32 + 8 * fq;
#pragma unroll
        for (int ai = 0; ai < 2; ++ai)
#pragma unroll
            for (int m = 0; m < 4; ++m) { bf16_t* rowp = O + (size_t)(row0 + ai * HALF + m * 16) * ldc + col0;
#pragma unroll
                for (int bj = 0; bj < 2; ++bj) *(u32x4*)(rowp + bj * HALF) = pack8(acc[ai][bj][m][0], acc[ai][bj][m][1]); }
    }
};
struct EpiSwiglu {
    bf16_t* ACT; const float* rs;
    typedef PreRs Pre; __device__ __forceinline__ Pre prefetch(const Unit& u, int wr, int fr) const { return load_rs(rs, u, wr, fr); }
    __device__ __forceinline__ void operator()(const Acc& acc, const Unit& u, int wr, int wc, int fr, int fq, const Pre& pre) const {
        const int row0 = u.pm * BM + wr * 64 + fr, col0 = u.pn * HALF + wc * 32 + 8 * fq;
#pragma unroll
        for (int ai = 0; ai < 2; ++ai)
#pragma unroll
            for (int m = 0; m < 4; ++m) { f32x4 v0, v1; const float rsr = pre.r[ai][m];
#pragma unroll
                for (int e = 0; e < 4; ++e) { v0[e] = silu_f(acc[ai][0][m][0][e] * rsr) * (acc[ai][1][m][0][e] * rsr); v1[e] = silu_f(acc[ai][0][m][1][e] * rsr) * (acc[ai][1][m][1][e] * rsr); }
                *(u32x4*)(ACT + (size_t)(row0 + ai * HALF + m * 16) * DFF + col0) = pack8(v0, v1); }
    }
};
struct EpiInB {
    bf16_t* Z; const float* rs;
    typedef PreRs Pre; __device__ __forceinline__ Pre prefetch(const Unit& u, int wr, int fr) const { return load_rs(rs, u, wr, fr); }
    __device__ __forceinline__ void operator()(const Acc& acc, const Unit& u, int wr, int wc, int fr, int fq, const Pre& pre) const {
        const int row0 = u.pm * BM + wr * 64 + fr, col0 = u.pn * BM + wc * 32 + 8 * fq;
        const float qs = ((u.pn < 6) || (u.pn >= 18)) ? QSCALE : 1.0f;
#pragma unroll
        for (int ai = 0; ai < 2; ++ai)
#pragma unroll
            for (int m = 0; m < 4; ++m) {
                const int row = row0 + ai * HALF + m * 16; bf16_t* rowp = Z + (size_t)row * ZP + col0; const float rsr = pre.r[ai][m] * qs;
#pragma unroll
                for (int bj = 0; bj < 2; ++bj) *(u32x4*)(rowp + bj * HALF) = pack8(acc[ai][bj][m][0] * rsr, acc[ai][bj][m][1] * rsr);
            }
    }
};
}

__device__ __forceinline__ unsigned f2bf(float f) { unsigned u = __builtin_bit_cast(unsigned, f); return (u + 0x7fffu + ((u >> 16) & 1u)) >> 16; }
__device__ __forceinline__ unsigned pk2(float lo, float hi) { return f2bf(lo) | (f2bf(hi) << 16); }
struct TItem { const float* src; bf16_t* dst; const float* gain; int N, K; };
__device__ __forceinline__ TItem t_make(const float* W, int K, int N, bf16_t* WT, bool upperm, const float* gain, int item) {
    const int nblk = N / 64, kb = item / nblk, nb = item % nblk, k0 = 64 * kb, n0 = 64 * nb;
    int s0 = n0;
    if (upperm) { const int pn = n0 >> 8, j = n0 & 255; s0 = (j < 128) ? (128 * pn + j) : (DFF + 128 * pn + (j - 128)); }
    TItem t; t.src = W + (size_t)k0 * N + s0; t.dst = WT + (size_t)n0 * K + k0; t.gain = gain != nullptr ? gain + k0 : nullptr; t.N = N; t.K = K; return t;
}
__device__ __forceinline__ void t_load(const TItem& t, int lane, f32x4 (&v)[16]) {
    const float* src = t.src + (size_t)(lane >> 4) * t.N + 4 * (lane & 15);
#pragma unroll
    for (int i = 0; i < 16; ++i) v[i] = __builtin_nontemporal_load((const f32x4*)(src + (size_t)(4 * i) * t.N));
}
__device__ __forceinline__ void t_store(const TItem& t, LAS float* scr, int lane, const f32x4 (&v)[16]) {
    const int lr = lane >> 4, lc = lane & 15;
#pragma unroll
    for (int i = 0; i < 16; ++i) { const int k = 4 * i + lr; const float gk = t.gain != nullptr ? t.gain[k] : 1.0f;
        *(LAS f32x4*)(scr + k * 64 + ((4 * lc) ^ (4 * (k >> 3)))) = v[i] * gk; }
    asm volatile("s_waitcnt lgkmcnt(0)" ::: "memory");
    const int c = lane & 7;
#pragma unroll
    for (int j = 0; j < 8; ++j) { const int n = (lane >> 3) + 8 * j; const LAS float* sp = scr + (8 * c) * 64 + (n ^ (4 * c));
        u32x4 o; o.x = cvt_pk_bf16(sp[0 * 64], sp[1 * 64]); o.y = cvt_pk_bf16(sp[2 * 64], sp[3 * 64]); o.z = cvt_pk_bf16(sp[4 * 64], sp[5 * 64]); o.w = cvt_pk_bf16(sp[6 * 64], sp[7 * 64]);
        __builtin_nontemporal_store(o, (u32x4*)(t.dst + (size_t)n * t.K + 8 * c)); }
    asm volatile("s_waitcnt lgkmcnt(0)" ::: "memory");
}
template <int MODE>
__device__ __forceinline__ void norm_row(const float* basef, bf16_t* yb, const bf16_t* o, const float* gpost, float* rs_out, float* yout, int lane) {
    f32x4 y[8];
    if (MODE == 0 || MODE == 1) {
#pragma unroll
        for (int j = 0; j < 8; ++j) y[j] = *(const f32x4*)(basef + 4 * (lane + 64 * j));
    } else {
#pragma unroll
        for (int j = 0; j < 8; ++j) { const u32x2 w = *(const u32x2*)(yb + 4 * (lane + 64 * j)); y[j] = (f32x4){bf_lo(w.x), bf_hi(w.x), bf_lo(w.y), bf_hi(w.y)}; }
    }
    if (MODE != 0) {
        f32x4 ov[8]; float ss = 0.f;
#pragma unroll
        for (int j = 0; j < 8; ++j) { const u32x2 w = *(const u32x2*)(o + 4 * (lane + 64 * j)); ov[j] = (f32x4){bf_lo(w.x), bf_hi(w.x), bf_lo(w.y), bf_hi(w.y)};
            ss += (ov[j][0] * ov[j][0] + ov[j][1] * ov[j][1]) + (ov[j][2] * ov[j][2] + ov[j][3] * ov[j][3]); }
        const float rstd = 1.0f / sqrtf(wave_sum(ss) * (1.0f / DM) + EPS);
#pragma unroll
        for (int j = 0; j < 8; ++j) { const f32x4 g = *(const f32x4*)(gpost + 4 * (lane + 64 * j)); y[j] = y[j] + ov[j] * rstd * g; }
    }
    if (MODE == 3) {
#pragma unroll
        for (int j = 0; j < 8; ++j) *(f32x4*)(yout + 4 * (lane + 64 * j)) = y[j];
    } else {
        float ss = 0.f;
#pragma unroll
        for (int j = 0; j < 8; ++j) { ss += (y[j][0] * y[j][0] + y[j][1] * y[j][1]) + (y[j][2] * y[j][2] + y[j][3] * y[j][3]);
            u32x2 w; w.x = cvt_pk_bf16(y[j][0], y[j][1]); w.y = cvt_pk_bf16(y[j][2], y[j][3]); *(u32x2*)(yb + 4 * (lane + 64 * j)) = w; }
        ss = wave_sum(ss);
        if (lane == 0) *rs_out = 1.0f / sqrtf(ss * (1.0f / DM) + EPS);
    }
}

struct KvDesc { const bf16_t* kbase; const bf16_t* vbase; long row0, rstep, pitch; int key_lo; };
__device__ __forceinline__ void kv_issue(const KvDesc& d, int tid, u32x4 (&kk)[8], u32x4 (&vv)[8]) {
    const int srow = tid >> 4, sch = tid & 15;
#pragma unroll
    for (int i = 0; i < 8; ++i) { const int row = srow + 32 * i, rowc = row < d.key_lo ? d.key_lo : row;
        const size_t e = (size_t)(d.row0 + (long)rowc * d.rstep) * d.pitch + sch * 8; kk[i] = *(const u32x4*)(d.kbase + e); vv[i] = *(const u32x4*)(d.vbase + e); }
}
__device__ __forceinline__ void kv_commit(LAS unsigned char* lds, int tid, int key_lo, const u32x4 (&kk)[8], const u32x4 (&vv)[8]) {
    const unsigned sb = off_b(tid >> 4, tid & 15); const int srow = tid >> 4; const u32x4 z = (u32x4){0u, 0u, 0u, 0u};
#pragma unroll
    for (int i = 0; i < 8; ++i) { const bool ok = (srow + 32 * i) >= key_lo; *(LAS u32x4*)(lds + sb + 8192 * i) = ok ? kk[i] : z; *(LAS u32x4*)(lds + 65536 + sb + 8192 * i) = ok ? vv[i] : z; }
}
template <bool BANDED>
__device__ __forceinline__ void attn_compute(LAS unsigned char* lds, int lane, int w, const bf16x8 (&qf)[4], int key_lo, bf16_t* orow, float* lsep, const LAS float* btab) {
    const int fr = lane & 15, fq = lane >> 4;
    LAS unsigned char* Kimg = lds; LAS unsigned char* Vimg = lds + 65536;
    constexpr int NBLK = BANDED ? 5 : 8;
    const int blk0 = BANDED ? (w >> 1) : 0;
    const int qi = 16 * w + fr;
    unsigned kb[2][4];
#pragma unroll
    for (int e = 0; e < 2; ++e)
#pragma unroll
        for (int kk = 0; kk < 4; ++kk) kb[e][kk] = off_b(8 * (fr >> 2) + 4 * e + (fr & 3), 4 * kk + fq);
    LAS unsigned char* Kb = Kimg + 8192 * blk0; LAS unsigned char* Vb = Vimg + 8192 * blk0;
    f32x4 s[2 * NBLK];
#pragma unroll
    for (int nt = 0; nt < 2 * NBLK; ++nt) s[nt] = (f32x4){0.f, 0.f, 0.f, 0.f};
    constexpr int TB = BANDED ? 2 * NBLK : NBLK;
#pragma unroll
    for (int t0 = 0; t0 < 2 * NBLK; t0 += TB)
#pragma unroll
        for (int kk = 0; kk < 4; ++kk) { bf16x8 kf[TB];
#pragma unroll
            for (int i = 0; i < TB; ++i) { const int nt = t0 + i; kf[i] = *(const LAS bf16x8*)(Kb + kb[nt & 1][kk] + 8192 * (nt >> 1)); }
            __builtin_amdgcn_sched_barrier(0);
#pragma unroll
            for (int i = 0; i < TB; ++i) s[t0 + i] = __builtin_amdgcn_mfma_f32_16x16x32_bf16(kf[i], qf[kk], s[t0 + i], 0, 0, 0);
            __builtin_amdgcn_sched_barrier(0); }
    float mx = -1e30f;
    const LAS float* bp = btab + (128 + 16 * (w & 1) + fr - 8 * fq + 32 - 135);
    const int cmin = BANDED ? (key_lo > 0 ? (128 + 16 * (w & 1) + fr - 8 * fq) - qi : -1000) : 0;
#pragma unroll
    for (int nt = 0; nt < 2 * NBLK; ++nt)
#pragma unroll
        for (int r = 0; r < 4; ++r) { float x = s[nt][r];
            if (BANDED) { const int c = 32 * (nt >> 1) + 4 * (nt & 1) + r; x = x + bp[135 - c]; x = (c >= cmin) ? x : -1e30f; s[nt][r] = x; }
            mx = fmaxf(mx, x); }
    mx = fmaxf(mx, __shfl_xor(mx, 16)); mx = fmaxf(mx, __shfl_xor(mx, 32));
    float l = 0.f;
#pragma unroll
    for (int nt = 0; nt < 2 * NBLK; ++nt)
#pragma unroll
        for (int r = 0; r < 4; ++r) { const float p = __builtin_amdgcn_exp2f(s[nt][r] - mx); s[nt][r] = p; l += p; }
    l += __shfl_xor(l, 16); l += __shfl_xor(l, 32);
    bf16x8 pf[NBLK];
#pragma unroll
    for (int ks = 0; ks < NBLK; ++ks) pf[ks] = __builtin_bit_cast(bf16x8, pg8::pack8(s[2 * ks], s[2 * ks + 1]));
    const float inv_l = 1.0f / l;
    unsigned vb[8][2];
#pragma unroll
    for (int ct = 0; ct < 8; ++ct) { vb[ct][0] = tr16_addr(lane, ct, 0, 0); vb[ct][1] = tr16_addr(lane, ct, 0, 1); }
    f32x4 oa[8];
#pragma unroll
    for (int ct = 0; ct < 8; ++ct) oa[ct] = (f32x4){0.f, 0.f, 0.f, 0.f};
#pragma unroll
    for (int ks = 0; ks < NBLK; ++ks) { s16x4 vlo[8], vhi[8];
#pragma unroll
        for (int ct = 0; ct < 8; ++ct) { vlo[ct] = tr_read(Vb + vb[ct][0] + 8192 * ks); vhi[ct] = tr_read(Vb + vb[ct][1] + 8192 * ks); }
        __builtin_amdgcn_sched_barrier(0);
#pragma unroll
        for (int ct = 0; ct < 8; ++ct) { const bf16x8 vf = (bf16x8){vlo[ct][0], vlo[ct][1], vlo[ct][2], vlo[ct][3], vhi[ct][0], vhi[ct][1], vhi[ct][2], vhi[ct][3]};
            oa[ct] = __builtin_amdgcn_mfma_f32_16x16x32_bf16(vf, pf[ks], oa[ct], 0, 0, 0); }
        __builtin_amdgcn_sched_barrier(0); }
#pragma unroll
    for (int ct = 0; ct < 8; ++ct) { u32x2 wv; wv.x = cvt_pk_bf16(oa[ct][0] * inv_l, oa[ct][1] * inv_l); wv.y = cvt_pk_bf16(oa[ct][2] * inv_l, oa[ct][3] * inv_l);
        *(u32x2*)(orow + 16 * ct) = wv; }
    if (lsep != nullptr && fq == 0) *lsep = (mx + __builtin_amdgcn_logf(l)) * LN2;
}
struct QoDesc { const bf16_t* qbase; long row0, rstep; bf16_t* obase; float* lsebase; int banded, dil, head; };

struct GateRegs { u32x4 v[2][6]; f32x4 wq[8]; f32x4 vs[3]; float gvl; };
__device__ __forceinline__ void gate_issue(int tid, int b, int chunk, int g, const bf16_t* Z, const float* VSS, const float* w_s, const float* g_v, GateRegs& R) {
    const int lane = tid & 63, w = __builtin_amdgcn_readfirstlane(tid >> 6), fr = lane & 15, fq = lane >> 4;
    const int tok0 = b * SEQ + chunk * 128;
    {
        const int r0 = tid >> 3, c0 = tid & 7; const bf16_t* gp = Z + (size_t)(tok0 + r0) * ZP + MIXW + g * 384 + c0 * 8;
#pragma unroll
        for (int i2 = 0; i2 < 2; ++i2)
#pragma unroll
            for (int i = 0; i < 6; ++i) R.v[i2][i] = *(const u32x4*)(gp + (size_t)i2 * 64 * ZP + 64 * i); }
    { const float* wp = w_s + (size_t)g * 16384 + (16 * w + fr) * 128 + 8 * fq;
#pragma unroll
      for (int kk = 0; kk < 4; ++kk) { R.wq[2 * kk] = *(const f32x4*)(wp + 32 * kk); R.wq[2 * kk + 1] = *(const f32x4*)(wp + 32 * kk + 4); } }
    { const float* p = VSS + (size_t)(tok0 + (tid & 127)) * 24 + 12 * ((tid >> 7) & 1);
#pragma unroll
      for (int i = 0; i < 3; ++i) R.vs[i] = *(const f32x4*)(p + 4 * i); }
    R.gvl = g_v[g * 384 + (tid < 384 ? tid : tid - 384)];
}
__device__ __forceinline__ void gate_run(LAS unsigned char* lds, int tid, int b, int chunk, int g, const GateRegs& R, const bf16_t* Z, const float* b_s, bf16_t* MIX) {
    const int lane = tid & 63, w = __builtin_amdgcn_readfirstlane(tid >> 6), fr = lane & 15, fq = lane >> 4;
    const int tok0 = b * SEQ + chunk * 128, i = 16 * w + fr;
    LAS float* rs = (LAS float*)(lds + LDS_TAB); LAS float* gvs = rs + 128;
    const size_t tokrow = (size_t)(tok0 + i);
    __syncthreads();
    const bf16_t* up = Z + tokrow * ZP + g * 384 + 4 * fq;
    u32x2 ucur[8];
    const float bs = b_s[g * 128 + i];
    {
        const int r0 = tid >> 3, c0 = tid & 7; const unsigned gsb0 = off_b(r0, c0), gsb1 = off_b(r0, c0 + 8);
#pragma unroll
        for (int i2 = 0; i2 < 2; ++i2)
#pragma unroll
            for (int k = 0; k < 6; ++k) *(LAS u32x4*)(lds + (k >> 1) * 32768 + ((k & 1) ? gsb1 : gsb0) + 16384 * i2) = R.v[i2][k]; }
    { float ssum = 0.f;
#pragma unroll
      for (int k = 0; k < 3; ++k) ssum += (R.vs[k][0] + R.vs[k][1]) + (R.vs[k][2] + R.vs[k][3]);
      if (tid < 256) rs[512 + tid] = ssum;
      if (tid < 384) gvs[tid] = R.gvl; }
    __syncthreads();
    if (tid < 128) rs[tid] = 1.0f / sqrtf((rs[512 + tid] + rs[512 + 128 + tid]) * (1.0f / MIXW) + EPS);
    __syncthreads();
    bf16x8 wf[4];
#pragma unroll
    for (int kk = 0; kk < 4; ++kk) { const int j0 = 32 * kk + 8 * fq;
        const f32x4 r0 = *(const LAS f32x4*)(rs + j0), r1 = *(const LAS f32x4*)(rs + j0 + 4);
        const f32x4 a = R.wq[2 * kk], c = R.wq[2 * kk + 1];
        float v[8] = {a[0] * r0[0], a[1] * r0[1], a[2] * r0[2], a[3] * r0[3], c[0] * r1[0], c[1] * r1[1], c[2] * r1[2], c[3] * r1[3]};
#pragma unroll
        for (int jj = 0; jj < 8; ++jj) v[jj] = (j0 + jj <= i) ? v[jj] : 0.f;
        u32x4 pk; pk.x = cvt_pk_bf16(v[0], v[1]); pk.y = cvt_pk_bf16(v[2], v[3]); pk.z = cvt_pk_bf16(v[4], v[5]); pk.w = cvt_pk_bf16(v[6], v[7]);
        wf[kk] = __builtin_bit_cast(bf16x8, pk); }
    unsigned vb[8][2];
#pragma unroll
    for (int c = 0; c < 8; ++c) { vb[c][0] = tr16_addr(lane, c, 0, 0); vb[c][1] = tr16_addr(lane, c, 0, 1); }
#pragma unroll
    for (int sub = 0; sub < 3; ++sub) { LAS unsigned char* img = lds + sub * 32768;
#pragma unroll
        for (int c = 0; c < 8; ++c) ucur[c] = *(const u32x2*)(up + sub * 128 + 16 * c);
#pragma unroll
        for (int c = 0; c < 8; ++c) { f32x4 a = (f32x4){0.f, 0.f, 0.f, 0.f};
#pragma unroll
            for (int kk = 0; kk < 4; ++kk) if (kk <= (w >> 1)) {
                const s16x4 lo = tr_read(img + vb[c][0] + 8192 * kk), hi = tr_read(img + vb[c][1] + 8192 * kk);
                const bf16x8 vf = (bf16x8){lo[0], lo[1], lo[2], lo[3], hi[0], hi[1], hi[2], hi[3]};
                a = __builtin_amdgcn_mfma_f32_16x16x32_bf16(vf, wf[kk], a, 0, 0, 0); }
            const int col = g * 384 + sub * 128 + 16 * c + 4 * fq;
            const f32x4 gv = *(const LAS f32x4*)(gvs + sub * 128 + 16 * c + 4 * fq);
            const u32x2 uw = ucur[c];
            const float o0 = bf_lo(uw.x) * (a[0] * gv[0] + bs), o1 = bf_hi(uw.x) * (a[1] * gv[1] + bs), o2 = bf_lo(uw.y) * (a[2] * gv[2] + bs), o3 = bf_hi(uw.y) * (a[3] * gv[3] + bs);
            u32x2 ov; ov.x = cvt_pk_bf16(o0, o1); ov.y = cvt_pk_bf16(o2, o3);
            *(u32x2*)(MIX + tokrow * DM + col) = ov; } }
}

template <int MODE, int K>
__device__ __forceinline__ void sample_gemv(LAS unsigned char* lds, const bf16_t* A, int a_pitch, const bf16_t* Wt, int N, int first, int stride,
                                            float* outf, bf16_t* outb, int ldb, float* win, const float* rs, const float* slse = nullptr) {
    int tid = threadIdx.x; asm volatile("" : "+v"(tid));
    const int lane = tid & 63, w = __builtin_amdgcn_readfirstlane(tid >> 6), fr = lane & 15, fq = lane >> 4;
    const int ntiles = (MODE == 2) ? N / 32 : N / 16;
    LAS float* red = (LAS float*)lds;
    constexpr int kw = K / 8;
    LAS float* atab = (LAS float*)(lds + LDS_TAB + 4096);
    if (slse != nullptr) {
        __syncthreads();
        if (tid < 128) { const int srow = tid >> 4, H = tid & 15; float al = 1.0f;
            if (H < 12) { const int hl = H & 3; const float l0 = slse[srow * 12 + hl], l1 = slse[srow * 12 + 4 + hl], l2 = slse[srow * 12 + 8 + hl], mm = fmaxf(l0, fmaxf(l1, l2));
                const float e0 = __expf(l0 - mm), e1 = __expf(l1 - mm), e2 = __expf(l2 - mm); al = (H < 4 ? e0 : (H < 8 ? e1 : e2)) / (e0 + e1 + e2); }
            atab[tid] = al; }
        __syncthreads();
    }
    for (int tile = first; tile < ntiles; tile += stride) {
        const int nrow0 = (MODE == 2) ? 256 * (tile >> 3) + 16 * (tile & 7) : 16 * tile;
        const bf16_t* ap = A + (size_t)(fr & 7) * a_pitch + w * kw + 8 * fq;
        const bf16_t* bp = Wt + (size_t)(nrow0 + fr) * K + w * kw + 8 * fq;
        f32x4 acc = (f32x4){0.f, 0.f, 0.f, 0.f}, acc2 = (f32x4){0.f, 0.f, 0.f, 0.f};
#pragma unroll
        for (int ks = 0; ks < kw / 32; ++ks) { bf16x8 a = *(const bf16x8*)(ap + 32 * ks); const bf16x8 b = *(const bf16x8*)(bp + 32 * ks);
            if (MODE == 1 && slse != nullptr) { const float al = atab[(fr & 7) * 16 + ((w * kw + 32 * ks + 8 * fq) >> 7)]; const u32x4 aw = __builtin_bit_cast(u32x4, a); u32x4 o;
                o.x = cvt_pk_bf16(bf_lo(aw.x) * al, bf_hi(aw.x) * al); o.y = cvt_pk_bf16(bf_lo(aw.y) * al, bf_hi(aw.y) * al);
                o.z = cvt_pk_bf16(bf_lo(aw.z) * al, bf_hi(aw.z) * al); o.w = cvt_pk_bf16(bf_lo(aw.w) * al, bf_hi(aw.w) * al); a = __builtin_bit_cast(bf16x8, o); }
            acc = __builtin_amdgcn_mfma_f32_16x16x32_bf16(b, a, acc, 0, 0, 0);
            if (MODE == 2) { const bf16x8 b2 = *(const bf16x8*)(bp + (size_t)128 * K + 32 * ks); acc2 = __builtin_amdgcn_mfma_f32_16x16x32_bf16(b2, a, acc2, 0, 0, 0); } }
        __syncthreads();
        *(LAS f32x4*)(red + (w * 16 + fr) * 16 + 4 * fq) = acc;
        if (MODE == 2) *(LAS f32x4*)(red + 2048 + (w * 16 + fr) * 16 + 4 * fq) = acc2;
        __syncthreads();
        if (tid < 128) { const int s = tid >> 4, c = tid & 15; float v = 0.f, v2 = 0.f;
#pragma unroll
            for (int ww = 0; ww < 8; ++ww) { v += red[(ww * 16 + s) * 16 + c]; if (MODE == 2) v2 += red[2048 + (ww * 16 + s) * 16 + c]; }
            if (rs != nullptr) { const float rsr = rs[s]; v *= rsr; v2 *= rsr; }
            if (MODE == 0) { const int n = nrow0 + c; outf[(size_t)s * ZP + n] = v;
                if (win != nullptr && n >= 1536 && n < 4608) { const int kv = n >= 3072 ? 1 : 0, cc = n - 1536 - 1536 * kv, grp = cc >> 9;
                    win[(size_t)grp * 8192 + (size_t)(s * 2 + kv) * 512 + (cc & 511)] = v; } }
            else if (MODE == 1) { outb[(size_t)s * ldb + nrow0 + c] = (bf16_t)f2bf(v); }
            else { outb[(size_t)s * ldb + 128 * (tile >> 3) + 16 * (tile & 7) + c] = (bf16_t)f2bf(silu_f(v) * v2); } }
    }
}

template <class KF, class VF>
__device__ __forceinline__ float sample_attend(LAS float* scr, const float* qv, int nkeys, KF kf, VF vf, const LAS float* btab, LAS float* o_out) {
    int tid = threadIdx.x; asm volatile("" : "+v"(tid));
    const int lane = tid & 63, w = __builtin_amdgcn_readfirstlane(tid >> 6);
    LAS float* sc = scr; LAS float* part = scr + 320; LAS float* stat = scr + 320 + 2048;
    {
        const int key = tid >> 1, half = tid & 1; float d = 0.f;
        if (key < nkeys) { const float* kp = kf(key) + 64 * half; const float* qp = qv + 64 * half; f32x4 k4[16];
#pragma unroll
            for (int i = 0; i < 16; ++i) k4[i] = *(const f32x4*)(kp + 4 * i);
#pragma unroll
            for (int i = 0; i < 16; ++i) { const f32x4 q4 = *(const f32x4*)(qp + 4 * i); d += (k4[i][0] * q4[0] + k4[i][1] * q4[1]) + (k4[i][2] * q4[2] + k4[i][3] * q4[3]); } }
        d += __shfl_xor(d, 1);
        if (half == 0 && key < nkeys) sc[key] = d * QSCALE + (btab != nullptr ? btab[key] : 0.f);
    }
    __syncthreads();
    if (w == 0) { float m = -1e30f; for (int j = lane; j < nkeys; j += 64) m = fmaxf(m, sc[j]); m = wave_max(m);
        float l = 0.f; for (int j = lane; j < nkeys; j += 64) { const float p = __builtin_amdgcn_exp2f(sc[j] - m); sc[j] = p; l += p; } l = wave_sum(l);
        if (lane == 0) { stat[0] = m; stat[1] = l; } }
    __syncthreads();
    {
        const int kg = tid >> 5, d4 = 4 * (tid & 31); f32x4 v4[16]; f32x4 a = (f32x4){0.f, 0.f, 0.f, 0.f};
#pragma unroll
        for (int i = 0; i < 16; ++i) { const int j = kg + 16 * i; v4[i] = (f32x4){0.f, 0.f, 0.f, 0.f}; if (j < nkeys) v4[i] = *(const f32x4*)(vf(j) + d4); }
#pragma unroll
        for (int i = 0; i < 16; ++i) { const int j = kg + 16 * i; const float pj = j < nkeys ? sc[j] : 0.f; a = a + v4[i] * pj; }
        *(LAS f32x4*)(part + kg * 128 + d4) = a; }
    __syncthreads();
    const float m = stat[0], l = stat[1];
    if (tid < 128) { float a = 0.f;
#pragma unroll
        for (int g = 0; g < 16; ++g) a += part[g * 128 + tid];
        o_out[tid] = a / l; }
    __syncthreads();
    return (m + __builtin_amdgcn_logf(l)) * LN2;
}

#define XB_TMO      128
#define XB_XCNT(j)  (256  + 64 * (j))
#define XB_XSUB(j)  (1280 + 64 * (j))
#define XB_XGEN(j)  (2304 + 64 * (j))
#define XB_TOP      3328
#define XB_TOPGEN   3392
#define XCD_BAR_WORDS 3456
#define XB_SPIN_CAP (1u << 18)
__device__ __forceinline__ unsigned xb_ld(unsigned* p)              { return __hip_atomic_load(p, __ATOMIC_RELAXED, __HIP_MEMORY_SCOPE_AGENT); }
__device__ __forceinline__ unsigned xb_add(unsigned* p, unsigned v) { return __hip_atomic_fetch_add(p, v, __ATOMIC_RELAXED, __HIP_MEMORY_SCOPE_AGENT); }
__device__ __forceinline__ unsigned xb_xcc_id() { return (unsigned)__builtin_amdgcn_s_getreg((3 << 11) | 20) & 0xFu; }
#define XB_SPIN(cond, bar) do { unsigned _sp = 0; while (cond) { __builtin_amdgcn_s_sleep(1); \
    if ((++_sp & 255u) == 0u) { if (xb_ld(&(bar)[XB_TMO])) break; if (_sp > XB_SPIN_CAP) { atomicAdd(&(bar)[XB_TMO], 1u); break; } } } } while (0)
struct XcdBarrier { unsigned* bar; unsigned x; volatile LAS unsigned* st; };
__device__ __forceinline__ XcdBarrier xcd_barrier_post(unsigned* bar, volatile LAS unsigned* st) {
    XcdBarrier b; b.bar = bar; b.x = xb_xcc_id(); b.st = st;
    if (threadIdx.x == 0) (void)xb_add(&bar[XB_XCNT(b.x)], 1u);
    return b;
}
__device__ __forceinline__ void xcd_barrier_complete(unsigned* bar, unsigned x, unsigned& nloc, unsigned& nx) {
    const unsigned G = gridDim.x * gridDim.y * gridDim.z;
    unsigned sum, cnt, mine, sp = 0u;
    for (;;) {
        sum = 0u; cnt = 0u; mine = 0u;
#pragma unroll
        for (unsigned j = 0; j < 16; ++j) { const unsigned c = xb_ld(&bar[XB_XCNT(j)]); sum += c; cnt += (c > 0u) ? 1u : 0u; mine = (j == x) ? c : mine; }
        if (sum == G) break;
        __builtin_amdgcn_s_sleep(1);
        if ((++sp & 255u) == 0u) { if (xb_ld(&bar[XB_TMO])) break; if (sp > XB_SPIN_CAP) { atomicAdd(&bar[XB_TMO], 1u); break; } }
    }
    nloc = mine > 0u ? mine : 1u; nx = cnt > 0u ? cnt : 1u;
}
__device__ __forceinline__ void xcd_barrier(const XcdBarrier& b) {
    asm volatile("s_waitcnt vmcnt(0)" ::: "memory");
    __syncthreads();
    if (threadIdx.x == 0) {
        unsigned* bar = b.bar;
        __builtin_amdgcn_s_waitcnt(0);
        unsigned nloc = b.st[0], nx = b.st[1];
        if (nloc == 0u) { xcd_barrier_complete(bar, b.x, nloc, nx); b.st[0] = nloc; b.st[1] = nx; }
        const unsigned old = xb_add(&bar[XB_XSUB(b.x)], 1u);
        const unsigned gen = old / nloc;
        if (old + 1u == (gen + 1u) * nloc) {
            __builtin_amdgcn_fence(__ATOMIC_RELEASE, "agent");
            asm volatile("s_waitcnt vmcnt(0)" ::: "memory");
            const unsigned og = xb_add(&bar[XB_TOP], 1u);
            const unsigned tg = og / nx;
            if (og + 1u == (tg + 1u) * nx) xb_add(&bar[XB_TOPGEN], 1u);
            else XB_SPIN(xb_ld(&bar[XB_TOPGEN]) == tg, bar);
            __builtin_amdgcn_fence(__ATOMIC_ACQUIRE, "agent");
            xb_add(&bar[XB_XGEN(b.x)], 1u);
            asm volatile("s_waitcnt vmcnt(0)" ::: "memory");
        } else {
            XB_SPIN(xb_ld(&bar[XB_XGEN(b.x)]) == gen, bar);
            __builtin_amdgcn_fence(__ATOMIC_ACQUIRE, "agent");
            asm volatile("s_waitcnt vmcnt(0)" ::: "memory");
        }
    }
    __syncthreads();
}

struct Args { const float* in[22]; float* out; unsigned char* ws; };
typedef const Args __attribute__((address_space(4)))* ArgsP;
__device__ __forceinline__ ArgsP args_ptr() { ArgsP p = (ArgsP)__builtin_amdgcn_kernarg_segment_ptr(); asm volatile("" : "+s"(p)); return p; }
#define WSP(T, off) ((T*)(A->ws + (off)))

constexpr int I_MKV = 32 * 16, I_INA = 32 * 56, I_INB = 32 * 80, I_OUT = 32 * 32, I_UP = 32 * 176, I_DN = 88 * 32, DN_P = 850, DN_A = 1170;
__device__ __forceinline__ int conv_count(int list) { return list == 0 ? 2 * I_MKV + I_INA + I_UP + DN_P : (list == 1 ? I_OUT + (DN_A - DN_P) : (list == 2 ? (I_DN - DN_A) + I_INB + I_OUT : (list == 3 ? I_UP : I_DN))); }
__device__ __forceinline__ TItem conv_item(ArgsP A, int list, int r) {
    const float* n_mix_pre = A->in[8]; const float* n_ffn_pre = A->in[10]; const float* n_mem = A->in[12]; const float* w_mem_kv = A->in[13]; const float* w_in_a = A->in[14];
    const float* w_in_b = A->in[18]; const float* w_out = A->in[19]; const float* w_up = A->in[20]; const float* w_dn = A->in[21];
    bf16_t* Wmkv = WSP(bf16_t, WS_WMKV); bf16_t* Wina = WSP(bf16_t, WS_WINA); bf16_t* Winb = WSP(bf16_t, WS_WINB); bf16_t* Wout = WSP(bf16_t, WS_WOUT);
    bf16_t* Wup = WSP(bf16_t, WS_WUP); bf16_t* Wdn = WSP(bf16_t, WS_WDN);
    if (list == 0) {
        if (r < 2 * I_MKV) { const int l = r / I_MKV; return t_make(w_mem_kv + (size_t)l * DM * NKV, DM, NKV, Wmkv + (size_t)l * NKV * DM, false, n_mem + l * DM, r % I_MKV); } r -= 2 * I_MKV;
        if (r < I_INA) return t_make(w_in_a, DM, NA, Wina, false, n_mix_pre, r); r -= I_INA;
        if (r < I_UP) return t_make(w_up, DM, NUP, Wup, true, n_ffn_pre, r); r -= I_UP;
        return t_make(w_dn, DFF, DM, Wdn, false, nullptr, r);
    } else if (list == 1) {
        if (r < I_OUT) return t_make(w_out, DM, DM, Wout, false, nullptr, r); r -= I_OUT;
        return t_make(w_dn, DFF, DM, Wdn, false, nullptr, DN_P + r);
    } else if (list == 2) {
        if (r < I_DN - DN_A) return t_make(w_dn, DFF, DM, Wdn, false, nullptr, DN_A + r); r -= I_DN - DN_A;
        if (r < I_INB) return t_make(w_in_b, DM, NB, Winb, false, n_mix_pre + DM, r); r -= I_INB;
        return t_make(w_out + (size_t)DM * DM, DM, DM, Wout + (size_t)DM * DM, false, nullptr, r);
    } else if (list == 3) {
        return t_make(w_up + (size_t)DM * NUP, DM, NUP, Wup + (size_t)NUP * DM, true, n_ffn_pre + DM, r);
    } else {
        return t_make(w_dn + (size_t)DFF * DM, DFF, DM, Wdn + (size_t)DM * DFF, false, nullptr, r);
    }
}
__device__ __forceinline__ void convert_list(LAS unsigned char* lds, ArgsP A, int list, int worker, int nworkers, int wave, int lane) {
    const int n = conv_count(list);
    LAS float* scr = (LAS float*)(lds + wave * 16384);
    int it = worker;
    if (it >= n) return;
    TItem cur = conv_item(A, list, it);
    f32x4 va[16], vb[16];
    t_load(cur, lane, va);
    for (;;) {
        const int itn = it + nworkers; const bool hn = itn < n;
        TItem nxt = cur;
        if (hn) { nxt = conv_item(A, list, itn); t_load(nxt, lane, vb); }
        t_store(cur, scr, lane, va);
        if (!hn) break;
#pragma unroll
        for (int i = 0; i < 16; ++i) va[i] = vb[i];
        cur = nxt; it = itn;
    }
}
__device__ __forceinline__ void convert_tail(LAS unsigned char* lds, ArgsP A, int list, int first_idle) {
    const int bid = blockIdx.x, G = gridDim.x;
    if (bid < first_idle || first_idle >= G) return;
    int tid = threadIdx.x; asm volatile("" : "+v"(tid));
    const int lane = tid & 63, wave = __builtin_amdgcn_readfirstlane(tid >> 6);
    __syncthreads();
    convert_list(lds, A, list, (bid - first_idle) * 8 + wave, (G - first_idle) * 8, wave, lane);
}
__device__ __forceinline__ void phase_prologue(LAS unsigned char* lds) {
    ArgsP A = args_ptr();
    int tid = threadIdx.x; asm volatile("" : "+v"(tid));
    const int lane = tid & 63, wave = __builtin_amdgcn_readfirstlane(tid >> 6), gw = blockIdx.x * 8 + wave, NGW = gridDim.x * 8;
    const float* x_prompt = A->in[0]; const float* x_sample = A->in[1]; const float* mem_prompt = A->in[2];
    bf16_t* YB = WSP(bf16_t, WS_HN); bf16_t* HM = WSP(bf16_t, WS_HM);
    float* RS = WSP(float, WS_RS); float* RSM = RS + 16384;
    convert_list(lds, A, 0, gw, NGW, wave, lane);
    if (gridDim.x != 256) { convert_list(lds, A, 1, gw, NGW, wave, lane); convert_list(lds, A, 2, gw, NGW, wave, lane); convert_list(lds, A, 3, gw, NGW, wave, lane); convert_list(lds, A, 4, gw, NGW, wave, lane); }
    for (int m = gw; m < 512 + TP + TSMP; m += NGW) {
        if (m < 512) norm_row<0>(mem_prompt + (size_t)m * DM, HM + (size_t)m * DM, nullptr, nullptr, RSM + m, nullptr, lane);
        else { const int r = m - 512; const float* xr = r < TP ? x_prompt + (size_t)r * DM : x_sample + (size_t)(r - TP) * DM;
            norm_row<0>(xr, YB + (size_t)r * DM, nullptr, nullptr, RS + r, nullptr, lane); }
    }
}

__device__ __forceinline__ void phase_in_a(LAS unsigned char* lds) {
    ArgsP A = args_ptr(); const int bid = blockIdx.x, G = gridDim.x;
    bf16_t* HN = WSP(bf16_t, WS_HN);
    { pg8::Gemm g{HN, WSP(bf16_t, WS_WINA), TP, NA, DM}; pg8::StaticOrder S; S.init(TP, NA, G, bid); pg8::EpiInA E{WSP(bf16_t, WS_Z), WSP(float, WS_VSS), WSP(float, WS_RS)};
      pg8::gemm_phase<pg8::EpiInA, true, true>(lds, g, S, E); }
#pragma unroll 1
    for (int l = 0; l < 2; ++l) { pg8::Gemm g{WSP(bf16_t, WS_HM), WSP(bf16_t, WS_WMKV) + (size_t)l * NKV * DM, 512, NKV, DM};
      pg8::StaticOrder S; S.init(512, NKV, G, (bid - 192 - 8 * l + 2 * G) % G);
      pg8::EpiMkv E{A->out + OUT_MKV + (size_t)l * 512 * NKV, WSP(bf16_t, WS_MKV) + (size_t)l * 512 * NKV, WSP(float, WS_RS) + 16384};
      pg8::gemm_phase<pg8::EpiMkv, true, true>(lds, g, S, E); }
    if (G == 256) { if (bid >= 208) sample_gemv<0, DM>(lds, HN + (size_t)TP * DM, DM, WSP(bf16_t, WS_WINA), NA, G - 1 - bid, 48, WSP(float, WS_ZS), nullptr, 0, nullptr, WSP(float, WS_RS) + TP); }
    else sample_gemv<0, DM>(lds, HN + (size_t)TP * DM, DM, WSP(bf16_t, WS_WINA), NA, G - 1 - bid, G, WSP(float, WS_ZS), nullptr, 0, nullptr, WSP(float, WS_RS) + TP);
    if (G == 256) convert_tail(lds, A, 1, 208);
}
__device__ __forceinline__ void phase_in_b(LAS unsigned char* lds) {
    ArgsP A = args_ptr(); const int bid = blockIdx.x, G = gridDim.x;
    bf16_t* HN = WSP(bf16_t, WS_HN); float* out = A->out;
    pg8::Gemm g{HN, WSP(bf16_t, WS_WINB), TP, NB, DM}; pg8::StaticOrder S; S.init(TP, NB, G, bid);
    pg8::EpiInB E{WSP(bf16_t, WS_Z), WSP(float, WS_RS)};
    pg8::gemm_phase<pg8::EpiInB, true, true>(lds, g, S, E);
    sample_gemv<0, DM>(lds, HN + (size_t)TP * DM, DM, WSP(bf16_t, WS_WINB), NB, G - 1 - bid, G, WSP(float, WS_ZS), nullptr, 0, out + OUT_W128S, WSP(float, WS_RS) + TP);
    if (G == 256) convert_tail(lds, A, 3, 128);
}
__device__ __forceinline__ void mem_unit_desc(ArgsP A, int v, int layer, KvDesc& kd, QoDesc& qd) {
    const int b = v >> 7, h = (v >> 5) & 3, qb = v & 31, qmoff = layer == 0 ? 3072 : 4608;
    const bf16_t* mkv = WSP(bf16_t, WS_MKV) + (size_t)layer * 512 * NKV + h * 128;
    kd.kbase = mkv; kd.vbase = mkv + 512; kd.row0 = (long)b * 256; kd.rstep = 1; kd.pitch = NKV; kd.key_lo = 0;
    qd.qbase = WSP(bf16_t, WS_Z) + qmoff + h * 128; qd.row0 = (long)b * SEQ + 128 * qb; qd.rstep = 1; qd.obase = WSP(bf16_t, WS_MIX) + MIXW + h * 128; qd.lsebase = nullptr;
    qd.banded = 0; qd.dil = 1; qd.head = 0;
}
__device__ __forceinline__ void swa_unit_desc(ArgsP A, int u, KvDesc& kd, QoDesc& qd) {
    const int b = u / 384, H = (u % 384) >> 5, idx = u & 31, g = H >> 2, dil = 1 << (2 * g), r = idx & (dil - 1), qb = idx >> (2 * g);
    const bf16_t* Z = WSP(bf16_t, WS_Z);
    kd.kbase = Z + MIXW + H * 128; kd.vbase = Z + 2 * MIXW + H * 128; kd.row0 = (long)b * SEQ + (long)(128 * qb - 128) * dil + r; kd.rstep = dil; kd.pitch = ZP; kd.key_lo = qb == 0 ? 128 : 0;
    qd.qbase = Z + H * 128; qd.row0 = (long)b * SEQ + (long)(128 * qb) * dil + r; qd.rstep = dil; qd.obase = WSP(bf16_t, WS_MIX) + H * 128; qd.lsebase = WSP(float, WS_LSE) + H;
    qd.banded = 1; qd.dil = dil; qd.head = H;
}
__device__ __forceinline__ void q_issue(const QoDesc& qd, int tid, bf16x8 (&qf)[4]) {
    const int lane = tid & 63, w = __builtin_amdgcn_readfirstlane(tid >> 6), fr = lane & 15, fq = lane >> 4;
    const long qrow = qd.row0 + (long)(16 * w + fr) * qd.rstep;
    const bf16_t* qp = qd.qbase + (size_t)qrow * ZP + 8 * fq;
#pragma unroll
    for (int k4 = 0; k4 < 4; ++k4) qf[k4] = *(const bf16x8*)(qp + 32 * k4);
}
__device__ __forceinline__ void build_bias_tables(LAS unsigned char* lds, int tid, const float* rel_bias) {
    LAS float* tab = (LAS float*)(lds + LDS_TAB); LAS float* rb = tab + 12 * 192;
    if (tid < 384) rb[tid] = rel_bias[tid] * LOG2E;
    __syncthreads();
    for (int i = tid; i < 12 * 192; i += 512) { const int H = i / 192, j = i % 192 - 32, dil = 1 << (2 * (H >> 2));
        tab[i] = (j >= 0 && j <= 128) ? rb[t5_bucket(j * dil) * 12 + H] : -1e30f; }
}
__device__ __forceinline__ void attn_unit_run(LAS unsigned char* lds, int tid, const QoDesc& qd, int key_lo, u32x4 (&kk)[8], u32x4 (&vv)[8], bf16x8 (&qf)[4],
                                              const bool has_next, const KvDesc nxt, const QoDesc nxtq) {
    const int lane = tid & 63, w = __builtin_amdgcn_readfirstlane(tid >> 6), fr = lane & 15, fq = lane >> 4;
    __syncthreads();
    kv_commit(lds, tid, key_lo, kk, vv);
    bf16x8 qc[4];
#pragma unroll
    for (int k4 = 0; k4 < 4; ++k4) qc[k4] = qf[k4];
    if (has_next) { kv_issue(nxt, tid, kk, vv); q_issue(nxtq, tid, qf); }
    __syncthreads();
    const long qrow = qd.row0 + (long)(16 * w + fr) * qd.rstep;
    bf16_t* orow = qd.obase + (size_t)qrow * DM + 4 * fq;
    float* lsep = qd.lsebase != nullptr ? qd.lsebase + (size_t)qrow * 12 : nullptr;
    if (qd.banded) attn_compute<true>(lds, lane, w, qc, key_lo, orow, lsep, (const LAS float*)(lds + LDS_TAB) + qd.head * 192);
    else attn_compute<false>(lds, lane, w, qc, key_lo, orow, lsep, (const LAS float*)(lds + LDS_TAB));
}
__device__ __forceinline__ void sample_mem_attn(LAS unsigned char* lds, int layer) {
    ArgsP A = args_ptr(); const int bid = blockIdx.x, G = gridDim.x;
    int tid = threadIdx.x; asm volatile("" : "+v"(tid));
    const int qmoff = layer == 0 ? 3072 : 4608;
    for (int it = G - 1 - 96 - bid; it >= 0 && it < 32; it += G) {
        const int s = it >> 2, h = it & 3;
        LAS float* scr = (LAS float*)lds; LAS float* og = scr + 2560;
        __syncthreads();
        const float* cm = A->in[3] + (size_t)(layer * 8 + s) * 256 * 1024;
        auto kf = [=](int j) -> const float* { return cm + (size_t)j * 1024 + h * 128; };
        auto vf = [=](int j) -> const float* { return cm + (size_t)j * 1024 + 512 + h * 128; };
        (void)sample_attend(scr, WSP(float, WS_ZS) + (size_t)s * ZP + qmoff + h * 128, 256, kf, vf, (const LAS float*)nullptr, og);
        if (tid < 128) WSP(bf16_t, WS_MIX)[(size_t)(TP + s) * DM + MIXW + h * 128 + tid] = (bf16_t)f2bf(og[tid]);
        __syncthreads();
    }
}
__device__ __forceinline__ void phase_mix_a(LAS unsigned char* lds) {
    ArgsP A = args_ptr(); const int bid = blockIdx.x, G = gridDim.x;
    int tid = threadIdx.x; asm volatile("" : "+v"(tid));
    const int lane = tid & 63, wave = __builtin_amdgcn_readfirstlane(tid >> 6);
    const float* ZS = WSP(float, WS_ZS); const float* n_v_a = A->in[15]; const float* w_sp = A->in[16]; const float* b_sp = A->in[17]; bf16_t* MIX = WSP(bf16_t, WS_MIX); float* out = A->out;
    for (int it = G - 1 - bid; it < TSMP; it += G) {
        LAS float* red = (LAS float*)lds; const int s = it;
        __syncthreads();
        float vv[3], uu[3], ss = 0.f;
#pragma unroll
        for (int i = 0; i < 3; ++i) { const int c = tid + 512 * i; uu[i] = gelu_tanh(ZS[(size_t)s * ZP + c]); vv[i] = gelu_tanh(ZS[(size_t)s * ZP + MIXW + c]); ss += vv[i] * vv[i]; }
        ss = wave_sum(ss); if (lane == 0) red[wave] = ss;
        __syncthreads();
        float tot = 0.f;
#pragma unroll
        for (int i = 0; i < 8; ++i) tot += red[i];
        const float rstd = 1.0f / sqrtf(tot * (1.0f / MIXW) + EPS);
#pragma unroll
        for (int i = 0; i < 3; ++i) { const int c = tid + 512 * i, g = c / 384; const float vn = vv[i] * rstd * n_v_a[c];
            out[OUT_CHV + (size_t)s * MIXW + c] = vn;
            const float sg = w_sp[(size_t)g * 16384] * vn + b_sp[g * 128];
            MIX[(size_t)(TP + s) * DM + c] = (bf16_t)f2bf(uu[i] * sg); }
    }
    sample_mem_attn(lds, 0);
    __syncthreads();
    for (int u = bid; u < 256; u += G) {
        KvDesc kd; QoDesc qd; mem_unit_desc(A, u, 0, kd, qd);
        u32x4 kk[8], vv[8]; bf16x8 qf[4]; GateRegs R;
        gate_issue(tid, u >> 7, (u >> 2) & 31, u & 3, WSP(bf16_t, WS_Z), WSP(float, WS_VSS), A->in[16], A->in[15], R);
        kv_issue(kd, tid, kk, vv); q_issue(qd, tid, qf);
        gate_run(lds, tid, u >> 7, (u >> 2) & 31, u & 3, R, WSP(bf16_t, WS_Z), A->in[17], WSP(bf16_t, WS_MIX));
        attn_unit_run(lds, tid, qd, kd.key_lo, kk, vv, qf, false, kd, qd);
    }
}
__device__ __forceinline__ void phase_mix_b1(LAS unsigned char* lds) {
    ArgsP A = args_ptr(); const int bid = blockIdx.x, G = gridDim.x;
    int tid = threadIdx.x; asm volatile("" : "+v"(tid));
    KvDesc kd{}, kn{}; QoDesc qd{}, qn{};
    u32x4 kk[8], vv[8]; bf16x8 qf[4];
    int u = bid;
    if (u < 1024) { if (u < 768) swa_unit_desc(A, u, kd, qd); else mem_unit_desc(A, u - 768, 1, kd, qd); kv_issue(kd, tid, kk, vv); q_issue(qd, tid, qf); }
    build_bias_tables(lds, tid, A->in[7]);
#pragma unroll 1
    for (; u < 1024; u += G) {
        const int un = u + G; const bool has_next = un < 1024;
        if (has_next) { if (un < 768) swa_unit_desc(A, un, kn, qn); else mem_unit_desc(A, un - 768, 1, kn, qn); }
        attn_unit_run(lds, tid, qd, kd.key_lo, kk, vv, qf, has_next, kn, qn);
        kd = kn; qd = qn;
    }
}
__device__ __forceinline__ void phase_mix_b2(LAS unsigned char* lds) {
    ArgsP A = args_ptr(); const int bid = blockIdx.x, G = gridDim.x;
    int tid = threadIdx.x; asm volatile("" : "+v"(tid));
    const int lane = tid & 63, wave = __builtin_amdgcn_readfirstlane(tid >> 6), gw = bid * 8 + wave, NGW = G * 8;
    bf16_t* MIX = WSP(bf16_t, WS_MIX); const float* LSE = WSP(float, WS_LSE);
    for (int row = gw; row < TP; row += NGW) {
        const float* lp = LSE + (size_t)row * 12;
#pragma unroll
        for (int i = 0; i < 3; ++i) { const int col = 8 * (lane + 64 * i), H = col >> 7, g = H >> 2, hl = H & 3;
            const float l0 = lp[hl], l1 = lp[4 + hl], l2 = lp[8 + hl], mm = fmaxf(l0, fmaxf(l1, l2));
            const float e0 = __expf(l0 - mm), e1 = __expf(l1 - mm), e2 = __expf(l2 - mm);
            const float al = (g == 0 ? e0 : (g == 1 ? e1 : e2)) / (e0 + e1 + e2);
            u32x4 wv = *(u32x4*)(MIX + (size_t)row * DM + col);
            wv.x = cvt_pk_bf16(bf_lo(wv.x) * al, bf_hi(wv.x) * al); wv.y = cvt_pk_bf16(bf_lo(wv.y) * al, bf_hi(wv.y) * al);
            wv.z = cvt_pk_bf16(bf_lo(wv.z) * al, bf_hi(wv.z) * al); wv.w = cvt_pk_bf16(bf_lo(wv.w) * al, bf_hi(wv.w) * al);
            *(u32x4*)(MIX + (size_t)row * DM + col) = wv; }
    }
    { const int nw = G > 128 ? G - 128 : G, wk = bid < nw ? bid : -1;
      if (wk >= 0) { const bf16_t* Z = WSP(bf16_t, WS_Z); float* o0 = A->out + OUT_W128P;
        for (int i = wk * 512 + tid; i < 688128; i += nw * 512) {
            const int g = i < 32768 ? 0 : (i < 163840 ? 1 : 2), ig = i - (g == 0 ? 0 : (g == 1 ? 32768 : 163840)), W = 128 << (2 * g);
            const int c8 = ig & 63, kv = (ig >> 6) & 1, tr = (ig >> 7) & (W - 1), b = (ig >> 7) / W;
            const u32x4 wv = *(const u32x4*)(Z + (size_t)(b * SEQ + (SEQ - W) + tr) * ZP + MIXW + kv * MIXW + g * 512 + c8 * 8);
            float* dst = o0 + (size_t)2048 * ((W - 128) / 3) + (size_t)ig * 8;
            *(f32x4*)dst = (f32x4){bf_lo(wv.x), bf_hi(wv.x), bf_lo(wv.y), bf_hi(wv.y)}; *(f32x4*)(dst + 4) = (f32x4){bf_lo(wv.z), bf_hi(wv.z), bf_lo(wv.w), bf_hi(wv.w)}; } } }
    const float* rel_bias = A->in[7]; const float* ZS = WSP(float, WS_ZS);
    for (int it = G - 1 - bid; it < 96; it += G) {
        const int s = it / 12, H = it % 12, g = H >> 2, hl = H & 3, dil = 1 << (2 * g), W = 128 << (2 * g);
        LAS float* scr = (LAS float*)lds; LAS float* btab = scr + 2400; LAS float* og = scr + 2560;
        __syncthreads();
        for (int j = tid; j <= 128; j += 512) btab[j] = rel_bias[t5_bucket(j * dil) * 12 + H] * LOG2E;
        __syncthreads();
        const float* cw = A->in[4 + g];
        const float* zrow = ZS + (size_t)s * ZP;
        auto kf = [=](int j) -> const float* { return j == 0 ? zrow + MIXW + H * 128 : cw + ((size_t)(s * W + (W - j * dil)) * 2 + 0) * 512 + hl * 128; };
        auto vf = [=](int j) -> const float* { return j == 0 ? zrow + 2 * MIXW + H * 128 : cw + ((size_t)(s * W + (W - j * dil)) * 2 + 1) * 512 + hl * 128; };
        const float lg = sample_attend(scr, zrow + H * 128, 129, kf, vf, btab, og);
        if (tid < 128) MIX[(size_t)(TP + s) * DM + H * 128 + tid] = (bf16_t)f2bf(og[tid]);
        if (tid == 0) WSP(float, WS_LSE)[(size_t)TP * 12 + s * 12 + H] = lg;
        __syncthreads();
    }
    sample_mem_attn(lds, 1);
}
__device__ __forceinline__ void phase_out(LAS unsigned char* lds, int layer) {
    ArgsP A = args_ptr(); const int bid = blockIdx.x, G = gridDim.x;
    bf16_t* MIX = WSP(bf16_t, WS_MIX); bf16_t* OB = WSP(bf16_t, WS_O); const bf16_t* W = WSP(bf16_t, WS_WOUT) + (size_t)layer * DM * DM;
    pg8::Gemm g{MIX, W, TP, DM, DM}; pg8::StaticOrder S; S.init(TP, DM, G, bid); pg8::EpiPlain E{OB, DM};
    pg8::gemm_phase<pg8::EpiPlain, false, true>(lds, g, S, E);
    sample_gemv<1, DM>(lds, MIX + (size_t)TP * DM, DM, W, DM, G - 1 - bid, G, nullptr, OB + (size_t)TP * DM, DM, nullptr, nullptr, layer == 1 ? WSP(float, WS_LSE) + (size_t)TP * 12 : nullptr);
}
__device__ __forceinline__ void phase_up(LAS unsigned char* lds, int layer) {
    ArgsP A = args_ptr(); const int bid = blockIdx.x, G = gridDim.x;
    bf16_t* HN = WSP(bf16_t, WS_HN); bf16_t* ACT = WSP(bf16_t, WS_ACT); const bf16_t* W = WSP(bf16_t, WS_WUP) + (size_t)layer * NUP * DM;
    pg8::Gemm g{HN, W, TP, NUP, DM}; pg8::StaticOrder S; S.init(TP, NUP, G, bid); pg8::EpiSwiglu E{ACT, WSP(float, WS_RS)};
    pg8::gemm_phase<pg8::EpiSwiglu, true, true>(lds, g, S, E);
    if (G == 256 && layer == 1) { if (bid >= 128) sample_gemv<2, DM>(lds, HN + (size_t)TP * DM, DM, W, NUP, G - 1 - bid, 128, nullptr, ACT + (size_t)TP * DFF, DFF, nullptr, WSP(float, WS_RS) + TP); }
    else sample_gemv<2, DM>(lds, HN + (size_t)TP * DM, DM, W, NUP, G - 1 - bid, G, nullptr, ACT + (size_t)TP * DFF, DFF, nullptr, WSP(float, WS_RS) + TP);
    if (G == 256) convert_tail(lds, A, layer == 0 ? 2 : 4, 128);
}
__device__ __forceinline__ void phase_down(LAS unsigned char* lds, int layer) {
    ArgsP A = args_ptr(); const int bid = blockIdx.x, G = gridDim.x;
    bf16_t* ACT = WSP(bf16_t, WS_ACT); bf16_t* OB = WSP(bf16_t, WS_O); const bf16_t* W = WSP(bf16_t, WS_WDN) + (size_t)layer * DM * DFF;
    pg8::Gemm g{ACT, W, TP, DM, DFF}; pg8::StaticOrder S; S.init(TP, DM, G, bid); pg8::EpiPlain E{OB, DM};
    pg8::gemm_phase<pg8::EpiPlain, false, true>(lds, g, S, E);
    sample_gemv<1, DFF>(lds, ACT + (size_t)TP * DFF, DFF, W, DM, G - 1 - bid, G, nullptr, OB + (size_t)TP * DM, DM, nullptr, nullptr);
}
__device__ __forceinline__ void phase_norm(int which) {
    ArgsP A = args_ptr();
    int tid = threadIdx.x; asm volatile("" : "+v"(tid));
    const int lane = tid & 63, wave = __builtin_amdgcn_readfirstlane(tid >> 6), gw = blockIdx.x * 8 + wave, NGW = gridDim.x * 8;
    const int layer = which >> 1;
    float* Y = A->out + OUT_Y; const bf16_t* OB = WSP(bf16_t, WS_O); bf16_t* YB = WSP(bf16_t, WS_HN); float* RS = WSP(float, WS_RS);
    const float* gpost = ((which & 1) ? A->in[11] : A->in[9]) + layer * DM;
    for (int r = gw; r < TP + TSMP; r += NGW) {
        if (which == 3) norm_row<3>(nullptr, YB + (size_t)r * DM, OB + (size_t)r * DM, gpost, nullptr, Y + (size_t)r * DM, lane);
        else norm_row<2>(nullptr, YB + (size_t)r * DM, OB + (size_t)r * DM, gpost, RS + r, nullptr, lane);
    }
}

__global__ void __launch_bounds__(512, 2) fwd_megakernel(Args args) {
    extern __shared__ __attribute__((aligned(16))) unsigned char lds_raw[];
    LAS unsigned char* lds = (LAS unsigned char*)lds_raw;
    volatile LAS unsigned* bst = (volatile LAS unsigned*)(lds + LDS_BYTES - 64);
    if (threadIdx.x < 16) bst[threadIdx.x] = 0u;
    __syncthreads();
    const XcdBarrier bar = xcd_barrier_post((unsigned*)args.ws, bst);
#define GRID_SYNC() xcd_barrier(bar)
    phase_prologue(lds);
    GRID_SYNC();
    phase_in_a(lds);
    GRID_SYNC();
    phase_mix_a(lds);
    GRID_SYNC();
    phase_out(lds, 0);
    GRID_SYNC();
    phase_norm(0);
    GRID_SYNC();
    phase_up(lds, 0);
    GRID_SYNC();
    phase_down(lds, 0);
    GRID_SYNC();
    phase_norm(1);
    GRID_SYNC();
    phase_in_b(lds);
    GRID_SYNC();
    phase_mix_b1(lds);
    GRID_SYNC();
    phase_mix_b2(lds);
    GRID_SYNC();
    phase_out(lds, 1);
    GRID_SYNC();
    phase_norm(2);
    GRID_SYNC();
    phase_up(lds, 1);
    GRID_SYNC();
    phase_down(lds, 1);
    GRID_SYNC();
    phase_norm(3);
#undef GRID_SYNC
}

extern "C" void kernel_launch(void* const* d_in, const int* in_sizes, int n_in, void* d_out, int out_size, void* d_ws, size_t ws_size, hipStream_t stream) {
    static int grid = 0;
    if (grid == 0) {
        if (n_in != 22 || (size_t)out_size != OUT_TOTAL || ws_size < WS_END) { fprintf(stderr, "kernel_launch: unexpected shapes (n_in %d, out %d, ws %zu)\n", n_in, out_size, ws_size); grid = -1; return; }
        int dev = 0, cus = 0, per_cu = 0;
        if (hipGetDevice(&dev) != hipSuccess || hipDeviceGetAttribute(&cus, hipDeviceAttributeMultiprocessorCount, dev) != hipSuccess) { grid = -1; return; }
        if (hipFuncSetAttribute((const void*)fwd_megakernel, hipFuncAttributeMaxDynamicSharedMemorySize, LDS_BYTES) != hipSuccess) { fprintf(stderr, "kernel_launch: hipFuncSetAttribute failed\n"); grid = -1; return; }
        if (hipOccupancyMaxActiveBlocksPerMultiprocessor(&per_cu, (const void*)fwd_megakernel, 512, LDS_BYTES) != hipSuccess || per_cu < 1) { fprintf(stderr, "kernel_launch: occupancy query says %d\n", per_cu); (void)hipGetLastError(); per_cu = 1; }
        grid = cus;
    }
    if (grid < 0) return;
    if (hipMemsetAsync(d_ws, 0, 16384, stream) != hipSuccess) { fprintf(stderr, "kernel_launch: memset of the barrier words failed\n"); return; }
    Args a{};
    for (int i = 0; i < 22; ++i) a.in[i] = (const float*)d_in[i];
    a.out = (float*)d_out; a.ws = (unsigned char*)d_ws;
    void* kargs[] = {&a};
    hipError_t e = hipLaunchCooperativeKernel((const void*)fwd_megakernel, dim3(grid), dim3(512), kargs, LDS_BYTES, stream);
    if (e != hipSuccess) fprintf(stderr, "kernel_launch: cooperative launch failed: %s (grid %d)\n", hipGetErrorString(e), grid);
}
```

```cpp
#include <hip/hip_runtime.h>
#include <cstdio>
#include <cstdint>

#define LAS __attribute__((address_space(3)))
typedef unsigned short bf16_t;
typedef short bf16x8 __attribute__((ext_vector_type(8)));
typedef short s16x4 __attribute__((ext_vector_type(4)));
typedef float f32x4 __attribute__((ext_vector_type(4)));
typedef float f32x2 __attribute__((ext_vector_type(2)));
typedef unsigned u32x4 __attribute__((ext_vector_type(4)));
typedef unsigned u32x2 __attribute__((ext_vector_type(2)));

constexpr int DM = 2048, TP = 8192, TSMP = 8, TROWS = TP + 16, SEQ = 4096;
constexpr int MIXW = 1536, NA = 3584, NB = 5120, DFF = 5632, NUP = 11264, NKV = 1024;
constexpr int ZP = 5120;
constexpr float EPS = 1e-6f;
constexpr float LOG2E = 1.4426950408889634f, LN2 = 0.6931471805599453f;
constexpr float QSCALE = 0.08838834764831845f * 1.4426950408889634f;

constexpr size_t MiB = 1u << 20;
constexpr size_t WS_WMKV = 1 * MiB;
constexpr size_t WS_WINA = 9 * MiB;
constexpr size_t WS_WINB = 23 * MiB;
constexpr size_t WS_WOUT = 43 * MiB;
constexpr size_t WS_WUP = 59 * MiB;
constexpr size_t WS_WDN = 147 * MiB;
constexpr size_t WS_HN = 191 * MiB;
constexpr size_t WS_HM = 224 * MiB;
constexpr size_t WS_MKV = 228 * MiB;
constexpr size_t WS_Z = 230 * MiB;
constexpr size_t WS_ZS = 310 * MiB;
constexpr size_t WS_VSS = 311 * MiB;
constexpr size_t WS_MIX = 312 * MiB;
constexpr size_t WS_LSE = 345 * MiB;
constexpr size_t WS_RS = 345 * MiB + 512 * 1024;
constexpr size_t WS_O = 346 * MiB;
constexpr size_t WS_ACT = 379 * MiB;
constexpr size_t WS_END = 468 * MiB;

constexpr size_t OUT_Y = 0;
constexpr size_t OUT_MKV = 16793600;
constexpr size_t OUT_CHV = OUT_MKV + 1048576;
constexpr size_t OUT_W128P = OUT_CHV + 12288;
constexpr size_t OUT_W512P = OUT_W128P + 262144;
constexpr size_t OUT_W2048P = OUT_W512P + 1048576;
constexpr size_t OUT_W128S = OUT_W2048P + 4194304;
constexpr size_t OUT_W512S = OUT_W128S + 8192;
constexpr size_t OUT_W2048S = OUT_W512S + 8192;
constexpr size_t OUT_TOTAL = OUT_W2048S + 8192;

constexpr int LDS_BYTES = 147456;
constexpr int LDS_TAB = 131072;

__device__ __forceinline__ unsigned cvt_pk_bf16(float lo, float hi) { unsigned r; asm volatile("v_cvt_pk_bf16_f32 %0, %1, %2" : "=v"(r) : "v"(lo), "v"(hi)); return r; }
__device__ __forceinline__ float bf_lo(unsigned w) { return __uint_as_float(w << 16); }
__device__ __forceinline__ float bf_hi(unsigned w) { return __uint_as_float(w & 0xffff0000u); }
__device__ __forceinline__ float wave_sum(float v) {
#pragma unroll
    for (int o = 1; o < 64; o <<= 1) v += __shfl_xor(v, o);
    return v;
}
__device__ __forceinline__ float wave_max(float v) {
#pragma unroll
    for (int o = 1; o < 64; o <<= 1) v = fmaxf(v, __shfl_xor(v, o));
    return v;
}
__device__ __forceinline__ float gelu_tanh(float x) {
    const float t = x * x;
    const float u2 = x * (1.5957691216057308f + 0.07135481627260024f * t);
    const float e = __builtin_amdgcn_exp2f(-LOG2E * u2);
    return x * __builtin_amdgcn_rcpf(1.0f + e);
}
__device__ __forceinline__ float silu_f(float x) {
    const float e = __builtin_amdgcn_exp2f(-LOG2E * x);
    return x * __builtin_amdgcn_rcpf(1.0f + e);
}
__device__ __forceinline__ int t5_bucket(int d) {
    if (d < 16) return d;
    int b = 16;
    b += (d >= 22); b += (d >= 30); b += (d >= 40); b += (d >= 54); b += (d >= 73); b += (d >= 99); b += (d >= 134); b += (d >= 182);
    b += (d >= 246); b += (d >= 332); b += (d >= 450); b += (d >= 609); b += (d >= 825); b += (d >= 1117); b += (d >= 1513);
    return b;
}
__device__ __forceinline__ unsigned off_b(unsigned row, unsigned ch) { return 256u * row + 16u * (ch ^ (((row & 3) << 2) | ((row >> 2) & 3))); }
__device__ __forceinline__ unsigned tr16_addr(unsigned lane, unsigned c, unsigned ks, unsigned t) {
    const unsigned g = lane >> 4, q = (lane & 15) >> 2, p = lane & 3;
    return off_b(32 * ks + 8 * g + 4 * t + q, 2 * c + (p >> 1)) + 8 * (p & 1);
}
typedef short v4i16_t __attribute__((ext_vector_type(4)));
__device__ __forceinline__ s16x4 tr_read(LAS unsigned char* p) { return __builtin_bit_cast(s16x4, __builtin_amdgcn_ds_read_tr16_b64_v4i16((LAS v4i16_t*)p)); }

namespace pg8 {
constexpr int BM = 256, BK = 64, HALF = 128, HTB = HALF * BK * 2, STAGE_BYTES = 8 * HTB, NXCD = 8, WGM = 8;
__host__ __device__ __forceinline__ int lds_byte(int r, int c) { const int st = (r >> 4) * 2 + (c >> 5), rr = r & 15, cc = c & 31, ob = rr * 64 + cc * 2; return st * 1024 + (ob ^ (((ob >> 9) & 1) << 5)); }
__host__ __device__ __forceinline__ void stage_rc(int b, int& R, int& C) { const int st = b / 1024, sb = b % 1024, swz = sb ^ (((sb >> 9) & 1) << 5); R = (st >> 1) * 16 + swz / 64; C = (st & 1) * 32 + (swz % 64) / 2; }
__host__ __device__ __forceinline__ int perm32(int rho) { const int n = rho >> 4, i = rho & 15; return 8 * (i >> 2) + 4 * n + (i & 3); }

struct Unit { int pm, pn; };
struct Gemm { const bf16_t* A; const bf16_t* Bt; int M, N, K; };

struct StaticOrder {
    int nM, nN, nwg, G, c;
    __host__ __device__ void init(int M, int N, int G_, int c_) { nM = M / BM; nN = N / BM; nwg = nM * nN; G = G_; c = c_; }
    __host__ __device__ bool next(int i, Unit& u) const {
        const long L = (long)i * G + c; if (L >= nwg) return false;
        int wgid = (int)L; { const int q = nwg / NXCD, r = nwg % NXCD, xcd = wgid % NXCD, off = wgid / NXCD; wgid = (xcd < r ? xcd * (q + 1) : r * (q + 1) + (xcd - r) * q) + off; }
        const int nig = WGM * nN, gid = wgid / nig, fm = gid * WGM, gsz = (nM - fm) < WGM ? (nM - fm) : WGM;
        u.pm = fm + ((wgid % nig) % gsz); u.pn = (wgid % nig) / gsz; return true;
    }
};

template <class Epi, bool ALIGN_EPI, bool SP2>
__device__ __forceinline__ void gemm_phase(LAS unsigned char* lds, const Gemm g, const StaticOrder& S, const Epi& E) {
    int tid = threadIdx.x; asm volatile("" : "+v"(tid));
    const int wid = __builtin_amdgcn_readfirstlane(tid >> 6), lane = tid & 63, wr = wid >> 2, wc = wid & 3, fr = lane & 15, fq = lane >> 4;
    const int K = g.K, nt = K / BK;
    unsigned voffA[2], voffB[2];
#pragma unroll
    for (int i = 0; i < 2; ++i) { int R, C; stage_rc(tid * 16 + i * 8192, R, C); const int Rb = (R & ~31) + perm32(R & 31);
        voffA[i] = (unsigned)(R * K + C) * 2u; voffB[i] = (unsigned)(Rb * K + C) * 2u; }
    const size_t kstep = (size_t)(BK * 2);
    const size_t hstep = (size_t)HALF * K * 2;
    const size_t tstep = 2 * hstep;
    const unsigned ldsw = (unsigned)wid * 1024u;
    const int aoff = lds_byte(wr * 64 + fr, fq * 8), boff = lds_byte(wc * 32 + fr, fq * 8);
#define PG8_SA(b, h) (((b) * 2 + (h)) * HTB)
#define PG8_SB(b, h) ((4 + (b) * 2 + (h)) * HTB)
#define PG8_STAGE(bufoff, gbase, voff) do { _Pragma("unroll") for (int _i = 0; _i < 2; ++_i) \
        __builtin_amdgcn_global_load_lds((const unsigned*)((const char*)(gbase) + (voff)[_i]), (LAS unsigned*)(lds + (bufoff) + ldsw + _i * 8192), 16, 0, 0); } while (0)
#define PG8_LDA(dst, b, h) do { _Pragma("unroll") for (int m = 0; m < 4; ++m) _Pragma("unroll") for (int k = 0; k < 2; ++k) dst[m][k] = *(const LAS bf16x8*)(lds + PG8_SA(b, h) + aoff + m * 2048 + k * 1024); } while (0)
#define PG8_LDB(dst, b, h) do { _Pragma("unroll") for (int n = 0; n < 2; ++n) _Pragma("unroll") for (int k = 0; k < 2; ++k) dst[n][k] = *(const LAS bf16x8*)(lds + PG8_SB(b, h) + boff + n * 2048 + k * 1024); } while (0)
#define PG8_MMA(ai, bj, At, Bt) do { __builtin_amdgcn_s_setprio(1); _Pragma("unroll") for (int m = 0; m < 4; ++m) _Pragma("unroll") for (int n = 0; n < 2; ++n) _Pragma("unroll") for (int k = 0; k < 2; ++k) \
        acc[ai][bj][m][n] = __builtin_amdgcn_mfma_f32_16x16x32_bf16(Bt[n][k], At[m][k], acc[ai][bj][m][n], 0, 0, 0); __builtin_amdgcn_s_setprio(0); } while (0)
#define PG8_WAIT_V(n) asm volatile("s_waitcnt vmcnt(" #n ")" ::: "memory")
#define PG8_WAIT_L(n) asm volatile("s_waitcnt lgkmcnt(" #n ")" ::: "memory")
#define PG8_BAR __builtin_amdgcn_s_barrier()
#define PG8_SCHED __builtin_amdgcn_sched_barrier(0)
    Unit cur, nxt; int ui = 0;
    if (!S.next(0, cur)) return;
    f32x4 acc[2][2][4][2];
#pragma unroll
    for (int a = 0; a < 2; ++a)
#pragma unroll
        for (int b = 0; b < 2; ++b)
#pragma unroll
            for (int m = 0; m < 4; ++m)
#pragma unroll
                for (int n = 0; n < 2; ++n) acc[a][b][m][n] = (f32x4){0.f, 0.f, 0.f, 0.f};
    bf16x8 At[4][2], B0[2][2], B1[2][2];
    const char* cA = (const char*)g.A + (size_t)cur.pm * tstep; const char* cB = (const char*)g.Bt + (size_t)cur.pn * tstep;
    if constexpr (SP2) {
        PG8_STAGE(PG8_SB(0, 0), cB, voffB); PG8_STAGE(PG8_SB(0, 1), cB + hstep, voffB); PG8_STAGE(PG8_SA(0, 0), cA, voffA); PG8_STAGE(PG8_SA(0, 1), cA + hstep, voffA);
        if (wr == 1) PG8_BAR;
        PG8_WAIT_V(2); PG8_BAR;
        PG8_STAGE(PG8_SB(1, 0), cB + kstep, voffB); PG8_STAGE(PG8_SA(1, 0), cA + kstep, voffA); PG8_STAGE(PG8_SB(1, 1), cB + hstep + kstep, voffB);
        PG8_WAIT_V(6); PG8_BAR;
    } else {
        PG8_STAGE(PG8_SB(0, 0), cB, voffB); PG8_STAGE(PG8_SA(0, 0), cA, voffA); PG8_STAGE(PG8_SB(0, 1), cB + hstep, voffB); PG8_STAGE(PG8_SA(0, 1), cA + hstep, voffA);
        if (wr == 1) PG8_BAR;
        PG8_WAIT_V(4); PG8_BAR;
        PG8_STAGE(PG8_SB(1, 0), cB + kstep, voffB); PG8_STAGE(PG8_SA(1, 0), cA + kstep, voffA); PG8_STAGE(PG8_SB(1, 1), cB + hstep + kstep, voffB);
        PG8_WAIT_V(6); PG8_BAR;
    }
    for (;;) {
        const typename Epi::Pre pre = E.prefetch(cur, wr, fr);
        const bool has_next = S.next(ui + 1, nxt);
        const char* nA = has_next ? (const char*)g.A + (size_t)nxt.pm * tstep : cA; const char* nB = has_next ? (const char*)g.Bt + (size_t)nxt.pn * tstep : cB;
        for (int t = 0; t < nt; t += 2) {
            const bool last = (t == nt - 2);
            const char* a1 = cA + (size_t)(t + 1) * kstep;
            const char* a2 = last ? nA : cA + (size_t)(t + 2) * kstep; const char* b2 = last ? nB : cB + (size_t)(t + 2) * kstep;
            const char* a3 = a2 + kstep; const char* b3 = b2 + kstep;
            if constexpr (SP2) {
            PG8_LDB(B0, 0, 0); PG8_LDB(B1, 0, 1); PG8_SCHED; PG8_LDA(At, 0, 0); PG8_STAGE(PG8_SA(1, 1), a1 + hstep, voffA);
            PG8_WAIT_V(8); PG8_WAIT_L(0); PG8_BAR; PG8_MMA(0, 0, At, B0); PG8_MMA(0, 1, At, B1); PG8_BAR; PG8_SCHED;
            PG8_LDA(At, 0, 1); PG8_STAGE(PG8_SB(0, 0), b2, voffB); PG8_STAGE(PG8_SB(0, 1), b2 + hstep, voffB); PG8_STAGE(PG8_SA(0, 0), a2, voffA);
            PG8_WAIT_V(8); PG8_WAIT_L(0); PG8_BAR; PG8_MMA(1, 0, At, B0); PG8_MMA(1, 1, At, B1); PG8_BAR; PG8_SCHED;
            PG8_LDB(B0, 1, 0); PG8_LDB(B1, 1, 1); PG8_SCHED; PG8_LDA(At, 1, 0); PG8_STAGE(PG8_SA(0, 1), a2 + hstep, voffA);
            PG8_WAIT_V(8); PG8_WAIT_L(0); PG8_BAR; PG8_MMA(0, 0, At, B0); PG8_MMA(0, 1, At, B1); PG8_BAR; PG8_SCHED;
            PG8_LDA(At, 1, 1); PG8_STAGE(PG8_SB(1, 0), b3, voffB); PG8_STAGE(PG8_SB(1, 1), b3 + hstep, voffB); PG8_STAGE(PG8_SA(1, 0), a3, voffA);
            PG8_WAIT_V(8); PG8_WAIT_L(0); PG8_BAR; PG8_MMA(1, 0, At, B0); PG8_MMA(1, 1, At, B1); PG8_BAR; PG8_SCHED;
            } else {
            PG8_LDB(B0, 0, 0); PG8_SCHED; PG8_LDA(At, 0, 0); PG8_STAGE(PG8_SA(1, 1), a1 + hstep, voffA);
            PG8_WAIT_L(8); PG8_BAR; PG8_WAIT_L(0); PG8_MMA(0, 0, At, B0); PG8_BAR; PG8_SCHED;
            PG8_LDB(B1, 0, 1); PG8_STAGE(PG8_SB(0, 0), b2, voffB);
            PG8_BAR; PG8_WAIT_L(0); PG8_MMA(0, 1, At, B1); PG8_BAR;
            PG8_LDA(At, 0, 1); PG8_STAGE(PG8_SA(0, 0), a2, voffA);
            PG8_BAR; PG8_WAIT_L(0); PG8_MMA(1, 0, At, B0); PG8_BAR; PG8_SCHED;
            PG8_STAGE(PG8_SB(0, 1), b2 + hstep, voffB);
            PG8_WAIT_V(6); PG8_BAR; PG8_MMA(1, 1, At, B1); PG8_BAR;
            PG8_LDB(B0, 1, 0); PG8_SCHED; PG8_LDA(At, 1, 0); PG8_STAGE(PG8_SA(0, 1), a2 + hstep, voffA);
            PG8_WAIT_L(8); PG8_BAR; PG8_WAIT_L(0); PG8_MMA(0, 0, At, B0); PG8_BAR; PG8_SCHED;
            PG8_LDB(B1, 1, 1); PG8_STAGE(PG8_SB(1, 0), b3, voffB);
            PG8_BAR; PG8_WAIT_L(0); PG8_MMA(0, 1, At, B1); PG8_BAR;
            PG8_LDA(At, 1, 1); PG8_STAGE(PG8_SA(1, 0), a3, voffA);
            PG8_BAR; PG8_WAIT_L(0); PG8_MMA(1, 0, At, B0); PG8_BAR; PG8_SCHED;
            PG8_STAGE(PG8_SB(1, 1), b3 + hstep, voffB);
            PG8_WAIT_V(6); PG8_BAR; PG8_MMA(1, 1, At, B1); PG8_BAR;
            }
        }
        if constexpr (ALIGN_EPI) { if (wr == 0) PG8_BAR; }
        E(acc, cur, wr, wc, fr, fq, pre);
        if (!has_next) break;
#pragma unroll
        for (int a = 0; a < 2; ++a)
#pragma unroll
            for (int b = 0; b < 2; ++b)
#pragma unroll
                for (int m = 0; m < 4; ++m)
#pragma unroll
                    for (int n = 0; n < 2; ++n) acc[a][b][m][n] = (f32x4){0.f, 0.f, 0.f, 0.f};
        cur = nxt; cA = nA; cB = nB; ++ui;
        if constexpr (ALIGN_EPI) { if (wr == 1) PG8_BAR; }
    }
    PG8_WAIT_V(0);
    if constexpr (!ALIGN_EPI) { if (wr == 0) PG8_BAR; }
    PG8_BAR;
#undef PG8_SA
#undef PG8_SB
#undef PG8_STAGE
#undef PG8_LDA
#undef PG8_LDB
#undef PG8_MMA
#undef PG8_WAIT_V
#undef PG8_WAIT_L
#undef PG8_BAR
#undef PG8_SCHED
}

typedef f32x4 Acc[2][2][4][2];
struct PreRs { float r[2][4]; };
struct PreNone { };
__device__ __forceinline__ PreRs load_rs(const float* rs, const Unit& u, int wr, int fr) { PreRs p; const int row0 = u.pm * BM + wr * 64 + fr;
#pragma unroll
    for (int ai = 0; ai < 2; ++ai)
#pragma unroll
        for (int m = 0; m < 4; ++m) p.r[ai][m] = rs[row0 + ai * HALF + m * 16];
    return p; }
__device__ __forceinline__ u32x4 pack8(const f32x4 a, const f32x4 b) { u32x4 w; w.x = cvt_pk_bf16(a[0], a[1]); w.y = cvt_pk_bf16(a[2], a[3]); w.z = cvt_pk_bf16(b[0], b[1]); w.w = cvt_pk_bf16(b[2], b[3]); return w; }

struct EpiInA {
    bf16_t* Z; float* VSS; const float* rs;
    typedef PreRs Pre; __device__ __forceinline__ Pre prefetch(const Unit& u, int wr, int fr) const { return load_rs(rs, u, wr, fr); }
    __device__ __forceinline__ void operator()(const Acc& acc, const Unit& u, int wr, int wc, int fr, int fq, const Pre& pre) const {
        const int row0 = u.pm * BM + wr * 64 + fr, col0 = u.pn * BM + wc * 32 + 8 * fq;
        const bool act = u.pn < 12, isv = (u.pn >= 6) && act;
#pragma unroll
        for (int ai = 0; ai < 2; ++ai)
#pragma unroll
            for (int m = 0; m < 4; ++m) {
                const int row = row0 + ai * HALF + m * 16; bf16_t* rowp = Z + (size_t)row * ZP + col0; float ss = 0.f; const float rsr = pre.r[ai][m];
#pragma unroll
                for (int bj = 0; bj < 2; ++bj) { f32x4 v0 = acc[ai][bj][m][0] * rsr, v1 = acc[ai][bj][m][1] * rsr;
                    if (act) {
#pragma unroll
                        for (int e = 0; e < 4; ++e) { v0[e] = gelu_tanh(v0[e]); v1[e] = gelu_tanh(v1[e]); ss += v0[e] * v0[e] + v1[e] * v1[e]; }
                    } else { v0 = v0 * QSCALE; v1 = v1 * QSCALE; }
                    *(u32x4*)(rowp + bj * HALF) = pack8(v0, v1); }
                if (isv) { ss += __shfl_xor(ss, 16); ss += __shfl_xor(ss, 32); if (fq == 0) VSS[(size_t)row * 24 + (u.pn - 6) * 4 + wc] = ss; }
            }
    }
};
struct EpiMkv {
    float* outf; bf16_t* outb; const float* rs;
    typedef PreRs Pre; __device__ __forceinline__ Pre prefetch(const Unit& u, int wr, int fr) const { return load_rs(rs, u, wr, fr); }
    __device__ __forceinline__ void operator()(const Acc& acc, const Unit& u, int wr, int wc, int fr, int fq, const Pre& pre) const {
        const int row0 = u.pm * BM + wr * 64 + fr, col0 = u.pn * BM + wc * 32 + 8 * fq;
#pragma unroll
        for (int ai = 0; ai < 2; ++ai)
#pragma unroll
            for (int m = 0; m < 4; ++m) { const size_t off = (size_t)(row0 + ai * HALF + m * 16) * NKV + col0; const float rsr = pre.r[ai][m];
#pragma unroll
                for (int bj = 0; bj < 2; ++bj) { const f32x4 v0 = acc[ai][bj][m][0] * rsr, v1 = acc[ai][bj][m][1] * rsr;
                    *(f32x4*)(outf + off + bj * HALF) = v0; *(f32x4*)(outf + off + bj * HALF + 4) = v1; *(u32x4*)(outb + off + bj * HALF) = pack8(v0, v1); } }
    }
};
struct EpiPlain {
    bf16_t* O; int ldc;
    typedef PreNone Pre; __device__ __forceinline__ Pre prefetch(const Unit&, int, int) const { return Pre{}; }
    __device__ __forceinline__ void operator()(const Acc& acc, const Unit& u, int wr, int wc, int fr, int fq, const Pre&) const {
        const int row0 = u.pm * BM + wr * 64 + fr, col0 = u.pn * BM + wc * 32 + 8 * fq;
#pragma unroll
        for (int ai = 0; ai < 2; ++ai)
#pragma unroll
            for (int m = 0; m < 4; ++m) { bf16_t* rowp = O + (size_t)(row0 + ai * HALF + m * 16) * ldc + col0;
#pragma unroll
                for (int bj = 0; bj < 2; ++bj) *(u32x4*)(rowp + bj * HALF) = pack8(acc[ai][bj][m][0], acc[ai][bj][m][1]); }
    }
};
struct EpiSwiglu {
    bf16_t* ACT; const float* rs;
    typedef PreRs Pre; __device__ __forceinline__ Pre prefetch(const Unit& u, int wr, int fr) const { return load_rs(rs, u, wr, fr); }
    __device__ __forceinline__ void operator()(const Acc& acc, const Unit& u, int wr, int wc, int fr, int fq, const Pre& pre) const {
        const int row0 = u.pm * BM + wr * 64 + fr, col0 = u.pn * HALF + wc * 32 + 8 * fq;
#pragma unroll
        for (int ai = 0; ai < 2; ++ai)
#pragma unroll
            for (int m = 0; m < 4; ++m) { f32x4 v0, v1; const float rsr = pre.r[ai][m];
#pragma unroll
                for (int e = 0; e < 4; ++e) { v0[e] = silu_f(acc[ai][0][m][0][e] * rsr) * (acc[ai][1][m][0][e] * rsr); v1[e] = silu_f(acc[ai][0][m][1][e] * rsr) * (acc[ai][1][m][1][e] * rsr); }
                *(u32x4*)(ACT + (size_t)(row0 + ai * HALF + m * 16) * DFF + col0) = pack8(v0, v1); }
    }
};
struct EpiInB {
    bf16_t* Z; const float* rs;
    typedef PreRs Pre; __device__ __forceinline__ Pre prefetch(const Unit& u, int wr, int fr) const { return load_rs(rs, u, wr, fr); }
    __device__ __forceinline__ void operator()(const Acc& acc, const Unit& u, int wr, int wc, int fr, int fq, const Pre& pre) const {
        const int row0 = u.pm * BM + wr * 64 + fr, col0 = u.pn * BM + wc * 32 + 8 * fq;
        const float qs = ((u.pn < 6) || (u.pn >= 18)) ? QSCALE : 1.0f;
#pragma unroll
        for (int ai = 0; ai < 2; ++ai)
#pragma unroll
            for (int m = 0; m < 4; ++m) {
                const int row = row0 + ai * HALF + m * 16; bf16_t* rowp = Z + (size_t)row * ZP + col0; const float rsr = pre.r[ai][m] * qs;
#pragma unroll
                for (int bj = 0; bj < 2; ++bj) *(u32x4*)(rowp + bj * HALF) = pack8(acc[ai][bj][m][0] * rsr, acc[ai][bj][m][1] * rsr);
            }
    }
};
}

__device__ __forceinline__ unsigned f2bf(float f) { unsigned u = __builtin_bit_cast(unsigned, f); return (u + 0x7fffu + ((u >> 16) & 1u)) >> 16; }
__device__ __forceinline__ unsigned pk2(float lo, float hi) { return f2bf(lo) | (f2bf(hi) << 16); }
struct TItem { const float* src; bf16_t* dst; const float* gain; int N, K; };
__device__ __forceinline__ TItem t_make(const float* W, int K, int N, bf16_t* WT, bool upperm, const float* gain, int item) {
    const int nblk = N / 64, kb = item / nblk, nb = item % nblk, k0 = 64 * kb, n0 = 64 * nb;
    int s0 = n0;
    if (upperm) { const int pn = n0 >> 8, j = n0 & 255; s0 = (j < 128) ? (128 * pn + j) : (DFF + 128 * pn + (j - 128)); }
    TItem t; t.src = W + (size_t)k0 * N + s0; t.dst = WT + (size_t)n0 * K + k0; t.gain = gain != nullptr ? gain + k0 : nullptr; t.N = N; t.K = K; return t;
}
__device__ __forceinline__ void t_load(const TItem& t, int lane, f32x4 (&v)[16]) {
    const float* src = t.src + (size_t)(lane >> 4) * t.N + 4 * (lane & 15);
#pragma unroll
    for (int i = 0; i < 16; ++i) v[i] = __builtin_nontemporal_load((const f32x4*)(src + (size_t)(4 * i) * t.N));
}
__device__ __forceinline__ void t_store(const TItem& t, LAS float* scr, int lane, const f32x4 (&v)[16]) {
    const int lr = lane >> 4, lc = lane & 15;
#pragma unroll
    for (int i = 0; i < 16; ++i) { const int k = 4 * i + lr; const float gk = t.gain != nullptr ? t.gain[k] : 1.0f;
        *(LAS f32x4*)(scr + k * 64 + ((4 * lc) ^ (4 * (k >> 3)))) = v[i] * gk; }
    asm volatile("s_waitcnt lgkmcnt(0)" ::: "memory");
    const int c = lane & 7;
#pragma unroll
    for (int j = 0; j < 8; ++j) { const int n = (lane >> 3) + 8 * j; const LAS float* sp = scr + (8 * c) * 64 + (n ^ (4 * c));
        u32x4 o; o.x = cvt_pk_bf16(sp[0 * 64], sp[1 * 64]); o.y = cvt_pk_bf16(sp[2 * 64], sp[3 * 64]); o.z = cvt_pk_bf16(sp[4 * 64], sp[5 * 64]); o.w = cvt_pk_bf16(sp[6 * 64], sp[7 * 64]);
        __builtin_nontemporal_store(o, (u32x4*)(t.dst + (size_t)n * t.K + 8 * c)); }
    asm volatile("s_waitcnt lgkmcnt(0)" ::: "memory");
}
template <int MODE>
__device__ __forceinline__ void norm_row(const float* basef, bf16_t* yb, const bf16_t* o, const float* gpost, float* rs_out, float* yout, int lane) {
    f32x4 y[8];
    if (MODE == 0 || MODE == 1) {
#pragma unroll
        for (int j = 0; j < 8; ++j) y[j] = *(const f32x4*)(basef + 4 * (lane + 64 * j));
    } else {
#pragma unroll
        for (int j = 0; j < 8; ++j) { const u32x2 w = *(const u32x2*)(yb + 4 * (lane + 64 * j)); y[j] = (f32x4){bf_lo(w.x), bf_hi(w.x), bf_lo(w.y), bf_hi(w.y)}; }
    }
    if (MODE != 0) {
        f32x4 ov[8]; float ss = 0.f;
#pragma unroll
        for (int j = 0; j < 8; ++j) { const u32x2 w = *(const u32x2*)(o + 4 * (lane + 64 * j)); ov[j] = (f32x4){bf_lo(w.x), bf_hi(w.x), bf_lo(w.y), bf_hi(w.y)};
            ss += (ov[j][0] * ov[j][0] + ov[j][1] * ov[j][1]) + (ov[j][2] * ov[j][2] + ov[j][3] * ov[j][3]); }
        const float rstd = 1.0f / sqrtf(wave_sum(ss) * (1.0f / DM) + EPS);
#pragma unroll
        for (int j = 0; j < 8; ++j) { const f32x4 g = *(const f32x4*)(gpost + 4 * (lane + 64 * j)); y[j] = y[j] + ov[j] * rstd * g; }
    }
    if (MODE == 3) {
#pragma unroll
        for (int j = 0; j < 8; ++j) *(f32x4*)(yout + 4 * (lane + 64 * j)) = y[j];
    } else {
        float ss = 0.f;
#pragma unroll
        for (int j = 0; j < 8; ++j) { ss += (y[j][0] * y[j][0] + y[j][1] * y[j][1]) + (y[j][2] * y[j][2] + y[j][3] * y[j][3]);
            u32x2 w; w.x = cvt_pk_bf16(y[j][0], y[j][1]); w.y = cvt_pk_bf16(y[j][2], y[j][3]); *(u32x2*)(yb + 4 * (lane + 64 * j)) = w; }
        ss = wave_sum(ss);
        if (lane == 0) *rs_out = 1.0f / sqrtf(ss * (1.0f / DM) + EPS);
    }
}

struct NormRaw { u32x2 yb[8]; u32x2 ob[8]; };
__device__ __forceinline__ void norm_load(const bf16_t* yb, const bf16_t* o, int lane, NormRaw& R) {
#pragma unroll
    for (int j = 0; j < 8; ++j) { R.yb[j] = *(const u32x2*)(yb + 4 * (lane + 64 * j)); R.ob[j] = *(const u32x2*)(o + 4 * (lane + 64 * j)); }
}
template <bool FINAL>
__device__ __forceinline__ void norm_finish(const NormRaw& R, bf16_t* yb, const float* gpost, float* rs_out, float* yout, int lane) {
    f32x4 y[8], ov[8]; float ss = 0.f;
#pragma unroll
    for (int j = 0; j < 8; ++j) { y[j] = (f32x4){bf_lo(R.yb[j].x), bf_hi(R.yb[j].x), bf_lo(R.yb[j].y), bf_hi(R.yb[j].y)}; ov[j] = (f32x4){bf_lo(R.ob[j].x), bf_hi(R.ob[j].x), bf_lo(R.ob[j].y), bf_hi(R.ob[j].y)};
        ss += (ov[j][0] * ov[j][0] + ov[j][1] * ov[j][1]) + (ov[j][2] * ov[j][2] + ov[j][3] * ov[j][3]); }
    const float rstd = 1.0f / sqrtf(wave_sum(ss) * (1.0f / DM) + EPS);
#pragma unroll
    for (int j = 0; j < 8; ++j) { const f32x4 g = *(const f32x4*)(gpost + 4 * (lane + 64 * j)); y[j] = y[j] + ov[j] * rstd * g; }
    if (FINAL) {
#pragma unroll
        for (int j = 0; j < 8; ++j) *(f32x4*)(yout + 4 * (lane + 64 * j)) = y[j];
    } else {
        float s2 = 0.f;
#pragma unroll
        for (int j = 0; j < 8; ++j) { s2 += (y[j][0] * y[j][0] + y[j][1] * y[j][1]) + (y[j][2] * y[j][2] + y[j][3] * y[j][3]);
            u32x2 w; w.x = cvt_pk_bf16(y[j][0], y[j][1]); w.y = cvt_pk_bf16(y[j][2], y[j][3]); *(u32x2*)(yb + 4 * (lane + 64 * j)) = w; }
        s2 = wave_sum(s2);
        if (lane == 0) *rs_out = 1.0f / sqrtf(s2 * (1.0f / DM) + EPS);
    }
}

struct KvDesc { const bf16_t* kbase; const bf16_t* vbase; long row0, rstep, pitch; int key_lo; };
__device__ __forceinline__ void kv_issue(const KvDesc& d, int tid, u32x4 (&kk)[8], u32x4 (&vv)[8]) {
    const int srow = tid >> 4, sch = tid & 15;
#pragma unroll
    for (int i = 0; i < 8; ++i) { const int row = srow + 32 * i, rowc = row < d.key_lo ? d.key_lo : row;
        const size_t e = (size_t)(d.row0 + (long)rowc * d.rstep) * d.pitch + sch * 8; kk[i] = *(const u32x4*)(d.kbase + e); vv[i] = *(const u32x4*)(d.vbase + e); }
}
__device__ __forceinline__ void kv_commit(LAS unsigned char* lds, int tid, int key_lo, const u32x4 (&kk)[8], const u32x4 (&vv)[8]) {
    const unsigned sb = off_b(tid >> 4, tid & 15); const int srow = tid >> 4; const u32x4 z = (u32x4){0u, 0u, 0u, 0u};
#pragma unroll
    for (int i = 0; i < 8; ++i) { const bool ok = (srow + 32 * i) >= key_lo; *(LAS u32x4*)(lds + sb + 8192 * i) = ok ? kk[i] : z; *(LAS u32x4*)(lds + 65536 + sb + 8192 * i) = ok ? vv[i] : z; }
}
template <bool BANDED>
__device__ __forceinline__ void attn_compute(LAS unsigned char* lds, int lane, int w, const bf16x8 (&qf)[4], int key_lo, bf16_t* orow, float* lsep, const LAS float* btab) {
    const int fr = lane & 15, fq = lane >> 4;
    LAS unsigned char* Kimg = lds; LAS unsigned char* Vimg = lds + 65536;
    constexpr int NBLK = BANDED ? 5 : 8;
    const int blk0 = BANDED ? (w >> 1) : 0;
    const int qi = 16 * w + fr;
    unsigned kb[2][4];
#pragma unroll
    for (int e = 0; e < 2; ++e)
#pragma unroll
        for (int kk = 0; kk < 4; ++kk) kb[e][kk] = off_b(8 * (fr >> 2) + 4 * e + (fr & 3), 4 * kk + fq);
    LAS unsigned char* Kb = Kimg + 8192 * blk0; LAS unsigned char* Vb = Vimg + 8192 * blk0;
    f32x4 s[2 * NBLK];
#pragma unroll
    for (int nt = 0; nt < 2 * NBLK; ++nt) s[nt] = (f32x4){0.f, 0.f, 0.f, 0.f};
    constexpr int TB = BANDED ? 2 * NBLK : NBLK;
#pragma unroll
    for (int t0 = 0; t0 < 2 * NBLK; t0 += TB)
#pragma unroll
        for (int kk = 0; kk < 4; ++kk) { bf16x8 kf[TB];
#pragma unroll
            for (int i = 0; i < TB; ++i) { const int nt = t0 + i; kf[i] = *(const LAS bf16x8*)(Kb + kb[nt & 1][kk] + 8192 * (nt >> 1)); }
            __builtin_amdgcn_sched_barrier(0);
#pragma unroll
            for (int i = 0; i < TB; ++i) s[t0 + i] = __builtin_amdgcn_mfma_f32_16x16x32_bf16(kf[i], qf[kk], s[t0 + i], 0, 0, 0);
            __builtin_amdgcn_sched_barrier(0); }
    float mx = -1e30f;
    const LAS float* bp = btab + (128 + 16 * (w & 1) + fr - 8 * fq + 32 - 135);
    const int cmin = BANDED ? (key_lo > 0 ? (128 + 16 * (w & 1) + fr - 8 * fq) - qi : -1000) : 0;
#pragma unroll
    for (int nt = 0; nt < 2 * NBLK; ++nt)
#pragma unroll
        for (int r = 0; r < 4; ++r) { float x = s[nt][r];
            if (BANDED) { const int c = 32 * (nt >> 1) + 4 * (nt & 1) + r; x = x + bp[135 - c]; x = (c >= cmin) ? x : -1e30f; s[nt][r] = x; }
            mx = fmaxf(mx, x); }
    mx = fmaxf(mx, __shfl_xor(mx, 16)); mx = fmaxf(mx, __shfl_xor(mx, 32));
    float l = 0.f;
#pragma unroll
    for (int nt = 0; nt < 2 * NBLK; ++nt)
#pragma unroll
        for (int r = 0; r < 4; ++r) { const float p = __builtin_amdgcn_exp2f(s[nt][r] - mx); s[nt][r] = p; l += p; }
    l += __shfl_xor(l, 16); l += __shfl_xor(l, 32);
    bf16x8 pf[NBLK];
#pragma unroll
    for (int ks = 0; ks < NBLK; ++ks) pf[ks] = __builtin_bit_cast(bf16x8, pg8::pack8(s[2 * ks], s[2 * ks + 1]));
    const float inv_l = 1.0f / l;
    unsigned vb[8][2];
#pragma unroll
    for (int ct = 0; ct < 8; ++ct) { vb[ct][0] = tr16_addr(lane, ct, 0, 0); vb[ct][1] = tr16_addr(lane, ct, 0, 1); }
    f32x4 oa[8];
#pragma unroll
    for (int ct = 0; ct < 8; ++ct) oa[ct] = (f32x4){0.f, 0.f, 0.f, 0.f};
#pragma unroll
    for (int ks = 0; ks < NBLK; ++ks) { s16x4 vlo[8], vhi[8];
#pragma unroll
        for (int ct = 0; ct < 8; ++ct) { vlo[ct] = tr_read(Vb + vb[ct][0] + 8192 * ks); vhi[ct] = tr_read(Vb + vb[ct][1] + 8192 * ks); }
        __builtin_amdgcn_sched_barrier(0);
#pragma unroll
        for (int ct = 0; ct < 8; ++ct) { const bf16x8 vf = (bf16x8){vlo[ct][0], vlo[ct][1], vlo[ct][2], vlo[ct][3], vhi[ct][0], vhi[ct][1], vhi[ct][2], vhi[ct][3]};
            oa[ct] = __builtin_amdgcn_mfma_f32_16x16x32_bf16(vf, pf[ks], oa[ct], 0, 0, 0); }
        __builtin_amdgcn_sched_barrier(0); }
#pragma unroll
    for (int ct = 0; ct < 8; ++ct) { u32x2 wv; wv.x = cvt_pk_bf16(oa[ct][0] * inv_l, oa[ct][1] * inv_l); wv.y = cvt_pk_bf16(oa[ct][2] * inv_l, oa[ct][3] * inv_l);
        *(u32x2*)(orow + 16 * ct) = wv; }
    if (lsep != nullptr && fq == 0) *lsep = (mx + __builtin_amdgcn_logf(l)) * LN2;
}
struct QoDesc { const bf16_t* qbase; long row0, rstep; bf16_t* obase; float* lsebase; int banded, dil, head; };

struct GateRegs { u32x4 v[2][6]; f32x4 wq[8]; f32x4 vs[3]; float gvl; };
__device__ __forceinline__ void gate_issue(int tid, int b, int chunk, int g, const bf16_t* Z, const float* VSS, const float* w_s, const float* g_v, GateRegs& R) {
    const int lane = tid & 63, w = __builtin_amdgcn_readfirstlane(tid >> 6), fr = lane & 15, fq = lane >> 4;
    const int tok0 = b * SEQ + chunk * 128;
    {
        const int r0 = tid >> 3, c0 = tid & 7; const bf16_t* gp = Z + (size_t)(tok0 + r0) * ZP + MIXW + g * 384 + c0 * 8;
#pragma unroll
        for (int i2 = 0; i2 < 2; ++i2)
#pragma unroll
            for (int i = 0; i < 6; ++i) R.v[i2][i] = *(const u32x4*)(gp + (size_t)i2 * 64 * ZP + 64 * i); }
    { const float* wp = w_s + (size_t)g * 16384 + (16 * w + fr) * 128 + 8 * fq;
#pragma unroll
      for (int kk = 0; kk < 4; ++kk) { R.wq[2 * kk] = *(const f32x4*)(wp + 32 * kk); R.wq[2 * kk + 1] = *(const f32x4*)(wp + 32 * kk + 4); } }
    { const float* p = VSS + (size_t)(tok0 + (tid & 127)) * 24 + 12 * ((tid >> 7) & 1);
#pragma unroll
      for (int i = 0; i < 3; ++i) R.vs[i] = *(const f32x4*)(p + 4 * i); }
    R.gvl = g_v[g * 384 + (tid < 384 ? tid : tid - 384)];
}
__device__ __forceinline__ void gate_run(LAS unsigned char* lds, int tid, int b, int chunk, int g, const GateRegs& R, const bf16_t* Z, const float* b_s, bf16_t* MIX) {
    const int lane = tid & 63, w = __builtin_amdgcn_readfirstlane(tid >> 6), fr = lane & 15, fq = lane >> 4;
    const int tok0 = b * SEQ + chunk * 128, i = 16 * w + fr;
    LAS float* rs = (LAS float*)(lds + LDS_TAB); LAS float* gvs = rs + 128;
    const size_t tokrow = (size_t)(tok0 + i);
    __syncthreads();
    const bf16_t* up = Z + tokrow * ZP + g * 384 + 4 * fq;
    u32x2 ucur[8];
    const float bs = b_s[g * 128 + i];
    {
        const int r0 = tid >> 3, c0 = tid & 7; const unsigned gsb0 = off_b(r0, c0), gsb1 = off_b(r0, c0 + 8);
#pragma unroll
        for (int i2 = 0; i2 < 2; ++i2)
#pragma unroll
            for (int k = 0; k < 6; ++k) *(LAS u32x4*)(lds + (k >> 1) * 32768 + ((k & 1) ? gsb1 : gsb0) + 16384 * i2) = R.v[i2][k]; }
    { float ssum = 0.f;
#pragma unroll
      for (int k = 0; k < 3; ++k) ssum += (R.vs[k][0] + R.vs[k][1]) + (R.vs[k][2] + R.vs[k][3]);
      if (tid < 256) rs[512 + tid] = ssum;
      if (tid < 384) gvs[tid] = R.gvl; }
    __syncthreads();
    if (tid < 128) rs[tid] = 1.0f / sqrtf((rs[512 + tid] + rs[512 + 128 + tid]) * (1.0f / MIXW) + EPS);
    __syncthreads();
    bf16x8 wf[4];
#pragma unroll
    for (int kk = 0; kk < 4; ++kk) { const int j0 = 32 * kk + 8 * fq;
        const f32x4 r0 = *(const LAS f32x4*)(rs + j0), r1 = *(const LAS f32x4*)(rs + j0 + 4);
        const f32x4 a = R.wq[2 * kk], c = R.wq[2 * kk + 1];
        float v[8] = {a[0] * r0[0], a[1] * r0[1], a[2] * r0[2], a[3] * r0[3], c[0] * r1[0], c[1] * r1[1], c[2] * r1[2], c[3] * r1[3]};
#pragma unroll
        for (int jj = 0; jj < 8; ++jj) v[jj] = (j0 + jj <= i) ? v[jj] : 0.f;
        u32x4 pk; pk.x = cvt_pk_bf16(v[0], v[1]); pk.y = cvt_pk_bf16(v[2], v[3]); pk.z = cvt_pk_bf16(v[4], v[5]); pk.w = cvt_pk_bf16(v[6], v[7]);
        wf[kk] = __builtin_bit_cast(bf16x8, pk); }
    unsigned vb[8][2];
#pragma unroll
    for (int c = 0; c < 8; ++c) { vb[c][0] = tr16_addr(lane, c, 0, 0); vb[c][1] = tr16_addr(lane, c, 0, 1); }
#pragma unroll
    for (int sub = 0; sub < 3; ++sub) { LAS unsigned char* img = lds + sub * 32768;
#pragma unroll
        for (int c = 0; c < 8; ++c) ucur[c] = *(const u32x2*)(up + sub * 128 + 16 * c);
#pragma unroll
        for (int c = 0; c < 8; ++c) { f32x4 a = (f32x4){0.f, 0.f, 0.f, 0.f};
#pragma unroll
            for (int kk = 0; kk < 4; ++kk) if (kk <= (w >> 1)) {
                const s16x4 lo = tr_read(img + vb[c][0] + 8192 * kk), hi = tr_read(img + vb[c][1] + 8192 * kk);
                const bf16x8 vf = (bf16x8){lo[0], lo[1], lo[2], lo[3], hi[0], hi[1], hi[2], hi[3]};
                a = __builtin_amdgcn_mfma_f32_16x16x32_bf16(vf, wf[kk], a, 0, 0, 0); }
            const int col = g * 384 + sub * 128 + 16 * c + 4 * fq;
            const f32x4 gv = *(const LAS f32x4*)(gvs + sub * 128 + 16 * c + 4 * fq);
            const u32x2 uw = ucur[c];
            const float o0 = bf_lo(uw.x) * (a[0] * gv[0] + bs), o1 = bf_hi(uw.x) * (a[1] * gv[1] + bs), o2 = bf_lo(uw.y) * (a[2] * gv[2] + bs), o3 = bf_hi(uw.y) * (a[3] * gv[3] + bs);
            u32x2 ov; ov.x = cvt_pk_bf16(o0, o1); ov.y = cvt_pk_bf16(o2, o3);
            *(u32x2*)(MIX + tokrow * DM + col) = ov; } }
}

template <int MODE, int K>
__device__ __forceinline__ void sample_gemv(LAS unsigned char* lds, const bf16_t* A, int a_pitch, const bf16_t* Wt, int N, int first, int stride,
                                            float* outf, bf16_t* outb, int ldb, float* win, const float* rs, const float* slse = nullptr) {
    int tid = threadIdx.x; asm volatile("" : "+v"(tid));
    const int lane = tid & 63, w = __builtin_amdgcn_readfirstlane(tid >> 6), fr = lane & 15, fq = lane >> 4;
    const int ntiles = (MODE == 2) ? N / 32 : N / 16;
    LAS float* red = (LAS float*)lds;
    constexpr int kw = K / 8;
    LAS float* atab = (LAS float*)(lds + LDS_TAB + 4096);
    if (slse != nullptr) {
        __syncthreads();
        if (tid < 128) { const int srow = tid >> 4, H = tid & 15; float al = 1.0f;
            if (H < 12) { const int hl = H & 3; const float l0 = slse[srow * 12 + hl], l1 = slse[srow * 12 + 4 + hl], l2 = slse[srow * 12 + 8 + hl], mm = fmaxf(l0, fmaxf(l1, l2));
                const float e0 = __expf(l0 - mm), e1 = __expf(l1 - mm), e2 = __expf(l2 - mm); al = (H < 4 ? e0 : (H < 8 ? e1 : e2)) / (e0 + e1 + e2); }
            atab[tid] = al; }
        __syncthreads();
    }
    for (int tile = first; tile < ntiles; tile += stride) {
        const int nrow0 = (MODE == 2) ? 256 * (tile >> 3) + 16 * (tile & 7) : 16 * tile;
        const bf16_t* ap = A + (size_t)(fr & 7) * a_pitch + w * kw + 8 * fq;
        const bf16_t* bp = Wt + (size_t)(nrow0 + fr) * K + w * kw + 8 * fq;
        f32x4 acc = (f32x4){0.f, 0.f, 0.f, 0.f}, acc2 = (f32x4){0.f, 0.f, 0.f, 0.f};
#pragma unroll
        for (int ks = 0; ks < kw / 32; ++ks) { bf16x8 a = *(const bf16x8*)(ap + 32 * ks); const bf16x8 b = *(const bf16x8*)(bp + 32 * ks);
            if (MODE == 1 && slse != nullptr) { const float al = atab[(fr & 7) * 16 + ((w * kw + 32 * ks + 8 * fq) >> 7)]; const u32x4 aw = __builtin_bit_cast(u32x4, a); u32x4 o;
                o.x = cvt_pk_bf16(bf_lo(aw.x) * al, bf_hi(aw.x) * al); o.y = cvt_pk_bf16(bf_lo(aw.y) * al, bf_hi(aw.y) * al);
                o.z = cvt_pk_bf16(bf_lo(aw.z) * al, bf_hi(aw.z) * al); o.w = cvt_pk_bf16(bf_lo(aw.w) * al, bf_hi(aw.w) * al); a = __builtin_bit_cast(bf16x8, o); }
            acc = __builtin_amdgcn_mfma_f32_16x16x32_bf16(b, a, acc, 0, 0, 0);
            if (MODE == 2) { const bf16x8 b2 = *(const bf16x8*)(bp + (size_t)128 * K + 32 * ks); acc2 = __builtin_amdgcn_mfma_f32_16x16x32_bf16(b2, a, acc2, 0, 0, 0); } }
        __syncthreads();
        *(LAS f32x4*)(red + (w * 16 + fr) * 16 + 4 * fq) = acc;
        if (MODE == 2) *(LAS f32x4*)(red + 2048 + (w * 16 + fr) * 16 + 4 * fq) = acc2;
        __syncthreads();
        if (tid < 128) { const int s = tid >> 4, c = tid & 15; float v = 0.f, v2 = 0.f;
#pragma unroll
            for (int ww = 0; ww < 8; ++ww) { v += red[(ww * 16 + s) * 16 + c]; if (MODE == 2) v2 += red[2048 + (ww * 16 + s) * 16 + c]; }
            if (rs != nullptr) { const float rsr = rs[s]; v *= rsr; v2 *= rsr; }
            if (MODE == 0) { const int n = nrow0 + c; outf[(size_t)s * ZP + n] = v;
                if (win != nullptr && n >= 1536 && n < 4608) { const int kv = n >= 3072 ? 1 : 0, cc = n - 1536 - 1536 * kv, grp = cc >> 9;
                    win[(size_t)grp * 8192 + (size_t)(s * 2 + kv) * 512 + (cc & 511)] = v; } }
            else if (MODE == 1) { outb[(size_t)s * ldb + nrow0 + c] = (bf16_t)f2bf(v); }
            else { outb[(size_t)s * ldb + 128 * (tile >> 3) + 16 * (tile & 7) + c] = (bf16_t)f2bf(silu_f(v) * v2); } }
    }
}

template <class KF, class VF>
__device__ __forceinline__ float sample_attend(LAS float* scr, const float* qv, int nkeys, KF kf, VF vf, const LAS float* btab, LAS float* o_out) {
    int tid = threadIdx.x; asm volatile("" : "+v"(tid));
    const int lane = tid & 63, w = __builtin_amdgcn_readfirstlane(tid >> 6);
    LAS float* sc = scr; LAS float* part = scr + 320; LAS float* stat = scr + 320 + 2048;
    {
        const int key = tid >> 1, half = tid & 1; float d = 0.f;
        if (key < nkeys) { const float* kp = kf(key) + 64 * half; const float* qp = qv + 64 * half; f32x4 k4[16];
#pragma unroll
            for (int i = 0; i < 16; ++i) k4[i] = *(const f32x4*)(kp + 4 * i);
#pragma unroll
            for (int i = 0; i < 16; ++i) { const f32x4 q4 = *(const f32x4*)(qp + 4 * i); d += (k4[i][0] * q4[0] + k4[i][1] * q4[1]) + (k4[i][2] * q4[2] + k4[i][3] * q4[3]); } }
        d += __shfl_xor(d, 1);
        if (half == 0 && key < nkeys) sc[key] = d * QSCALE + (btab != nullptr ? btab[key] : 0.f);
    }
    __syncthreads();
    if (w == 0) { float m = -1e30f; for (int j = lane; j < nkeys; j += 64) m = fmaxf(m, sc[j]); m = wave_max(m);
        float l = 0.f; for (int j = lane; j < nkeys; j += 64) { const float p = __builtin_amdgcn_exp2f(sc[j] - m); sc[j] = p; l += p; } l = wave_sum(l);
        if (lane == 0) { stat[0] = m; stat[1] = l; } }
    __syncthreads();
    {
        const int kg = tid >> 5, d4 = 4 * (tid & 31); f32x4 v4[16]; f32x4 a = (f32x4){0.f, 0.f, 0.f, 0.f};
#pragma unroll
        for (int i = 0; i < 16; ++i) { const int j = kg + 16 * i; v4[i] = (f32x4){0.f, 0.f, 0.f, 0.f}; if (j < nkeys) v4[i] = *(const f32x4*)(vf(j) + d4); }
#pragma unroll
        for (int i = 0; i < 16; ++i) { const int j = kg + 16 * i; const float pj = j < nkeys ? sc[j] : 0.f; a = a + v4[i] * pj; }
        *(LAS f32x4*)(part + kg * 128 + d4) = a; }
    __syncthreads();
    const float m = stat[0], l = stat[1];
    if (tid < 128) { float a = 0.f;
#pragma unroll
        for (int g = 0; g < 16; ++g) a += part[g * 128 + tid];
        o_out[tid] = a / l; }
    __syncthreads();
    return (m + __builtin_amdgcn_logf(l)) * LN2;
}

#define XB_TMO      128
#define XB_XCNT(j)  (256  + 64 * (j))
#define XB_XSUB(j)  (1280 + 64 * (j))
#define XB_XGEN(j)  (2304 + 64 * (j))
#define XB_TOP      3328
#define XB_TOPGEN   3392
#define XCD_BAR_WORDS 3456
#define XB_SPIN_CAP (1u << 18)
__device__ __forceinline__ unsigned xb_ld(unsigned* p)              { return __hip_atomic_load(p, __ATOMIC_RELAXED, __HIP_MEMORY_SCOPE_AGENT); }
__device__ __forceinline__ unsigned xb_add(unsigned* p, unsigned v) { return __hip_atomic_fetch_add(p, v, __ATOMIC_RELAXED, __HIP_MEMORY_SCOPE_AGENT); }
__device__ __forceinline__ unsigned xb_xcc_id() { return (unsigned)__builtin_amdgcn_s_getreg((3 << 11) | 20) & 0xFu; }
#define XB_SPIN(cond, bar) do { unsigned _sp = 0; while (cond) { __builtin_amdgcn_s_sleep(1); \
    if ((++_sp & 255u) == 0u) { if (xb_ld(&(bar)[XB_TMO])) break; if (_sp > XB_SPIN_CAP) { atomicAdd(&(bar)[XB_TMO], 1u); break; } } } } while (0)
struct XcdBarrier { unsigned* bar; unsigned x; volatile LAS unsigned* st; };
__device__ __forceinline__ XcdBarrier xcd_barrier_post(unsigned* bar, volatile LAS unsigned* st) {
    XcdBarrier b; b.bar = bar; b.x = xb_xcc_id(); b.st = st;
    if (threadIdx.x == 0) (void)xb_add(&bar[XB_XCNT(b.x)], 1u);
    return b;
}
__device__ __forceinline__ void xcd_barrier_complete(unsigned* bar, unsigned x, unsigned& nloc, unsigned& nx) {
    const unsigned G = gridDim.x * gridDim.y * gridDim.z;
    unsigned sum, cnt, mine, sp = 0u;
    for (;;) {
        sum = 0u; cnt = 0u; mine = 0u;
#pragma unroll
        for (unsigned j = 0; j < 16; ++j) { const unsigned c = xb_ld(&bar[XB_XCNT(j)]); sum += c; cnt += (c > 0u) ? 1u : 0u; mine = (j == x) ? c : mine; }
        if (sum == G) break;
        __builtin_amdgcn_s_sleep(1);
        if ((++sp & 255u) == 0u) { if (xb_ld(&bar[XB_TMO])) break; if (sp > XB_SPIN_CAP) { atomicAdd(&bar[XB_TMO], 1u); break; } }
    }
    nloc = mine > 0u ? mine : 1u; nx = cnt > 0u ? cnt : 1u;
}
__device__ __forceinline__ void xcd_barrier(const XcdBarrier& b) {
    asm volatile("s_waitcnt vmcnt(0)" ::: "memory");
    __syncthreads();
    if (threadIdx.x == 0) {
        unsigned* bar = b.bar;
        __builtin_amdgcn_s_waitcnt(0);
        unsigned nloc = b.st[0], nx = b.st[1];
        if (nloc == 0u) { xcd_barrier_complete(bar, b.x, nloc, nx); b.st[0] = nloc; b.st[1] = nx; }
        const unsigned old = xb_add(&bar[XB_XSUB(b.x)], 1u);
        const unsigned gen = old / nloc;
        if (old + 1u == (gen + 1u) * nloc) {
            __builtin_amdgcn_fence(__ATOMIC_RELEASE, "agent");
            asm volatile("s_waitcnt vmcnt(0)" ::: "memory");
            const unsigned og = xb_add(&bar[XB_TOP], 1u);
            const unsigned tg = og / nx;
            if (og + 1u == (tg + 1u) * nx) xb_add(&bar[XB_TOPGEN], 1u);
            else XB_SPIN(xb_ld(&bar[XB_TOPGEN]) == tg, bar);
            __builtin_amdgcn_fence(__ATOMIC_ACQUIRE, "agent");
            xb_add(&bar[XB_XGEN(b.x)], 1u);
            asm volatile("s_waitcnt vmcnt(0)" ::: "memory");
        } else {
            XB_SPIN(xb_ld(&bar[XB_XGEN(b.x)]) == gen, bar);
            __builtin_amdgcn_fence(__ATOMIC_ACQUIRE, "agent");
            asm volatile("s_waitcnt vmcnt(0)" ::: "memory");
        }
    }
    __syncthreads();
}

struct Args { const float* in[22]; float* out; unsigned char* ws; };
typedef const Args __attribute__((address_space(4)))* ArgsP;
__device__ __forceinline__ ArgsP args_ptr() { ArgsP p = (ArgsP)__builtin_amdgcn_kernarg_segment_ptr(); asm volatile("" : "+s"(p)); return p; }
#define WSP(T, off) ((T*)(A->ws + (off)))

constexpr int I_MKV = 32 * 16, I_INA = 32 * 56, I_INB = 32 * 80, I_OUT = 32 * 32, I_UP = 32 * 176, I_DN = 88 * 32, DN_P = 850, DN_A = 1170;
__device__ __forceinline__ int conv_count(int list) { return list == 0 ? 2 * I_MKV + I_INA + I_UP + DN_P : (list == 1 ? I_OUT + (DN_A - DN_P) : (list == 2 ? (I_DN - DN_A) + I_INB + I_OUT : (list == 3 ? I_UP : I_DN))); }
__device__ __forceinline__ TItem conv_item(ArgsP A, int list, int r) {
    const float* n_mix_pre = A->in[8]; const float* n_ffn_pre = A->in[10]; const float* n_mem = A->in[12]; const float* w_mem_kv = A->in[13]; const float* w_in_a = A->in[14];
    const float* w_in_b = A->in[18]; const float* w_out = A->in[19]; const float* w_up = A->in[20]; const float* w_dn = A->in[21];
    bf16_t* Wmkv = WSP(bf16_t, WS_WMKV); bf16_t* Wina = WSP(bf16_t, WS_WINA); bf16_t* Winb = WSP(bf16_t, WS_WINB); bf16_t* Wout = WSP(bf16_t, WS_WOUT);
    bf16_t* Wup = WSP(bf16_t, WS_WUP); bf16_t* Wdn = WSP(bf16_t, WS_WDN);
    if (list == 0) {
        if (r < 2 * I_MKV) { const int l = r / I_MKV; return t_make(w_mem_kv + (size_t)l * DM * NKV, DM, NKV, Wmkv + (size_t)l * NKV * DM, false, n_mem + l * DM, r % I_MKV); } r -= 2 * I_MKV;
        if (r < I_INA) return t_make(w_in_a, DM, NA, Wina, false, n_mix_pre, r); r -= I_INA;
        if (r < I_UP) return t_make(w_up, DM, NUP, Wup, true, n_ffn_pre, r); r -= I_UP;
        return t_make(w_dn, DFF, DM, Wdn, false, nullptr, r);
    } else if (list == 1) {
        if (r < I_OUT) return t_make(w_out, DM, DM, Wout, false, nullptr, r); r -= I_OUT;
        return t_make(w_dn, DFF, DM, Wdn, false, nullptr, DN_P + r);
    } else if (list == 2) {
        if (r < I_DN - DN_A) return t_make(w_dn, DFF, DM, Wdn, false, nullptr, DN_A + r); r -= I_DN - DN_A;
        if (r < I_INB) return t_make(w_in_b, DM, NB, Winb, false, n_mix_pre + DM, r); r -= I_INB;
        return t_make(w_out + (size_t)DM * DM, DM, DM, Wout + (size_t)DM * DM, false, nullptr, r);
    } else if (list == 3) {
        return t_make(w_up + (size_t)DM * NUP, DM, NUP, Wup + (size_t)NUP * DM, true, n_ffn_pre + DM, r);
    } else {
        return t_make(w_dn + (size_t)DFF * DM, DFF, DM, Wdn + (size_t)DM * DFF, false, nullptr, r);
    }
}
__device__ __forceinline__ void convert_list(LAS unsigned char* lds, ArgsP A, int list, int worker, int nworkers, int wave, int lane) {
    const int n = conv_count(list);
    LAS float* scr = (LAS float*)(lds + wave * 16384);
    int it = worker;
    if (it >= n) return;
    TItem cur = conv_item(A, list, it);
    f32x4 va[16], vb[16];
    t_load(cur, lane, va);
    for (;;) {
        const int itn = it + nworkers; const bool hn = itn < n;
        TItem nxt = cur;
        if (hn) { nxt = conv_item(A, list, itn); t_load(nxt, lane, vb); }
        t_store(cur, scr, lane, va);
        if (!hn) break;
#pragma unroll
        for (int i = 0; i < 16; ++i) va[i] = vb[i];
        cur = nxt; it = itn;
    }
}
__device__ __forceinline__ void convert_tail(LAS unsigned char* lds, ArgsP A, int list, int first_idle) {
    const int bid = blockIdx.x, G = gridDim.x;
    if (bid < first_idle || first_idle >= G) return;
    int tid = threadIdx.x; asm volatile("" : "+v"(tid));
    const int lane = tid & 63, wave = __builtin_amdgcn_readfirstlane(tid >> 6);
    __syncthreads();
    convert_list(lds, A, list, (bid - first_idle) * 8 + wave, (G - first_idle) * 8, wave, lane);
}
__device__ __forceinline__ void phase_prologue(LAS unsigned char* lds) {
    ArgsP A = args_ptr();
    int tid = threadIdx.x; asm volatile("" : "+v"(tid));
    const int lane = tid & 63, wave = __builtin_amdgcn_readfirstlane(tid >> 6), gw = blockIdx.x * 8 + wave, NGW = gridDim.x * 8;
    const float* x_prompt = A->in[0]; const float* x_sample = A->in[1]; const float* mem_prompt = A->in[2];
    bf16_t* YB = WSP(bf16_t, WS_HN); bf16_t* HM = WSP(bf16_t, WS_HM);
    float* RS = WSP(float, WS_RS); float* RSM = RS + 16384;
    convert_list(lds, A, 0, gw, NGW, wave, lane);
    if (gridDim.x != 256) { convert_list(lds, A, 1, gw, NGW, wave, lane); convert_list(lds, A, 2, gw, NGW, wave, lane); convert_list(lds, A, 3, gw, NGW, wave, lane); convert_list(lds, A, 4, gw, NGW, wave, lane); }
    for (int m = gw; m < 512 + TP + TSMP; m += NGW) {
        if (m < 512) norm_row<0>(mem_prompt + (size_t)m * DM, HM + (size_t)m * DM, nullptr, nullptr, RSM + m, nullptr, lane);
        else { const int r = m - 512; const float* xr = r < TP ? x_prompt + (size_t)r * DM : x_sample + (size_t)(r - TP) * DM;
            norm_row<0>(xr, YB + (size_t)r * DM, nullptr, nullptr, RS + r, nullptr, lane); }
    }
}

__device__ __forceinline__ void phase_in_a(LAS unsigned char* lds) {
    ArgsP A = args_ptr(); const int bid = blockIdx.x, G = gridDim.x;
    bf16_t* HN = WSP(bf16_t, WS_HN);
    { pg8::Gemm g{HN, WSP(bf16_t, WS_WINA), TP, NA, DM}; pg8::StaticOrder S; S.init(TP, NA, G, bid); pg8::EpiInA E{WSP(bf16_t, WS_Z), WSP(float, WS_VSS), WSP(float, WS_RS)};
      pg8::gemm_phase<pg8::EpiInA, true, true>(lds, g, S, E); }
#pragma unroll 1
    for (int l = 0; l < 2; ++l) { pg8::Gemm g{WSP(bf16_t, WS_HM), WSP(bf16_t, WS_WMKV) + (size_t)l * NKV * DM, 512, NKV, DM};
      pg8::StaticOrder S; S.init(512, NKV, G, (bid - 192 - 8 * l + 2 * G) % G);
      pg8::EpiMkv E{A->out + OUT_MKV + (size_t)l * 512 * NKV, WSP(bf16_t, WS_MKV) + (size_t)l * 512 * NKV, WSP(float, WS_RS) + 16384};
      pg8::gemm_phase<pg8::EpiMkv, true, true>(lds, g, S, E); }
    if (G == 256) { if (bid >= 208) sample_gemv<0, DM>(lds, HN + (size_t)TP * DM, DM, WSP(bf16_t, WS_WINA), NA, G - 1 - bid, 48, WSP(float, WS_ZS), nullptr, 0, nullptr, WSP(float, WS_RS) + TP); }
    else sample_gemv<0, DM>(lds, HN + (size_t)TP * DM, DM, WSP(bf16_t, WS_WINA), NA, G - 1 - bid, G, WSP(float, WS_ZS), nullptr, 0, nullptr, WSP(float, WS_RS) + TP);
    if (G == 256) convert_tail(lds, A, 1, 208);
}
__device__ __forceinline__ void phase_in_b(LAS unsigned char* lds) {
    ArgsP A = args_ptr(); const int bid = blockIdx.x, G = gridDim.x;
    bf16_t* HN = WSP(bf16_t, WS_HN); float* out = A->out;
    pg8::Gemm g{HN, WSP(bf16_t, WS_WINB), TP, NB, DM}; pg8::StaticOrder S; S.init(TP, NB, G, bid);
    pg8::EpiInB E{WSP(bf16_t, WS_Z), WSP(float, WS_RS)};
    pg8::gemm_phase<pg8::EpiInB, true, true>(lds, g, S, E);
    sample_gemv<0, DM>(lds, HN + (size_t)TP * DM, DM, WSP(bf16_t, WS_WINB), NB, G - 1 - bid, G, WSP(float, WS_ZS), nullptr, 0, out + OUT_W128S, WSP(float, WS_RS) + TP);
    if (G == 256) convert_tail(lds, A, 3, 128);
}
__device__ __forceinline__ void mem_unit_desc(ArgsP A, int v, int layer, KvDesc& kd, QoDesc& qd) {
    const int b = v >> 7, h = (v >> 5) & 3, qb = v & 31, qmoff = layer == 0 ? 3072 : 4608;
    const bf16_t* mkv = WSP(bf16_t, WS_MKV) + (size_t)layer * 512 * NKV + h * 128;
    kd.kbase = mkv; kd.vbase = mkv + 512; kd.row0 = (long)b * 256; kd.rstep = 1; kd.pitch = NKV; kd.key_lo = 0;
    qd.qbase = WSP(bf16_t, WS_Z) + qmoff + h * 128; qd.row0 = (long)b * SEQ + 128 * qb; qd.rstep = 1; qd.obase = WSP(bf16_t, WS_MIX) + MIXW + h * 128; qd.lsebase = nullptr;
    qd.banded = 0; qd.dil = 1; qd.head = 0;
}
__device__ __forceinline__ void swa_unit_desc(ArgsP A, int u, KvDesc& kd, QoDesc& qd) {
    const int b = u / 384, H = (u % 384) >> 5, idx = u & 31, g = H >> 2, dil = 1 << (2 * g), r = idx & (dil - 1), qb = idx >> (2 * g);
    const bf16_t* Z = WSP(bf16_t, WS_Z);
    kd.kbase = Z + MIXW + H * 128; kd.vbase = Z + 2 * MIXW + H * 128; kd.row0 = (long)b * SEQ + (long)(128 * qb - 128) * dil + r; kd.rstep = dil; kd.pitch = ZP; kd.key_lo = qb == 0 ? 128 : 0;
    qd.qbase = Z + H * 128; qd.row0 = (long)b * SEQ + (long)(128 * qb) * dil + r; qd.rstep = dil; qd.obase = WSP(bf16_t, WS_MIX) + H * 128; qd.lsebase = WSP(float, WS_LSE) + H;
    qd.banded = 1; qd.dil = dil; qd.head = H;
}
__device__ __forceinline__ void q_issue(const QoDesc& qd, int tid, bf16x8 (&qf)[4]) {
    const int lane = tid & 63, w = __builtin_amdgcn_readfirstlane(tid >> 6), fr = lane & 15, fq = lane >> 4;
    const long qrow = qd.row0 + (long)(16 * w + fr) * qd.rstep;
    const bf16_t* qp = qd.qbase + (size_t)qrow * ZP + 8 * fq;
#pragma unroll
    for (int k4 = 0; k4 < 4; ++k4) qf[k4] = *(const bf16x8*)(qp + 32 * k4);
}
__device__ __forceinline__ void build_bias_tables(LAS unsigned char* lds, int tid, const float* rel_bias) {
    LAS float* tab = (LAS float*)(lds + LDS_TAB); LAS float* rb = tab + 12 * 192;
    if (tid < 384) rb[tid] = rel_bias[tid] * LOG2E;
    __syncthreads();
    for (int i = tid; i < 12 * 192; i += 512) { const int H = i / 192, j = i % 192 - 32, dil = 1 << (2 * (H >> 2));
        tab[i] = (j >= 0 && j <= 128) ? rb[t5_bucket(j * dil) * 12 + H] : -1e30f; }
}
__device__ __forceinline__ void attn_unit_run(LAS unsigned char* lds, int tid, const QoDesc& qd, int key_lo, u32x4 (&kk)[8], u32x4 (&vv)[8], bf16x8 (&qf)[4],
                                              const bool has_next, const KvDesc nxt, const QoDesc nxtq) {
    const int lane = tid & 63, w = __builtin_amdgcn_readfirstlane(tid >> 6), fr = lane & 15, fq = lane >> 4;
    __syncthreads();
    kv_commit(lds, tid, key_lo, kk, vv);
    bf16x8 qc[4];
#pragma unroll
    for (int k4 = 0; k4 < 4; ++k4) qc[k4] = qf[k4];
    if (has_next) { kv_issue(nxt, tid, kk, vv); q_issue(nxtq, tid, qf); }
    __syncthreads();
    const long qrow = qd.row0 + (long)(16 * w + fr) * qd.rstep;
    bf16_t* orow = qd.obase + (size_t)qrow * DM + 4 * fq;
    float* lsep = qd.lsebase != nullptr ? qd.lsebase + (size_t)qrow * 12 : nullptr;
    if (qd.banded) attn_compute<true>(lds, lane, w, qc, key_lo, orow, lsep, (const LAS float*)(lds + LDS_TAB) + qd.head * 192);
    else attn_compute<false>(lds, lane, w, qc, key_lo, orow, lsep, (const LAS float*)(lds + LDS_TAB));
}
__device__ __forceinline__ void sample_mem_attn(LAS unsigned char* lds, int layer) {
    ArgsP A = args_ptr(); const int bid = blockIdx.x, G = gridDim.x;
    int tid = threadIdx.x; asm volatile("" : "+v"(tid));
    const int qmoff = layer == 0 ? 3072 : 4608;
    for (int it = G - 1 - 96 - bid; it >= 0 && it < 32; it += G) {
        const int s = it >> 2, h = it & 3;
        LAS float* scr = (LAS float*)lds; LAS float* og = scr + 2560;
        __syncthreads();
        const float* cm = A->in[3] + (size_t)(layer * 8 + s) * 256 * 1024;
        auto kf = [=](int j) -> const float* { return cm + (size_t)j * 1024 + h * 128; };
        auto vf = [=](int j) -> const float* { return cm + (size_t)j * 1024 + 512 + h * 128; };
        (void)sample_attend(scr, WSP(float, WS_ZS) + (size_t)s * ZP + qmoff + h * 128, 256, kf, vf, (const LAS float*)nullptr, og);
        if (tid < 128) WSP(bf16_t, WS_MIX)[(size_t)(TP + s) * DM + MIXW + h * 128 + tid] = (bf16_t)f2bf(og[tid]);
        __syncthreads();
    }
}
__device__ __forceinline__ void phase_mix_a(LAS unsigned char* lds) {
    ArgsP A = args_ptr(); const int bid = blockIdx.x, G = gridDim.x;
    int tid = threadIdx.x; asm volatile("" : "+v"(tid));
    const int lane = tid & 63, wave = __builtin_amdgcn_readfirstlane(tid >> 6);
    const float* ZS = WSP(float, WS_ZS); const float* n_v_a = A->in[15]; const float* w_sp = A->in[16]; const float* b_sp = A->in[17]; bf16_t* MIX = WSP(bf16_t, WS_MIX); float* out = A->out;
    for (int it = G - 1 - bid; it < TSMP; it += G) {
        LAS float* red = (LAS float*)lds; const int s = it;
        __syncthreads();
        float vv[3], uu[3], ss = 0.f;
#pragma unroll
        for (int i = 0; i < 3; ++i) { const int c = tid + 512 * i; uu[i] = gelu_tanh(ZS[(size_t)s * ZP + c]); vv[i] = gelu_tanh(ZS[(size_t)s * ZP + MIXW + c]); ss += vv[i] * vv[i]; }
        ss = wave_sum(ss); if (lane == 0) red[wave] = ss;
        __syncthreads();
        float tot = 0.f;
#pragma unroll
        for (int i = 0; i < 8; ++i) tot += red[i];
        const float rstd = 1.0f / sqrtf(tot * (1.0f / MIXW) + EPS);
#pragma unroll
        for (int i = 0; i < 3; ++i) { const int c = tid + 512 * i, g = c / 384; const float vn = vv[i] * rstd * n_v_a[c];
            out[OUT_CHV + (size_t)s * MIXW + c] = vn;
            const float sg = w_sp[(size_t)g * 16384] * vn + b_sp[g * 128];
            MIX[(size_t)(TP + s) * DM + c] = (bf16_t)f2bf(uu[i] * sg); }
    }
    sample_mem_attn(lds, 0);
    __syncthreads();
    for (int u = bid; u < 256; u += G) {
        KvDesc kd; QoDesc qd; mem_unit_desc(A, u, 0, kd, qd);
        u32x4 kk[8], vv[8]; bf16x8 qf[4]; GateRegs R;
        gate_issue(tid, u >> 7, (u >> 2) & 31, u & 3, WSP(bf16_t, WS_Z), WSP(float, WS_VSS), A->in[16], A->in[15], R);
        kv_issue(kd, tid, kk, vv); q_issue(qd, tid, qf);
        gate_run(lds, tid, u >> 7, (u >> 2) & 31, u & 3, R, WSP(bf16_t, WS_Z), A->in[17], WSP(bf16_t, WS_MIX));
        attn_unit_run(lds, tid, qd, kd.key_lo, kk, vv, qf, false, kd, qd);
    }
}
__device__ __forceinline__ void phase_mix_b1(LAS unsigned char* lds) {
    ArgsP A = args_ptr(); const int bid = blockIdx.x, G = gridDim.x;
    int tid = threadIdx.x; asm volatile("" : "+v"(tid));
    KvDesc kd{}, kn{}; QoDesc qd{}, qn{};
    u32x4 kk[8], vv[8]; bf16x8 qf[4];
    int u = bid;
    if (u < 1024) { if (u < 768) swa_unit_desc(A, u, kd, qd); else mem_unit_desc(A, u - 768, 1, kd, qd); kv_issue(kd, tid, kk, vv); q_issue(qd, tid, qf); }
    build_bias_tables(lds, tid, A->in[7]);
#pragma unroll 1
    for (; u < 1024; u += G) {
        const int un = u + G; const bool has_next = un < 1024;
        if (has_next) { if (un < 768) swa_unit_desc(A, un, kn, qn); else mem_unit_desc(A, un - 768, 1, kn, qn); }
        attn_unit_run(lds, tid, qd, kd.key_lo, kk, vv, qf, has_next, kn, qn);
        kd = kn; qd = qn;
    }
}
__device__ __forceinline__ void phase_mix_b2(LAS unsigned char* lds) {
    ArgsP A = args_ptr(); const int bid = blockIdx.x, G = gridDim.x;
    int tid = threadIdx.x; asm volatile("" : "+v"(tid));
    const int lane = tid & 63, wave = __builtin_amdgcn_readfirstlane(tid >> 6), gw = bid * 8 + wave, NGW = G * 8;
    bf16_t* MIX = WSP(bf16_t, WS_MIX); const float* LSE = WSP(float, WS_LSE);
    for (int row = gw; row < TP; row += NGW) {
        const float* lp = LSE + (size_t)row * 12;
#pragma unroll
        for (int i = 0; i < 3; ++i) { const int col = 8 * (lane + 64 * i), H = col >> 7, g = H >> 2, hl = H & 3;
            const float l0 = lp[hl], l1 = lp[4 + hl], l2 = lp[8 + hl], mm = fmaxf(l0, fmaxf(l1, l2));
            const float e0 = __expf(l0 - mm), e1 = __expf(l1 - mm), e2 = __expf(l2 - mm);
            const float al = (g == 0 ? e0 : (g == 1 ? e1 : e2)) / (e0 + e1 + e2);
            u32x4 wv = *(u32x4*)(MIX + (size_t)row * DM + col);
            wv.x = cvt_pk_bf16(bf_lo(wv.x) * al, bf_hi(wv.x) * al); wv.y = cvt_pk_bf16(bf_lo(wv.y) * al, bf_hi(wv.y) * al);
            wv.z = cvt_pk_bf16(bf_lo(wv.z) * al, bf_hi(wv.z) * al); wv.w = cvt_pk_bf16(bf_lo(wv.w) * al, bf_hi(wv.w) * al);
            *(u32x4*)(MIX + (size_t)row * DM + col) = wv; }
    }
    { const int nw = G > 128 ? G - 128 : G, wk = bid < nw ? bid : -1;
      if (wk >= 0) { const bf16_t* Z = WSP(bf16_t, WS_Z); float* o0 = A->out + OUT_W128P;
        for (int i = wk * 512 + tid; i < 688128; i += nw * 512) {
            const int g = i < 32768 ? 0 : (i < 163840 ? 1 : 2), ig = i - (g == 0 ? 0 : (g == 1 ? 32768 : 163840)), W = 128 << (2 * g);
            const int c8 = ig & 63, kv = (ig >> 6) & 1, tr = (ig >> 7) & (W - 1), b = (ig >> 7) / W;
            const u32x4 wv = *(const u32x4*)(Z + (size_t)(b * SEQ + (SEQ - W) + tr) * ZP + MIXW + kv * MIXW + g * 512 + c8 * 8);
            float* dst = o0 + (size_t)2048 * ((W - 128) / 3) + (size_t)ig * 8;
            *(f32x4*)dst = (f32x4){bf_lo(wv.x), bf_hi(wv.x), bf_lo(wv.y), bf_hi(wv.y)}; *(f32x4*)(dst + 4) = (f32x4){bf_lo(wv.z), bf_hi(wv.z), bf_lo(wv.w), bf_hi(wv.w)}; } } }
    const float* rel_bias = A->in[7]; const float* ZS = WSP(float, WS_ZS);
    for (int it = G - 1 - bid; it < 96; it += G) {
        const int s = it / 12, H = it % 12, g = H >> 2, hl = H & 3, dil = 1 << (2 * g), W = 128 << (2 * g);
        LAS float* scr = (LAS float*)lds; LAS float* btab = scr + 2400; LAS float* og = scr + 2560;
        __syncthreads();
        for (int j = tid; j <= 128; j += 512) btab[j] = rel_bias[t5_bucket(j * dil) * 12 + H] * LOG2E;
        __syncthreads();
        const float* cw = A->in[4 + g];
        const float* zrow = ZS + (size_t)s * ZP;
        auto kf = [=](int j) -> const float* { return j == 0 ? zrow + MIXW + H * 128 : cw + ((size_t)(s * W + (W - j * dil)) * 2 + 0) * 512 + hl * 128; };
        auto vf = [=](int j) -> const float* { return j == 0 ? zrow + 2 * MIXW + H * 128 : cw + ((size_t)(s * W + (W - j * dil)) * 2 + 1) * 512 + hl * 128; };
        const float lg = sample_attend(scr, zrow + H * 128, 129, kf, vf, btab, og);
        if (tid < 128) MIX[(size_t)(TP + s) * DM + H * 128 + tid] = (bf16_t)f2bf(og[tid]);
        if (tid == 0) WSP(float, WS_LSE)[(size_t)TP * 12 + s * 12 + H] = lg;
        __syncthreads();
    }
    sample_mem_attn(lds, 1);
}
__device__ __forceinline__ void phase_out(LAS unsigned char* lds, int layer) {
    ArgsP A = args_ptr(); const int bid = blockIdx.x, G = gridDim.x;
    bf16_t* MIX = WSP(bf16_t, WS_MIX); bf16_t* OB = WSP(bf16_t, WS_O); const bf16_t* W = WSP(bf16_t, WS_WOUT) + (size_t)layer * DM * DM;
    pg8::Gemm g{MIX, W, TP, DM, DM}; pg8::StaticOrder S; S.init(TP, DM, G, bid); pg8::EpiPlain E{OB, DM};
    pg8::gemm_phase<pg8::EpiPlain, false, true>(lds, g, S, E);
    sample_gemv<1, DM>(lds, MIX + (size_t)TP * DM, DM, W, DM, G - 1 - bid, G, nullptr, OB + (size_t)TP * DM, DM, nullptr, nullptr, layer == 1 ? WSP(float, WS_LSE) + (size_t)TP * 12 : nullptr);
}
__device__ __forceinline__ void phase_up(LAS unsigned char* lds, int layer) {
    ArgsP A = args_ptr(); const int bid = blockIdx.x, G = gridDim.x;
    bf16_t* HN = WSP(bf16_t, WS_HN); bf16_t* ACT = WSP(bf16_t, WS_ACT); const bf16_t* W = WSP(bf16_t, WS_WUP) + (size_t)layer * NUP * DM;
    pg8::Gemm g{HN, W, TP, NUP, DM}; pg8::StaticOrder S; S.init(TP, NUP, G, bid); pg8::EpiSwiglu E{ACT, WSP(float, WS_RS)};
    pg8::gemm_phase<pg8::EpiSwiglu, true, true>(lds, g, S, E);
    if (G == 256 && layer == 1) { if (bid >= 128) sample_gemv<2, DM>(lds, HN + (size_t)TP * DM, DM, W, NUP, G - 1 - bid, 128, nullptr, ACT + (size_t)TP * DFF, DFF, nullptr, WSP(float, WS_RS) + TP); }
    else sample_gemv<2, DM>(lds, HN + (size_t)TP * DM, DM, W, NUP, G - 1 - bid, G, nullptr, ACT + (size_t)TP * DFF, DFF, nullptr, WSP(float, WS_RS) + TP);
    if (G == 256) convert_tail(lds, A, layer == 0 ? 2 : 4, 128);
}
__device__ __forceinline__ void phase_down(LAS unsigned char* lds, int layer) {
    ArgsP A = args_ptr(); const int bid = blockIdx.x, G = gridDim.x;
    bf16_t* ACT = WSP(bf16_t, WS_ACT); bf16_t* OB = WSP(bf16_t, WS_O); const bf16_t* W = WSP(bf16_t, WS_WDN) + (size_t)layer * DM * DFF;
    pg8::Gemm g{ACT, W, TP, DM, DFF}; pg8::StaticOrder S; S.init(TP, DM, G, bid); pg8::EpiPlain E{OB, DM};
    pg8::gemm_phase<pg8::EpiPlain, false, true>(lds, g, S, E);
    sample_gemv<1, DFF>(lds, ACT + (size_t)TP * DFF, DFF, W, DM, G - 1 - bid, G, nullptr, OB + (size_t)TP * DM, DM, nullptr, nullptr);
}
__device__ __forceinline__ void phase_norm(int which) {
    ArgsP A = args_ptr();
    int tid = threadIdx.x; asm volatile("" : "+v"(tid));
    const int lane = tid & 63, wave = __builtin_amdgcn_readfirstlane(tid >> 6), gw = blockIdx.x * 8 + wave, NGW = gridDim.x * 8;
    const int layer = which >> 1;
    float* Y = A->out + OUT_Y; const bf16_t* OB = WSP(bf16_t, WS_O); bf16_t* YB = WSP(bf16_t, WS_HN); float* RS = WSP(float, WS_RS);
    const float* gpost = ((which & 1) ? A->in[11] : A->in[9]) + layer * DM;
    int r = gw;
    if (r >= TP + TSMP) return;
    NormRaw cur, nxt;
    norm_load(YB + (size_t)r * DM, OB + (size_t)r * DM, lane, cur);
    for (;;) {
        const int rn = r + NGW; const bool hn = rn < TP + TSMP;
        if (hn) norm_load(YB + (size_t)rn * DM, OB + (size_t)rn * DM, lane, nxt);
        if (which == 3) norm_finish<true>(cur, nullptr, gpost, nullptr, Y + (size_t)r * DM, lane);
        else norm_finish<false>(cur, YB + (size_t)r * DM, gpost, RS + r, nullptr, lane);
        if (!hn) break;
        cur = nxt; r = rn;
    }
}

__global__ void __launch_bounds__(512, 2) fwd_megakernel(Args args) {
    extern __shared__ __attribute__((aligned(16))) unsigned char lds_raw[];
    LAS unsigned char* lds = (LAS unsigned char*)lds_raw;
    volatile LAS unsigned* bst = (volatile LAS unsigned*)(lds + LDS_BYTES - 64);
    if (threadIdx.x < 16) bst[threadIdx.x] = 0u;
    __syncthreads();
    const XcdBarrier bar = xcd_barrier_post((unsigned*)args.ws, bst);
#define GRID_SYNC() xcd_barrier(bar)
    phase_prologue(lds);
    GRID_SYNC();
    phase_in_a(lds);
    GRID_SYNC();
    phase_mix_a(lds);
    GRID_SYNC();
    phase_out(lds, 0);
    GRID_SYNC();
    phase_norm(0);
    GRID_SYNC();
    phase_up(lds, 0);
    GRID_SYNC();
    phase_down(lds, 0);
    GRID_SYNC();
    phase_norm(1);
    GRID_SYNC();
    phase_in_b(lds);
    GRID_SYNC();
    phase_mix_b1(lds);
    GRID_SYNC();
    phase_mix_b2(lds);
    GRID_SYNC();
    phase_out(lds, 1);
    GRID_SYNC();
    phase_norm(2);
    GRID_SYNC();
    phase_up(lds, 1);
    GRID_SYNC();
    phase_down(lds, 1);
    GRID_SYNC();
    phase_norm(3);
#undef GRID_SYNC
}

extern "C" void kernel_launch(void* const* d_in, const int* in_sizes, int n_in, void* d_out, int out_size, void* d_ws, size_t ws_size, hipStream_t stream) {
    static int grid = 0;
    if (grid == 0) {
        if (n_in != 22 || (size_t)out_size != OUT_TOTAL || ws_size < WS_END) { fprintf(stderr, "kernel_launch: unexpected shapes (n_in %d, out %d, ws %zu)\n", n_in, out_size, ws_size); grid = -1; return; }
        int dev = 0, cus = 0, per_cu = 0;
        if (hipGetDevice(&dev) != hipSuccess || hipDeviceGetAttribute(&cus, hipDeviceAttributeMultiprocessorCount, dev) != hipSuccess) { grid = -1; return; }
        if (hipFuncSetAttribute((const void*)fwd_megakernel, hipFuncAttributeMaxDynamicSharedMemorySize, LDS_BYTES) != hipSuccess) { fprintf(stderr, "kernel_launch: hipFuncSetAttribute failed\n"); grid = -1; return; }
        if (hipOccupancyMaxActiveBlocksPerMultiprocessor(&per_cu, (const void*)fwd_megakernel, 512, LDS_BYTES) != hipSuccess || per_cu < 1) { fprintf(stderr, "kernel_launch: occupancy query says %d\n", per_cu); (void)hipGetLastError(); per_cu = 1; }
        grid = cus;
    }
    if (grid < 0) return;
    if (hipMemsetAsync(d_ws, 0, 16384, stream) != hipSuccess) { fprintf(stderr, "kernel_launch: memset of the barrier words failed\n"); return; }
    Args a{};
    for (int i = 0; i < 22; ++i) a.in[i] = (const float*)d_in[i];
    a.out = (float*)d_out; a.ws = (unsigned char*)d_ws;
    void* kargs[] = {&a};
    hipError_t e = hipLaunchCooperativeKernel((const void*)fwd_megakernel, dim3(grid), dim3(512), kargs, LDS_BYTES, stream);
    if (e != hipSuccess) fprintf(stderr, "kernel_launch: cooperative launch failed: %s (grid %d)\n", hipGetErrorString(e), grid);
}
```

```cpp
#include <hip/hip_runtime.h>
#include <cstdio>
#include <cstdint>

#define LAS __attribute__((address_space(3)))
typedef unsigned short bf16_t;
typedef short bf16x8 __attribute__((ext_vector_type(8)));
typedef short s16x4 __attribute__((ext_vector_type(4)));
typedef float f32x4 __attribute__((ext_vector_type(4)));
typedef float f32x2 __attribute__((ext_vector_type(2)));
typedef unsigned u32x4 __attribute__((ext_vector_type(4)));
typedef unsigned u32x2 __attribute__((ext_vector_type(2)));

constexpr int DM = 2048, TP = 8192, TSMP = 8, TROWS = TP + 16, SEQ = 4096;
constexpr int MIXW = 1536, NA = 3584, NB = 5120, DFF = 5632, NUP = 11264, NKV = 1024;
constexpr int ZP = 5120;
constexpr float EPS = 1e-6f;
constexpr float LOG2E = 1.4426950408889634f, LN2 = 0.6931471805599453f;
constexpr float QSCALE = 0.08838834764831845f * 1.4426950408889634f;

constexpr size_t MiB = 1u << 20;
constexpr size_t WS_WMKV = 1 * MiB;
constexpr size_t WS_WINA = 9 * MiB;
constexpr size_t WS_WINB = 23 * MiB;
constexpr size_t WS_WOUT = 43 * MiB;
constexpr size_t WS_WUP = 59 * MiB;
constexpr size_t WS_WDN = 147 * MiB;
constexpr size_t WS_HN = 191 * MiB;
constexpr size_t WS_HM = 224 * MiB;
constexpr size_t WS_MKV = 228 * MiB;
constexpr size_t WS_Z = 230 * MiB;
constexpr size_t WS_ZS = 310 * MiB;
constexpr size_t WS_VSS = 311 * MiB;
constexpr size_t WS_MIX = 312 * MiB;
constexpr size_t WS_LSE = 345 * MiB;
constexpr size_t WS_RS = 345 * MiB + 512 * 1024;
constexpr size_t WS_O = 346 * MiB;
constexpr size_t WS_ACT = 379 * MiB;
constexpr size_t WS_END = 468 * MiB;

constexpr size_t OUT_Y = 0;
constexpr size_t OUT_MKV = 16793600;
constexpr size_t OUT_CHV = OUT_MKV + 1048576;
constexpr size_t OUT_W128P = OUT_CHV + 12288;
constexpr size_t OUT_W512P = OUT_W128P + 262144;
constexpr size_t OUT_W2048P = OUT_W512P + 1048576;
constexpr size_t OUT_W128S = OUT_W2048P + 4194304;
constexpr size_t OUT_W512S = OUT_W128S + 8192;
constexpr size_t OUT_W2048S = OUT_W512S + 8192;
constexpr size_t OUT_TOTAL = OUT_W2048S + 8192;

constexpr int LDS_BYTES = 147456;
constexpr int LDS_TAB = 131072;

__device__ __forceinline__ unsigned cvt_pk_bf16(float lo, float hi) { unsigned r; asm volatile("v_cvt_pk_bf16_f32 %0, %1, %2" : "=v"(r) : "v"(lo), "v"(hi)); return r; }
__device__ __forceinline__ float bf_lo(unsigned w) { return __uint_as_float(w << 16); }
__device__ __forceinline__ float bf_hi(unsigned w) { return __uint_as_float(w & 0xffff0000u); }
__device__ __forceinline__ float wave_sum(float v) {
#pragma unroll
    for (int o = 1; o < 64; o <<= 1) v += __shfl_xor(v, o);
    return v;
}
__device__ __forceinline__ float wave_max(float v) {
#pragma unroll
    for (int o = 1; o < 64; o <<= 1) v = fmaxf(v, __shfl_xor(v, o));
    return v;
}
__device__ __forceinline__ float gelu_tanh(float x) {
    const float t = x * x;
    const float u2 = x * (1.5957691216057308f + 0.07135481627260024f * t);
    const float e = __builtin_amdgcn_exp2f(-LOG2E * u2);
    return x * __builtin_amdgcn_rcpf(1.0f + e);
}
__device__ __forceinline__ float silu_f(float x) {
    const float e = __builtin_amdgcn_exp2f(-LOG2E * x);
    return x * __builtin_amdgcn_rcpf(1.0f + e);
}
__device__ __forceinline__ int t5_bucket(int d) {
    if (d < 16) return d;
    int b = 16;
    b += (d >= 22); b += (d >= 30); b += (d >= 40); b += (d >= 54); b += (d >= 73); b += (d >= 99); b += (d >= 134); b += (d >= 182);
    b += (d >= 246); b += (d >= 332); b += (d >= 450); b += (d >= 609); b += (d >= 825); b += (d >= 1117); b += (d >= 1513);
    return b;
}
__device__ __forceinline__ unsigned off_b(unsigned row, unsigned ch) { return 256u * row + 16u * (ch ^ (((row & 3) << 2) | ((row >> 2) & 3))); }
__device__ __forceinline__ unsigned tr16_addr(unsigned lane, unsigned c, unsigned ks, unsigned t) {
    const unsigned g = lane >> 4, q = (lane & 15) >> 2, p = lane & 3;
    return off_b(32 * ks + 8 * g + 4 * t + q, 2 * c + (p >> 1)) + 8 * (p & 1);
}
typedef short v4i16_t __attribute__((ext_vector_type(4)));
__device__ __forceinline__ s16x4 tr_read(LAS unsigned char* p) { return __builtin_bit_cast(s16x4, __builtin_amdgcn_ds_read_tr16_b64_v4i16((LAS v4i16_t*)p)); }

namespace pg8 {
constexpr int BM = 256, BK = 64, HALF = 128, HTB = HALF * BK * 2, STAGE_BYTES = 8 * HTB, NXCD = 8, WGM = 4;
__host__ __device__ __forceinline__ int lds_byte(int r, int c) { const int st = (r >> 4) * 2 + (c >> 5), rr = r & 15, cc = c & 31, ob = rr * 64 + cc * 2; return st * 1024 + (ob ^ (((ob >> 9) & 1) << 5)); }
__host__ __device__ __forceinline__ void stage_rc(int b, int& R, int& C) { const int st = b / 1024, sb = b % 1024, swz = sb ^ (((sb >> 9) & 1) << 5); R = (st >> 1) * 16 + swz / 64; C = (st & 1) * 32 + (swz % 64) / 2; }
__host__ __device__ __forceinline__ int perm32(int rho) { const int n = rho >> 4, i = rho & 15; return 8 * (i >> 2) + 4 * n + (i & 3); }

struct Unit { int pm, pn; };
struct Gemm { const bf16_t* A; const bf16_t* Bt; int M, N, K; };

struct StaticOrder {
    int nM, nN, nwg, G, c;
    __host__ __device__ void init(int M, int N, int G_, int c_) { nM = M / BM; nN = N / BM; nwg = nM * nN; G = G_; c = c_; }
    __host__ __device__ bool next(int i, Unit& u) const {
        const long L = (long)i * G + c; if (L >= nwg) return false;
        int wgid = (int)L; { const int q = nwg / NXCD, r = nwg % NXCD, xcd = wgid % NXCD, off = wgid / NXCD; wgid = (xcd < r ? xcd * (q + 1) : r * (q + 1) + (xcd - r) * q) + off; }
        const int nig = WGM * nN, gid = wgid / nig, fm = gid * WGM, gsz = (nM - fm) < WGM ? (nM - fm) : WGM;
        u.pm = fm + ((wgid % nig) % gsz); u.pn = (wgid % nig) / gsz; return true;
    }
};

template <class Epi, bool ALIGN_EPI, bool SP2>
__device__ __forceinline__ void gemm_phase(LAS unsigned char* lds, const Gemm g, const StaticOrder& S, const Epi& E) {
    int tid = threadIdx.x; asm volatile("" : "+v"(tid));
    const int wid = __builtin_amdgcn_readfirstlane(tid >> 6), lane = tid & 63, wr = wid >> 2, wc = wid & 3, fr = lane & 15, fq = lane >> 4;
    const int K = g.K, nt = K / BK;
    unsigned voffA[2], voffB[2];
#pragma unroll
    for (int i = 0; i < 2; ++i) { int R, C; stage_rc(tid * 16 + i * 8192, R, C); const int Rb = (R & ~31) + perm32(R & 31);
        voffA[i] = (unsigned)(R * K + C) * 2u; voffB[i] = (unsigned)(Rb * K + C) * 2u; }
    const size_t kstep = (size_t)(BK * 2);
    const size_t hstep = (size_t)HALF * K * 2;
    const size_t tstep = 2 * hstep;
    const unsigned ldsw = (unsigned)wid * 1024u;
    const int aoff = lds_byte(wr * 64 + fr, fq * 8), boff = lds_byte(wc * 32 + fr, fq * 8);
#define PG8_SA(b, h) (((b) * 2 + (h)) * HTB)
#define PG8_SB(b, h) ((4 + (b) * 2 + (h)) * HTB)
#define PG8_STAGE(bufoff, gbase, voff) do { _Pragma("unroll") for (int _i = 0; _i < 2; ++_i) \
        __builtin_amdgcn_global_load_lds((const unsigned*)((const char*)(gbase) + (voff)[_i]), (LAS unsigned*)(lds + (bufoff) + ldsw + _i * 8192), 16, 0, 0); } while (0)
#define PG8_LDA(dst, b, h) do { _Pragma("unroll") for (int m = 0; m < 4; ++m) _Pragma("unroll") for (int k = 0; k < 2; ++k) dst[m][k] = *(const LAS bf16x8*)(lds + PG8_SA(b, h) + aoff + m * 2048 + k * 1024); } while (0)
#define PG8_LDB(dst, b, h) do { _Pragma("unroll") for (int n = 0; n < 2; ++n) _Pragma("unroll") for (int k = 0; k < 2; ++k) dst[n][k] = *(const LAS bf16x8*)(lds + PG8_SB(b, h) + boff + n * 2048 + k * 1024); } while (0)
#define PG8_MMA(ai, bj, At, Bt) do { __builtin_amdgcn_s_setprio(1); _Pragma("unroll") for (int m = 0; m < 4; ++m) _Pragma("unroll") for (int n = 0; n < 2; ++n) _Pragma("unroll") for (int k = 0; k < 2; ++k) \
        acc[ai][bj][m][n] = __builtin_amdgcn_mfma_f32_16x16x32_bf16(Bt[n][k], At[m][k], acc[ai][bj][m][n], 0, 0, 0); __builtin_amdgcn_s_setprio(0); } while (0)
#define PG8_WAIT_V(n) asm volatile("s_waitcnt vmcnt(" #n ")" ::: "memory")
#define PG8_WAIT_L(n) asm volatile("s_waitcnt lgkmcnt(" #n ")" ::: "memory")
#define PG8_BAR __builtin_amdgcn_s_barrier()
#define PG8_SCHED __builtin_amdgcn_sched_barrier(0)
    Unit cur, nxt; int ui = 0;
    if (!S.next(0, cur)) return;
    f32x4 acc[2][2][4][2];
#pragma unroll
    for (int a = 0; a < 2; ++a)
#pragma unroll
        for (int b = 0; b < 2; ++b)
#pragma unroll
            for (int m = 0; m < 4; ++m)
#pragma unroll
                for (int n = 0; n < 2; ++n) acc[a][b][m][n] = (f32x4){0.f, 0.f, 0.f, 0.f};
    bf16x8 At[4][2], B0[2][2], B1[2][2];
    const char* cA = (const char*)g.A + (size_t)cur.pm * tstep; const char* cB = (const char*)g.Bt + (size_t)cur.pn * tstep;
    if constexpr (SP2) {
        PG8_STAGE(PG8_SB(0, 0), cB, voffB); PG8_STAGE(PG8_SB(0, 1), cB + hstep, voffB); PG8_STAGE(PG8_SA(0, 0), cA, voffA); PG8_STAGE(PG8_SA(0, 1), cA + hstep, voffA);
        if (wr == 1) PG8_BAR;
        PG8_WAIT_V(2); PG8_BAR;
        PG8_STAGE(PG8_SB(1, 0), cB + kstep, voffB); PG8_STAGE(PG8_SA(1, 0), cA + kstep, voffA); PG8_STAGE(PG8_SB(1, 1), cB + hstep + kstep, voffB);
        PG8_WAIT_V(6); PG8_BAR;
    } else {
        PG8_STAGE(PG8_SB(0, 0), cB, voffB); PG8_STAGE(PG8_SA(0, 0), cA, voffA); PG8_STAGE(PG8_SB(0, 1), cB + hstep, voffB); PG8_STAGE(PG8_SA(0, 1), cA + hstep, voffA);
        if (wr == 1) PG8_BAR;
        PG8_WAIT_V(4); PG8_BAR;
        PG8_STAGE(PG8_SB(1, 0), cB + kstep, voffB); PG8_STAGE(PG8_SA(1, 0), cA + kstep, voffA); PG8_STAGE(PG8_SB(1, 1), cB + hstep + kstep, voffB);
        PG8_WAIT_V(6); PG8_BAR;
    }
    for (;;) {
        const typename Epi::Pre pre = E.prefetch(cur, wr, fr);
        const bool has_next = S.next(ui + 1, nxt);
        const char* nA = has_next ? (const char*)g.A + (size_t)nxt.pm * tstep : cA; const char* nB = has_next ? (const char*)g.Bt + (size_t)nxt.pn * tstep : cB;
        for (int t = 0; t < nt; t += 2) {
            const bool last = (t == nt - 2);
            const char* a1 = cA + (size_t)(t + 1) * kstep;
            const char* a2 = last ? nA : cA + (size_t)(t + 2) * kstep; const char* b2 = last ? nB : cB + (size_t)(t + 2) * kstep;
            const char* a3 = a2 + kstep; const char* b3 = b2 + kstep;
            if constexpr (SP2) {
            PG8_LDB(B0, 0, 0); PG8_LDB(B1, 0, 1); PG8_SCHED; PG8_LDA(At, 0, 0); PG8_STAGE(PG8_SA(1, 1), a1 + hstep, voffA);
            PG8_WAIT_V(8); PG8_WAIT_L(0); PG8_BAR; PG8_MMA(0, 0, At, B0); PG8_MMA(0, 1, At, B1); PG8_BAR; PG8_SCHED;
            PG8_LDA(At, 0, 1); PG8_STAGE(PG8_SB(0, 0), b2, voffB); PG8_STAGE(PG8_SB(0, 1), b2 + hstep, voffB); PG8_STAGE(PG8_SA(0, 0), a2, voffA);
            PG8_WAIT_V(8); PG8_WAIT_L(0); PG8_BAR; PG8_MMA(1, 0, At, B0); PG8_MMA(1, 1, At, B1); PG8_BAR; PG8_SCHED;
            PG8_LDB(B0, 1, 0); PG8_LDB(B1, 1, 1); PG8_SCHED; PG8_LDA(At, 1, 0); PG8_STAGE(PG8_SA(0, 1), a2 + hstep, voffA);
            PG8_WAIT_V(8); PG8_WAIT_L(0); PG8_BAR; PG8_MMA(0, 0, At, B0); PG8_MMA(0, 1, At, B1); PG8_BAR; PG8_SCHED;
            PG8_LDA(At, 1, 1); PG8_STAGE(PG8_SB(1, 0), b3, voffB); PG8_STAGE(PG8_SB(1, 1), b3 + hstep, voffB); PG8_STAGE(PG8_SA(1, 0), a3, voffA);
            PG8_WAIT_V(8); PG8_WAIT_L(0); PG8_BAR; PG8_MMA(1, 0, At, B0); PG8_MMA(1, 1, At, B1); PG8_BAR; PG8_SCHED;
            } else {
            PG8_LDB(B0, 0, 0); PG8_SCHED; PG8_LDA(At, 0, 0); PG8_STAGE(PG8_SA(1, 1), a1 + hstep, voffA);
            PG8_WAIT_L(8); PG8_BAR; PG8_WAIT_L(0); PG8_MMA(0, 0, At, B0); PG8_BAR; PG8_SCHED;
            PG8_LDB(B1, 0, 1); PG8_STAGE(PG8_SB(0, 0), b2, voffB);
            PG8_BAR; PG8_WAIT_L(0); PG8_MMA(0, 1, At, B1); PG8_BAR;
            PG8_LDA(At, 0, 1); PG8_STAGE(PG8_SA(0, 0), a2, voffA);
            PG8_BAR; PG8_WAIT_L(0); PG8_MMA(1, 0, At, B0); PG8_BAR; PG8_SCHED;
            PG8_STAGE(PG8_SB(0, 1), b2 + hstep, voffB);
            PG8_WAIT_V(6); PG8_BAR; PG8_MMA(1, 1, At, B1); PG8_BAR;
            PG8_LDB(B0, 1, 0); PG8_SCHED; PG8_LDA(At, 1, 0); PG8_STAGE(PG8_SA(0, 1), a2 + hstep, voffA);
            PG8_WAIT_L(8); PG8_BAR; PG8_WAIT_L(0); PG8_MMA(0, 0, At, B0); PG8_BAR; PG8_SCHED;
            PG8_LDB(B1, 1, 1); PG8_STAGE(PG8_SB(1, 0), b3, voffB);
            PG8_BAR; PG8_WAIT_L(0); PG8_MMA(0, 1, At, B1); PG8_BAR;
            PG8_LDA(At, 1, 1); PG8_STAGE(PG8_SA(1, 0), a3, voffA);
            PG8_BAR; PG8_WAIT_L(0); PG8_MMA(1, 0, At, B0); PG8_BAR; PG8_SCHED;
            PG8_STAGE(PG8_SB(1, 1), b3 + hstep, voffB);
            PG8_WAIT_V(6); PG8_BAR; PG8_MMA(1, 1, At, B1); PG8_BAR;
            }
        }
        if constexpr (ALIGN_EPI) { if (wr == 0) PG8_BAR; }
        E(acc, cur, wr, wc, fr, fq, pre);
        if (!has_next) break;
#pragma unroll
        for (int a = 0; a < 2; ++a)
#pragma unroll
            for (int b = 0; b < 2; ++b)
#pragma unroll
                for (int m = 0; m < 4; ++m)
#pragma unroll
                    for (int n = 0; n < 2; ++n) acc[a][b][m][n] = (f32x4){0.f, 0.f, 0.f, 0.f};
        cur = nxt; cA = nA; cB = nB; ++ui;
        if constexpr (ALIGN_EPI) { if (wr == 1) PG8_BAR; }
    }
    PG8_WAIT_V(0);
    if constexpr (!ALIGN_EPI) { if (wr == 0) PG8_BAR; }
    PG8_BAR;
#undef PG8_SA
#undef PG8_SB
#undef PG8_STAGE
#undef PG8_LDA
#undef PG8_LDB
#undef PG8_MMA
#undef PG8_WAIT_V
#undef PG8_WAIT_L
#undef PG8_BAR
#undef PG8_SCHED
}

typedef f32x4 Acc[2][2][4][2];
struct PreRs { float r[2][4]; };
struct PreNone { };
__device__ __forceinline__ PreRs load_rs(const float* rs, const Unit& u, int wr, int fr) { PreRs p; const int row0 = u.pm * BM + wr * 64 + fr;
#pragma unroll
    for (int ai = 0; ai < 2; ++ai)
#pragma unroll
        for (int m = 0; m < 4; ++m) p.r[ai][m] = rs[row0 + ai * HALF + m * 16];
    return p; }
__device__ __forceinline__ u32x4 pack8(const f32x4 a, const f32x4 b) { u32x4 w; w.x = cvt_pk_bf16(a[0], a[1]); w.y = cvt_pk_bf16(a[2], a[3]); w.z = cvt_pk_bf16(b[0], b[1]); w.w = cvt_pk_bf16(b[2], b[3]); return w; }

struct EpiInA {
    bf16_t* Z; float* VSS; const float* rs;
    typedef PreRs Pre; __device__ __forceinline__ Pre prefetch(const Unit& u, int wr, int fr) const { return load_rs(rs, u, wr, fr); }
    __device__ __forceinline__ void operator()(const Acc& acc, const Unit& u, int wr, int wc, int fr, int fq, const Pre& pre) const {
        const int row0 = u.pm * BM + wr * 64 + fr, col0 = u.pn * BM + wc * 32 + 8 * fq;
        const bool act = u.pn < 12, isv = (u.pn >= 6) && act;
#pragma unroll
        for (int ai = 0; ai < 2; ++ai)
#pragma unroll
            for (int m = 0; m < 4; ++m) {
                const int row = row0 + ai * HALF + m * 16; bf16_t* rowp = Z + (size_t)row * ZP + col0; float ss = 0.f; const float rsr = pre.r[ai][m];
#pragma unroll
                for (int bj = 0; bj < 2; ++bj) { f32x4 v0 = acc[ai][bj][m][0] * rsr, v1 = acc[ai][bj][m][1] * rsr;
                    if (act) {
#pragma unroll
                        for (int e = 0; e < 4; ++e) { v0[e] = gelu_tanh(v0[e]); v1[e] = gelu_tanh(v1[e]); ss += v0[e] * v0[e] + v1[e] * v1[e]; }
                    } else { v0 = v0 * QSCALE; v1 = v1 * QSCALE; }
                    *(u32x4*)(rowp + bj * HALF) = pack8(v0, v1); }
                if (isv) { ss += __shfl_xor(ss, 16); ss += __shfl_xor(ss, 32); if (fq == 0) VSS[(size_t)row * 24 + (u.pn - 6) * 4 + wc] = ss; }
            }
    }
};
struct EpiMkv {
    float* outf; bf16_t* outb; const float* rs;
    typedef PreRs Pre; __device__ __forceinline__ Pre prefetch(const Unit& u, int wr, int fr) const { return load_rs(rs, u, wr, fr); }
    __device__ __forceinline__ void operator()(const Acc& acc, const Unit& u, int wr, int wc, int fr, int fq, const Pre& pre) const {
        const int row0 = u.pm * BM + wr * 64 + fr, col0 = u.pn * BM + wc * 32 + 8 * fq;
#pragma unroll
        for (int ai = 0; ai < 2; ++ai)
#pragma unroll
            for (int m = 0; m < 4; ++m) { const size_t off = (size_t)(row0 + ai * HALF + m * 16) * NKV + col0; const float rsr = pre.r[ai][m];
#pragma unroll
                for (int bj = 0; bj < 2; ++bj) { const f32x4 v0 = acc[ai][bj][m][0] * rsr, v1 = acc[ai][bj][m][1] * rsr;
                    *(f32x4*)(outf + off + bj * HALF) = v0; *(f32x4*)(outf + off + bj * HALF + 4) = v1; *(u32x4*)(outb + off + bj * HALF) = pack8(v0, v1); } }
    }
};
struct EpiPlain {
    bf16_t* O; int ldc;
    typedef PreNone Pre; __device__ __forceinline__ Pre prefetch(const Unit&, int, int) const { return Pre{}; }
    __device__ __forceinline__ void operator()(const Acc& acc, const Unit& u, int wr, int wc, int fr, int fq, const Pre&) const {
        const int row0 = u.pm * BM + wr * 64 + fr, col0 = u.pn * BM + wc * 32 + 8 * fq;
#pragma unroll
        for (int ai = 0; ai < 2; ++ai)
#pragma unroll
            for (int m = 0; m < 4; ++m) { bf16_t* rowp = O + (size_t)(row0 + ai * HALF + m * 16) * ldc + col0;
#pragma unroll
                for (int bj = 0; bj < 2; ++bj) *(u32x4*)(rowp + bj * HALF) = pack8(acc[ai][bj][m][0], acc[ai][bj][m][1]); }
    }
};
struct EpiSwiglu {
    bf16_t* ACT; const float* rs;
    typedef PreRs Pre; __device__ __forceinline__ Pre prefetch(const Unit& u, int wr, int fr) const { return load_rs(rs, u, wr, fr); }
    __device__ __forceinline__ void operator()(const Acc& acc, const Unit& u, int wr, int wc, int fr, int fq, const Pre& pre) const {
        const int row0 = u.pm * BM + wr * 64 + fr, col0 = u.pn * HALF + wc * 32 + 8 * fq;
#pragma unroll
        for (int ai = 0; ai < 2; ++ai)
#pragma unroll
            for (int m = 0; m < 4; ++m) { f32x4 v0, v1; const float rsr = pre.r[ai][m];
#pragma unroll
                for (int e = 0; e < 4; ++e) { v0[e] = silu_f(acc[ai][0][m][0][e] * rsr) * (acc[ai][1][m][0][e] * rsr); v1[e] = silu_f(acc[ai][0][m][1][e] * rsr) * (acc[ai][1][m][1][e] * rsr); }
                *(u32x4*)(ACT + (size_t)(row0 + ai * HALF + m * 16) * DFF + col0) = pack8(v0, v1); }
    }
};
struct EpiInB {
    bf16_t* Z; const float* rs;
    typedef PreRs Pre; __device__ __forceinline__ Pre prefetch(const Unit& u, int wr, int fr) const { return load_rs(rs, u, wr, fr); }
    __device__ __forceinline__ void operator()(const Acc& acc, const Unit& u, int wr, int wc, int fr, int fq, const Pre& pre) const {
        const int row0 = u.pm * BM + wr * 64 + fr, col0 = u.pn * BM + wc * 32 + 8 * fq;
        const float qs = ((u.pn < 6) || (u.pn >= 18)) ? QSCALE : 1.0f;
#pragma unroll
        for (int ai = 0; ai < 2; ++ai)
#pragma unroll
            for (int m = 0; m < 4; ++m) {
                const int row = row0 + ai * HALF + m * 16; bf16_t* rowp = Z + (size_t)row * ZP + col0; const float rsr = pre.r[ai][m] * qs;
#pragma unroll
                for (int bj = 0; bj < 2; ++bj) *(u32x4*)(rowp + bj * HALF) = pack8(acc[ai][bj][m][0] * rsr, acc[ai][bj][m][1] * rsr);
            }
    }
};
}

__device__ __forceinline__ unsigned f2bf(float f) { unsigned u = __builtin_bit_cast(unsigned, f); return (u + 0x7fffu + ((u >> 16) & 1u)) >> 16; }
__device__ __forceinline__ unsigned pk2(float lo, float hi) { return f2bf(lo) | (f2bf(hi) << 16); }
struct TItem { const float* src; bf16_t* dst; const float* gain; int N, K; };
__device__ __forceinline__ TItem t_make(const float* W, int K, int N, bf16_t* WT, bool upperm, const float* gain, int item) {
    const int nblk = N / 64, kb = item / nblk, nb = item % nblk, k0 = 64 * kb, n0 = 64 * nb;
    int s0 = n0;
    if (upperm) { const int pn = n0 >> 8, j = n0 & 255; s0 = (j < 128) ? (128 * pn + j) : (DFF + 128 * pn + (j - 128)); }
    TItem t; t.src = W + (size_t)k0 * N + s0; t.dst = WT + (size_t)n0 * K + k0; t.gain = gain != nullptr ? gain + k0 : nullptr; t.N = N; t.K = K; return t;
}
__device__ __forceinline__ void t_load(const TItem& t, int lane, f32x4 (&v)[16]) {
    const float* src = t.src + (size_t)(lane >> 4) * t.N + 4 * (lane & 15);
#pragma unroll
    for (int i = 0; i < 16; ++i) v[i] = __builtin_nontemporal_load((const f32x4*)(src + (size_t)(4 * i) * t.N));
}
__device__ __forceinline__ void t_store(const TItem& t, LAS float* scr, int lane, const f32x4 (&v)[16]) {
    const int lr = lane >> 4, lc = lane & 15;
#pragma unroll
    for (int i = 0; i < 16; ++i) { const int k = 4 * i + lr; const float gk = t.gain != nullptr ? t.gain[k] : 1.0f;
        *(LAS f32x4*)(scr + k * 64 + ((4 * lc) ^ (4 * (k >> 3)))) = v[i] * gk; }
    asm volatile("s_waitcnt lgkmcnt(0)" ::: "memory");
    const int c = lane & 7;
#pragma unroll
    for (int j = 0; j < 8; ++j) { const int n = (lane >> 3) + 8 * j; const LAS float* sp = scr + (8 * c) * 64 + (n ^ (4 * c));
        u32x4 o; o.x = cvt_pk_bf16(sp[0 * 64], sp[1 * 64]); o.y = cvt_pk_bf16(sp[2 * 64], sp[3 * 64]); o.z = cvt_pk_bf16(sp[4 * 64], sp[5 * 64]); o.w = cvt_pk_bf16(sp[6 * 64], sp[7 * 64]);
        __builtin_nontemporal_store(o, (u32x4*)(t.dst + (size_t)n * t.K + 8 * c)); }
    asm volatile("s_waitcnt lgkmcnt(0)" ::: "memory");
}
template <int MODE>
__device__ __forceinline__ void norm_row(const float* basef, bf16_t* yb, const bf16_t* o, const float* gpost, float* rs_out, float* yout, int lane) {
    f32x4 y[8];
    if (MODE == 0 || MODE == 1) {
#pragma unroll
        for (int j = 0; j < 8; ++j) y[j] = *(const f32x4*)(basef + 4 * (lane + 64 * j));
    } else {
#pragma unroll
        for (int j = 0; j < 8; ++j) { const u32x2 w = *(const u32x2*)(yb + 4 * (lane + 64 * j)); y[j] = (f32x4){bf_lo(w.x), bf_hi(w.x), bf_lo(w.y), bf_hi(w.y)}; }
    }
    if (MODE != 0) {
        f32x4 ov[8]; float ss = 0.f;
#pragma unroll
        for (int j = 0; j < 8; ++j) { const u32x2 w = *(const u32x2*)(o + 4 * (lane + 64 * j)); ov[j] = (f32x4){bf_lo(w.x), bf_hi(w.x), bf_lo(w.y), bf_hi(w.y)};
            ss += (ov[j][0] * ov[j][0] + ov[j][1] * ov[j][1]) + (ov[j][2] * ov[j][2] + ov[j][3] * ov[j][3]); }
        const float rstd = 1.0f / sqrtf(wave_sum(ss) * (1.0f / DM) + EPS);
#pragma unroll
        for (int j = 0; j < 8; ++j) { const f32x4 g = *(const f32x4*)(gpost + 4 * (lane + 64 * j)); y[j] = y[j] + ov[j] * rstd * g; }
    }
    if (MODE == 3) {
#pragma unroll
        for (int j = 0; j < 8; ++j) *(f32x4*)(yout + 4 * (lane + 64 * j)) = y[j];
    } else {
        float ss = 0.f;
#pragma unroll
        for (int j = 0; j < 8; ++j) { ss += (y[j][0] * y[j][0] + y[j][1] * y[j][1]) + (y[j][2] * y[j][2] + y[j][3] * y[j][3]);
            u32x2 w; w.x = cvt_pk_bf16(y[j][0], y[j][1]); w.y = cvt_pk_bf16(y[j][2], y[j][3]); *(u32x2*)(yb + 4 * (lane + 64 * j)) = w; }
        ss = wave_sum(ss);
        if (lane == 0) *rs_out = 1.0f / sqrtf(ss * (1.0f / DM) + EPS);
    }
}

struct NormRaw { u32x2 yb[8]; u32x2 ob[8]; };
__device__ __forceinline__ void norm_load(const bf16_t* yb, const bf16_t* o, int lane, NormRaw& R) {
#pragma unroll
    for (int j = 0; j < 8; ++j) { R.yb[j] = *(const u32x2*)(yb + 4 * (lane + 64 * j)); R.ob[j] = *(const u32x2*)(o + 4 * (lane + 64 * j)); }
}
template <bool FINAL>
__device__ __forceinline__ void norm_finish(const NormRaw& R, bf16_t* yb, const float* gpost, float* rs_out, float* yout, int lane) {
    f32x4 y[8], ov[8]; float ss = 0.f;
#pragma unroll
    for (int j = 0; j < 8; ++j) { y[j] = (f32x4){bf_lo(R.yb[j].x), bf_hi(R.yb[j].x), bf_lo(R.yb[j].y), bf_hi(R.yb[j].y)}; ov[j] = (f32x4){bf_lo(R.ob[j].x), bf_hi(R.ob[j].x), bf_lo(R.ob[j].y), bf_hi(R.ob[j].y)};
        ss += (ov[j][0] * ov[j][0] + ov[j][1] * ov[j][1]) + (ov[j][2] * ov[j][2] + ov[j][3] * ov[j][3]); }
    const float rstd = 1.0f / sqrtf(wave_sum(ss) * (1.0f / DM) + EPS);
#pragma unroll
    for (int j = 0; j < 8; ++j) { const f32x4 g = *(const f32x4*)(gpost + 4 * (lane + 64 * j)); y[j] = y[j] + ov[j] * rstd * g; }
    if (FINAL) {
#pragma unroll
        for (int j = 0; j < 8; ++j) *(f32x4*)(yout + 4 * (lane + 64 * j)) = y[j];
    } else {
        float s2 = 0.f;
#pragma unroll
        for (int j = 0; j < 8; ++j) { s2 += (y[j][0] * y[j][0] + y[j][1] * y[j][1]) + (y[j][2] * y[j][2] + y[j][3] * y[j][3]);
            u32x2 w; w.x = cvt_pk_bf16(y[j][0], y[j][1]); w.y = cvt_pk_bf16(y[j][2], y[j][3]); *(u32x2*)(yb + 4 * (lane + 64 * j)) = w; }
        s2 = wave_sum(s2);
        if (lane == 0) *rs_out = 1.0f / sqrtf(s2 * (1.0f / DM) + EPS);
    }
}

struct KvDesc { const bf16_t* kbase; const bf16_t* vbase; long row0, rstep, pitch; int key_lo; };
__device__ __forceinline__ void kv_issue(const KvDesc& d, int tid, u32x4 (&kk)[8], u32x4 (&vv)[8]) {
    const int srow = tid >> 4, sch = tid & 15;
#pragma unroll
    for (int i = 0; i < 8; ++i) { const int row = srow + 32 * i, rowc = row < d.key_lo ? d.key_lo : row;
        const size_t e = (size_t)(d.row0 + (long)rowc * d.rstep) * d.pitch + sch * 8; kk[i] = *(const u32x4*)(d.kbase + e); vv[i] = *(const u32x4*)(d.vbase + e); }
}
__device__ __forceinline__ void kv_commit(LAS unsigned char* lds, int tid, int key_lo, const u32x4 (&kk)[8], const u32x4 (&vv)[8]) {
    const unsigned sb = off_b(tid >> 4, tid & 15); const int srow = tid >> 4; const u32x4 z = (u32x4){0u, 0u, 0u, 0u};
#pragma unroll
    for (int i = 0; i < 8; ++i) { const bool ok = (srow + 32 * i) >= key_lo; *(LAS u32x4*)(lds + sb + 8192 * i) = ok ? kk[i] : z; *(LAS u32x4*)(lds + 65536 + sb + 8192 * i) = ok ? vv[i] : z; }
}
template <bool BANDED>
__device__ __forceinline__ void attn_compute(LAS unsigned char* lds, int lane, int w, const bf16x8 (&qf)[4], int key_lo, bf16_t* orow, float* lsep, const LAS float* btab) {
    const int fr = lane & 15, fq = lane >> 4;
    LAS unsigned char* Kimg = lds; LAS unsigned char* Vimg = lds + 65536;
    constexpr int NBLK = BANDED ? 5 : 8;
    const int blk0 = BANDED ? (w >> 1) : 0;
    const int qi = 16 * w + fr;
    unsigned kb[2][4];
#pragma unroll
    for (int e = 0; e < 2; ++e)
#pragma unroll
        for (int kk = 0; kk < 4; ++kk) kb[e][kk] = off_b(8 * (fr >> 2) + 4 * e + (fr & 3), 4 * kk + fq);
    LAS unsigned char* Kb = Kimg + 8192 * blk0; LAS unsigned char* Vb = Vimg + 8192 * blk0;
    f32x4 s[2 * NBLK];
#pragma unroll
    for (int nt = 0; nt < 2 * NBLK; ++nt) s[nt] = (f32x4){0.f, 0.f, 0.f, 0.f};
    constexpr int TB = BANDED ? 2 * NBLK : NBLK;
#pragma unroll
    for (int t0 = 0; t0 < 2 * NBLK; t0 += TB)
#pragma unroll
        for (int kk = 0; kk < 4; ++kk) { bf16x8 kf[TB];
#pragma unroll
            for (int i = 0; i < TB; ++i) { const int nt = t0 + i; kf[i] = *(const LAS bf16x8*)(Kb + kb[nt & 1][kk] + 8192 * (nt >> 1)); }
            __builtin_amdgcn_sched_barrier(0);
#pragma unroll
            for (int i = 0; i < TB; ++i) s[t0 + i] = __builtin_amdgcn_mfma_f32_16x16x32_bf16(kf[i], qf[kk], s[t0 + i], 0, 0, 0);
            __builtin_amdgcn_sched_barrier(0); }
    float mx = -1e30f;
    const LAS float* bp = btab + (128 + 16 * (w & 1) + fr - 8 * fq + 32 - 135);
    const int cmin = BANDED ? (key_lo > 0 ? (128 + 16 * (w & 1) + fr - 8 * fq) - qi : -1000) : 0;
#pragma unroll
    for (int nt = 0; nt < 2 * NBLK; ++nt)
#pragma unroll
        for (int r = 0; r < 4; ++r) { float x = s[nt][r];
            if (BANDED) { const int c = 32 * (nt >> 1) + 4 * (nt & 1) + r; x = x + bp[135 - c]; x = (c >= cmin) ? x : -1e30f; s[nt][r] = x; }
            mx = fmaxf(mx, x); }
    mx = fmaxf(mx, __shfl_xor(mx, 16)); mx = fmaxf(mx, __shfl_xor(mx, 32));
    float l = 0.f;
#pragma unroll
    for (int nt = 0; nt < 2 * NBLK; ++nt)
#pragma unroll
        for (int r = 0; r < 4; ++r) { const float p = __builtin_amdgcn_exp2f(s[nt][r] - mx); s[nt][r] = p; l += p; }
    l += __shfl_xor(l, 16); l += __shfl_xor(l, 32);
    bf16x8 pf[NBLK];
#pragma unroll
    for (int ks = 0; ks < NBLK; ++ks) pf[ks] = __builtin_bit_cast(bf16x8, pg8::pack8(s[2 * ks], s[2 * ks + 1]));
    const float inv_l = 1.0f / l;
    unsigned vb[8][2];
#pragma unroll
    for (int ct = 0; ct < 8; ++ct) { vb[ct][0] = tr16_addr(lane, ct, 0, 0); vb[ct][1] = tr16_addr(lane, ct, 0, 1); }
    f32x4 oa[8];
#pragma unroll
    for (int ct = 0; ct < 8; ++ct) oa[ct] = (f32x4){0.f, 0.f, 0.f, 0.f};
#pragma unroll
    for (int ks = 0; ks < NBLK; ++ks) { s16x4 vlo[8], vhi[8];
#pragma unroll
        for (int ct = 0; ct < 8; ++ct) { vlo[ct] = tr_read(Vb + vb[ct][0] + 8192 * ks); vhi[ct] = tr_read(Vb + vb[ct][1] + 8192 * ks); }
        __builtin_amdgcn_sched_barrier(0);
#pragma unroll
        for (int ct = 0; ct < 8; ++ct) { const bf16x8 vf = (bf16x8){vlo[ct][0], vlo[ct][1], vlo[ct][2], vlo[ct][3], vhi[ct][0], vhi[ct][1], vhi[ct][2], vhi[ct][3]};
            oa[ct] = __builtin_amdgcn_mfma_f32_16x16x32_bf16(vf, pf[ks], oa[ct], 0, 0, 0); }
        __builtin_amdgcn_sched_barrier(0); }
#pragma unroll
    for (int ct = 0; ct < 8; ++ct) { u32x2 wv; wv.x = cvt_pk_bf16(oa[ct][0] * inv_l, oa[ct][1] * inv_l); wv.y = cvt_pk_bf16(oa[ct][2] * inv_l, oa[ct][3] * inv_l);
        *(u32x2*)(orow + 16 * ct) = wv; }
    if (lsep != nullptr && fq == 0) *lsep = (mx + __builtin_amdgcn_logf(l)) * LN2;
}
struct QoDesc { const bf16_t* qbase; long row0, rstep; bf16_t* obase; float* lsebase; int banded, dil, head; };

struct GateRegs { u32x4 v[2][6]; f32x4 wq[8]; f32x4 vs[3]; float gvl; };
__device__ __forceinline__ void gate_issue(int tid, int b, int chunk, int g, const bf16_t* Z, const float* VSS, const float* w_s, const float* g_v, GateRegs& R) {
    const int lane = tid & 63, w = __builtin_amdgcn_readfirstlane(tid >> 6), fr = lane & 15, fq = lane >> 4;
    const int tok0 = b * SEQ + chunk * 128;
    {
        const int r0 = tid >> 3, c0 = tid & 7; const bf16_t* gp = Z + (size_t)(tok0 + r0) * ZP + MIXW + g * 384 + c0 * 8;
#pragma unroll
        for (int i2 = 0; i2 < 2; ++i2)
#pragma unroll
            for (int i = 0; i < 6; ++i) R.v[i2][i] = *(const u32x4*)(gp + (size_t)i2 * 64 * ZP + 64 * i); }
    { const float* wp = w_s + (size_t)g * 16384 + (16 * w + fr) * 128 + 8 * fq;
#pragma unroll
      for (int kk = 0; kk < 4; ++kk) { R.wq[2 * kk] = *(const f32x4*)(wp + 32 * kk); R.wq[2 * kk + 1] = *(const f32x4*)(wp + 32 * kk + 4); } }
    { const float* p = VSS + (size_t)(tok0 + (tid & 127)) * 24 + 12 * ((tid >> 7) & 1);
#pragma unroll
      for (int i = 0; i < 3; ++i) R.vs[i] = *(const f32x4*)(p + 4 * i); }
    R.gvl = g_v[g * 384 + (tid < 384 ? tid : tid - 384)];
}
__device__ __forceinline__ void gate_run(LAS unsigned char* lds, int tid, int b, int chunk, int g, const GateRegs& R, const bf16_t* Z, const float* b_s, bf16_t* MIX) {
    const int lane = tid & 63, w = __builtin_amdgcn_readfirstlane(tid >> 6), fr = lane & 15, fq = lane >> 4;
    const int tok0 = b * SEQ + chunk * 128, i = 16 * w + fr;
    LAS float* rs = (LAS float*)(lds + LDS_TAB); LAS float* gvs = rs + 128;
    const size_t tokrow = (size_t)(tok0 + i);
    __syncthreads();
    const bf16_t* up = Z + tokrow * ZP + g * 384 + 4 * fq;
    u32x2 ucur[8];
    const float bs = b_s[g * 128 + i];
    {
        const int r0 = tid >> 3, c0 = tid & 7; const unsigned gsb0 = off_b(r0, c0), gsb1 = off_b(r0, c0 + 8);
#pragma unroll
        for (int i2 = 0; i2 < 2; ++i2)
#pragma unroll
            for (int k = 0; k < 6; ++k) *(LAS u32x4*)(lds + (k >> 1) * 32768 + ((k & 1) ? gsb1 : gsb0) + 16384 * i2) = R.v[i2][k]; }
    { float ssum = 0.f;
#pragma unroll
      for (int k = 0; k < 3; ++k) ssum += (R.vs[k][0] + R.vs[k][1]) + (R.vs[k][2] + R.vs[k][3]);
      if (tid < 256) rs[512 + tid] = ssum;
      if (tid < 384) gvs[tid] = R.gvl; }
    __syncthreads();
    if (tid < 128) rs[tid] = 1.0f / sqrtf((rs[512 + tid] + rs[512 + 128 + tid]) * (1.0f / MIXW) + EPS);
    __syncthreads();
    bf16x8 wf[4];
#pragma unroll
    for (int kk = 0; kk < 4; ++kk) { const int j0 = 32 * kk + 8 * fq;
        const f32x4 r0 = *(const LAS f32x4*)(rs + j0), r1 = *(const LAS f32x4*)(rs + j0 + 4);
        const f32x4 a = R.wq[2 * kk], c = R.wq[2 * kk + 1];
        float v[8] = {a[0] * r0[0], a[1] * r0[1], a[2] * r0[2], a[3] * r0[3], c[0] * r1[0], c[1] * r1[1], c[2] * r1[2], c[3] * r1[3]};
#pragma unroll
        for (int jj = 0; jj < 8; ++jj) v[jj] = (j0 + jj <= i) ? v[jj] : 0.f;
        u32x4 pk; pk.x = cvt_pk_bf16(v[0], v[1]); pk.y = cvt_pk_bf16(v[2], v[3]); pk.z = cvt_pk_bf16(v[4], v[5]); pk.w = cvt_pk_bf16(v[6], v[7]);
        wf[kk] = __builtin_bit_cast(bf16x8, pk); }
    unsigned vb[8][2];
#pragma unroll
    for (int c = 0; c < 8; ++c) { vb[c][0] = tr16_addr(lane, c, 0, 0); vb[c][1] = tr16_addr(lane, c, 0, 1); }
#pragma unroll
    for (int sub = 0; sub < 3; ++sub) { LAS unsigned char* img = lds + sub * 32768;
#pragma unroll
        for (int c = 0; c < 8; ++c) ucur[c] = *(const u32x2*)(up + sub * 128 + 16 * c);
#pragma unroll
        for (int c = 0; c < 8; ++c) { f32x4 a = (f32x4){0.f, 0.f, 0.f, 0.f};
#pragma unroll
            for (int kk = 0; kk < 4; ++kk) if (kk <= (w >> 1)) {
                const s16x4 lo = tr_read(img + vb[c][0] + 8192 * kk), hi = tr_read(img + vb[c][1] + 8192 * kk);
                const bf16x8 vf = (bf16x8){lo[0], lo[1], lo[2], lo[3], hi[0], hi[1], hi[2], hi[3]};
                a = __builtin_amdgcn_mfma_f32_16x16x32_bf16(vf, wf[kk], a, 0, 0, 0); }
            const int col = g * 384 + sub * 128 + 16 * c + 4 * fq;
            const f32x4 gv = *(const LAS f32x4*)(gvs + sub * 128 + 16 * c + 4 * fq);
            const u32x2 uw = ucur[c];
            const float o0 = bf_lo(uw.x) * (a[0] * gv[0] + bs), o1 = bf_hi(uw.x) * (a[1] * gv[1] + bs), o2 = bf_lo(uw.y) * (a[2] * gv[2] + bs), o3 = bf_hi(uw.y) * (a[3] * gv[3] + bs);
            u32x2 ov; ov.x = cvt_pk_bf16(o0, o1); ov.y = cvt_pk_bf16(o2, o3);
            *(u32x2*)(MIX + tokrow * DM + col) = ov; } }
}

template <int MODE, int K>
__device__ __forceinline__ void sample_gemv(LAS unsigned char* lds, const bf16_t* A, int a_pitch, const bf16_t* Wt, int N, int first, int stride,
                                            float* outf, bf16_t* outb, int ldb, float* win, const float* rs, const float* slse = nullptr) {
    int tid = threadIdx.x; asm volatile("" : "+v"(tid));
    const int lane = tid & 63, w = __builtin_amdgcn_readfirstlane(tid >> 6), fr = lane & 15, fq = lane >> 4;
    const int ntiles = (MODE == 2) ? N / 32 : N / 16;
    LAS float* red = (LAS float*)lds;
    constexpr int kw = K / 8;
    LAS float* atab = (LAS float*)(lds + LDS_TAB + 4096);
    if (slse != nullptr) {
        __syncthreads();
        if (tid < 128) { const int srow = tid >> 4, H = tid & 15; float al = 1.0f;
            if (H < 12) { const int hl = H & 3; const float l0 = slse[srow * 12 + hl], l1 = slse[srow * 12 + 4 + hl], l2 = slse[srow * 12 + 8 + hl], mm = fmaxf(l0, fmaxf(l1, l2));
                const float e0 = __expf(l0 - mm), e1 = __expf(l1 - mm), e2 = __expf(l2 - mm); al = (H < 4 ? e0 : (H < 8 ? e1 : e2)) / (e0 + e1 + e2); }
            atab[tid] = al; }
        __syncthreads();
    }
    for (int tile = first; tile < ntiles; tile += stride) {
        const int nrow0 = (MODE == 2) ? 256 * (tile >> 3) + 16 * (tile & 7) : 16 * tile;
        const bf16_t* ap = A + (size_t)(fr & 7) * a_pitch + w * kw + 8 * fq;
        const bf16_t* bp = Wt + (size_t)(nrow0 + fr) * K + w * kw + 8 * fq;
        f32x4 acc = (f32x4){0.f, 0.f, 0.f, 0.f}, acc2 = (f32x4){0.f, 0.f, 0.f, 0.f};
#pragma unroll
        for (int ks = 0; ks < kw / 32; ++ks) { bf16x8 a = *(const bf16x8*)(ap + 32 * ks); const bf16x8 b = *(const bf16x8*)(bp + 32 * ks);
            if (MODE == 1 && slse != nullptr) { const float al = atab[(fr & 7) * 16 + ((w * kw + 32 * ks + 8 * fq) >> 7)]; const u32x4 aw = __builtin_bit_cast(u32x4, a); u32x4 o;
                o.x = cvt_pk_bf16(bf_lo(aw.x) * al, bf_hi(aw.x) * al); o.y = cvt_pk_bf16(bf_lo(aw.y) * al, bf_hi(aw.y) * al);
                o.z = cvt_pk_bf16(bf_lo(aw.z) * al, bf_hi(aw.z) * al); o.w = cvt_pk_bf16(bf_lo(aw.w) * al, bf_hi(aw.w) * al); a = __builtin_bit_cast(bf16x8, o); }
            acc = __builtin_amdgcn_mfma_f32_16x16x32_bf16(b, a, acc, 0, 0, 0);
            if (MODE == 2) { const bf16x8 b2 = *(const bf16x8*)(bp + (size_t)128 * K + 32 * ks); acc2 = __builtin_amdgcn_mfma_f32_16x16x32_bf16(b2, a, acc2, 0, 0, 0); } }
        __syncthreads();
        *(LAS f32x4*)(red + (w * 16 + fr) * 16 + 4 * fq) = acc;
        if (MODE == 2) *(LAS f32x4*)(red + 2048 + (w * 16 + fr) * 16 + 4 * fq) = acc2;
        __syncthreads();
        if (tid < 128) { const int s = tid >> 4, c = tid & 15; float v = 0.f, v2 = 0.f;
#pragma unroll
            for (int ww = 0; ww < 8; ++ww) { v += red[(ww * 16 + s) * 16 + c]; if (MODE == 2) v2 += red[2048 + (ww * 16 + s) * 16 + c]; }
            if (rs != nullptr) { const float rsr = rs[s]; v *= rsr; v2 *= rsr; }
            if (MODE == 0) { const int n = nrow0 + c; outf[(size_t)s * ZP + n] = v;
                if (win != nullptr && n >= 1536 && n < 4608) { const int kv = n >= 3072 ? 1 : 0, cc = n - 1536 - 1536 * kv, grp = cc >> 9;
                    win[(size_t)grp * 8192 + (size_t)(s * 2 + kv) * 512 + (cc & 511)] = v; } }
            else if (MODE == 1) { outb[(size_t)s * ldb + nrow0 + c] = (bf16_t)f2bf(v); }
            else { outb[(size_t)s * ldb + 128 * (tile >> 3) + 16 * (tile & 7) + c] = (bf16_t)f2bf(silu_f(v) * v2); } }
    }
}

template <class KF, class VF>
__device__ __forceinline__ float sample_attend(LAS float* scr, const float* qv, int nkeys, KF kf, VF vf, const LAS float* btab, LAS float* o_out) {
    int tid = threadIdx.x; asm volatile("" : "+v"(tid));
    const int lane = tid & 63, w = __builtin_amdgcn_readfirstlane(tid >> 6);
    LAS float* sc = scr; LAS float* part = scr + 320; LAS float* stat = scr + 320 + 2048;
    {
        const int key = tid >> 1, half = tid & 1; float d = 0.f;
        if (key < nkeys) { const float* kp = kf(key) + 64 * half; const float* qp = qv + 64 * half; f32x4 k4[16];
#pragma unroll
            for (int i = 0; i < 16; ++i) k4[i] = *(const f32x4*)(kp + 4 * i);
#pragma unroll
            for (int i = 0; i < 16; ++i) { const f32x4 q4 = *(const f32x4*)(qp + 4 * i); d += (k4[i][0] * q4[0] + k4[i][1] * q4[1]) + (k4[i][2] * q4[2] + k4[i][3] * q4[3]); } }
        d += __shfl_xor(d, 1);
        if (half == 0 && key < nkeys) sc[key] = d * QSCALE + (btab != nullptr ? btab[key] : 0.f);
    }
    __syncthreads();
    if (w == 0) { float m = -1e30f; for (int j = lane; j < nkeys; j += 64) m = fmaxf(m, sc[j]); m = wave_max(m);
        float l = 0.f; for (int j = lane; j < nkeys; j += 64) { const float p = __builtin_amdgcn_exp2f(sc[j] - m); sc[j] = p; l += p; } l = wave_sum(l);
        if (lane == 0) { stat[0] = m; stat[1] = l; } }
    __syncthreads();
    {
        const int kg = tid >> 5, d4 = 4 * (tid & 31); f32x4 v4[16]; f32x4 a = (f32x4){0.f, 0.f, 0.f, 0.f};
#pragma unroll
        for (int i = 0; i < 16; ++i) { const int j = kg + 16 * i; v4[i] = (f32x4){0.f, 0.f, 0.f, 0.f}; if (j < nkeys) v4[i] = *(const f32x4*)(vf(j) + d4); }
#pragma unroll
        for (int i = 0; i < 16; ++i) { const int j = kg + 16 * i; const float pj = j < nkeys ? sc[j] : 0.f; a = a + v4[i] * pj; }
        *(LAS f32x4*)(part + kg * 128 + d4) = a; }
    __syncthreads();
    const float m = stat[0], l = stat[1];
    if (tid < 128) { float a = 0.f;
#pragma unroll
        for (int g = 0; g < 16; ++g) a += part[g * 128 + tid];
        o_out[tid] = a / l; }
    __syncthreads();
    return (m + __builtin_amdgcn_logf(l)) * LN2;
}

#define XB_TMO      128
#define XB_XCNT(j)  (256  + 64 * (j))
#define XB_XSUB(j)  (1280 + 64 * (j))
#define XB_XGEN(j)  (2304 + 64 * (j))
#define XB_TOP      3328
#define XB_TOPGEN   3392
#define XCD_BAR_WORDS 3456
#define XB_SPIN_CAP (1u << 18)
__device__ __forceinline__ unsigned xb_ld(unsigned* p)              { return __hip_atomic_load(p, __ATOMIC_RELAXED, __HIP_MEMORY_SCOPE_AGENT); }
__device__ __forceinline__ unsigned xb_add(unsigned* p, unsigned v) { return __hip_atomic_fetch_add(p, v, __ATOMIC_RELAXED, __HIP_MEMORY_SCOPE_AGENT); }
__device__ __forceinline__ unsigned xb_xcc_id() { return (unsigned)__builtin_amdgcn_s_getreg((3 << 11) | 20) & 0xFu; }
#define XB_SPIN(cond, bar) do { unsigned _sp = 0; while (cond) { __builtin_amdgcn_s_sleep(1); \
    if ((++_sp & 255u) == 0u) { if (xb_ld(&(bar)[XB_TMO])) break; if (_sp > XB_SPIN_CAP) { atomicAdd(&(bar)[XB_TMO], 1u); break; } } } } while (0)
struct XcdBarrier { unsigned* bar; unsigned x; volatile LAS unsigned* st; };
__device__ __forceinline__ XcdBarrier xcd_barrier_post(unsigned* bar, volatile LAS unsigned* st) {
    XcdBarrier b; b.bar = bar; b.x = xb_xcc_id(); b.st = st;
    if (threadIdx.x == 0) (void)xb_add(&bar[XB_XCNT(b.x)], 1u);
    return b;
}
__device__ __forceinline__ void xcd_barrier_complete(unsigned* bar, unsigned x, unsigned& nloc, unsigned& nx) {
    const unsigned G = gridDim.x * gridDim.y * gridDim.z;
    unsigned sum, cnt, mine, sp = 0u;
    for (;;) {
        sum = 0u; cnt = 0u; mine = 0u;
#pragma unroll
        for (unsigned j = 0; j < 16; ++j) { const unsigned c = xb_ld(&bar[XB_XCNT(j)]); sum += c; cnt += (c > 0u) ? 1u : 0u; mine = (j == x) ? c : mine; }
        if (sum == G) break;
        __builtin_amdgcn_s_sleep(1);
        if ((++sp & 255u) == 0u) { if (xb_ld(&bar[XB_TMO])) break; if (sp > XB_SPIN_CAP) { atomicAdd(&bar[XB_TMO], 1u); break; } }
    }
    nloc = mine > 0u ? mine : 1u; nx = cnt > 0u ? cnt : 1u;
}
__device__ __forceinline__ void xcd_barrier(const XcdBarrier& b) {
    asm volatile("s_waitcnt vmcnt(0)" ::: "memory");
    __syncthreads();
    if (threadIdx.x == 0) {
        unsigned* bar = b.bar;
        __builtin_amdgcn_s_waitcnt(0);
        unsigned nloc = b.st[0], nx = b.st[1];
        if (nloc == 0u) { xcd_barrier_complete(bar, b.x, nloc, nx); b.st[0] = nloc; b.st[1] = nx; }
        const unsigned old = xb_add(&bar[XB_XSUB(b.x)], 1u);
        const unsigned gen = old / nloc;
        if (old + 1u == (gen + 1u) * nloc) {
            __builtin_amdgcn_fence(__ATOMIC_RELEASE, "agent");
            asm volatile("s_waitcnt vmcnt(0)" ::: "memory");
            const unsigned og = xb_add(&bar[XB_TOP], 1u);
            const unsigned tg = og / nx;
            if (og + 1u == (tg + 1u) * nx) xb_add(&bar[XB_TOPGEN], 1u);
            else XB_SPIN(xb_ld(&bar[XB_TOPGEN]) == tg, bar);
            __builtin_amdgcn_fence(__ATOMIC_ACQUIRE, "agent");
            xb_add(&bar[XB_XGEN(b.x)], 1u);
            asm volatile("s_waitcnt vmcnt(0)" ::: "memory");
        } else {
            XB_SPIN(xb_ld(&bar[XB_XGEN(b.x)]) == gen, bar);
            __builtin_amdgcn_fence(__ATOMIC_ACQUIRE, "agent");
            asm volatile("s_waitcnt vmcnt(0)" ::: "memory");
        }
    }
    __syncthreads();
}

struct Args { const float* in[22]; float* out; unsigned char* ws; };
typedef const Args __attribute__((address_space(4)))* ArgsP;
__device__ __forceinline__ ArgsP args_ptr() { ArgsP p = (ArgsP)__builtin_amdgcn_kernarg_segment_ptr(); asm volatile("" : "+s"(p)); return p; }
#define WSP(T, off) ((T*)(A->ws + (off)))

constexpr int I_MKV = 32 * 16, I_INA = 32 * 56, I_INB = 32 * 80, I_OUT = 32 * 32, I_UP = 32 * 176, I_DN = 88 * 32, DN_P = 850, DN_A = 1170;
__device__ __forceinline__ int conv_count(int list) { return list == 0 ? 2 * I_MKV + I_INA + I_UP + DN_P : (list == 1 ? I_OUT + (DN_A - DN_P) : (list == 2 ? (I_DN - DN_A) + I_INB + I_OUT : (list == 3 ? I_UP : I_DN))); }
__device__ __forceinline__ TItem conv_item(ArgsP A, int list, int r) {
    const float* n_mix_pre = A->in[8]; const float* n_ffn_pre = A->in[10]; const float* n_mem = A->in[12]; const float* w_mem_kv = A->in[13]; const float* w_in_a = A->in[14];
    const float* w_in_b = A->in[18]; const float* w_out = A->in[19]; const float* w_up = A->in[20]; const float* w_dn = A->in[21];
    bf16_t* Wmkv = WSP(bf16_t, WS_WMKV); bf16_t* Wina = WSP(bf16_t, WS_WINA); bf16_t* Winb = WSP(bf16_t, WS_WINB); bf16_t* Wout = WSP(bf16_t, WS_WOUT);
    bf16_t* Wup = WSP(bf16_t, WS_WUP); bf16_t* Wdn = WSP(bf16_t, WS_WDN);
    if (list == 0) {
        if (r < 2 * I_MKV) { const int l = r / I_MKV; return t_make(w_mem_kv + (size_t)l * DM * NKV, DM, NKV, Wmkv + (size_t)l * NKV * DM, false, n_mem + l * DM, r % I_MKV); } r -= 2 * I_MKV;
        if (r < I_INA) return t_make(w_in_a, DM, NA, Wina, false, n_mix_pre, r); r -= I_INA;
        if (r < I_UP) return t_make(w_up, DM, NUP, Wup, true, n_ffn_pre, r); r -= I_UP;
        return t_make(w_dn, DFF, DM, Wdn, false, nullptr, r);
    } else if (list == 1) {
        if (r < I_OUT) return t_make(w_out, DM, DM, Wout, false, nullptr, r); r -= I_OUT;
        return t_make(w_dn, DFF, DM, Wdn, false, nullptr, DN_P + r);
    } else if (list == 2) {
        if (r < I_DN - DN_A) return t_make(w_dn, DFF, DM, Wdn, false, nullptr, DN_A + r); r -= I_DN - DN_A;
        if (r < I_INB) return t_make(w_in_b, DM, NB, Winb, false, n_mix_pre + DM, r); r -= I_INB;
        return t_make(w_out + (size_t)DM * DM, DM, DM, Wout + (size_t)DM * DM, false, nullptr, r);
    } else if (list == 3) {
        return t_make(w_up + (size_t)DM * NUP, DM, NUP, Wup + (size_t)NUP * DM, true, n_ffn_pre + DM, r);
    } else {
        return t_make(w_dn + (size_t)DFF * DM, DFF, DM, Wdn + (size_t)DM * DFF, false, nullptr, r);
    }
}
__device__ __forceinline__ void convert_list(LAS unsigned char* lds, ArgsP A, int list, int worker, int nworkers, int wave, int lane) {
    const int n = conv_count(list);
    LAS float* scr = (LAS float*)(lds + wave * 16384);
    int it = worker;
    if (it >= n) return;
    TItem cur = conv_item(A, list, it);
    f32x4 va[16], vb[16];
    t_load(cur, lane, va);
    for (;;) {
        const int itn = it + nworkers; const bool hn = itn < n;
        TItem nxt = cur;
        if (hn) { nxt = conv_item(A, list, itn); t_load(nxt, lane, vb); }
        t_store(cur, scr, lane, va);
        if (!hn) break;
#pragma unroll
        for (int i = 0; i < 16; ++i) va[i] = vb[i];
        cur = nxt; it = itn;
    }
}
__device__ __forceinline__ void convert_tail(LAS unsigned char* lds, ArgsP A, int list, int first_idle) {
    const int bid = blockIdx.x, G = gridDim.x;
    if (bid < first_idle || first_idle >= G) return;
    int tid = threadIdx.x; asm volatile("" : "+v"(tid));
    const int lane = tid & 63, wave = __builtin_amdgcn_readfirstlane(tid >> 6);
    __syncthreads();
    convert_list(lds, A, list, (bid - first_idle) * 8 + wave, (G - first_idle) * 8, wave, lane);
}
__device__ __forceinline__ void phase_prologue(LAS unsigned char* lds) {
    ArgsP A = args_ptr();
    int tid = threadIdx.x; asm volatile("" : "+v"(tid));
    const int lane = tid & 63, wave = __builtin_amdgcn_readfirstlane(tid >> 6), gw = blockIdx.x * 8 + wave, NGW = gridDim.x * 8;
    const float* x_prompt = A->in[0]; const float* x_sample = A->in[1]; const float* mem_prompt = A->in[2];
    bf16_t* YB = WSP(bf16_t, WS_HN); bf16_t* HM = WSP(bf16_t, WS_HM);
    float* RS = WSP(float, WS_RS); float* RSM = RS + 16384;
    convert_list(lds, A, 0, gw, NGW, wave, lane);
    if (gridDim.x != 256) { convert_list(lds, A, 1, gw, NGW, wave, lane); convert_list(lds, A, 2, gw, NGW, wave, lane); convert_list(lds, A, 3, gw, NGW, wave, lane); convert_list(lds, A, 4, gw, NGW, wave, lane); }
    for (int m = gw; m < 512 + TP + TSMP; m += NGW) {
        if (m < 512) norm_row<0>(mem_prompt + (size_t)m * DM, HM + (size_t)m * DM, nullptr, nullptr, RSM + m, nullptr, lane);
        else { const int r = m - 512; const float* xr = r < TP ? x_prompt + (size_t)r * DM : x_sample + (size_t)(r - TP) * DM;
            norm_row<0>(xr, YB + (size_t)r * DM, nullptr, nullptr, RS + r, nullptr, lane); }
    }
}

__device__ __forceinline__ void phase_in_a(LAS unsigned char* lds) {
    ArgsP A = args_ptr(); const int bid = blockIdx.x, G = gridDim.x;
    bf16_t* HN = WSP(bf16_t, WS_HN);
    { pg8::Gemm g{HN, WSP(bf16_t, WS_WINA), TP, NA, DM}; pg8::StaticOrder S; S.init(TP, NA, G, bid); pg8::EpiInA E{WSP(bf16_t, WS_Z), WSP(float, WS_VSS), WSP(float, WS_RS)};
      pg8::gemm_phase<pg8::EpiInA, true, true>(lds, g, S, E); }
#pragma unroll 1
    for (int l = 0; l < 2; ++l) { pg8::Gemm g{WSP(bf16_t, WS_HM), WSP(bf16_t, WS_WMKV) + (size_t)l * NKV * DM, 512, NKV, DM};
      pg8::StaticOrder S; S.init(512, NKV, G, (bid - 192 - 8 * l + 2 * G) % G);
      pg8::EpiMkv E{A->out + OUT_MKV + (size_t)l * 512 * NKV, WSP(bf16_t, WS_MKV) + (size_t)l * 512 * NKV, WSP(float, WS_RS) + 16384};
      pg8::gemm_phase<pg8::EpiMkv, true, true>(lds, g, S, E); }
    if (G == 256) { if (bid >= 208) sample_gemv<0, DM>(lds, HN + (size_t)TP * DM, DM, WSP(bf16_t, WS_WINA), NA, G - 1 - bid, 48, WSP(float, WS_ZS), nullptr, 0, nullptr, WSP(float, WS_RS) + TP); }
    else sample_gemv<0, DM>(lds, HN + (size_t)TP * DM, DM, WSP(bf16_t, WS_WINA), NA, G - 1 - bid, G, WSP(float, WS_ZS), nullptr, 0, nullptr, WSP(float, WS_RS) + TP);
    if (G == 256) convert_tail(lds, A, 1, 208);
}
__device__ __forceinline__ void phase_in_b(LAS unsigned char* lds) {
    ArgsP A = args_ptr(); const int bid = blockIdx.x, G = gridDim.x;
    bf16_t* HN = WSP(bf16_t, WS_HN); float* out = A->out;
    pg8::Gemm g{HN, WSP(bf16_t, WS_WINB), TP, NB, DM}; pg8::StaticOrder S; S.init(TP, NB, G, bid);
    pg8::EpiInB E{WSP(bf16_t, WS_Z), WSP(float, WS_RS)};
    pg8::gemm_phase<pg8::EpiInB, true, true>(lds, g, S, E);
    sample_gemv<0, DM>(lds, HN + (size_t)TP * DM, DM, WSP(bf16_t, WS_WINB), NB, G - 1 - bid, G, WSP(float, WS_ZS), nullptr, 0, out + OUT_W128S, WSP(float, WS_RS) + TP);
    if (G == 256) convert_tail(lds, A, 3, 128);
}
__device__ __forceinline__ void mem_unit_desc(ArgsP A, int v, int layer, KvDesc& kd, QoDesc& qd) {
    const int b = v >> 7, h = (v >> 5) & 3, qb = v & 31, qmoff = layer == 0 ? 3072 : 4608;
    const bf16_t* mkv = WSP(bf16_t, WS_MKV) + (size_t)layer * 512 * NKV + h * 128;
    kd.kbase = mkv; kd.vbase = mkv + 512; kd.row0 = (long)b * 256; kd.rstep = 1; kd.pitch = NKV; kd.key_lo = 0;
    qd.qbase = WSP(bf16_t, WS_Z) + qmoff + h * 128; qd.row0 = (long)b * SEQ + 128 * qb; qd.rstep = 1; qd.obase = WSP(bf16_t, WS_MIX) + MIXW + h * 128; qd.lsebase = nullptr;
    qd.banded = 0; qd.dil = 1; qd.head = 0;
}
__device__ __forceinline__ void swa_unit_desc(ArgsP A, int u, KvDesc& kd, QoDesc& qd) {
    const int b = u / 384, H = (u % 384) >> 5, idx = u & 31, g = H >> 2, dil = 1 << (2 * g), r = idx & (dil - 1), qb = idx >> (2 * g);
    const bf16_t* Z = WSP(bf16_t, WS_Z);
    kd.kbase = Z + MIXW + H * 128; kd.vbase = Z + 2 * MIXW + H * 128; kd.row0 = (long)b * SEQ + (long)(128 * qb - 128) * dil + r; kd.rstep = dil; kd.pitch = ZP; kd.key_lo = qb == 0 ? 128 : 0;
    qd.qbase = Z + H * 128; qd.row0 = (long)b * SEQ + (long)(128 * qb) * dil + r; qd.rstep = dil; qd.obase = WSP(bf16_t, WS_MIX) + H * 128; qd.lsebase = WSP(float, WS_LSE) + H;
    qd.banded = 1; qd.dil = dil; qd.head = H;
}
__device__ __forceinline__ void q_issue(const QoDesc& qd, int tid, bf16x8 (&qf)[4]) {
    const int lane = tid & 63, w = __builtin_amdgcn_readfirstlane(tid >> 6), fr = lane & 15, fq = lane >> 4;
    const long qrow = qd.row0 + (long)(16 * w + fr) * qd.rstep;
    const bf16_t* qp = qd.qbase + (size_t)qrow * ZP + 8 * fq;
#pragma unroll
    for (int k4 = 0; k4 < 4; ++k4) qf[k4] = *(const bf16x8*)(qp + 32 * k4);
}
__device__ __forceinline__ void build_bias_tables(LAS unsigned char* lds, int tid, const float* rel_bias) {
    LAS float* tab = (LAS float*)(lds + LDS_TAB); LAS float* rb = tab + 12 * 192;
    if (tid < 384) rb[tid] = rel_bias[tid] * LOG2E;
    __syncthreads();
    for (int i = tid; i < 12 * 192; i += 512) { const int H = i / 192, j = i % 192 - 32, dil = 1 << (2 * (H >> 2));
        tab[i] = (j >= 0 && j <= 128) ? rb[t5_bucket(j * dil) * 12 + H] : -1e30f; }
}
__device__ __forceinline__ void attn_unit_run(LAS unsigned char* lds, int tid, const QoDesc& qd, int key_lo, u32x4 (&kk)[8], u32x4 (&vv)[8], bf16x8 (&qf)[4],
                                              const bool has_next, const KvDesc nxt, const QoDesc nxtq) {
    const int lane = tid & 63, w = __builtin_amdgcn_readfirstlane(tid >> 6), fr = lane & 15, fq = lane >> 4;
    __syncthreads();
    kv_commit(lds, tid, key_lo, kk, vv);
    bf16x8 qc[4];
#pragma unroll
    for (int k4 = 0; k4 < 4; ++k4) qc[k4] = qf[k4];
    if (has_next) { kv_issue(nxt, tid, kk, vv); q_issue(nxtq, tid, qf); }
    __syncthreads();
    const long qrow = qd.row0 + (long)(16 * w + fr) * qd.rstep;
    bf16_t* orow = qd.obase + (size_t)qrow * DM + 4 * fq;
    float* lsep = qd.lsebase != nullptr ? qd.lsebase + (size_t)qrow * 12 : nullptr;
    if (qd.banded) attn_compute<true>(lds, lane, w, qc, key_lo, orow, lsep, (const LAS float*)(lds + LDS_TAB) + qd.head * 192);
    else attn_compute<false>(lds, lane, w, qc, key_lo, orow, lsep, (const LAS float*)(lds + LDS_TAB));
}
__device__ __forceinline__ void sample_mem_attn(LAS unsigned char* lds, int layer) {
    ArgsP A = args_ptr(); const int bid = blockIdx.x, G = gridDim.x;
    int tid = threadIdx.x; asm volatile("" : "+v"(tid));
    const int qmoff = layer == 0 ? 3072 : 4608;
    for (int it = G - 1 - 96 - bid; it >= 0 && it < 32; it += G) {
        const int s = it >> 2, h = it & 3;
        LAS float* scr = (LAS float*)lds; LAS float* og = scr + 2560;
        __syncthreads();
        const float* cm = A->in[3] + (size_t)(layer * 8 + s) * 256 * 1024;
        auto kf = [=](int j) -> const float* { return cm + (size_t)j * 1024 + h * 128; };
        auto vf = [=](int j) -> const float* { return cm + (size_t)j * 1024 + 512 + h * 128; };
        (void)sample_attend(scr, WSP(float, WS_ZS) + (size_t)s * ZP + qmoff + h * 128, 256, kf, vf, (const LAS float*)nullptr, og);
        if (tid < 128) WSP(bf16_t, WS_MIX)[(size_t)(TP + s) * DM + MIXW + h * 128 + tid] = (bf16_t)f2bf(og[tid]);
        __syncthreads();
    }
}
__device__ __forceinline__ void phase_mix_a(LAS unsigned char* lds) {
    ArgsP A = args_ptr(); const int bid = blockIdx.x, G = gridDim.x;
    int tid = threadIdx.x; asm volatile("" : "+v"(tid));
    const int lane = tid & 63, wave = __builtin_amdgcn_readfirstlane(tid >> 6);
    const float* ZS = WSP(float, WS_ZS); const float* n_v_a = A->in[15]; const float* w_sp = A->in[16]; const float* b_sp = A->in[17]; bf16_t* MIX = WSP(bf16_t, WS_MIX); float* out = A->out;
    for (int it = G - 1 - bid; it < TSMP; it += G) {
        LAS float* red = (LAS float*)lds; const int s = it;
        __syncthreads();
        float vv[3], uu[3], ss = 0.f;
#pragma unroll
        for (int i = 0; i < 3; ++i) { const int c = tid + 512 * i; uu[i] = gelu_tanh(ZS[(size_t)s * ZP + c]); vv[i] = gelu_tanh(ZS[(size_t)s * ZP + MIXW + c]); ss += vv[i] * vv[i]; }
        ss = wave_sum(ss); if (lane == 0) red[wave] = ss;
        __syncthreads();
        float tot = 0.f;
#pragma unroll
        for (int i = 0; i < 8; ++i) tot += red[i];
        const float rstd = 1.0f / sqrtf(tot * (1.0f / MIXW) + EPS);
#pragma unroll
        for (int i = 0; i < 3; ++i) { const int c = tid + 512 * i, g = c / 384; const float vn = vv[i] * rstd * n_v_a[c];
            out[OUT_CHV + (size_t)s * MIXW + c] = vn;
            const float sg = w_sp[(size_t)g * 16384] * vn + b_sp[g * 128];
            MIX[(size_t)(TP + s) * DM + c] = (bf16_t)f2bf(uu[i] * sg); }
    }
    sample_mem_attn(lds, 0);
    __syncthreads();
    for (int u = bid; u < 256; u += G) {
        KvDesc kd; QoDesc qd; mem_unit_desc(A, u, 0, kd, qd);
        u32x4 kk[8], vv[8]; bf16x8 qf[4]; GateRegs R;
        gate_issue(tid, u >> 7, (u >> 2) & 31, u & 3, WSP(bf16_t, WS_Z), WSP(float, WS_VSS), A->in[16], A->in[15], R);
        kv_issue(kd, tid, kk, vv); q_issue(qd, tid, qf);
        gate_run(lds, tid, u >> 7, (u >> 2) & 31, u & 3, R, WSP(bf16_t, WS_Z), A->in[17], WSP(bf16_t, WS_MIX));
        attn_unit_run(lds, tid, qd, kd.key_lo, kk, vv, qf, false, kd, qd);
    }
}
__device__ __forceinline__ void phase_mix_b1(LAS unsigned char* lds) {
    ArgsP A = args_ptr(); const int bid = blockIdx.x, G = gridDim.x;
    int tid = threadIdx.x; asm volatile("" : "+v"(tid));
    KvDesc kd{}, kn{}; QoDesc qd{}, qn{};
    u32x4 kk[8], vv[8]; bf16x8 qf[4];
    int u = bid;
    if (u < 1024) { if (u < 768) swa_unit_desc(A, u, kd, qd); else mem_unit_desc(A, u - 768, 1, kd, qd); kv_issue(kd, tid, kk, vv); q_issue(qd, tid, qf); }
    build_bias_tables(lds, tid, A->in[7]);
#pragma unroll 1
    for (; u < 1024; u += G) {
        const int un = u + G; const bool has_next = un < 1024;
        if (has_next) { if (un < 768) swa_unit_desc(A, un, kn, qn); else mem_unit_desc(A, un - 768, 1, kn, qn); }
        attn_unit_run(lds, tid, qd, kd.key_lo, kk, vv, qf, has_next, kn, qn);
        kd = kn; qd = qn;
    }
}
__device__ __forceinline__ void phase_mix_b2(LAS unsigned char* lds) {
    ArgsP A = args_ptr(); const int bid = blockIdx.x, G = gridDim.x;
    int tid = threadIdx.x; asm volatile("" : "+v"(tid));
    const int lane = tid & 63, wave = __builtin_amdgcn_readfirstlane(tid >> 6), gw = bid * 8 + wave, NGW = G * 8;
    bf16_t* MIX = WSP(bf16_t, WS_MIX); const float* LSE = WSP(float, WS_LSE);
    for (int row = gw; row < TP; row += NGW) {
        const float* lp = LSE + (size_t)row * 12;
#pragma unroll
        for (int i = 0; i < 3; ++i) { const int col = 8 * (lane + 64 * i), H = col >> 7, g = H >> 2, hl = H & 3;
            const float l0 = lp[hl], l1 = lp[4 + hl], l2 = lp[8 + hl], mm = fmaxf(l0, fmaxf(l1, l2));
            const float e0 = __expf(l0 - mm), e1 = __expf(l1 - mm), e2 = __expf(l2 - mm);
            const float al = (g == 0 ? e0 : (g == 1 ? e1 : e2)) / (e0 + e1 + e2);
            u32x4 wv = *(u32x4*)(MIX + (size_t)row * DM + col);
            wv.x = cvt_pk_bf16(bf_lo(wv.x) * al, bf_hi(wv.x) * al); wv.y = cvt_pk_bf16(bf_lo(wv.y) * al, bf_hi(wv.y) * al);
            wv.z = cvt_pk_bf16(bf_lo(wv.z) * al, bf_hi(wv.z) * al); wv.w = cvt_pk_bf16(bf_lo(wv.w) * al, bf_hi(wv.w) * al);
            *(u32x4*)(MIX + (size_t)row * DM + col) = wv; }
    }
    { const int nw = G > 128 ? G - 128 : G, wk = bid < nw ? bid : -1;
      if (wk >= 0) { const bf16_t* Z = WSP(bf16_t, WS_Z); float* o0 = A->out + OUT_W128P;
        for (int i = wk * 512 + tid; i < 688128; i += nw * 512) {
            const int g = i < 32768 ? 0 : (i < 163840 ? 1 : 2), ig = i - (g == 0 ? 0 : (g == 1 ? 32768 : 163840)), W = 128 << (2 * g);
            const int c8 = ig & 63, kv = (ig >> 6) & 1, tr = (ig >> 7) & (W - 1), b = (ig >> 7) / W;
            const u32x4 wv = *(const u32x4*)(Z + (size_t)(b * SEQ + (SEQ - W) + tr) * ZP + MIXW + kv * MIXW + g * 512 + c8 * 8);
            float* dst = o0 + (size_t)2048 * ((W - 128) / 3) + (size_t)ig * 8;
            *(f32x4*)dst = (f32x4){bf_lo(wv.x), bf_hi(wv.x), bf_lo(wv.y), bf_hi(wv.y)}; *(f32x4*)(dst + 4) = (f32x4){bf_lo(wv.z), bf_hi(wv.z), bf_lo(wv.w), bf_hi(wv.w)}; } } }
    const float* rel_bias = A->in[7]; const float* ZS = WSP(float, WS_ZS);
    for (int it = G - 1 - bid; it < 96; it += G) {
        const int s = it / 12, H = it % 12, g = H >> 2, hl = H & 3, dil = 1 << (2 * g), W = 128 << (2 * g);
        LAS float* scr = (LAS float*)lds; LAS float* btab = scr + 2400; LAS float* og = scr + 2560;
        __syncthreads();
        for (int j = tid; j <= 128; j += 512) btab[j] = rel_bias[t5_bucket(j * dil) * 12 + H] * LOG2E;
        __syncthreads();
        const float* cw = A->in[4 + g];
        const float* zrow = ZS + (size_t)s * ZP;
        auto kf = [=](int j) -> const float* { return j == 0 ? zrow + MIXW + H * 128 : cw + ((size_t)(s * W + (W - j * dil)) * 2 + 0) * 512 + hl * 128; };
        auto vf = [=](int j) -> const float* { return j == 0 ? zrow + 2 * MIXW + H * 128 : cw + ((size_t)(s * W + (W - j * dil)) * 2 + 1) * 512 + hl * 128; };
        const float lg = sample_attend(scr, zrow + H * 128, 129, kf, vf, btab, og);
        if (tid < 128) MIX[(size_t)(TP + s) * DM + H * 128 + tid] = (bf16_t)f2bf(og[tid]);
        if (tid == 0) WSP(float, WS_LSE)[(size_t)TP * 12 + s * 12 + H] = lg;
        __syncthreads();
    }
    sample_mem_attn(lds, 1);
}
__device__ __forceinline__ void phase_out(LAS unsigned char* lds, int layer) {
    ArgsP A = args_ptr(); const int bid = blockIdx.x, G = gridDim.x;
    bf16_t* MIX = WSP(bf16_t, WS_MIX); bf16_t* OB = WSP(bf16_t, WS_O); const bf16_t* W = WSP(bf16_t, WS_WOUT) + (size_t)layer * DM * DM;
    pg8::Gemm g{MIX, W, TP, DM, DM}; pg8::StaticOrder S; S.init(TP, DM, G, bid); pg8::EpiPlain E{OB, DM};
    pg8::gemm_phase<pg8::EpiPlain, false, true>(lds, g, S, E);
    sample_gemv<1, DM>(lds, MIX + (size_t)TP * DM, DM, W, DM, G - 1 - bid, G, nullptr, OB + (size_t)TP * DM, DM, nullptr, nullptr, layer == 1 ? WSP(float, WS_LSE) + (size_t)TP * 12 : nullptr);
}
__device__ __forceinline__ void phase_up(LAS unsigned char* lds, int layer) {
    ArgsP A = args_ptr(); const int bid = blockIdx.x, G = gridDim.x;
    bf16_t* HN = WSP(bf16_t, WS_HN); bf16_t* ACT = WSP(bf16_t, WS_ACT); const bf16_t* W = WSP(bf16_t, WS_WUP) + (size_t)layer * NUP * DM;
    pg8::Gemm g{HN, W, TP, NUP, DM}; pg8::StaticOrder S; S.init(TP, NUP, G, bid); pg8::EpiSwiglu E{ACT, WSP(float, WS_RS)};
    pg8::gemm_phase<pg8::EpiSwiglu, true, true>(lds, g, S, E);
    if (G == 256 && layer == 1) { if (bid >= 128) sample_gemv<2, DM>(lds, HN + (size_t)TP * DM, DM, W, NUP, G - 1 - bid, 128, nullptr, ACT + (size_t)TP * DFF, DFF, nullptr, WSP(float, WS_RS) + TP); }
    else sample_gemv<2, DM>(lds, HN + (size_t)TP * DM, DM, W, NUP, G - 1 - bid, G, nullptr, ACT + (size_t)TP * DFF, DFF, nullptr, WSP(float, WS_RS) + TP);
    if (G == 256) convert_tail(lds, A, layer == 0 ? 2 : 4, 128);
}
__device__ __forceinline__ void phase_down(LAS unsigned char* lds, int layer) {
    ArgsP A = args_ptr(); const int bid = blockIdx.x, G = gridDim.x;
    bf16_t* ACT = WSP(bf16_t, WS_ACT); bf16_t* OB = WSP(bf16_t, WS_O); const bf16_t* W = WSP(bf16_t, WS_WDN) + (size_t)layer * DM * DFF;
    pg8::Gemm g{ACT, W, TP, DM, DFF}; pg8::StaticOrder S; S.init(TP, DM, G, bid); pg8::EpiPlain E{OB, DM};
    pg8::gemm_phase<pg8::EpiPlain, false, true>(lds, g, S, E);
    sample_gemv<1, DFF>(lds, ACT + (size_t)TP * DFF, DFF, W, DM, G - 1 - bid, G, nullptr, OB + (size_t)TP * DM, DM, nullptr, nullptr);
}
__device__ __forceinline__ void phase_norm(int which) {
    ArgsP A = args_ptr();
    int tid = threadIdx.x; asm volatile("" : "+v"(tid));
    const int lane = tid & 63, wave = __builtin_amdgcn_readfirstlane(tid >> 6), gw = blockIdx.x * 8 + wave, NGW = gridDim.x * 8;
    const int layer = which >> 1;
    float* Y = A->out + OUT_Y; const bf16_t* OB = WSP(bf16_t, WS_O); bf16_t* YB = WSP(bf16_t, WS_HN); float* RS = WSP(float, WS_RS);
    const float* gpost = ((which & 1) ? A->in[11] : A->in[9]) + layer * DM;
    int r = gw;
    if (r >= TP + TSMP) return;
    NormRaw cur, nxt;
    norm_load(YB + (size_t)r * DM, OB + (size_t)r * DM, lane, cur);
    for (;;) {
        const int rn = r + NGW; const bool hn = rn < TP + TSMP;
        if (hn) norm_load(YB + (size_t)rn * DM, OB + (size_t)rn * DM, lane, nxt);
        if (which == 3) norm_finish<true>(cur, nullptr, gpost, nullptr, Y + (size_t)r * DM, lane);
        else norm_finish<false>(cur, YB + (size_t)r * DM, gpost, RS + r, nullptr, lane);
        if (!hn) break;
        cur = nxt; r = rn;
    }
}

__global__ void __launch_bounds__(512, 2) fwd_megakernel(Args args) {
    extern __shared__ __attribute__((aligned(16))) unsigned char lds_raw[];
    LAS unsigned char* lds = (LAS unsigned char*)lds_raw;
    volatile LAS unsigned* bst = (volatile LAS unsigned*)(lds + LDS_BYTES - 64);
    if (threadIdx.x < 16) bst[threadIdx.x] = 0u;
    __syncthreads();
    const XcdBarrier bar = xcd_barrier_post((unsigned*)args.ws, bst);
#define GRID_SYNC() xcd_barrier(bar)
    phase_prologue(lds);
    GRID_SYNC();
    phase_in_a(lds);
    GRID_SYNC();
    phase_mix_a(lds);
    GRID_SYNC();
    phase_out(lds, 0);
    GRID_SYNC();
    phase_norm(0);
    GRID_SYNC();
    phase_up(lds, 0);
    GRID_SYNC();
    phase_down(lds, 0);
    GRID_SYNC();
    phase_norm(1);
    GRID_SYNC();
    phase_in_b(lds);
    GRID_SYNC();
    phase_mix_b1(lds);
    GRID_SYNC();
    phase_mix_b2(lds);
    GRID_SYNC();
    phase_out(lds, 1);
    GRID_SYNC();
    phase_norm(2);
    GRID_SYNC();
    phase_up(lds, 1);
    GRID_SYNC();
    phase_down(lds, 1);
    GRID_SYNC();
    phase_norm(3);
#undef GRID_SYNC
}

extern "C" void kernel_launch(void* const* d_in, const int* in_sizes, int n_in, void* d_out, int out_size, void* d_ws, size_t ws_size, hipStream_t stream) {
    static int grid = 0;
    if (grid == 0) {
        if (n_in != 22 || (size_t)out_size != OUT_TOTAL || ws_size < WS_END) { fprintf(stderr, "kernel_launch: unexpected shapes (n_in %d, out %d, ws %zu)\n", n_in, out_size, ws_size); grid = -1; return; }
        int dev = 0, cus = 0, per_cu = 0;
        if (hipGetDevice(&dev) != hipSuccess || hipDeviceGetAttribute(&cus, hipDeviceAttributeMultiprocessorCount, dev) != hipSuccess) { grid = -1; return; }
        if (hipFuncSetAttribute((const void*)fwd_megakernel, hipFuncAttributeMaxDynamicSharedMemorySize, LDS_BYTES) != hipSuccess) { fprintf(stderr, "kernel_launch: hipFuncSetAttribute failed\n"); grid = -1; return; }
        if (hipOccupancyMaxActiveBlocksPerMultiprocessor(&per_cu, (const void*)fwd_megakernel, 512, LDS_BYTES) != hipSuccess || per_cu < 1) { fprintf(stderr, "kernel_launch: occupancy query says %d\n", per_cu); (void)hipGetLastError(); per_cu = 1; }
        grid = cus;
    }
    if (grid < 0) return;
    if (hipMemsetAsync(d_ws, 0, 16384, stream) != hipSuccess) { fprintf(stderr, "kernel_launch: memset of the barrier words failed\n"); return; }
    Args a{};
    for (int i = 0; i < 22; ++i) a.in[i] = (const float*)d_in[i];
    a.out = (float*)d_out; a.ws = (unsigned char*)d_ws;
    void* kargs[] = {&a};
    hipError_t e = hipLaunchCooperativeKernel((const void*)fwd_megakernel, dim3(grid), dim3(512), kargs, LDS_BYTES, stream);
    if (e != hipSuccess) fprintf(stderr, "kernel_launch: cooperative launch failed: %s (grid %d)\n", hipGetErrorString(e), grid);
}
```

```cpp
#include <hip/hip_runtime.h>
#include <cstdio>
#include <cstdint>

#define LAS __attribute__((address_space(3)))
typedef unsigned short bf16_t;
typedef short bf16x8 __attribute__((ext_vector_type(8)));
typedef short s16x4 __attribute__((ext_vector_type(4)));
typedef float f32x4 __attribute__((ext_vector_type(4)));
typedef float f32x2 __attribute__((ext_vector_type(2)));
typedef unsigned u32x4 __attribute__((ext_vector_type(4)));
typedef unsigned u32x2 __attribute__((ext_vector_type(2)));

constexpr int DM = 2048, TP = 8192, TSMP = 8, TROWS = TP + 16, SEQ = 4096;
constexpr int MIXW = 1536, NA = 3584, NB = 5120, DFF = 5632, NUP = 11264, NKV = 1024;
constexpr int ZP = 5120;
constexpr float EPS = 1e-6f;
constexpr float LOG2E = 1.4426950408889634f, LN2 = 0.6931471805599453f;
constexpr float QSCALE = 0.08838834764831845f * 1.4426950408889634f;

constexpr size_t MiB = 1u << 20;
constexpr size_t WS_WMKV = 1 * MiB;
constexpr size_t WS_WINA = 9 * MiB;
constexpr size_t WS_WINB = 23 * MiB;
constexpr size_t WS_WOUT = 43 * MiB;
constexpr size_t WS_WUP = 59 * MiB;
constexpr size_t WS_WDN = 147 * MiB;
constexpr size_t WS_HN = 191 * MiB;
constexpr size_t WS_HM = 224 * MiB;
constexpr size_t WS_MKV = 228 * MiB;
constexpr size_t WS_Z = 230 * MiB;
constexpr size_t WS_ZS = 310 * MiB;
constexpr size_t WS_VSS = 311 * MiB;
constexpr size_t WS_MIX = 312 * MiB;
constexpr size_t WS_LSE = 345 * MiB;
constexpr size_t WS_RS = 345 * MiB + 512 * 1024;
constexpr size_t WS_O = 346 * MiB;
constexpr size_t WS_ACT = 230 * MiB;
constexpr size_t WS_END = 468 * MiB;

constexpr size_t OUT_Y = 0;
constexpr size_t OUT_MKV = 16793600;
constexpr size_t OUT_CHV = OUT_MKV + 1048576;
constexpr size_t OUT_W128P = OUT_CHV + 12288;
constexpr size_t OUT_W512P = OUT_W128P + 262144;
constexpr size_t OUT_W2048P = OUT_W512P + 1048576;
constexpr size_t OUT_W128S = OUT_W2048P + 4194304;
constexpr size_t OUT_W512S = OUT_W128S + 8192;
constexpr size_t OUT_W2048S = OUT_W512S + 8192;
constexpr size_t OUT_TOTAL = OUT_W2048S + 8192;

constexpr int LDS_BYTES = 147456;
constexpr int LDS_TAB = 131072;

__device__ __forceinline__ unsigned cvt_pk_bf16(float lo, float hi) { unsigned r; asm volatile("v_cvt_pk_bf16_f32 %0, %1, %2" : "=v"(r) : "v"(lo), "v"(hi)); return r; }
__device__ __forceinline__ float bf_lo(unsigned w) { return __uint_as_float(w << 16); }
__device__ __forceinline__ float bf_hi(unsigned w) { return __uint_as_float(w & 0xffff0000u); }
__device__ __forceinline__ float wave_sum(float v) {
#pragma unroll
    for (int o = 1; o < 64; o <<= 1) v += __shfl_xor(v, o);
    return v;
}
__device__ __forceinline__ float wave_max(float v) {
#pragma unroll
    for (int o = 1; o < 64; o <<= 1) v = fmaxf(v, __shfl_xor(v, o));
    return v;
}
__device__ __forceinline__ float gelu_tanh(float x) {
    const float t = x * x;
    const float u2 = x * (1.5957691216057308f + 0.07135481627260024f * t);
    const float e = __builtin_amdgcn_exp2f(-LOG2E * u2);
    return x * __builtin_amdgcn_rcpf(1.0f + e);
}
__device__ __forceinline__ float silu_f(float x) {
    const float e = __builtin_amdgcn_exp2f(-LOG2E * x);
    return x * __builtin_amdgcn_rcpf(1.0f + e);
}
__device__ __forceinline__ int t5_bucket(int d) {
    if (d < 16) return d;
    int b = 16;
    b += (d >= 22); b += (d >= 30); b += (d >= 40); b += (d >= 54); b += (d >= 73); b += (d >= 99); b += (d >= 134); b += (d >= 182);
    b += (d >= 246); b += (d >= 332); b += (d >= 450); b += (d >= 609); b += (d >= 825); b += (d >= 1117); b += (d >= 1513);
    return b;
}
__device__ __forceinline__ unsigned off_b(unsigned row, unsigned ch) { return 256u * row + 16u * (ch ^ (((row & 3) << 2) | ((row >> 2) & 3))); }
__device__ __forceinline__ unsigned tr16_addr(unsigned lane, unsigned c, unsigned ks, unsigned t) {
    const unsigned g = lane >> 4, q = (lane & 15) >> 2, p = lane & 3;
    return off_b(32 * ks + 8 * g + 4 * t + q, 2 * c + (p >> 1)) + 8 * (p & 1);
}
typedef short v4i16_t __attribute__((ext_vector_type(4)));
__device__ __forceinline__ s16x4 tr_read(LAS unsigned char* p) { return __builtin_bit_cast(s16x4, __builtin_amdgcn_ds_read_tr16_b64_v4i16((LAS v4i16_t*)p)); }

namespace pg8 {
constexpr int BM = 256, BK = 64, HALF = 128, HTB = HALF * BK * 2, STAGE_BYTES = 8 * HTB, NXCD = 8, WGM = 4;
__host__ __device__ __forceinline__ int lds_byte(int r, int c) { const int st = (r >> 4) * 2 + (c >> 5), rr = r & 15, cc = c & 31, ob = rr * 64 + cc * 2; return st * 1024 + (ob ^ (((ob >> 9) & 1) << 5)); }
__host__ __device__ __forceinline__ void stage_rc(int b, int& R, int& C) { const int st = b / 1024, sb = b % 1024, swz = sb ^ (((sb >> 9) & 1) << 5); R = (st >> 1) * 16 + swz / 64; C = (st & 1) * 32 + (swz % 64) / 2; }
__host__ __device__ __forceinline__ int perm32(int rho) { const int n = rho >> 4, i = rho & 15; return 8 * (i >> 2) + 4 * n + (i & 3); }

struct Unit { int pm, pn; };
struct Gemm { const bf16_t* A; const bf16_t* Bt; int M, N, K; };

struct StaticOrder {
    int nM, nN, nwg, G, c;
    __host__ __device__ void init(int M, int N, int G_, int c_) { nM = M / BM; nN = N / BM; nwg = nM * nN; G = G_; c = c_; }
    __host__ __device__ bool next(int i, Unit& u) const {
        const long L = (long)i * G + c; if (L >= nwg) return false;
        int wgid = (int)L; { const int q = nwg / NXCD, r = nwg % NXCD, xcd = wgid % NXCD, off = wgid / NXCD; wgid = (xcd < r ? xcd * (q + 1) : r * (q + 1) + (xcd - r) * q) + off; }
        const int nig = WGM * nN, gid = wgid / nig, fm = gid * WGM, gsz = (nM - fm) < WGM ? (nM - fm) : WGM;
        u.pm = fm + ((wgid % nig) % gsz); u.pn = (wgid % nig) / gsz; return true;
    }
};

template <class Epi, bool ALIGN_EPI, bool SP2>
__device__ __forceinline__ void gemm_phase(LAS unsigned char* lds, const Gemm g, const StaticOrder& S, const Epi& E) {
    int tid = threadIdx.x; asm volatile("" : "+v"(tid));
    const int wid = __builtin_amdgcn_readfirstlane(tid >> 6), lane = tid & 63, wr = wid >> 2, wc = wid & 3, fr = lane & 15, fq = lane >> 4;
    const int K = g.K, nt = K / BK;
    unsigned voffA[2], voffB[2];
#pragma unroll
    for (int i = 0; i < 2; ++i) { int R, C; stage_rc(tid * 16 + i * 8192, R, C); const int Rb = (R & ~31) + perm32(R & 31);
        voffA[i] = (unsigned)(R * K + C) * 2u; voffB[i] = (unsigned)(Rb * K + C) * 2u; }
    const size_t kstep = (size_t)(BK * 2);
    const size_t hstep = (size_t)HALF * K * 2;
    const size_t tstep = 2 * hstep;
    const unsigned ldsw = (unsigned)wid * 1024u;
    const int aoff = lds_byte(wr * 64 + fr, fq * 8), boff = lds_byte(wc * 32 + fr, fq * 8);
#define PG8_SA(b, h) (((b) * 2 + (h)) * HTB)
#define PG8_SB(b, h) ((4 + (b) * 2 + (h)) * HTB)
#define PG8_STAGE(bufoff, gbase, voff) do { _Pragma("unroll") for (int _i = 0; _i < 2; ++_i) \
        __builtin_amdgcn_global_load_lds((const unsigned*)((const char*)(gbase) + (voff)[_i]), (LAS unsigned*)(lds + (bufoff) + ldsw + _i * 8192), 16, 0, 0); } while (0)
#define PG8_LDA(dst, b, h) do { _Pragma("unroll") for (int m = 0; m < 4; ++m) _Pragma("unroll") for (int k = 0; k < 2; ++k) dst[m][k] = *(const LAS bf16x8*)(lds + PG8_SA(b, h) + aoff + m * 2048 + k * 1024); } while (0)
#define PG8_LDB(dst, b, h) do { _Pragma("unroll") for (int n = 0; n < 2; ++n) _Pragma("unroll") for (int k = 0; k < 2; ++k) dst[n][k] = *(const LAS bf16x8*)(lds + PG8_SB(b, h) + boff + n * 2048 + k * 1024); } while (0)
#define PG8_MMA(ai, bj, At, Bt) do { __builtin_amdgcn_s_setprio(1); _Pragma("unroll") for (int m = 0; m < 4; ++m) _Pragma("unroll") for (int n = 0; n < 2; ++n) _Pragma("unroll") for (int k = 0; k < 2; ++k) \
        acc[ai][bj][m][n] = __builtin_amdgcn_mfma_f32_16x16x32_bf16(Bt[n][k], At[m][k], acc[ai][bj][m][n], 0, 0, 0); __builtin_amdgcn_s_setprio(0); } while (0)
#define PG8_WAIT_V(n) asm volatile("s_waitcnt vmcnt(" #n ")" ::: "memory")
#define PG8_WAIT_L(n) asm volatile("s_waitcnt lgkmcnt(" #n ")" ::: "memory")
#define PG8_BAR __builtin_amdgcn_s_barrier()
#define PG8_SCHED __builtin_amdgcn_sched_barrier(0)
    Unit cur, nxt; int ui = 0;
    if (!S.next(0, cur)) return;
    f32x4 acc[2][2][4][2];
#pragma unroll
    for (int a = 0; a < 2; ++a)
#pragma unroll
        for (int b = 0; b < 2; ++b)
#pragma unroll
            for (int m = 0; m < 4; ++m)
#pragma unroll
                for (int n = 0; n < 2; ++n) acc[a][b][m][n] = (f32x4){0.f, 0.f, 0.f, 0.f};
    bf16x8 At[4][2], B0[2][2], B1[2][2];
    const char* cA = (const char*)g.A + (size_t)cur.pm * tstep; const char* cB = (const char*)g.Bt + (size_t)cur.pn * tstep;
    if constexpr (SP2) {
        PG8_STAGE(PG8_SB(0, 0), cB, voffB); PG8_STAGE(PG8_SB(0, 1), cB + hstep, voffB); PG8_STAGE(PG8_SA(0, 0), cA, voffA); PG8_STAGE(PG8_SA(0, 1), cA + hstep, voffA);
        if (wr == 1) PG8_BAR;
        PG8_WAIT_V(2); PG8_BAR;
        PG8_STAGE(PG8_SB(1, 0), cB + kstep, voffB); PG8_STAGE(PG8_SA(1, 0), cA + kstep, voffA); PG8_STAGE(PG8_SB(1, 1), cB + hstep + kstep, voffB);
        PG8_WAIT_V(6); PG8_BAR;
    } else {
        PG8_STAGE(PG8_SB(0, 0), cB, voffB); PG8_STAGE(PG8_SA(0, 0), cA, voffA); PG8_STAGE(PG8_SB(0, 1), cB + hstep, voffB); PG8_STAGE(PG8_SA(0, 1), cA + hstep, voffA);
        if (wr == 1) PG8_BAR;
        PG8_WAIT_V(4); PG8_BAR;
        PG8_STAGE(PG8_SB(1, 0), cB + kstep, voffB); PG8_STAGE(PG8_SA(1, 0), cA + kstep, voffA); PG8_STAGE(PG8_SB(1, 1), cB + hstep + kstep, voffB);
        PG8_WAIT_V(6); PG8_BAR;
    }
    for (;;) {
        const typename Epi::Pre pre = E.prefetch(cur, wr, fr);
        const bool has_next = S.next(ui + 1, nxt);
        const char* nA = has_next ? (const char*)g.A + (size_t)nxt.pm * tstep : cA; const char* nB = has_next ? (const char*)g.Bt + (size_t)nxt.pn * tstep : cB;
        for (int t = 0; t < nt; t += 2) {
            const bool last = (t == nt - 2);
            const char* a1 = cA + (size_t)(t + 1) * kstep;
            const char* a2 = last ? nA : cA + (size_t)(t + 2) * kstep; const char* b2 = last ? nB : cB + (size_t)(t + 2) * kstep;
            const char* a3 = a2 + kstep; const char* b3 = b2 + kstep;
            if constexpr (SP2) {
            PG8_LDB(B0, 0, 0); PG8_LDB(B1, 0, 1); PG8_SCHED; PG8_LDA(At, 0, 0); PG8_STAGE(PG8_SA(1, 1), a1 + hstep, voffA);
            PG8_WAIT_V(8); PG8_WAIT_L(0); PG8_BAR; PG8_MMA(0, 0, At, B0); PG8_MMA(0, 1, At, B1); PG8_BAR; PG8_SCHED;
            PG8_LDA(At, 0, 1); PG8_STAGE(PG8_SB(0, 0), b2, voffB); PG8_STAGE(PG8_SB(0, 1), b2 + hstep, voffB); PG8_STAGE(PG8_SA(0, 0), a2, voffA);
            PG8_WAIT_V(8); PG8_WAIT_L(0); PG8_BAR; PG8_MMA(1, 0, At, B0); PG8_MMA(1, 1, At, B1); PG8_BAR; PG8_SCHED;
            PG8_LDB(B0, 1, 0); PG8_LDB(B1, 1, 1); PG8_SCHED; PG8_LDA(At, 1, 0); PG8_STAGE(PG8_SA(0, 1), a2 + hstep, voffA);
            PG8_WAIT_V(8); PG8_WAIT_L(0); PG8_BAR; PG8_MMA(0, 0, At, B0); PG8_MMA(0, 1, At, B1); PG8_BAR; PG8_SCHED;
            PG8_LDA(At, 1, 1); PG8_STAGE(PG8_SB(1, 0), b3, voffB); PG8_STAGE(PG8_SB(1, 1), b3 + hstep, voffB); PG8_STAGE(PG8_SA(1, 0), a3, voffA);
            PG8_WAIT_V(8); PG8_WAIT_L(0); PG8_BAR; PG8_MMA(1, 0, At, B0); PG8_MMA(1, 1, At, B1); PG8_BAR; PG8_SCHED;
            } else {
            PG8_LDB(B0, 0, 0); PG8_SCHED; PG8_LDA(At, 0, 0); PG8_STAGE(PG8_SA(1, 1), a1 + hstep, voffA);
            PG8_WAIT_L(8); PG8_BAR; PG8_WAIT_L(0); PG8_MMA(0, 0, At, B0); PG8_BAR; PG8_SCHED;
            PG8_LDB(B1, 0, 1); PG8_STAGE(PG8_SB(0, 0), b2, voffB);
            PG8_BAR; PG8_WAIT_L(0); PG8_MMA(0, 1, At, B1); PG8_BAR;
            PG8_LDA(At, 0, 1); PG8_STAGE(PG8_SA(0, 0), a2, voffA);
            PG8_BAR; PG8_WAIT_L(0); PG8_MMA(1, 0, At, B0); PG8_BAR; PG8_SCHED;
            PG8_STAGE(PG8_SB(0, 1), b2 + hstep, voffB);
            PG8_WAIT_V(6); PG8_BAR; PG8_MMA(1, 1, At, B1); PG8_BAR;
            PG8_LDB(B0, 1, 0); PG8_SCHED; PG8_LDA(At, 1, 0); PG8_STAGE(PG8_SA(0, 1), a2 + hstep, voffA);
            PG8_WAIT_L(8); PG8_BAR; PG8_WAIT_L(0); PG8_MMA(0, 0, At, B0); PG8_BAR; PG8_SCHED;
            PG8_LDB(B1, 1, 1); PG8_STAGE(PG8_SB(1, 0), b3, voffB);
            PG8_BAR; PG8_WAIT_L(0); PG8_MMA(0, 1, At, B1); PG8_BAR;
            PG8_LDA(At, 1, 1); PG8_STAGE(PG8_SA(1, 0), a3, voffA);
            PG8_BAR; PG8_WAIT_L(0); PG8_MMA(1, 0, At, B0); PG8_BAR; PG8_SCHED;
            PG8_STAGE(PG8_SB(1, 1), b3 + hstep, voffB);
            PG8_WAIT_V(6); PG8_BAR; PG8_MMA(1, 1, At, B1); PG8_BAR;
            }
        }
        if constexpr (ALIGN_EPI) { if (wr == 0) PG8_BAR; }
        E(acc, cur, wr, wc, fr, fq, pre);
        if (!has_next) break;
#pragma unroll
        for (int a = 0; a < 2; ++a)
#pragma unroll
            for (int b = 0; b < 2; ++b)
#pragma unroll
                for (int m = 0; m < 4; ++m)
#pragma unroll
                    for (int n = 0; n < 2; ++n) acc[a][b][m][n] = (f32x4){0.f, 0.f, 0.f, 0.f};
        cur = nxt; cA = nA; cB = nB; ++ui;
        if constexpr (ALIGN_EPI) { if (wr == 1) PG8_BAR; }
    }
    PG8_WAIT_V(0);
    if constexpr (!ALIGN_EPI) { if (wr == 0) PG8_BAR; }
    PG8_BAR;
#undef PG8_SA
#undef PG8_SB
#undef PG8_STAGE
#undef PG8_LDA
#undef PG8_LDB
#undef PG8_MMA
#undef PG8_WAIT_V
#undef PG8_WAIT_L
#undef PG8_BAR
#undef PG8_SCHED
}

typedef f32x4 Acc[2][2][4][2];
struct PreRs { float r[2][4]; };
struct PreNone { };
__device__ __forceinline__ PreRs load_rs(const float* rs, const Unit& u, int wr, int fr) { PreRs p; const int row0 = u.pm * BM + wr * 64 + fr;
#pragma unroll
    for (int ai = 0; ai < 2; ++ai)
#pragma unroll
        for (int m = 0; m < 4; ++m) p.r[ai][m] = rs[row0 + ai * HALF + m * 16];
    return p; }
__device__ __forceinline__ u32x4 pack8(const f32x4 a, const f32x4 b) { u32x4 w; w.x = cvt_pk_bf16(a[0], a[1]); w.y = cvt_pk_bf16(a[2], a[3]); w.z = cvt_pk_bf16(b[0], b[1]); w.w = cvt_pk_bf16(b[2], b[3]); return w; }

struct EpiInA {
    bf16_t* Z; float* VSS; const float* rs;
    typedef PreRs Pre; __device__ __forceinline__ Pre prefetch(const Unit& u, int wr, int fr) const { return load_rs(rs, u, wr, fr); }
    __device__ __forceinline__ void operator()(const Acc& acc, const Unit& u, int wr, int wc, int fr, int fq, const Pre& pre) const {
        const int row0 = u.pm * BM + wr * 64 + fr, col0 = u.pn * BM + wc * 32 + 8 * fq;
        const bool act = u.pn < 12, isv = (u.pn >= 6) && act;
#pragma unroll
        for (int ai = 0; ai < 2; ++ai)
#pragma unroll
            for (int m = 0; m < 4; ++m) {
                const int row = row0 + ai * HALF + m * 16; bf16_t* rowp = Z + (size_t)row * ZP + col0; float ss = 0.f; const float rsr = pre.r[ai][m];
#pragma unroll
                for (int bj = 0; bj < 2; ++bj) { f32x4 v0 = acc[ai][bj][m][0] * rsr, v1 = acc[ai][bj][m][1] * rsr;
                    if (act) {
#pragma unroll
                        for (int e = 0; e < 4; ++e) { v0[e] = gelu_tanh(v0[e]); v1[e] = gelu_tanh(v1[e]); ss += v0[e] * v0[e] + v1[e] * v1[e]; }
                    } else { v0 = v0 * QSCALE; v1 = v1 * QSCALE; }
                    *(u32x4*)(rowp + bj * HALF) = pack8(v0, v1); }
                if (isv) { ss += __shfl_xor(ss, 16); ss += __shfl_xor(ss, 32); if (fq == 0) VSS[(size_t)row * 24 + (u.pn - 6) * 4 + wc] = ss; }
            }
    }
};
struct EpiMkv {
    float* outf; bf16_t* outb; const float* rs;
    typedef PreRs Pre; __device__ __forceinline__ Pre prefetch(const Unit& u, int wr, int fr) const { return load_rs(rs, u, wr, fr); }
    __device__ __forceinline__ void operator()(const Acc& acc, const Unit& u, int wr, int wc, int fr, int fq, const Pre& pre) const {
        const int row0 = u.pm * BM + wr * 64 + fr, col0 = u.pn * BM + wc * 32 + 8 * fq;
#pragma unroll
        for (int ai = 0; ai < 2; ++ai)
#pragma unroll
            for (int m = 0; m < 4; ++m) { const size_t off = (size_t)(row0 + ai * HALF + m * 16) * NKV + col0; const float rsr = pre.r[ai][m];
#pragma unroll
                for (int bj = 0; bj < 2; ++bj) { const f32x4 v0 = acc[ai][bj][m][0] * rsr, v1 = acc[ai][bj][m][1] * rsr;
                    *(f32x4*)(outf + off + bj * HALF) = v0; *(f32x4*)(outf + off + bj * HALF + 4) = v1; *(u32x4*)(outb + off + bj * HALF) = pack8(v0, v1); } }
    }
};
struct EpiPlain {
    bf16_t* O; int ldc;
    typedef PreNone Pre; __device__ __forceinline__ Pre prefetch(const Unit&, int, int) const { return Pre{}; }
    __device__ __forceinline__ void operator()(const Acc& acc, const Unit& u, int wr, int wc, int fr, int fq, const Pre&) const {
        const int row0 = u.pm * BM + wr * 64 + fr, col0 = u.pn * BM + wc * 32 + 8 * fq;
#pragma unroll
        for (int ai = 0; ai < 2; ++ai)
#pragma unroll
            for (int m = 0; m < 4; ++m) { bf16_t* rowp = O + (size_t)(row0 + ai * HALF + m * 16) * ldc + col0;
#pragma unroll
                for (int bj = 0; bj < 2; ++bj) *(u32x4*)(rowp + bj * HALF) = pack8(acc[ai][bj][m][0], acc[ai][bj][m][1]); }
    }
};
struct EpiSwiglu {
    bf16_t* ACT; const float* rs;
    typedef PreRs Pre; __device__ __forceinline__ Pre prefetch(const Unit& u, int wr, int fr) const { return load_rs(rs, u, wr, fr); }
    __device__ __forceinline__ void operator()(const Acc& acc, const Unit& u, int wr, int wc, int fr, int fq, const Pre& pre) const {
        const int row0 = u.pm * BM + wr * 64 + fr, col0 = u.pn * HALF + wc * 32 + 8 * fq;
#pragma unroll
        for (int ai = 0; ai < 2; ++ai)
#pragma unroll
            for (int m = 0; m < 4; ++m) { f32x4 v0, v1; const float rsr = pre.r[ai][m];
#pragma unroll
                for (int e = 0; e < 4; ++e) { v0[e] = silu_f(acc[ai][0][m][0][e] * rsr) * (acc[ai][1][m][0][e] * rsr); v1[e] = silu_f(acc[ai][0][m][1][e] * rsr) * (acc[ai][1][m][1][e] * rsr); }
                *(u32x4*)(ACT + (size_t)(row0 + ai * HALF + m * 16) * DFF + col0) = pack8(v0, v1); }
    }
};
struct EpiInB {
    bf16_t* Z; const float* rs;
    typedef PreRs Pre; __device__ __forceinline__ Pre prefetch(const Unit& u, int wr, int fr) const { return load_rs(rs, u, wr, fr); }
    __device__ __forceinline__ void operator()(const Acc& acc, const Unit& u, int wr, int wc, int fr, int fq, const Pre& pre) const {
        const int row0 = u.pm * BM + wr * 64 + fr, col0 = u.pn * BM + wc * 32 + 8 * fq;
        const float qs = ((u.pn < 6) || (u.pn >= 18)) ? QSCALE : 1.0f;
#pragma unroll
        for (int ai = 0; ai < 2; ++ai)
#pragma unroll
            for (int m = 0; m < 4; ++m) {
                const int row = row0 + ai * HALF + m * 16; bf16_t* rowp = Z + (size_t)row * ZP + col0; const float rsr = pre.r[ai][m] * qs;
#pragma unroll
                for (int bj = 0; bj < 2; ++bj) *(u32x4*)(rowp + bj * HALF) = pack8(acc[ai][bj][m][0] * rsr, acc[ai][bj][m][1] * rsr);
            }
    }
};
}

__device__ __forceinline__ unsigned f2bf(float f) { unsigned u = __builtin_bit_cast(unsigned, f); return (u + 0x7fffu + ((u >> 16) & 1u)) >> 16; }
__device__ __forceinline__ unsigned pk2(float lo, float hi) { return f2bf(lo) | (f2bf(hi) << 16); }
struct TItem { const float* src; bf16_t* dst; const float* gain; int N, K; };
__device__ __forceinline__ TItem t_make(const float* W, int K, int N, bf16_t* WT, bool upperm, const float* gain, int item) {
    const int nblk = N / 64, kb = item / nblk, nb = item % nblk, k0 = 64 * kb, n0 = 64 * nb;
    int s0 = n0;
    if (upperm) { const int pn = n0 >> 8, j = n0 & 255; s0 = (j < 128) ? (128 * pn + j) : (DFF + 128 * pn + (j - 128)); }
    TItem t; t.src = W + (size_t)k0 * N + s0; t.dst = WT + (size_t)n0 * K + k0; t.gain = gain != nullptr ? gain + k0 : nullptr; t.N = N; t.K = K; return t;
}
__device__ __forceinline__ void t_load(const TItem& t, int lane, f32x4 (&v)[16]) {
    const float* src = t.src + (size_t)(lane >> 4) * t.N + 4 * (lane & 15);
#pragma unroll
    for (int i = 0; i < 16; ++i) v[i] = __builtin_nontemporal_load((const f32x4*)(src + (size_t)(4 * i) * t.N));
}
__device__ __forceinline__ void t_store(const TItem& t, LAS float* scr, int lane, const f32x4 (&v)[16]) {
    const int lr = lane >> 4, lc = lane & 15;
#pragma unroll
    for (int i = 0; i < 16; ++i) { const int k = 4 * i + lr; const float gk = t.gain != nullptr ? t.gain[k] : 1.0f;
        *(LAS f32x4*)(scr + k * 64 + ((4 * lc) ^ (4 * (k >> 3)))) = v[i] * gk; }
    asm volatile("s_waitcnt lgkmcnt(0)" ::: "memory");
    const int c = lane & 7;
#pragma unroll
    for (int j = 0; j < 8; ++j) { const int n = (lane >> 3) + 8 * j; const LAS float* sp = scr + (8 * c) * 64 + (n ^ (4 * c));
        u32x4 o; o.x = cvt_pk_bf16(sp[0 * 64], sp[1 * 64]); o.y = cvt_pk_bf16(sp[2 * 64], sp[3 * 64]); o.z = cvt_pk_bf16(sp[4 * 64], sp[5 * 64]); o.w = cvt_pk_bf16(sp[6 * 64], sp[7 * 64]);
        __builtin_nontemporal_store(o, (u32x4*)(t.dst + (size_t)n * t.K + 8 * c)); }
    asm volatile("s_waitcnt lgkmcnt(0)" ::: "memory");
}
template <int MODE>
__device__ __forceinline__ void norm_row(const float* basef, bf16_t* yb, const bf16_t* o, const float* gpost, float* rs_out, float* yout, int lane) {
    f32x4 y[8];
    if (MODE == 0 || MODE == 1) {
#pragma unroll
        for (int j = 0; j < 8; ++j) y[j] = *(const f32x4*)(basef + 4 * (lane + 64 * j));
    } else {
#pragma unroll
        for (int j = 0; j < 8; ++j) { const u32x2 w = *(const u32x2*)(yb + 4 * (lane + 64 * j)); y[j] = (f32x4){bf_lo(w.x), bf_hi(w.x), bf_lo(w.y), bf_hi(w.y)}; }
    }
    if (MODE != 0) {
        f32x4 ov[8]; float ss = 0.f;
#pragma unroll
        for (int j = 0; j < 8; ++j) { const u32x2 w = *(const u32x2*)(o + 4 * (lane + 64 * j)); ov[j] = (f32x4){bf_lo(w.x), bf_hi(w.x), bf_lo(w.y), bf_hi(w.y)};
            ss += (ov[j][0] * ov[j][0] + ov[j][1] * ov[j][1]) + (ov[j][2] * ov[j][2] + ov[j][3] * ov[j][3]); }
        const float rstd = 1.0f / sqrtf(wave_sum(ss) * (1.0f / DM) + EPS);
#pragma unroll
        for (int j = 0; j < 8; ++j) { const f32x4 g = *(const f32x4*)(gpost + 4 * (lane + 64 * j)); y[j] = y[j] + ov[j] * rstd * g; }
    }
    if (MODE == 3) {
#pragma unroll
        for (int j = 0; j < 8; ++j) *(f32x4*)(yout + 4 * (lane + 64 * j)) = y[j];
    } else {
        float ss = 0.f;
#pragma unroll
        for (int j = 0; j < 8; ++j) { ss += (y[j][0] * y[j][0] + y[j][1] * y[j][1]) + (y[j][2] * y[j][2] + y[j][3] * y[j][3]);
            u32x2 w; w.x = cvt_pk_bf16(y[j][0], y[j][1]); w.y = cvt_pk_bf16(y[j][2], y[j][3]); *(u32x2*)(yb + 4 * (lane + 64 * j)) = w; }
        ss = wave_sum(ss);
        if (lane == 0) *rs_out = 1.0f / sqrtf(ss * (1.0f / DM) + EPS);
    }
}

struct NormRaw { u32x2 yb[8]; u32x2 ob[8]; };
__device__ __forceinline__ void norm_load(const bf16_t* yb, const bf16_t* o, int lane, NormRaw& R) {
#pragma unroll
    for (int j = 0; j < 8; ++j) { R.yb[j] = *(const u32x2*)(yb + 4 * (lane + 64 * j)); R.ob[j] = *(const u32x2*)(o + 4 * (lane + 64 * j)); }
}
template <bool FINAL>
__device__ __forceinline__ void norm_finish(const NormRaw& R, bf16_t* yb, const float* gpost, float* rs_out, float* yout, int lane) {
    f32x4 y[8], ov[8]; float ss = 0.f;
#pragma unroll
    for (int j = 0; j < 8; ++j) { y[j] = (f32x4){bf_lo(R.yb[j].x), bf_hi(R.yb[j].x), bf_lo(R.yb[j].y), bf_hi(R.yb[j].y)}; ov[j] = (f32x4){bf_lo(R.ob[j].x), bf_hi(R.ob[j].x), bf_lo(R.ob[j].y), bf_hi(R.ob[j].y)};
        ss += (ov[j][0] * ov[j][0] + ov[j][1] * ov[j][1]) + (ov[j][2] * ov[j][2] + ov[j][3] * ov[j][3]); }
    const float rstd = 1.0f / sqrtf(wave_sum(ss) * (1.0f / DM) + EPS);
#pragma unroll
    for (int j = 0; j < 8; ++j) { const f32x4 g = *(const f32x4*)(gpost + 4 * (lane + 64 * j)); y[j] = y[j] + ov[j] * rstd * g; }
    if (FINAL) {
#pragma unroll
        for (int j = 0; j < 8; ++j) *(f32x4*)(yout + 4 * (lane + 64 * j)) = y[j];
    } else {
        float s2 = 0.f;
#pragma unroll
        for (int j = 0; j < 8; ++j) { s2 += (y[j][0] * y[j][0] + y[j][1] * y[j][1]) + (y[j][2] * y[j][2] + y[j][3] * y[j][3]);
            u32x2 w; w.x = cvt_pk_bf16(y[j][0], y[j][1]); w.y = cvt_pk_bf16(y[j][2], y[j][3]); *(u32x2*)(yb + 4 * (lane + 64 * j)) = w; }
        s2 = wave_sum(s2);
        if (lane == 0) *rs_out = 1.0f / sqrtf(s2 * (1.0f / DM) + EPS);
    }
}

struct KvDesc { const bf16_t* kbase; const bf16_t* vbase; long row0, rstep, pitch; int key_lo; };
__device__ __forceinline__ void kv_issue(const KvDesc& d, int tid, u32x4 (&kk)[8], u32x4 (&vv)[8]) {
    const int srow = tid >> 4, sch = tid & 15;
#pragma unroll
    for (int i = 0; i < 8; ++i) { const int row = srow + 32 * i, rowc = row < d.key_lo ? d.key_lo : row;
        const size_t e = (size_t)(d.row0 + (long)rowc * d.rstep) * d.pitch + sch * 8; kk[i] = *(const u32x4*)(d.kbase + e); vv[i] = *(const u32x4*)(d.vbase + e); }
}
__device__ __forceinline__ void kv_commit(LAS unsigned char* lds, int tid, int key_lo, const u32x4 (&kk)[8], const u32x4 (&vv)[8]) {
    const unsigned sb = off_b(tid >> 4, tid & 15); const int srow = tid >> 4; const u32x4 z = (u32x4){0u, 0u, 0u, 0u};
#pragma unroll
    for (int i = 0; i < 8; ++i) { const bool ok = (srow + 32 * i) >= key_lo; *(LAS u32x4*)(lds + sb + 8192 * i) = ok ? kk[i] : z; *(LAS u32x4*)(lds + 65536 + sb + 8192 * i) = ok ? vv[i] : z; }
}
template <bool BANDED>
__device__ __forceinline__ void attn_compute(LAS unsigned char* lds, int lane, int w, const bf16x8 (&qf)[4], int key_lo, bf16_t* orow, float* lsep, const LAS float* btab) {
    const int fr = lane & 15, fq = lane >> 4;
    LAS unsigned char* Kimg = lds; LAS unsigned char* Vimg = lds + 65536;
    constexpr int NBLK = BANDED ? 5 : 8;
    const int blk0 = BANDED ? (w >> 1) : 0;
    const int qi = 16 * w + fr;
    unsigned kb[2][4];
#pragma unroll
    for (int e = 0; e < 2; ++e)
#pragma unroll
        for (int kk = 0; kk < 4; ++kk) kb[e][kk] = off_b(8 * (fr >> 2) + 4 * e + (fr & 3), 4 * kk + fq);
    LAS unsigned char* Kb = Kimg + 8192 * blk0; LAS unsigned char* Vb = Vimg + 8192 * blk0;
    f32x4 s[2 * NBLK];
#pragma unroll
    for (int nt = 0; nt < 2 * NBLK; ++nt) s[nt] = (f32x4){0.f, 0.f, 0.f, 0.f};
    constexpr int TB = BANDED ? 2 * NBLK : NBLK;
#pragma unroll
    for (int t0 = 0; t0 < 2 * NBLK; t0 += TB)
#pragma unroll
        for (int kk = 0; kk < 4; ++kk) { bf16x8 kf[TB];
#pragma unroll
            for (int i = 0; i < TB; ++i) { const int nt = t0 + i; kf[i] = *(const LAS bf16x8*)(Kb + kb[nt & 1][kk] + 8192 * (nt >> 1)); }
            __builtin_amdgcn_sched_barrier(0);
#pragma unroll
            for (int i = 0; i < TB; ++i) s[t0 + i] = __builtin_amdgcn_mfma_f32_16x16x32_bf16(kf[i], qf[kk], s[t0 + i], 0, 0, 0);
            __builtin_amdgcn_sched_barrier(0); }
    float mx = -1e30f;
    const LAS float* bp = btab + (128 + 16 * (w & 1) + fr - 8 * fq + 32 - 135);
    const int cmin = BANDED ? (key_lo > 0 ? (128 + 16 * (w & 1) + fr - 8 * fq) - qi : -1000) : 0;
#pragma unroll
    for (int nt = 0; nt < 2 * NBLK; ++nt)
#pragma unroll
        for (int r = 0; r < 4; ++r) { float x = s[nt][r];
            if (BANDED) { const int c = 32 * (nt >> 1) + 4 * (nt & 1) + r; x = x + bp[135 - c]; x = (c >= cmin) ? x : -1e30f; s[nt][r] = x; }
            mx = fmaxf(mx, x); }
    mx = fmaxf(mx, __shfl_xor(mx, 16)); mx = fmaxf(mx, __shfl_xor(mx, 32));
    float l = 0.f;
#pragma unroll
    for (int nt = 0; nt < 2 * NBLK; ++nt)
#pragma unroll
        for (int r = 0; r < 4; ++r) { const float p = __builtin_amdgcn_exp2f(s[nt][r] - mx); s[nt][r] = p; l += p; }
    l += __shfl_xor(l, 16); l += __shfl_xor(l, 32);
    bf16x8 pf[NBLK];
#pragma unroll
    for (int ks = 0; ks < NBLK; ++ks) pf[ks] = __builtin_bit_cast(bf16x8, pg8::pack8(s[2 * ks], s[2 * ks + 1]));
    const float inv_l = 1.0f / l;
    unsigned vb[8][2];
#pragma unroll
    for (int ct = 0; ct < 8; ++ct) { vb[ct][0] = tr16_addr(lane, ct, 0, 0); vb[ct][1] = tr16_addr(lane, ct, 0, 1); }
    f32x4 oa[8];
#pragma unroll
    for (int ct = 0; ct < 8; ++ct) oa[ct] = (f32x4){0.f, 0.f, 0.f, 0.f};
#pragma unroll
    for (int ks = 0; ks < NBLK; ++ks) { s16x4 vlo[8], vhi[8];
#pragma unroll
        for (int ct = 0; ct < 8; ++ct) { vlo[ct] = tr_read(Vb + vb[ct][0] + 8192 * ks); vhi[ct] = tr_read(Vb + vb[ct][1] + 8192 * ks); }
        __builtin_amdgcn_sched_barrier(0);
#pragma unroll
        for (int ct = 0; ct < 8; ++ct) { const bf16x8 vf = (bf16x8){vlo[ct][0], vlo[ct][1], vlo[ct][2], vlo[ct][3], vhi[ct][0], vhi[ct][1], vhi[ct][2], vhi[ct][3]};
            oa[ct] = __builtin_amdgcn_mfma_f32_16x16x32_bf16(vf, pf[ks], oa[ct], 0, 0, 0); }
        __builtin_amdgcn_sched_barrier(0); }
#pragma unroll
    for (int ct = 0; ct < 8; ++ct) { u32x2 wv; wv.x = cvt_pk_bf16(oa[ct][0] * inv_l, oa[ct][1] * inv_l); wv.y = cvt_pk_bf16(oa[ct][2] * inv_l, oa[ct][3] * inv_l);
        *(u32x2*)(orow + 16 * ct) = wv; }
    if (lsep != nullptr && fq == 0) *lsep = (mx + __builtin_amdgcn_logf(l)) * LN2;
}
struct QoDesc { const bf16_t* qbase; long row0, rstep; bf16_t* obase; float* lsebase; int banded, dil, head; };

struct GateRegs { u32x4 v[2][6]; f32x4 wq[8]; f32x4 vs[3]; float gvl; };
__device__ __forceinline__ void gate_issue(int tid, int b, int chunk, int g, const bf16_t* Z, const float* VSS, const float* w_s, const float* g_v, GateRegs& R) {
    const int lane = tid & 63, w = __builtin_amdgcn_readfirstlane(tid >> 6), fr = lane & 15, fq = lane >> 4;
    const int tok0 = b * SEQ + chunk * 128;
    {
        const int r0 = tid >> 3, c0 = tid & 7; const bf16_t* gp = Z + (size_t)(tok0 + r0) * ZP + MIXW + g * 384 + c0 * 8;
#pragma unroll
        for (int i2 = 0; i2 < 2; ++i2)
#pragma unroll
            for (int i = 0; i < 6; ++i) R.v[i2][i] = *(const u32x4*)(gp + (size_t)i2 * 64 * ZP + 64 * i); }
    { const float* wp = w_s + (size_t)g * 16384 + (16 * w + fr) * 128 + 8 * fq;
#pragma unroll
      for (int kk = 0; kk < 4; ++kk) { R.wq[2 * kk] = *(const f32x4*)(wp + 32 * kk); R.wq[2 * kk + 1] = *(const f32x4*)(wp + 32 * kk + 4); } }
    { const float* p = VSS + (size_t)(tok0 + (tid & 127)) * 24 + 12 * ((tid >> 7) & 1);
#pragma unroll
      for (int i = 0; i < 3; ++i) R.vs[i] = *(const f32x4*)(p + 4 * i); }
    R.gvl = g_v[g * 384 + (tid < 384 ? tid : tid - 384)];
}
__device__ __forceinline__ void gate_run(LAS unsigned char* lds, int tid, int b, int chunk, int g, const GateRegs& R, const bf16_t* Z, const float* b_s, bf16_t* MIX) {
    const int lane = tid & 63, w = __builtin_amdgcn_readfirstlane(tid >> 6), fr = lane & 15, fq = lane >> 4;
    const int tok0 = b * SEQ + chunk * 128, i = 16 * w + fr;
    LAS float* rs = (LAS float*)(lds + LDS_TAB); LAS float* gvs = rs + 128;
    const size_t tokrow = (size_t)(tok0 + i);
    __syncthreads();
    const bf16_t* up = Z + tokrow * ZP + g * 384 + 4 * fq;
    u32x2 ucur[8];
    const float bs = b_s[g * 128 + i];
    {
        const int r0 = tid >> 3, c0 = tid & 7; const unsigned gsb0 = off_b(r0, c0), gsb1 = off_b(r0, c0 + 8);
#pragma unroll
        for (int i2 = 0; i2 < 2; ++i2)
#pragma unroll
            for (int k = 0; k < 6; ++k) *(LAS u32x4*)(lds + (k >> 1) * 32768 + ((k & 1) ? gsb1 : gsb0) + 16384 * i2) = R.v[i2][k]; }
    { float ssum = 0.f;
#pragma unroll
      for (int k = 0; k < 3; ++k) ssum += (R.vs[k][0] + R.vs[k][1]) + (R.vs[k][2] + R.vs[k][3]);
      if (tid < 256) rs[512 + tid] = ssum;
      if (tid < 384) gvs[tid] = R.gvl; }
    __syncthreads();
    if (tid < 128) rs[tid] = 1.0f / sqrtf((rs[512 + tid] + rs[512 + 128 + tid]) * (1.0f / MIXW) + EPS);
    __syncthreads();
    bf16x8 wf[4];
#pragma unroll
    for (int kk = 0; kk < 4; ++kk) { const int j0 = 32 * kk + 8 * fq;
        const f32x4 r0 = *(const LAS f32x4*)(rs + j0), r1 = *(const LAS f32x4*)(rs + j0 + 4);
        const f32x4 a = R.wq[2 * kk], c = R.wq[2 * kk + 1];
        float v[8] = {a[0] * r0[0], a[1] * r0[1], a[2] * r0[2], a[3] * r0[3], c[0] * r1[0], c[1] * r1[1], c[2] * r1[2], c[3] * r1[3]};
#pragma unroll
        for (int jj = 0; jj < 8; ++jj) v[jj] = (j0 + jj <= i) ? v[jj] : 0.f;
        u32x4 pk; pk.x = cvt_pk_bf16(v[0], v[1]); pk.y = cvt_pk_bf16(v[2], v[3]); pk.z = cvt_pk_bf16(v[4], v[5]); pk.w = cvt_pk_bf16(v[6], v[7]);
        wf[kk] = __builtin_bit_cast(bf16x8, pk); }
    unsigned vb[8][2];
#pragma unroll
    for (int c = 0; c < 8; ++c) { vb[c][0] = tr16_addr(lane, c, 0, 0); vb[c][1] = tr16_addr(lane, c, 0, 1); }
#pragma unroll
    for (int sub = 0; sub < 3; ++sub) { LAS unsigned char* img = lds + sub * 32768;
#pragma unroll
        for (int c = 0; c < 8; ++c) ucur[c] = *(const u32x2*)(up + sub * 128 + 16 * c);
#pragma unroll
        for (int c = 0; c < 8; ++c) { f32x4 a = (f32x4){0.f, 0.f, 0.f, 0.f};
#pragma unroll
            for (int kk = 0; kk < 4; ++kk) if (kk <= (w >> 1)) {
                const s16x4 lo = tr_read(img + vb[c][0] + 8192 * kk), hi = tr_read(img + vb[c][1] + 8192 * kk);
                const bf16x8 vf = (bf16x8){lo[0], lo[1], lo[2], lo[3], hi[0], hi[1], hi[2], hi[3]};
                a = __builtin_amdgcn_mfma_f32_16x16x32_bf16(vf, wf[kk], a, 0, 0, 0); }
            const int col = g * 384 + sub * 128 + 16 * c + 4 * fq;
            const f32x4 gv = *(const LAS f32x4*)(gvs + sub * 128 + 16 * c + 4 * fq);
            const u32x2 uw = ucur[c];
            const float o0 = bf_lo(uw.x) * (a[0] * gv[0] + bs), o1 = bf_hi(uw.x) * (a[1] * gv[1] + bs), o2 = bf_lo(uw.y) * (a[2] * gv[2] + bs), o3 = bf_hi(uw.y) * (a[3] * gv[3] + bs);
            u32x2 ov; ov.x = cvt_pk_bf16(o0, o1); ov.y = cvt_pk_bf16(o2, o3);
            *(u32x2*)(MIX + tokrow * DM + col) = ov; } }
}

template <int MODE, int K>
__device__ __forceinline__ void sample_gemv(LAS unsigned char* lds, const bf16_t* A, int a_pitch, const bf16_t* Wt, int N, int first, int stride,
                                            float* outf, bf16_t* outb, int ldb, float* win, const float* rs, const float* slse = nullptr) {
    int tid = threadIdx.x; asm volatile("" : "+v"(tid));
    const int lane = tid & 63, w = __builtin_amdgcn_readfirstlane(tid >> 6), fr = lane & 15, fq = lane >> 4;
    const int ntiles = (MODE == 2) ? N / 32 : N / 16;
    LAS float* red = (LAS float*)lds;
    constexpr int kw = K / 8;
    LAS float* atab = (LAS float*)(lds + LDS_TAB + 4096);
    if (slse != nullptr) {
        __syncthreads();
        if (tid < 128) { const int srow = tid >> 4, H = tid & 15; float al = 1.0f;
            if (H < 12) { const int hl = H & 3; const float l0 = slse[srow * 12 + hl], l1 = slse[srow * 12 + 4 + hl], l2 = slse[srow * 12 + 8 + hl], mm = fmaxf(l0, fmaxf(l1, l2));
                const float e0 = __expf(l0 - mm), e1 = __expf(l1 - mm), e2 = __expf(l2 - mm); al = (H < 4 ? e0 : (H < 8 ? e1 : e2)) / (e0 + e1 + e2); }
            atab[tid] = al; }
        __syncthreads();
    }
    for (int tile = first; tile < ntiles; tile += stride) {
        const int nrow0 = (MODE == 2) ? 256 * (tile >> 3) + 16 * (tile & 7) : 16 * tile;
        const bf16_t* ap = A + (size_t)(fr & 7) * a_pitch + w * kw + 8 * fq;
        const bf16_t* bp = Wt + (size_t)(nrow0 + fr) * K + w * kw + 8 * fq;
        f32x4 acc = (f32x4){0.f, 0.f, 0.f, 0.f}, acc2 = (f32x4){0.f, 0.f, 0.f, 0.f};
#pragma unroll
        for (int ks = 0; ks < kw / 32; ++ks) { bf16x8 a = *(const bf16x8*)(ap + 32 * ks); const bf16x8 b = *(const bf16x8*)(bp + 32 * ks);
            if (MODE == 1 && slse != nullptr) { const float al = atab[(fr & 7) * 16 + ((w * kw + 32 * ks + 8 * fq) >> 7)]; const u32x4 aw = __builtin_bit_cast(u32x4, a); u32x4 o;
                o.x = cvt_pk_bf16(bf_lo(aw.x) * al, bf_hi(aw.x) * al); o.y = cvt_pk_bf16(bf_lo(aw.y) * al, bf_hi(aw.y) * al);
                o.z = cvt_pk_bf16(bf_lo(aw.z) * al, bf_hi(aw.z) * al); o.w = cvt_pk_bf16(bf_lo(aw.w) * al, bf_hi(aw.w) * al); a = __builtin_bit_cast(bf16x8, o); }
            acc = __builtin_amdgcn_mfma_f32_16x16x32_bf16(b, a, acc, 0, 0, 0);
            if (MODE == 2) { const bf16x8 b2 = *(const bf16x8*)(bp + (size_t)128 * K + 32 * ks); acc2 = __builtin_amdgcn_mfma_f32_16x16x32_bf16(b2, a, acc2, 0, 0, 0); } }
        __syncthreads();
        *(LAS f32x4*)(red + (w * 16 + fr) * 16 + 4 * fq) = acc;
        if (MODE == 2) *(LAS f32x4*)(red + 2048 + (w * 16 + fr) * 16 + 4 * fq) = acc2;
        __syncthreads();
        if (tid < 128) { const int s = tid >> 4, c = tid & 15; float v = 0.f, v2 = 0.f;
#pragma unroll
            for (int ww = 0; ww < 8; ++ww) { v += red[(ww * 16 + s) * 16 + c]; if (MODE == 2) v2 += red[2048 + (ww * 16 + s) * 16 + c]; }
            if (rs != nullptr) { const float rsr = rs[s]; v *= rsr; v2 *= rsr; }
            if (MODE == 0) { const int n = nrow0 + c; outf[(size_t)s * ZP + n] = v;
                if (win != nullptr && n >= 1536 && n < 4608) { const int kv = n >= 3072 ? 1 : 0, cc = n - 1536 - 1536 * kv, grp = cc >> 9;
                    win[(size_t)grp * 8192 + (size_t)(s * 2 + kv) * 512 + (cc & 511)] = v; } }
            else if (MODE == 1) { outb[(size_t)s * ldb + nrow0 + c] = (bf16_t)f2bf(v); }
            else { outb[(size_t)s * ldb + 128 * (tile >> 3) + 16 * (tile & 7) + c] = (bf16_t)f2bf(silu_f(v) * v2); } }
    }
}

template <class KF, class VF>
__device__ __forceinline__ float sample_attend(LAS float* scr, const float* qv, int nkeys, KF kf, VF vf, const LAS float* btab, LAS float* o_out) {
    int tid = threadIdx.x; asm volatile("" : "+v"(tid));
    const int lane = tid & 63, w = __builtin_amdgcn_readfirstlane(tid >> 6);
    LAS float* sc = scr; LAS float* part = scr + 320; LAS float* stat = scr + 320 + 2048;
    {
        const int key = tid >> 1, half = tid & 1; float d = 0.f;
        if (key < nkeys) { const float* kp = kf(key) + 64 * half; const float* qp = qv + 64 * half; f32x4 k4[16];
#pragma unroll
            for (int i = 0; i < 16; ++i) k4[i] = *(const f32x4*)(kp + 4 * i);
#pragma unroll
            for (int i = 0; i < 16; ++i) { const f32x4 q4 = *(const f32x4*)(qp + 4 * i); d += (k4[i][0] * q4[0] + k4[i][1] * q4[1]) + (k4[i][2] * q4[2] + k4[i][3] * q4[3]); } }
        d += __shfl_xor(d, 1);
        if (half == 0 && key < nkeys) sc[key] = d * QSCALE + (btab != nullptr ? btab[key] : 0.f);
    }
    __syncthreads();
    if (w == 0) { float m = -1e30f; for (int j = lane; j < nkeys; j += 64) m = fmaxf(m, sc[j]); m = wave_max(m);
        float l = 0.f; for (int j = lane; j < nkeys; j += 64) { const float p = __builtin_amdgcn_exp2f(sc[j] - m); sc[j] = p; l += p; } l = wave_sum(l);
        if (lane == 0) { stat[0] = m; stat[1] = l; } }
    __syncthreads();
    {
        const int kg = tid >> 5, d4 = 4 * (tid & 31); f32x4 v4[16]; f32x4 a = (f32x4){0.f, 0.f, 0.f, 0.f};
#pragma unroll
        for (int i = 0; i < 16; ++i) { const int j = kg + 16 * i; v4[i] = (f32x4){0.f, 0.f, 0.f, 0.f}; if (j < nkeys) v4[i] = *(const f32x4*)(vf(j) + d4); }
#pragma unroll
        for (int i = 0; i < 16; ++i) { const int j = kg + 16 * i; const float pj = j < nkeys ? sc[j] : 0.f; a = a + v4[i] * pj; }
        *(LAS f32x4*)(part + kg * 128 + d4) = a; }
    __syncthreads();
    const float m = stat[0], l = stat[1];
    if (tid < 128) { float a = 0.f;
#pragma unroll
        for (int g = 0; g < 16; ++g) a += part[g * 128 + tid];
        o_out[tid] = a / l; }
    __syncthreads();
    return (m + __builtin_amdgcn_logf(l)) * LN2;
}

#define XB_TMO      128
#define XB_XCNT(j)  (256  + 64 * (j))
#define XB_XSUB(j)  (1280 + 64 * (j))
#define XB_XGEN(j)  (2304 + 64 * (j))
#define XB_TOP      3328
#define XB_TOPGEN   3392
#define XCD_BAR_WORDS 3456
#define XB_SPIN_CAP (1u << 18)
__device__ __forceinline__ unsigned xb_ld(unsigned* p)              { return __hip_atomic_load(p, __ATOMIC_RELAXED, __HIP_MEMORY_SCOPE_AGENT); }
__device__ __forceinline__ unsigned xb_add(unsigned* p, unsigned v) { return __hip_atomic_fetch_add(p, v, __ATOMIC_RELAXED, __HIP_MEMORY_SCOPE_AGENT); }
__device__ __forceinline__ unsigned xb_xcc_id() { return (unsigned)__builtin_amdgcn_s_getreg((3 << 11) | 20) & 0xFu; }
#define XB_SPIN(cond, bar) do { unsigned _sp = 0; while (cond) { __builtin_amdgcn_s_sleep(1); \
    if ((++_sp & 255u) == 0u) { if (xb_ld(&(bar)[XB_TMO])) break; if (_sp > XB_SPIN_CAP) { atomicAdd(&(bar)[XB_TMO], 1u); break; } } } } while (0)
struct XcdBarrier { unsigned* bar; unsigned x; volatile LAS unsigned* st; };
__device__ __forceinline__ XcdBarrier xcd_barrier_post(unsigned* bar, volatile LAS unsigned* st) {
    XcdBarrier b; b.bar = bar; b.x = xb_xcc_id(); b.st = st;
    if (threadIdx.x == 0) (void)xb_add(&bar[XB_XCNT(b.x)], 1u);
    return b;
}
__device__ __forceinline__ void xcd_barrier_complete(unsigned* bar, unsigned x, unsigned& nloc, unsigned& nx) {
    const unsigned G = gridDim.x * gridDim.y * gridDim.z;
    unsigned sum, cnt, mine, sp = 0u;
    for (;;) {
        sum = 0u; cnt = 0u; mine = 0u;
#pragma unroll
        for (unsigned j = 0; j < 16; ++j) { const unsigned c = xb_ld(&bar[XB_XCNT(j)]); sum += c; cnt += (c > 0u) ? 1u : 0u; mine = (j == x) ? c : mine; }
        if (sum == G) break;
        __builtin_amdgcn_s_sleep(1);
        if ((++sp & 255u) == 0u) { if (xb_ld(&bar[XB_TMO])) break; if (sp > XB_SPIN_CAP) { atomicAdd(&bar[XB_TMO], 1u); break; } }
    }
    nloc = mine > 0u ? mine : 1u; nx = cnt > 0u ? cnt : 1u;
}
__device__ __forceinline__ void xcd_barrier(const XcdBarrier& b) {
    asm volatile("s_waitcnt vmcnt(0)" ::: "memory");
    __syncthreads();
    if (threadIdx.x == 0) {
        unsigned* bar = b.bar;
        __builtin_amdgcn_s_waitcnt(0);
        unsigned nloc = b.st[0], nx = b.st[1];
        if (nloc == 0u) { xcd_barrier_complete(bar, b.x, nloc, nx); b.st[0] = nloc; b.st[1] = nx; }
        const unsigned old = xb_add(&bar[XB_XSUB(b.x)], 1u);
        const unsigned gen = old / nloc;
        if (old + 1u == (gen + 1u) * nloc) {
            __builtin_amdgcn_fence(__ATOMIC_RELEASE, "agent");
            asm volatile("s_waitcnt vmcnt(0)" ::: "memory");
            const unsigned og = xb_add(&bar[XB_TOP], 1u);
            const unsigned tg = og / nx;
            if (og + 1u == (tg + 1u) * nx) xb_add(&bar[XB_TOPGEN], 1u);
            else XB_SPIN(xb_ld(&bar[XB_TOPGEN]) == tg, bar);
            __builtin_amdgcn_fence(__ATOMIC_ACQUIRE, "agent");
            xb_add(&bar[XB_XGEN(b.x)], 1u);
            asm volatile("s_waitcnt vmcnt(0)" ::: "memory");
        } else {
            XB_SPIN(xb_ld(&bar[XB_XGEN(b.x)]) == gen, bar);
            __builtin_amdgcn_fence(__ATOMIC_ACQUIRE, "agent");
            asm volatile("s_waitcnt vmcnt(0)" ::: "memory");
        }
    }
    __syncthreads();
}

struct Args { const float* in[22]; float* out; unsigned char* ws; };
typedef const Args __attribute__((address_space(4)))* ArgsP;
__device__ __forceinline__ ArgsP args_ptr() { ArgsP p = (ArgsP)__builtin_amdgcn_kernarg_segment_ptr(); asm volatile("" : "+s"(p)); return p; }
#define WSP(T, off) ((T*)(A->ws + (off)))

constexpr int I_MKV = 32 * 16, I_INA = 32 * 56, I_INB = 32 * 80, I_OUT = 32 * 32, I_UP = 32 * 176, I_DN = 88 * 32, DN_P = 850, DN_A = 1170;
__device__ __forceinline__ int conv_count(int list) { return list == 0 ? 2 * I_MKV + I_INA + I_UP + DN_P : (list == 1 ? I_OUT + (DN_A - DN_P) : (list == 2 ? (I_DN - DN_A) + I_INB + I_OUT : (list == 3 ? I_UP : I_DN))); }
__device__ __forceinline__ TItem conv_item(ArgsP A, int list, int r) {
    const float* n_mix_pre = A->in[8]; const float* n_ffn_pre = A->in[10]; const float* n_mem = A->in[12]; const float* w_mem_kv = A->in[13]; const float* w_in_a = A->in[14];
    const float* w_in_b = A->in[18]; const float* w_out = A->in[19]; const float* w_up = A->in[20]; const float* w_dn = A->in[21];
    bf16_t* Wmkv = WSP(bf16_t, WS_WMKV); bf16_t* Wina = WSP(bf16_t, WS_WINA); bf16_t* Winb = WSP(bf16_t, WS_WINB); bf16_t* Wout = WSP(bf16_t, WS_WOUT);
    bf16_t* Wup = WSP(bf16_t, WS_WUP); bf16_t* Wdn = WSP(bf16_t, WS_WDN);
    if (list == 0) {
        if (r < 2 * I_MKV) { const int l = r / I_MKV; return t_make(w_mem_kv + (size_t)l * DM * NKV, DM, NKV, Wmkv + (size_t)l * NKV * DM, false, n_mem + l * DM, r % I_MKV); } r -= 2 * I_MKV;
        if (r < I_INA) return t_make(w_in_a, DM, NA, Wina, false, n_mix_pre, r); r -= I_INA;
        if (r < I_UP) return t_make(w_up, DM, NUP, Wup, true, n_ffn_pre, r); r -= I_UP;
        return t_make(w_dn, DFF, DM, Wdn, false, nullptr, r);
    } else if (list == 1) {
        if (r < I_OUT) return t_make(w_out, DM, DM, Wout, false, nullptr, r); r -= I_OUT;
        return t_make(w_dn, DFF, DM, Wdn, false, nullptr, DN_P + r);
    } else if (list == 2) {
        if (r < I_DN - DN_A) return t_make(w_dn, DFF, DM, Wdn, false, nullptr, DN_A + r); r -= I_DN - DN_A;
        if (r < I_INB) return t_make(w_in_b, DM, NB, Winb, false, n_mix_pre + DM, r); r -= I_INB;
        return t_make(w_out + (size_t)DM * DM, DM, DM, Wout + (size_t)DM * DM, false, nullptr, r);
    } else if (list == 3) {
        return t_make(w_up + (size_t)DM * NUP, DM, NUP, Wup + (size_t)NUP * DM, true, n_ffn_pre + DM, r);
    } else {
        return t_make(w_dn + (size_t)DFF * DM, DFF, DM, Wdn + (size_t)DM * DFF, false, nullptr, r);
    }
}
__device__ __forceinline__ void convert_list(LAS unsigned char* lds, ArgsP A, int list, int worker, int nworkers, int wave, int lane) {
    const int n = conv_count(list);
    LAS float* scr = (LAS float*)(lds + wave * 16384);
    int it = worker;
    if (it >= n) return;
    TItem cur = conv_item(A, list, it);
    f32x4 va[16], vb[16];
    t_load(cur, lane, va);
    for (;;) {
        const int itn = it + nworkers; const bool hn = itn < n;
        TItem nxt = cur;
        if (hn) { nxt = conv_item(A, list, itn); t_load(nxt, lane, vb); }
        t_store(cur, scr, lane, va);
        if (!hn) break;
#pragma unroll
        for (int i = 0; i < 16; ++i) va[i] = vb[i];
        cur = nxt; it = itn;
    }
}
__device__ __forceinline__ void convert_tail(LAS unsigned char* lds, ArgsP A, int list, int first_idle) {
    const int bid = blockIdx.x, G = gridDim.x;
    if (bid < first_idle || first_idle >= G) return;
    int tid = threadIdx.x; asm volatile("" : "+v"(tid));
    const int lane = tid & 63, wave = __builtin_amdgcn_readfirstlane(tid >> 6);
    __syncthreads();
    convert_list(lds, A, list, (bid - first_idle) * 8 + wave, (G - first_idle) * 8, wave, lane);
}
__device__ __forceinline__ void phase_prologue(LAS unsigned char* lds) {
    ArgsP A = args_ptr();
    int tid = threadIdx.x; asm volatile("" : "+v"(tid));
    const int lane = tid & 63, wave = __builtin_amdgcn_readfirstlane(tid >> 6), gw = blockIdx.x * 8 + wave, NGW = gridDim.x * 8;
    const float* x_prompt = A->in[0]; const float* x_sample = A->in[1]; const float* mem_prompt = A->in[2];
    bf16_t* YB = WSP(bf16_t, WS_HN); bf16_t* HM = WSP(bf16_t, WS_HM);
    float* RS = WSP(float, WS_RS); float* RSM = RS + 16384;
    convert_list(lds, A, 0, gw, NGW, wave, lane);
    if (gridDim.x != 256) { convert_list(lds, A, 1, gw, NGW, wave, lane); convert_list(lds, A, 2, gw, NGW, wave, lane); convert_list(lds, A, 3, gw, NGW, wave, lane); convert_list(lds, A, 4, gw, NGW, wave, lane); }
    for (int m = gw; m < 512 + TP + TSMP; m += NGW) {
        if (m < 512) norm_row<0>(mem_prompt + (size_t)m * DM, HM + (size_t)m * DM, nullptr, nullptr, RSM + m, nullptr, lane);
        else { const int r = m - 512; const float* xr = r < TP ? x_prompt + (size_t)r * DM : x_sample + (size_t)(r - TP) * DM;
            norm_row<0>(xr, YB + (size_t)r * DM, nullptr, nullptr, RS + r, nullptr, lane); }
    }
}

__device__ __forceinline__ void phase_in_a(LAS unsigned char* lds) {
    ArgsP A = args_ptr(); const int bid = blockIdx.x, G = gridDim.x;
    bf16_t* HN = WSP(bf16_t, WS_HN);
    { pg8::Gemm g{HN, WSP(bf16_t, WS_WINA), TP, NA, DM}; pg8::StaticOrder S; S.init(TP, NA, G, bid); pg8::EpiInA E{WSP(bf16_t, WS_Z), WSP(float, WS_VSS), WSP(float, WS_RS)};
      pg8::gemm_phase<pg8::EpiInA, true, true>(lds, g, S, E); }
#pragma unroll 1
    for (int l = 0; l < 2; ++l) { pg8::Gemm g{WSP(bf16_t, WS_HM), WSP(bf16_t, WS_WMKV) + (size_t)l * NKV * DM, 512, NKV, DM};
      pg8::StaticOrder S; S.init(512, NKV, G, (bid - 192 - 8 * l + 2 * G) % G);
      pg8::EpiMkv E{A->out + OUT_MKV + (size_t)l * 512 * NKV, WSP(bf16_t, WS_MKV) + (size_t)l * 512 * NKV, WSP(float, WS_RS) + 16384};
      pg8::gemm_phase<pg8::EpiMkv, true, true>(lds, g, S, E); }
    if (G == 256) { if (bid >= 208) sample_gemv<0, DM>(lds, HN + (size_t)TP * DM, DM, WSP(bf16_t, WS_WINA), NA, G - 1 - bid, 48, WSP(float, WS_ZS), nullptr, 0, nullptr, WSP(float, WS_RS) + TP); }
    else sample_gemv<0, DM>(lds, HN + (size_t)TP * DM, DM, WSP(bf16_t, WS_WINA), NA, G - 1 - bid, G, WSP(float, WS_ZS), nullptr, 0, nullptr, WSP(float, WS_RS) + TP);
    if (G == 256) convert_tail(lds, A, 1, 208);
}
__device__ __forceinline__ void phase_in_b(LAS unsigned char* lds) {
    ArgsP A = args_ptr(); const int bid = blockIdx.x, G = gridDim.x;
    bf16_t* HN = WSP(bf16_t, WS_HN); float* out = A->out;
    pg8::Gemm g{HN, WSP(bf16_t, WS_WINB), TP, NB, DM}; pg8::StaticOrder S; S.init(TP, NB, G, bid);
    pg8::EpiInB E{WSP(bf16_t, WS_Z), WSP(float, WS_RS)};
    pg8::gemm_phase<pg8::EpiInB, true, true>(lds, g, S, E);
    sample_gemv<0, DM>(lds, HN + (size_t)TP * DM, DM, WSP(bf16_t, WS_WINB), NB, G - 1 - bid, G, WSP(float, WS_ZS), nullptr, 0, out + OUT_W128S, WSP(float, WS_RS) + TP);
    if (G == 256) convert_tail(lds, A, 3, 128);
}
__device__ __forceinline__ void mem_unit_desc(ArgsP A, int v, int layer, KvDesc& kd, QoDesc& qd) {
    const int b = v >> 7, h = (v >> 5) & 3, qb = v & 31, qmoff = layer == 0 ? 3072 : 4608;
    const bf16_t* mkv = WSP(bf16_t, WS_MKV) + (size_t)layer * 512 * NKV + h * 128;
    kd.kbase = mkv; kd.vbase = mkv + 512; kd.row0 = (long)b * 256; kd.rstep = 1; kd.pitch = NKV; kd.key_lo = 0;
    qd.qbase = WSP(bf16_t, WS_Z) + qmoff + h * 128; qd.row0 = (long)b * SEQ + 128 * qb; qd.rstep = 1; qd.obase = WSP(bf16_t, WS_MIX) + MIXW + h * 128; qd.lsebase = nullptr;
    qd.banded = 0; qd.dil = 1; qd.head = 0;
}
__device__ __forceinline__ void swa_unit_desc(ArgsP A, int u, KvDesc& kd, QoDesc& qd) {
    const int b = u / 384, H = (u % 384) >> 5, idx = u & 31, g = H >> 2, dil = 1 << (2 * g), r = idx & (dil - 1), qb = idx >> (2 * g);
    const bf16_t* Z = WSP(bf16_t, WS_Z);
    kd.kbase = Z + MIXW + H * 128; kd.vbase = Z + 2 * MIXW + H * 128; kd.row0 = (long)b * SEQ + (long)(128 * qb - 128) * dil + r; kd.rstep = dil; kd.pitch = ZP; kd.key_lo = qb == 0 ? 128 : 0;
    qd.qbase = Z + H * 128; qd.row0 = (long)b * SEQ + (long)(128 * qb) * dil + r; qd.rstep = dil; qd.obase = WSP(bf16_t, WS_MIX) + H * 128; qd.lsebase = WSP(float, WS_LSE) + H;
    qd.banded = 1; qd.dil = dil; qd.head = H;
}
__device__ __forceinline__ void q_issue(const QoDesc& qd, int tid, bf16x8 (&qf)[4]) {
    const int lane = tid & 63, w = __builtin_amdgcn_readfirstlane(tid >> 6), fr = lane & 15, fq = lane >> 4;
    const long qrow = qd.row0 + (long)(16 * w + fr) * qd.rstep;
    const bf16_t* qp = qd.qbase + (size_t)qrow * ZP + 8 * fq;
#pragma unroll
    for (int k4 = 0; k4 < 4; ++k4) qf[k4] = *(const bf16x8*)(qp + 32 * k4);
}
__device__ __forceinline__ void build_bias_tables(LAS unsigned char* lds, int tid, const float* rel_bias) {
    LAS float* tab = (LAS float*)(lds + LDS_TAB); LAS float* rb = tab + 12 * 192;
    if (tid < 384) rb[tid] = rel_bias[tid] * LOG2E;
    __syncthreads();
    for (int i = tid; i < 12 * 192; i += 512) { const int H = i / 192, j = i % 192 - 32, dil = 1 << (2 * (H >> 2));
        tab[i] = (j >= 0 && j <= 128) ? rb[t5_bucket(j * dil) * 12 + H] : -1e30f; }
}
__device__ __forceinline__ void attn_unit_run(LAS unsigned char* lds, int tid, const QoDesc& qd, int key_lo, u32x4 (&kk)[8], u32x4 (&vv)[8], bf16x8 (&qf)[4],
                                              const bool has_next, const KvDesc nxt, const QoDesc nxtq) {
    const int lane = tid & 63, w = __builtin_amdgcn_readfirstlane(tid >> 6), fr = lane & 15, fq = lane >> 4;
    __syncthreads();
    kv_commit(lds, tid, key_lo, kk, vv);
    bf16x8 qc[4];
#pragma unroll
    for (int k4 = 0; k4 < 4; ++k4) qc[k4] = qf[k4];
    if (has_next) { kv_issue(nxt, tid, kk, vv); q_issue(nxtq, tid, qf); }
    __syncthreads();
    const long qrow = qd.row0 + (long)(16 * w + fr) * qd.rstep;
    bf16_t* orow = qd.obase + (size_t)qrow * DM + 4 * fq;
    float* lsep = qd.lsebase != nullptr ? qd.lsebase + (size_t)qrow * 12 : nullptr;
    if (qd.banded) attn_compute<true>(lds, lane, w, qc, key_lo, orow, lsep, (const LAS float*)(lds + LDS_TAB) + qd.head * 192);
    else attn_compute<false>(lds, lane, w, qc, key_lo, orow, lsep, (const LAS float*)(lds + LDS_TAB));
}
__device__ __forceinline__ void sample_mem_attn(LAS unsigned char* lds, int layer) {
    ArgsP A = args_ptr(); const int bid = blockIdx.x, G = gridDim.x;
    int tid = threadIdx.x; asm volatile("" : "+v"(tid));
    const int qmoff = layer == 0 ? 3072 : 4608;
    for (int it = G - 1 - 96 - bid; it >= 0 && it < 32; it += G) {
        const int s = it >> 2, h = it & 3;
        LAS float* scr = (LAS float*)lds; LAS float* og = scr + 2560;
        __syncthreads();
        const float* cm = A->in[3] + (size_t)(layer * 8 + s) * 256 * 1024;
        auto kf = [=](int j) -> const float* { return cm + (size_t)j * 1024 + h * 128; };
        auto vf = [=](int j) -> const float* { return cm + (size_t)j * 1024 + 512 + h * 128; };
        (void)sample_attend(scr, WSP(float, WS_ZS) + (size_t)s * ZP + qmoff + h * 128, 256, kf, vf, (const LAS float*)nullptr, og);
        if (tid < 128) WSP(bf16_t, WS_MIX)[(size_t)(TP + s) * DM + MIXW + h * 128 + tid] = (bf16_t)f2bf(og[tid]);
        __syncthreads();
    }
}
__device__ __forceinline__ void phase_mix_a(LAS unsigned char* lds) {
    ArgsP A = args_ptr(); const int bid = blockIdx.x, G = gridDim.x;
    int tid = threadIdx.x; asm volatile("" : "+v"(tid));
    const int lane = tid & 63, wave = __builtin_amdgcn_readfirstlane(tid >> 6);
    const float* ZS = WSP(float, WS_ZS); const float* n_v_a = A->in[15]; const float* w_sp = A->in[16]; const float* b_sp = A->in[17]; bf16_t* MIX = WSP(bf16_t, WS_MIX); float* out = A->out;
    for (int it = G - 1 - bid; it < TSMP; it += G) {
        LAS float* red = (LAS float*)lds; const int s = it;
        __syncthreads();
        float vv[3], uu[3], ss = 0.f;
#pragma unroll
        for (int i = 0; i < 3; ++i) { const int c = tid + 512 * i; uu[i] = gelu_tanh(ZS[(size_t)s * ZP + c]); vv[i] = gelu_tanh(ZS[(size_t)s * ZP + MIXW + c]); ss += vv[i] * vv[i]; }
        ss = wave_sum(ss); if (lane == 0) red[wave] = ss;
        __syncthreads();
        float tot = 0.f;
#pragma unroll
        for (int i = 0; i < 8; ++i) tot += red[i];
        const float rstd = 1.0f / sqrtf(tot * (1.0f / MIXW) + EPS);
#pragma unroll
        for (int i = 0; i < 3; ++i) { const int c = tid + 512 * i, g = c / 384; const float vn = vv[i] * rstd * n_v_a[c];
            out[OUT_CHV + (size_t)s * MIXW + c] = vn;
            const float sg = w_sp[(size_t)g * 16384] * vn + b_sp[g * 128];
            MIX[(size_t)(TP + s) * DM + c] = (bf16_t)f2bf(uu[i] * sg); }
    }
    sample_mem_attn(lds, 0);
    __syncthreads();
    for (int u = bid; u < 256; u += G) {
        KvDesc kd; QoDesc qd; mem_unit_desc(A, u, 0, kd, qd);
        u32x4 kk[8], vv[8]; bf16x8 qf[4]; GateRegs R;
        gate_issue(tid, u >> 7, (u >> 2) & 31, u & 3, WSP(bf16_t, WS_Z), WSP(float, WS_VSS), A->in[16], A->in[15], R);
        kv_issue(kd, tid, kk, vv); q_issue(qd, tid, qf);
        gate_run(lds, tid, u >> 7, (u >> 2) & 31, u & 3, R, WSP(bf16_t, WS_Z), A->in[17], WSP(bf16_t, WS_MIX));
        attn_unit_run(lds, tid, qd, kd.key_lo, kk, vv, qf, false, kd, qd);
    }
}
__device__ __forceinline__ void phase_mix_b1(LAS unsigned char* lds) {
    ArgsP A = args_ptr(); const int bid = blockIdx.x, G = gridDim.x;
    int tid = threadIdx.x; asm volatile("" : "+v"(tid));
    KvDesc kd{}, kn{}; QoDesc qd{}, qn{};
    u32x4 kk[8], vv[8]; bf16x8 qf[4];
    int u = bid;
    if (u < 1024) { if (u < 768) swa_unit_desc(A, u, kd, qd); else mem_unit_desc(A, u - 768, 1, kd, qd); kv_issue(kd, tid, kk, vv); q_issue(qd, tid, qf); }
    build_bias_tables(lds, tid, A->in[7]);
#pragma unroll 1
    for (; u < 1024; u += G) {
        const int un = u + G; const bool has_next = un < 1024;
        if (has_next) { if (un < 768) swa_unit_desc(A, un, kn, qn); else mem_unit_desc(A, un - 768, 1, kn, qn); }
        attn_unit_run(lds, tid, qd, kd.key_lo, kk, vv, qf, has_next, kn, qn);
        kd = kn; qd = qn;
    }
}
__device__ __forceinline__ void phase_mix_b2(LAS unsigned char* lds) {
    ArgsP A = args_ptr(); const int bid = blockIdx.x, G = gridDim.x;
    int tid = threadIdx.x; asm volatile("" : "+v"(tid));
    const int lane = tid & 63, wave = __builtin_amdgcn_readfirstlane(tid >> 6), gw = bid * 8 + wave, NGW = G * 8;
    bf16_t* MIX = WSP(bf16_t, WS_MIX); const float* LSE = WSP(float, WS_LSE);
    for (int row = gw; row < TP; row += NGW) {
        const float* lp = LSE + (size_t)row * 12;
#pragma unroll
        for (int i = 0; i < 3; ++i) { const int col = 8 * (lane + 64 * i), H = col >> 7, g = H >> 2, hl = H & 3;
            const float l0 = lp[hl], l1 = lp[4 + hl], l2 = lp[8 + hl], mm = fmaxf(l0, fmaxf(l1, l2));
            const float e0 = __expf(l0 - mm), e1 = __expf(l1 - mm), e2 = __expf(l2 - mm);
            const float al = (g == 0 ? e0 : (g == 1 ? e1 : e2)) / (e0 + e1 + e2);
            u32x4 wv = *(u32x4*)(MIX + (size_t)row * DM + col);
            wv.x = cvt_pk_bf16(bf_lo(wv.x) * al, bf_hi(wv.x) * al); wv.y = cvt_pk_bf16(bf_lo(wv.y) * al, bf_hi(wv.y) * al);
            wv.z = cvt_pk_bf16(bf_lo(wv.z) * al, bf_hi(wv.z) * al); wv.w = cvt_pk_bf16(bf_lo(wv.w) * al, bf_hi(wv.w) * al);
            *(u32x4*)(MIX + (size_t)row * DM + col) = wv; }
    }
    { const int nw = G > 128 ? G - 128 : G, wk = bid < nw ? bid : -1;
      if (wk >= 0) { const bf16_t* Z = WSP(bf16_t, WS_Z); float* o0 = A->out + OUT_W128P;
        for (int i = wk * 512 + tid; i < 688128; i += nw * 512) {
            const int g = i < 32768 ? 0 : (i < 163840 ? 1 : 2), ig = i - (g == 0 ? 0 : (g == 1 ? 32768 : 163840)), W = 128 << (2 * g);
            const int c8 = ig & 63, kv = (ig >> 6) & 1, tr = (ig >> 7) & (W - 1), b = (ig >> 7) / W;
            const u32x4 wv = *(const u32x4*)(Z + (size_t)(b * SEQ + (SEQ - W) + tr) * ZP + MIXW + kv * MIXW + g * 512 + c8 * 8);
            float* dst = o0 + (size_t)2048 * ((W - 128) / 3) + (size_t)ig * 8;
            *(f32x4*)dst = (f32x4){bf_lo(wv.x), bf_hi(wv.x), bf_lo(wv.y), bf_hi(wv.y)}; *(f32x4*)(dst + 4) = (f32x4){bf_lo(wv.z), bf_hi(wv.z), bf_lo(wv.w), bf_hi(wv.w)}; } } }
    const float* rel_bias = A->in[7]; const float* ZS = WSP(float, WS_ZS);
    for (int it = G - 1 - bid; it < 96; it += G) {
        const int s = it / 12, H = it % 12, g = H >> 2, hl = H & 3, dil = 1 << (2 * g), W = 128 << (2 * g);
        LAS float* scr = (LAS float*)lds; LAS float* btab = scr + 2400; LAS float* og = scr + 2560;
        __syncthreads();
        for (int j = tid; j <= 128; j += 512) btab[j] = rel_bias[t5_bucket(j * dil) * 12 + H] * LOG2E;
        __syncthreads();
        const float* cw = A->in[4 + g];
        const float* zrow = ZS + (size_t)s * ZP;
        auto kf = [=](int j) -> const float* { return j == 0 ? zrow + MIXW + H * 128 : cw + ((size_t)(s * W + (W - j * dil)) * 2 + 0) * 512 + hl * 128; };
        auto vf = [=](int j) -> const float* { return j == 0 ? zrow + 2 * MIXW + H * 128 : cw + ((size_t)(s * W + (W - j * dil)) * 2 + 1) * 512 + hl * 128; };
        const float lg = sample_attend(scr, zrow + H * 128, 129, kf, vf, btab, og);
        if (tid < 128) MIX[(size_t)(TP + s) * DM + H * 128 + tid] = (bf16_t)f2bf(og[tid]);
        if (tid == 0) WSP(float, WS_LSE)[(size_t)TP * 12 + s * 12 + H] = lg;
        __syncthreads();
    }
    sample_mem_attn(lds, 1);
}
__device__ __forceinline__ void phase_out(LAS unsigned char* lds, int layer) {
    ArgsP A = args_ptr(); const int bid = blockIdx.x, G = gridDim.x;
    bf16_t* MIX = WSP(bf16_t, WS_MIX); bf16_t* OB = WSP(bf16_t, WS_O); const bf16_t* W = WSP(bf16_t, WS_WOUT) + (size_t)layer * DM * DM;
    pg8::Gemm g{MIX, W, TP, DM, DM}; pg8::StaticOrder S; S.init(TP, DM, G, bid); pg8::EpiPlain E{OB, DM};
    pg8::gemm_phase<pg8::EpiPlain, false, true>(lds, g, S, E);
    sample_gemv<1, DM>(lds, MIX + (size_t)TP * DM, DM, W, DM, G - 1 - bid, G, nullptr, OB + (size_t)TP * DM, DM, nullptr, nullptr, layer == 1 ? WSP(float, WS_LSE) + (size_t)TP * 12 : nullptr);
}
__device__ __forceinline__ void phase_up(LAS unsigned char* lds, int layer) {
    ArgsP A = args_ptr(); const int bid = blockIdx.x, G = gridDim.x;
    bf16_t* HN = WSP(bf16_t, WS_HN); bf16_t* ACT = WSP(bf16_t, WS_ACT); const bf16_t* W = WSP(bf16_t, WS_WUP) + (size_t)layer * NUP * DM;
    pg8::Gemm g{HN, W, TP, NUP, DM}; pg8::StaticOrder S; S.init(TP, NUP, G, bid); pg8::EpiSwiglu E{ACT, WSP(float, WS_RS)};
    pg8::gemm_phase<pg8::EpiSwiglu, true, true>(lds, g, S, E);
    if (G == 256 && layer == 1) { if (bid >= 128) sample_gemv<2, DM>(lds, HN + (size_t)TP * DM, DM, W, NUP, G - 1 - bid, 128, nullptr, ACT + (size_t)TP * DFF, DFF, nullptr, WSP(float, WS_RS) + TP); }
    else sample_gemv<2, DM>(lds, HN + (size_t)TP * DM, DM, W, NUP, G - 1 - bid, G, nullptr, ACT + (size_t)TP * DFF, DFF, nullptr, WSP(float, WS_RS) + TP);
    if (G == 256) convert_tail(lds, A, layer == 0 ? 2 : 4, 128);
}
__device__ __forceinline__ void phase_down(LAS unsigned char* lds, int layer) {
    ArgsP A = args_ptr(); const int bid = blockIdx.x, G = gridDim.x;
    bf16_t* ACT = WSP(bf16_t, WS_ACT); bf16_t* OB = WSP(bf16_t, WS_O); const bf16_t* W = WSP(bf16_t, WS_WDN) + (size_t)layer * DM * DFF;
    pg8::Gemm g{ACT, W, TP, DM, DFF}; pg8::StaticOrder S; S.init(TP, DM, G, bid); pg8::EpiPlain E{OB, DM};
    pg8::gemm_phase<pg8::EpiPlain, false, true>(lds, g, S, E);
    sample_gemv<1, DFF>(lds, ACT + (size_t)TP * DFF, DFF, W, DM, G - 1 - bid, G, nullptr, OB + (size_t)TP * DM, DM, nullptr, nullptr);
}
__device__ __forceinline__ void phase_norm(int which) {
    ArgsP A = args_ptr();
    int tid = threadIdx.x; asm volatile("" : "+v"(tid));
    const int lane = tid & 63, wave = __builtin_amdgcn_readfirstlane(tid >> 6), gw = blockIdx.x * 8 + wave, NGW = gridDim.x * 8;
    const int layer = which >> 1;
    float* Y = A->out + OUT_Y; const bf16_t* OB = WSP(bf16_t, WS_O); bf16_t* YB = WSP(bf16_t, WS_HN); float* RS = WSP(float, WS_RS);
    const float* gpost = ((which & 1) ? A->in[11] : A->in[9]) + layer * DM;
    int r = gw;
    if (r >= TP + TSMP) return;
    NormRaw cur, nxt;
    norm_load(YB + (size_t)r * DM, OB + (size_t)r * DM, lane, cur);
    for (;;) {
        const int rn = r + NGW; const bool hn = rn < TP + TSMP;
        if (hn) norm_load(YB + (size_t)rn * DM, OB + (size_t)rn * DM, lane, nxt);
        if (which == 3) norm_finish<true>(cur, nullptr, gpost, nullptr, Y + (size_t)r * DM, lane);
        else norm_finish<false>(cur, YB + (size_t)r * DM, gpost, RS + r, nullptr, lane);
        if (!hn) break;
        cur = nxt; r = rn;
    }
}

__global__ void __launch_bounds__(512, 2) fwd_megakernel(Args args) {
    extern __shared__ __attribute__((aligned(16))) unsigned char lds_raw[];
    LAS unsigned char* lds = (LAS unsigned char*)lds_raw;
    volatile LAS unsigned* bst = (volatile LAS unsigned*)(lds + LDS_BYTES - 64);
    if (threadIdx.x < 16) bst[threadIdx.x] = 0u;
    __syncthreads();
    const XcdBarrier bar = xcd_barrier_post((unsigned*)args.ws, bst);
#define GRID_SYNC() xcd_barrier(bar)
    phase_prologue(lds);
    GRID_SYNC();
    phase_in_a(lds);
    GRID_SYNC();
    phase_mix_a(lds);
    GRID_SYNC();
    phase_out(lds, 0);
    GRID_SYNC();
    phase_norm(0);
    GRID_SYNC();
    phase_up(lds, 0);
    GRID_SYNC();
    phase_down(lds, 0);
    GRID_SYNC();
    phase_norm(1);
    GRID_SYNC();
    phase_in_b(lds);
    GRID_SYNC();
    phase_mix_b1(lds);
    GRID_SYNC();
    phase_mix_b2(lds);
    GRID_SYNC();
    phase_out(lds, 1);
    GRID_SYNC();
    phase_norm(2);
    GRID_SYNC();
    phase_up(lds, 1);
    GRID_SYNC();
    phase_down(lds, 1);
    GRID_SYNC();
    phase_norm(3);
#undef GRID_SYNC
}

extern "C" void kernel_launch(void* const* d_in, const int* in_sizes, int n_in, void* d_out, int out_size, void* d_ws, size_t ws_size, hipStream_t stream) {
    static int grid = 0;
    if (grid == 0) {
        if (n_in != 22 || (size_t)out_size != OUT_TOTAL || ws_size < WS_END) { fprintf(stderr, "kernel_launch: unexpected shapes (n_in %d, out %d, ws %zu)\n", n_in, out_size, ws_size); grid = -1; return; }
        int dev = 0, cus = 0, per_cu = 0;
        if (hipGetDevice(&dev) != hipSuccess || hipDeviceGetAttribute(&cus, hipDeviceAttributeMultiprocessorCount, dev) != hipSuccess) { grid = -1; return; }
        if (hipFuncSetAttribute((const void*)fwd_megakernel, hipFuncAttributeMaxDynamicSharedMemorySize, LDS_BYTES) != hipSuccess) { fprintf(stderr, "kernel_launch: hipFuncSetAttribute failed\n"); grid = -1; return; }
        if (hipOccupancyMaxActiveBlocksPerMultiprocessor(&per_cu, (const void*)fwd_megakernel, 512, LDS_BYTES) != hipSuccess || per_cu < 1) { fprintf(stderr, "kernel_launch: occupancy query says %d\n", per_cu); (void)hipGetLastError(); per_cu = 1; }
        grid = cus;
    }
    if (grid < 0) return;
    if (hipMemsetAsync(d_ws, 0, 16384, stream) != hipSuccess) { fprintf(stderr, "kernel_launch: memset of the barrier words failed\n"); return; }
    Args a{};
    for (int i = 0; i < 22; ++i) a.in[i] = (const float*)d_in[i];
    a.out = (float*)d_out; a.ws = (unsigned char*)d_ws;
    void* kargs[] = {&a};
    hipError_t e = hipLaunchCooperativeKernel((const void*)fwd_megakernel, dim3(grid), dim3(512), kargs, LDS_BYTES, stream);
    if (e != hipSuccess) fprintf(stderr, "kernel_launch: cooperative launch failed: %s (grid %d)\n", hipGetErrorString(e), grid);
}
```

```cpp
#include <hip/hip_runtime.h>
#include <cstdio>
#include <cstdint>

#define LAS __attribute__((address_space(3)))
typedef unsigned short bf16_t;
typedef short bf16x8 __attribute__((ext_vector_type(8)));
typedef short s16x4 __attribute__((ext_vector_type(4)));
typedef float f32x4 __attribute__((ext_vector_type(4)));
typedef float f32x2 __attribute__((ext_vector_type(2)));
typedef unsigned u32x4 __attribute__((ext_vector_type(4)));
typedef unsigned u32x2 __attribute__((ext_vector_type(2)));

constexpr int DM = 2048, TP = 8192, TSMP = 8, TROWS = TP + 16, SEQ = 4096;
constexpr int MIXW = 1536, NA = 3584, NB = 5120, DFF = 5632, NUP = 11264, NKV = 1024;
constexpr int ZP = 5120;
constexpr float EPS = 1e-6f;
constexpr float LOG2E = 1.4426950408889634f, LN2 = 0.6931471805599453f;
constexpr float QSCALE = 0.08838834764831845f * 1.4426950408889634f;

constexpr size_t MiB = 1u << 20;
constexpr size_t WS_WMKV = 1 * MiB;
constexpr size_t WS_WINA = 9 * MiB;
constexpr size_t WS_WINB = 23 * MiB;
constexpr size_t WS_WOUT = 43 * MiB;
constexpr size_t WS_WUP = 59 * MiB;
constexpr size_t WS_WDN = 147 * MiB;
constexpr size_t WS_HN = 191 * MiB;
constexpr size_t WS_HM = 224 * MiB;
constexpr size_t WS_MKV = 228 * MiB;
constexpr size_t WS_Z = 230 * MiB;
constexpr size_t WS_ZS = 310 * MiB;
constexpr size_t WS_VSS = 311 * MiB;
constexpr size_t WS_MIX = 312 * MiB;
constexpr size_t WS_LSE = 345 * MiB;
constexpr size_t WS_RS = 345 * MiB + 512 * 1024;
constexpr size_t WS_O = 346 * MiB;
constexpr size_t WS_ACT = 230 * MiB;
constexpr size_t WS_END = 468 * MiB;

constexpr size_t OUT_Y = 0;
constexpr size_t OUT_MKV = 16793600;
constexpr size_t OUT_CHV = OUT_MKV + 1048576;
constexpr size_t OUT_W128P = OUT_CHV + 12288;
constexpr size_t OUT_W512P = OUT_W128P + 262144;
constexpr size_t OUT_W2048P = OUT_W512P + 1048576;
constexpr size_t OUT_W128S = OUT_W2048P + 4194304;
constexpr size_t OUT_W512S = OUT_W128S + 8192;
constexpr size_t OUT_W2048S = OUT_W512S + 8192;
constexpr size_t OUT_TOTAL = OUT_W2048S + 8192;

constexpr int LDS_BYTES = 147456;
constexpr int LDS_TAB = 131072;

__device__ __forceinline__ unsigned cvt_pk_bf16(float lo, float hi) { unsigned r; asm volatile("v_cvt_pk_bf16_f32 %0, %1, %2" : "=v"(r) : "v"(lo), "v"(hi)); return r; }
__device__ __forceinline__ float bf_lo(unsigned w) { return __uint_as_float(w << 16); }
__device__ __forceinline__ float bf_hi(unsigned w) { return __uint_as_float(w & 0xffff0000u); }
__device__ __forceinline__ float wave_sum(float v) {
#pragma unroll
    for (int o = 1; o < 64; o <<= 1) v += __shfl_xor(v, o);
    return v;
}
__device__ __forceinline__ float wave_max(float v) {
#pragma unroll
    for (int o = 1; o < 64; o <<= 1) v = fmaxf(v, __shfl_xor(v, o));
    return v;
}
__device__ __forceinline__ float gelu_tanh(float x) {
    const float t = x * x;
    const float u2 = x * (1.5957691216057308f + 0.07135481627260024f * t);
    const float e = __builtin_amdgcn_exp2f(-LOG2E * u2);
    return x * __builtin_amdgcn_rcpf(1.0f + e);
}
__device__ __forceinline__ float silu_f(float x) {
    const float e = __builtin_amdgcn_exp2f(-LOG2E * x);
    return x * __builtin_amdgcn_rcpf(1.0f + e);
}
__device__ __forceinline__ int t5_bucket(int d) {
    if (d < 16) return d;
    int b = 16;
    b += (d >= 22); b += (d >= 30); b += (d >= 40); b += (d >= 54); b += (d >= 73); b += (d >= 99); b += (d >= 134); b += (d >= 182);
    b += (d >= 246); b += (d >= 332); b += (d >= 450); b += (d >= 609); b += (d >= 825); b += (d >= 1117); b += (d >= 1513);
    return b;
}
__device__ __forceinline__ unsigned off_b(unsigned row, unsigned ch) { return 256u * row + 16u * (ch ^ (((row & 3) << 2) | ((row >> 2) & 3))); }
__device__ __forceinline__ unsigned tr16_addr(unsigned lane, unsigned c, unsigned ks, unsigned t) {
    const unsigned g = lane >> 4, q = (lane & 15) >> 2, p = lane & 3;
    return off_b(32 * ks + 8 * g + 4 * t + q, 2 * c + (p >> 1)) + 8 * (p & 1);
}
typedef short v4i16_t __attribute__((ext_vector_type(4)));
__device__ __forceinline__ s16x4 tr_read(LAS unsigned char* p) { return __builtin_bit_cast(s16x4, __builtin_amdgcn_ds_read_tr16_b64_v4i16((LAS v4i16_t*)p)); }

namespace pg8 {
constexpr int BM = 256, BK = 64, HALF = 128, HTB = HALF * BK * 2, STAGE_BYTES = 8 * HTB, NXCD = 8, WGM = 4;
__host__ __device__ __forceinline__ int lds_byte(int r, int c) { const int st = (r >> 4) * 2 + (c >> 5), rr = r & 15, cc = c & 31, ob = rr * 64 + cc * 2; return st * 1024 + (ob ^ (((ob >> 9) & 1) << 5)); }
__host__ __device__ __forceinline__ void stage_rc(int b, int& R, int& C) { const int st = b / 1024, sb = b % 1024, swz = sb ^ (((sb >> 9) & 1) << 5); R = (st >> 1) * 16 + swz / 64; C = (st & 1) * 32 + (swz % 64) / 2; }
__host__ __device__ __forceinline__ int perm32(int rho) { const int n = rho >> 4, i = rho & 15; return 8 * (i >> 2) + 4 * n + (i & 3); }

struct Unit { int pm, pn; };
struct Gemm { const bf16_t* A; const bf16_t* Bt; int M, N, K; };

struct StaticOrder {
    int nM, nN, nwg, G, c;
    __host__ __device__ void init(int M, int N, int G_, int c_) { nM = M / BM; nN = N / BM; nwg = nM * nN; G = G_; c = c_; }
    __host__ __device__ bool next(int i, Unit& u) const {
        const long L = (long)i * G + c; if (L >= nwg) return false;
        int wgid = (int)L; { const int q = nwg / NXCD, r = nwg % NXCD, xcd = wgid % NXCD, off = wgid / NXCD; wgid = (xcd < r ? xcd * (q + 1) : r * (q + 1) + (xcd - r) * q) + off; }
        const int nig = WGM * nN, gid = wgid / nig, fm = gid * WGM, gsz = (nM - fm) < WGM ? (nM - fm) : WGM;
        u.pm = fm + ((wgid % nig) % gsz); u.pn = (wgid % nig) / gsz; return true;
    }
};

template <class Epi, bool ALIGN_EPI, bool SP2>
__device__ __forceinline__ void gemm_phase(LAS unsigned char* lds, const Gemm g, const StaticOrder& S, const Epi& E) {
    int tid = threadIdx.x; asm volatile("" : "+v"(tid));
    const int wid = __builtin_amdgcn_readfirstlane(tid >> 6), lane = tid & 63, wr = wid >> 2, wc = wid & 3, fr = lane & 15, fq = lane >> 4;
    const int K = g.K, nt = K / BK;
    unsigned voffA[2], voffB[2];
#pragma unroll
    for (int i = 0; i < 2; ++i) { int R, C; stage_rc(tid * 16 + i * 8192, R, C); const int Rb = (R & ~31) + perm32(R & 31);
        voffA[i] = (unsigned)(R * K + C) * 2u; voffB[i] = (unsigned)(Rb * K + C) * 2u; }
    const size_t kstep = (size_t)(BK * 2);
    const size_t hstep = (size_t)HALF * K * 2;
    const size_t tstep = 2 * hstep;
    const unsigned ldsw = (unsigned)wid * 1024u;
    const int aoff = lds_byte(wr * 64 + fr, fq * 8), boff = lds_byte(wc * 32 + fr, fq * 8);
#define PG8_SA(b, h) (((b) * 2 + (h)) * HTB)
#define PG8_SB(b, h) ((4 + (b) * 2 + (h)) * HTB)
#define PG8_STAGE(bufoff, gbase, voff) do { _Pragma("unroll") for (int _i = 0; _i < 2; ++_i) \
        __builtin_amdgcn_global_load_lds((const unsigned*)((const char*)(gbase) + (voff)[_i]), (LAS unsigned*)(lds + (bufoff) + ldsw + _i * 8192), 16, 0, 0); } while (0)
#define PG8_LDA(dst, b, h) do { _Pragma("unroll") for (int m = 0; m < 4; ++m) _Pragma("unroll") for (int k = 0; k < 2; ++k) dst[m][k] = *(const LAS bf16x8*)(lds + PG8_SA(b, h) + aoff + m * 2048 + k * 1024); } while (0)
#define PG8_LDB(dst, b, h) do { _Pragma("unroll") for (int n = 0; n < 2; ++n) _Pragma("unroll") for (int k = 0; k < 2; ++k) dst[n][k] = *(const LAS bf16x8*)(lds + PG8_SB(b, h) + boff + n * 2048 + k * 1024); } while (0)
#define PG8_MMA(ai, bj, At, Bt) do { __builtin_amdgcn_s_setprio(1); _Pragma("unroll") for (int m = 0; m < 4; ++m) _Pragma("unroll") for (int n = 0; n < 2; ++n) _Pragma("unroll") for (int k = 0; k < 2; ++k) \
        acc[ai][bj][m][n] = __builtin_amdgcn_mfma_f32_16x16x32_bf16(Bt[n][k], At[m][k], acc[ai][bj][m][n], 0, 0, 0); __builtin_amdgcn_s_setprio(0); } while (0)
#define PG8_WAIT_V(n) asm volatile("s_waitcnt vmcnt(" #n ")" ::: "memory")
#define PG8_WAIT_L(n) asm volatile("s_waitcnt lgkmcnt(" #n ")" ::: "memory")
#define PG8_BAR __builtin_amdgcn_s_barrier()
#define PG8_SCHED __builtin_amdgcn_sched_barrier(0)
    Unit cur, nxt; int ui = 0;
    if (!S.next(0, cur)) return;
    f32x4 acc[2][2][4][2];
#pragma unroll
    for (int a = 0; a < 2; ++a)
#pragma unroll
        for (int b = 0; b < 2; ++b)
#pragma unroll
            for (int m = 0; m < 4; ++m)
#pragma unroll
                for (int n = 0; n < 2; ++n) acc[a][b][m][n] = (f32x4){0.f, 0.f, 0.f, 0.f};
    bf16x8 At[4][2], B0[2][2], B1[2][2];
    const char* cA = (const char*)g.A + (size_t)cur.pm * tstep; const char* cB = (const char*)g.Bt + (size_t)cur.pn * tstep;
    if constexpr (SP2) {
        PG8_STAGE(PG8_SB(0, 0), cB, voffB); PG8_STAGE(PG8_SB(0, 1), cB + hstep, voffB); PG8_STAGE(PG8_SA(0, 0), cA, voffA); PG8_STAGE(PG8_SA(0, 1), cA + hstep, voffA);
        if (wr == 1) PG8_BAR;
        PG8_WAIT_V(2); PG8_BAR;
        PG8_STAGE(PG8_SB(1, 0), cB + kstep, voffB); PG8_STAGE(PG8_SA(1, 0), cA + kstep, voffA); PG8_STAGE(PG8_SB(1, 1), cB + hstep + kstep, voffB);
        PG8_WAIT_V(6); PG8_BAR;
    } else {
        PG8_STAGE(PG8_SB(0, 0), cB, voffB); PG8_STAGE(PG8_SA(0, 0), cA, voffA); PG8_STAGE(PG8_SB(0, 1), cB + hstep, voffB); PG8_STAGE(PG8_SA(0, 1), cA + hstep, voffA);
        if (wr == 1) PG8_BAR;
        PG8_WAIT_V(4); PG8_BAR;
        PG8_STAGE(PG8_SB(1, 0), cB + kstep, voffB); PG8_STAGE(PG8_SA(1, 0), cA + kstep, voffA); PG8_STAGE(PG8_SB(1, 1), cB + hstep + kstep, voffB);
        PG8_WAIT_V(6); PG8_BAR;
    }
    for (;;) {
        const typename Epi::Pre pre = E.prefetch(cur, wr, fr);
        const bool has_next = S.next(ui + 1, nxt);
        const char* nA = has_next ? (const char*)g.A + (size_t)nxt.pm * tstep : cA; const char* nB = has_next ? (const char*)g.Bt + (size_t)nxt.pn * tstep : cB;
        for (int t = 0; t < nt; t += 2) {
            const bool last = (t == nt - 2);
            const char* a1 = cA + (size_t)(t + 1) * kstep;
            const char* a2 = last ? nA : cA + (size_t)(t + 2) * kstep; const char* b2 = last ? nB : cB + (size_t)(t + 2) * kstep;
            const char* a3 = a2 + kstep; const char* b3 = b2 + kstep;
            if constexpr (SP2) {
            PG8_LDB(B0, 0, 0); PG8_LDB(B1, 0, 1); PG8_SCHED; PG8_LDA(At, 0, 0); PG8_STAGE(PG8_SA(1, 1), a1 + hstep, voffA);
            PG8_WAIT_V(8); PG8_WAIT_L(0); PG8_BAR; PG8_MMA(0, 0, At, B0); PG8_MMA(0, 1, At, B1); PG8_BAR; PG8_SCHED;
            PG8_LDA(At, 0, 1); PG8_STAGE(PG8_SB(0, 0), b2, voffB); PG8_STAGE(PG8_SB(0, 1), b2 + hstep, voffB); PG8_STAGE(PG8_SA(0, 0), a2, voffA);
            PG8_WAIT_V(8); PG8_WAIT_L(0); PG8_BAR; PG8_MMA(1, 0, At, B0); PG8_MMA(1, 1, At, B1); PG8_BAR; PG8_SCHED;
            PG8_LDB(B0, 1, 0); PG8_LDB(B1, 1, 1); PG8_SCHED; PG8_LDA(At, 1, 0); PG8_STAGE(PG8_SA(0, 1), a2 + hstep, voffA);
            PG8_WAIT_V(8); PG8_WAIT_L(0); PG8_BAR; PG8_MMA(0, 0, At, B0); PG8_MMA(0, 1, At, B1); PG8_BAR; PG8_SCHED;
            PG8_LDA(At, 1, 1); PG8_STAGE(PG8_SB(1, 0), b3, voffB); PG8_STAGE(PG8_SB(1, 1), b3 + hstep, voffB); PG8_STAGE(PG8_SA(1, 0), a3, voffA);
            PG8_WAIT_V(8); PG8_WAIT_L(0); PG8_BAR; PG8_MMA(1, 0, At, B0); PG8_MMA(1, 1, At, B1); PG8_BAR; PG8_SCHED;
            } else {
            PG8_LDB(B0, 0, 0); PG8_SCHED; PG8_LDA(At, 0, 0); PG8_STAGE(PG8_SA(1, 1), a1 + hstep, voffA);
            PG8_WAIT_L(8); PG8_BAR; PG8_WAIT_L(0); PG8_MMA(0, 0, At, B0); PG8_BAR; PG8_SCHED;
            PG8_LDB(B1, 0, 1); PG8_STAGE(PG8_SB(0, 0), b2, voffB);
            PG8_BAR; PG8_WAIT_L(0); PG8_MMA(0, 1, At, B1); PG8_BAR;
            PG8_LDA(At, 0, 1); PG8_STAGE(PG8_SA(0, 0), a2, voffA);
            PG8_BAR; PG8_WAIT_L(0); PG8_MMA(1, 0, At, B0); PG8_BAR; PG8_SCHED;
            PG8_STAGE(PG8_SB(0, 1), b2 + hstep, voffB);
            PG8_WAIT_V(6); PG8_BAR; PG8_MMA(1, 1, At, B1); PG8_BAR;
            PG8_LDB(B0, 1, 0); PG8_SCHED; PG8_LDA(At, 1, 0); PG8_STAGE(PG8_SA(0, 1), a2 + hstep, voffA);
            PG8_WAIT_L(8); PG8_BAR; PG8_WAIT_L(0); PG8_MMA(0, 0, At, B0); PG8_BAR; PG8_SCHED;
            PG8_LDB(B1, 1, 1); PG8_STAGE(PG8_SB(1, 0), b3, voffB);
            PG8_BAR; PG8_WAIT_L(0); PG8_MMA(0, 1, At, B1); PG8_BAR;
            PG8_LDA(At, 1, 1); PG8_STAGE(PG8_SA(1, 0), a3, voffA);
            PG8_BAR; PG8_WAIT_L(0); PG8_MMA(1, 0, At, B0); PG8_BAR; PG8_SCHED;
            PG8_STAGE(PG8_SB(1, 1), b3 + hstep, voffB);
            PG8_WAIT_V(6); PG8_BAR; PG8_MMA(1, 1, At, B1); PG8_BAR;
            }
        }
        if constexpr (ALIGN_EPI) { if (wr == 0) PG8_BAR; }
        E(acc, cur, wr, wc, fr, fq, pre);
        if (!has_next) break;
#pragma unroll
        for (int a = 0; a < 2; ++a)
#pragma unroll
            for (int b = 0; b < 2; ++b)
#pragma unroll
                for (int m = 0; m < 4; ++m)
#pragma unroll
                    for (int n = 0; n < 2; ++n) acc[a][b][m][n] = (f32x4){0.f, 0.f, 0.f, 0.f};
        cur = nxt; cA = nA; cB = nB; ++ui;
        if constexpr (ALIGN_EPI) { if (wr == 1) PG8_BAR; }
    }
    PG8_WAIT_V(0);
    if constexpr (!ALIGN_EPI) { if (wr == 0) PG8_BAR; }
    PG8_BAR;
#undef PG8_SA
#undef PG8_SB
#undef PG8_STAGE
#undef PG8_LDA
#undef PG8_LDB
#undef PG8_MMA
#undef PG8_WAIT_V
#undef PG8_WAIT_L
#undef PG8_BAR
#undef PG8_SCHED
}

typedef f32x4 Acc[2][2][4][2];
struct PreRs { float r[2][4]; };
struct PreNone { };
__device__ __forceinline__ PreRs load_rs(const float* rs, const Unit& u, int wr, int fr) { PreRs p; const int row0 = u.pm * BM + wr * 64 + fr;
#pragma unroll
    for (int ai = 0; ai < 2; ++ai)
#pragma unroll
        for (int m = 0; m < 4; ++m) p.r[ai][m] = rs[row0 + ai * HALF + m * 16];
    return p; }
__device__ __forceinline__ u32x4 pack8(const f32x4 a, const f32x4 b) { u32x4 w; w.x = cvt_pk_bf16(a[0], a[1]); w.y = cvt_pk_bf16(a[2], a[3]); w.z = cvt_pk_bf16(b[0], b[1]); w.w = cvt_pk_bf16(b[2], b[3]); return w; }

struct EpiInA {
    bf16_t* Z; float* VSS; const float* rs;
    typedef PreRs Pre; __device__ __forceinline__ Pre prefetch(const Unit& u, int wr, int fr) const { return load_rs(rs, u, wr, fr); }
    __device__ __forceinline__ void operator()(const Acc& acc, const Unit& u, int wr, int wc, int fr, int fq, const Pre& pre) const {
        const int row0 = u.pm * BM + wr * 64 + fr, col0 = u.pn * BM + wc * 32 + 8 * fq;
        const bool act = u.pn < 12, isv = (u.pn >= 6) && act;
#pragma unroll
        for (int ai = 0; ai < 2; ++ai)
#pragma unroll
            for (int m = 0; m < 4; ++m) {
                const int row = row0 + ai * HALF + m * 16; bf16_t* rowp = Z + (size_t)row * ZP + col0; float ss = 0.f; const float rsr = pre.r[ai][m];
#pragma unroll
                for (int bj = 0; bj < 2; ++bj) { f32x4 v0 = acc[ai][bj][m][0] * rsr, v1 = acc[ai][bj][m][1] * rsr;
                    if (act) {
#pragma unroll
                        for (int e = 0; e < 4; ++e) { v0[e] = gelu_tanh(v0[e]); v1[e] = gelu_tanh(v1[e]); ss += v0[e] * v0[e] + v1[e] * v1[e]; }
                    } else { v0 = v0 * QSCALE; v1 = v1 * QSCALE; }
                    *(u32x4*)(rowp + bj * HALF) = pack8(v0, v1); }
                if (isv) { ss += __shfl_xor(ss, 16); ss += __shfl_xor(ss, 32); if (fq == 0) VSS[(size_t)row * 24 + (u.pn - 6) * 4 + wc] = ss; }
            }
    }
};
struct EpiMkv {
    float* outf; bf16_t* outb; const float* rs;
    typedef PreRs Pre; __device__ __forceinline__ Pre prefetch(const Unit& u, int wr, int fr) const { return load_rs(rs, u, wr, fr); }
    __device__ __forceinline__ void operator()(const Acc& acc, const Unit& u, int wr, int wc, int fr, int fq, const Pre& pre) const {
        const int row0 = u.pm * BM + wr * 64 + fr, col0 = u.pn * BM + wc * 32 + 8 * fq;
#pragma unroll
        for (int ai = 0; ai < 2; ++ai)
#pragma unroll
            for (int m = 0; m < 4; ++m) { const size_t off = (size_t)(row0 + ai * HALF + m * 16) * NKV + col0; const float rsr = pre.r[ai][m];
#pragma unroll
                for (int bj = 0; bj < 2; ++bj) { const f32x4 v0 = acc[ai][bj][m][0] * rsr, v1 = acc[ai][bj][m][1] * rsr;
                    *(f32x4*)(outf + off + bj * HALF) = v0; *(f32x4*)(outf + off + bj * HALF + 4) = v1; *(u32x4*)(outb + off + bj * HALF) = pack8(v0, v1); } }
    }
};
struct EpiPlain {
    bf16_t* O; int ldc;
    typedef PreNone Pre; __device__ __forceinline__ Pre prefetch(const Unit&, int, int) const { return Pre{}; }
    __device__ __forceinline__ void operator()(const Acc& acc, const Unit& u, int wr, int wc, int fr, int fq, const Pre&) const {
        const int row0 = u.pm * BM + wr * 64 + fr, col0 = u.pn * BM + wc * 32 + 8 * fq;
#pragma unroll
        for (int ai = 0; ai < 2; ++ai)
#pragma unroll
            for (int m = 0; m < 4; ++m) { bf16_t* rowp = O + (size_t)(row0 + ai * HALF + m * 16) * ldc + col0;
#pragma unroll
                for (int bj = 0; bj < 2; ++bj) *(u32x4*)(rowp + bj * HALF) = pack8(acc[ai][bj][m][0], acc[ai][bj][m][1]); }
    }
};
struct EpiSwiglu {
    bf16_t* ACT; const float* rs;
    typedef PreRs Pre; __device__ __forceinline__ Pre prefetch(const Unit& u, int wr, int fr) const { return load_rs(rs, u, wr, fr); }
    __device__ __forceinline__ void operator()(const Acc& acc, const Unit& u, int wr, int wc, int fr, int fq, const Pre& pre) const {
        const int row0 = u.pm * BM + wr * 64 + fr, col0 = u.pn * HALF + wc * 32 + 8 * fq;
#pragma unroll
        for (int ai = 0; ai < 2; ++ai)
#pragma unroll
            for (int m = 0; m < 4; ++m) { f32x4 v0, v1; const float rsr = pre.r[ai][m];
#pragma unroll
                for (int e = 0; e < 4; ++e) { v0[e] = silu_f(acc[ai][0][m][0][e] * rsr) * (acc[ai][1][m][0][e] * rsr); v1[e] = silu_f(acc[ai][0][m][1][e] * rsr) * (acc[ai][1][m][1][e] * rsr); }
                *(u32x4*)(ACT + (size_t)(row0 + ai * HALF + m * 16) * DFF + col0) = pack8(v0, v1); }
    }
};
struct EpiInB {
    bf16_t* Z; const float* rs;
    typedef PreRs Pre; __device__ __forceinline__ Pre prefetch(const Unit& u, int wr, int fr) const { return load_rs(rs, u, wr, fr); }
    __device__ __forceinline__ void operator()(const Acc& acc, const Unit& u, int wr, int wc, int fr, int fq, const Pre& pre) const {
        const int row0 = u.pm * BM + wr * 64 + fr, col0 = u.pn * BM + wc * 32 + 8 * fq;
        const float qs = ((u.pn < 6) || (u.pn >= 18)) ? QSCALE : 1.0f;
#pragma unroll
        for (int ai = 0; ai < 2; ++ai)
#pragma unroll
            for (int m = 0; m < 4; ++m) {
                const int row = row0 + ai * HALF + m * 16; bf16_t* rowp = Z + (size_t)row * ZP + col0; const float rsr = pre.r[ai][m] * qs;
#pragma unroll
                for (int bj = 0; bj < 2; ++bj) *(u32x4*)(rowp + bj * HALF) = pack8(acc[ai][bj][m][0] * rsr, acc[ai][bj][m][1] * rsr);
            }
    }
};
}

__device__ __forceinline__ unsigned f2bf(float f) { unsigned u = __builtin_bit_cast(unsigned, f); return (u + 0x7fffu + ((u >> 16) & 1u)) >> 16; }
__device__ __forceinline__ unsigned pk2(float lo, float hi) { return f2bf(lo) | (f2bf(hi) << 16); }
struct TItem { const float* src; bf16_t* dst; const float* gain; int N, K; };
__device__ __forceinline__ TItem t_make(const float* W, int K, int N, bf16_t* WT, bool upperm, const float* gain, int item) {
    const int nblk = N / 64, kb = item / nblk, nb = item % nblk, k0 = 64 * kb, n0 = 64 * nb;
    int s0 = n0;
    if (upperm) { const int pn = n0 >> 8, j = n0 & 255; s0 = (j < 128) ? (128 * pn + j) : (DFF + 128 * pn + (j - 128)); }
    TItem t; t.src = W + (size_t)k0 * N + s0; t.dst = WT + (size_t)n0 * K + k0; t.gain = gain != nullptr ? gain + k0 : nullptr; t.N = N; t.K = K; return t;
}
__device__ __forceinline__ void t_load(const TItem& t, int lane, f32x4 (&v)[16]) {
    const float* src = t.src + (size_t)(lane >> 4) * t.N + 4 * (lane & 15);
#pragma unroll
    for (int i = 0; i < 16; ++i) v[i] = __builtin_nontemporal_load((const f32x4*)(src + (size_t)(4 * i) * t.N));
}
__device__ __forceinline__ void t_store(const TItem& t, LAS float* scr, int lane, const f32x4 (&v)[16]) {
    const int lr = lane >> 4, lc = lane & 15;
#pragma unroll
    for (int i = 0; i < 16; ++i) { const int k = 4 * i + lr; const float gk = t.gain != nullptr ? t.gain[k] : 1.0f;
        *(LAS f32x4*)(scr + k * 64 + ((4 * lc) ^ (4 * (k >> 3)))) = v[i] * gk; }
    asm volatile("s_waitcnt lgkmcnt(0)" ::: "memory");
    const int c = lane & 7;
#pragma unroll
    for (int j = 0; j < 8; ++j) { const int n = (lane >> 3) + 8 * j; const LAS float* sp = scr + (8 * c) * 64 + (n ^ (4 * c));
        u32x4 o; o.x = cvt_pk_bf16(sp[0 * 64], sp[1 * 64]); o.y = cvt_pk_bf16(sp[2 * 64], sp[3 * 64]); o.z = cvt_pk_bf16(sp[4 * 64], sp[5 * 64]); o.w = cvt_pk_bf16(sp[6 * 64], sp[7 * 64]);
        *(u32x4*)(t.dst + (size_t)n * t.K + 8 * c) = o; }
    asm volatile("s_waitcnt lgkmcnt(0)" ::: "memory");
}
template <int MODE>
__device__ __forceinline__ void norm_row(const float* basef, bf16_t* yb, const bf16_t* o, const float* gpost, float* rs_out, float* yout, int lane) {
    f32x4 y[8];
    if (MODE == 0 || MODE == 1) {
#pragma unroll
        for (int j = 0; j < 8; ++j) y[j] = *(const f32x4*)(basef + 4 * (lane + 64 * j));
    } else {
#pragma unroll
        for (int j = 0; j < 8; ++j) { const u32x2 w = *(const u32x2*)(yb + 4 * (lane + 64 * j)); y[j] = (f32x4){bf_lo(w.x), bf_hi(w.x), bf_lo(w.y), bf_hi(w.y)}; }
    }
    if (MODE != 0) {
        f32x4 ov[8]; float ss = 0.f;
#pragma unroll
        for (int j = 0; j < 8; ++j) { const u32x2 w = *(const u32x2*)(o + 4 * (lane + 64 * j)); ov[j] = (f32x4){bf_lo(w.x), bf_hi(w.x), bf_lo(w.y), bf_hi(w.y)};
            ss += (ov[j][0] * ov[j][0] + ov[j][1] * ov[j][1]) + (ov[j][2] * ov[j][2] + ov[j][3] * ov[j][3]); }
        const float rstd = 1.0f / sqrtf(wave_sum(ss) * (1.0f / DM) + EPS);
#pragma unroll
        for (int j = 0; j < 8; ++j) { const f32x4 g = *(const f32x4*)(gpost + 4 * (lane + 64 * j)); y[j] = y[j] + ov[j] * rstd * g; }
    }
    if (MODE == 3) {
#pragma unroll
        for (int j = 0; j < 8; ++j) *(f32x4*)(yout + 4 * (lane + 64 * j)) = y[j];
    } else {
        float ss = 0.f;
#pragma unroll
        for (int j = 0; j < 8; ++j) { ss += (y[j][0] * y[j][0] + y[j][1] * y[j][1]) + (y[j][2] * y[j][2] + y[j][3] * y[j][3]);
            u32x2 w; w.x = cvt_pk_bf16(y[j][0], y[j][1]); w.y = cvt_pk_bf16(y[j][2], y[j][3]); *(u32x2*)(yb + 4 * (lane + 64 * j)) = w; }
        ss = wave_sum(ss);
        if (lane == 0) *rs_out = 1.0f / sqrtf(ss * (1.0f / DM) + EPS);
    }
}

struct NormRaw { u32x2 yb[8]; u32x2 ob[8]; };
__device__ __forceinline__ void norm_load(const bf16_t* yb, const bf16_t* o, int lane, NormRaw& R) {
#pragma unroll
    for (int j = 0; j < 8; ++j) { R.yb[j] = *(const u32x2*)(yb + 4 * (lane + 64 * j)); R.ob[j] = *(const u32x2*)(o + 4 * (lane + 64 * j)); }
}
template <bool FINAL>
__device__ __forceinline__ void norm_finish(const NormRaw& R, bf16_t* yb, const float* gpost, float* rs_out, float* yout, int lane) {
    f32x4 y[8], ov[8]; float ss = 0.f;
#pragma unroll
    for (int j = 0; j < 8; ++j) { y[j] = (f32x4){bf_lo(R.yb[j].x), bf_hi(R.yb[j].x), bf_lo(R.yb[j].y), bf_hi(R.yb[j].y)}; ov[j] = (f32x4){bf_lo(R.ob[j].x), bf_hi(R.ob[j].x), bf_lo(R.ob[j].y), bf_hi(R.ob[j].y)};
        ss += (ov[j][0] * ov[j][0] + ov[j][1] * ov[j][1]) + (ov[j][2] * ov[j][2] + ov[j][3] * ov[j][3]); }
    const float rstd = 1.0f / sqrtf(wave_sum(ss) * (1.0f / DM) + EPS);
#pragma unroll
    for (int j = 0; j < 8; ++j) { const f32x4 g = *(const f32x4*)(gpost + 4 * (lane + 64 * j)); y[j] = y[j] + ov[j] * rstd * g; }
    if (FINAL) {
#pragma unroll
        for (int j = 0; j < 8; ++j) *(f32x4*)(yout + 4 * (lane + 64 * j)) = y[j];
    } else {
        float s2 = 0.f;
#pragma unroll
        for (int j = 0; j < 8; ++j) { s2 += (y[j][0] * y[j][0] + y[j][1] * y[j][1]) + (y[j][2] * y[j][2] + y[j][3] * y[j][3]);
            u32x2 w; w.x = cvt_pk_bf16(y[j][0], y[j][1]); w.y = cvt_pk_bf16(y[j][2], y[j][3]); *(u32x2*)(yb + 4 * (lane + 64 * j)) = w; }
        s2 = wave_sum(s2);
        if (lane == 0) *rs_out = 1.0f / sqrtf(s2 * (1.0f / DM) + EPS);
    }
}

struct KvDesc { const bf16_t* kbase; const bf16_t* vbase; long row0, rstep, pitch; int key_lo; };
__device__ __forceinline__ void kv_issue(const KvDesc& d, int tid, u32x4 (&kk)[8], u32x4 (&vv)[8]) {
    const int srow = tid >> 4, sch = tid & 15;
#pragma unroll
    for (int i = 0; i < 8; ++i) { const int row = srow + 32 * i, rowc = row < d.key_lo ? d.key_lo : row;
        const size_t e = (size_t)(d.row0 + (long)rowc * d.rstep) * d.pitch + sch * 8; kk[i] = *(const u32x4*)(d.kbase + e); vv[i] = *(const u32x4*)(d.vbase + e); }
}
__device__ __forceinline__ void kv_commit(LAS unsigned char* lds, int tid, int key_lo, const u32x4 (&kk)[8], const u32x4 (&vv)[8]) {
    const unsigned sb = off_b(tid >> 4, tid & 15); const int srow = tid >> 4; const u32x4 z = (u32x4){0u, 0u, 0u, 0u};
#pragma unroll
    for (int i = 0; i < 8; ++i) { const bool ok = (srow + 32 * i) >= key_lo; *(LAS u32x4*)(lds + sb + 8192 * i) = ok ? kk[i] : z; *(LAS u32x4*)(lds + 65536 + sb + 8192 * i) = ok ? vv[i] : z; }
}
template <bool BANDED>
__device__ __forceinline__ void attn_compute(LAS unsigned char* lds, int lane, int w, const bf16x8 (&qf)[4], int key_lo, bf16_t* orow, float* lsep, const LAS float* btab) {
    const int fr = lane & 15, fq = lane >> 4;
    LAS unsigned char* Kimg = lds; LAS unsigned char* Vimg = lds + 65536;
    constexpr int NBLK = BANDED ? 5 : 8;
    const int blk0 = BANDED ? (w >> 1) : 0;
    const int qi = 16 * w + fr;
    unsigned kb[2][4];
#pragma unroll
    for (int e = 0; e < 2; ++e)
#pragma unroll
        for (int kk = 0; kk < 4; ++kk) kb[e][kk] = off_b(8 * (fr >> 2) + 4 * e + (fr & 3), 4 * kk + fq);
    LAS unsigned char* Kb = Kimg + 8192 * blk0; LAS unsigned char* Vb = Vimg + 8192 * blk0;
    f32x4 s[2 * NBLK];
#pragma unroll
    for (int nt = 0; nt < 2 * NBLK; ++nt) s[nt] = (f32x4){0.f, 0.f, 0.f, 0.f};
    constexpr int TB = BANDED ? 2 * NBLK : NBLK;
#pragma unroll
    for (int t0 = 0; t0 < 2 * NBLK; t0 += TB)
#pragma unroll
        for (int kk = 0; kk < 4; ++kk) { bf16x8 kf[TB];
#pragma unroll
            for (int i = 0; i < TB; ++i) { const int nt = t0 + i; kf[i] = *(const LAS bf16x8*)(Kb + kb[nt & 1][kk] + 8192 * (nt >> 1)); }
            __builtin_amdgcn_sched_barrier(0);
#pragma unroll
            for (int i = 0; i < TB; ++i) s[t0 + i] = __builtin_amdgcn_mfma_f32_16x16x32_bf16(kf[i], qf[kk], s[t0 + i], 0, 0, 0);
            __builtin_amdgcn_sched_barrier(0); }
    float mx = -1e30f;
    const LAS float* bp = btab + (128 + 16 * (w & 1) + fr - 8 * fq + 32 - 135);
    const int cmin = BANDED ? (key_lo > 0 ? (128 + 16 * (w & 1) + fr - 8 * fq) - qi : -1000) : 0;
#pragma unroll
    for (int nt = 0; nt < 2 * NBLK; ++nt)
#pragma unroll
        for (int r = 0; r < 4; ++r) { float x = s[nt][r];
            if (BANDED) { const int c = 32 * (nt >> 1) + 4 * (nt & 1) + r; x = x + bp[135 - c]; x = (c >= cmin) ? x : -1e30f; s[nt][r] = x; }
            mx = fmaxf(mx, x); }
    mx = fmaxf(mx, __shfl_xor(mx, 16)); mx = fmaxf(mx, __shfl_xor(mx, 32));
    float l = 0.f;
#pragma unroll
    for (int nt = 0; nt < 2 * NBLK; ++nt)
#pragma unroll
        for (int r = 0; r < 4; ++r) { const float p = __builtin_amdgcn_exp2f(s[nt][r] - mx); s[nt][r] = p; l += p; }
    l += __shfl_xor(l, 16); l += __shfl_xor(l, 32);
    bf16x8 pf[NBLK];
#pragma unroll
    for (int ks = 0; ks < NBLK; ++ks) pf[ks] = __builtin_bit_cast(bf16x8, pg8::pack8(s[2 * ks], s[2 * ks + 1]));
    const float inv_l = 1.0f / l;
    unsigned vb[8][2];
#pragma unroll
    for (int ct = 0; ct < 8; ++ct) { vb[ct][0] = tr16_addr(lane, ct, 0, 0); vb[ct][1] = tr16_addr(lane, ct, 0, 1); }
    f32x4 oa[8];
#pragma unroll
    for (int ct = 0; ct < 8; ++ct) oa[ct] = (f32x4){0.f, 0.f, 0.f, 0.f};
#pragma unroll
    for (int ks = 0; ks < NBLK; ++ks) { s16x4 vlo[8], vhi[8];
#pragma unroll
        for (int ct = 0; ct < 8; ++ct) { vlo[ct] = tr_read(Vb + vb[ct][0] + 8192 * ks); vhi[ct] = tr_read(Vb + vb[ct][1] + 8192 * ks); }
        __builtin_amdgcn_sched_barrier(0);
#pragma unroll
        for (int ct = 0; ct < 8; ++ct) { const bf16x8 vf = (bf16x8){vlo[ct][0], vlo[ct][1], vlo[ct][2], vlo[ct][3], vhi[ct][0], vhi[ct][1], vhi[ct][2], vhi[ct][3]};
            oa[ct] = __builtin_amdgcn_mfma_f32_16x16x32_bf16(vf, pf[ks], oa[ct], 0, 0, 0); }
        __builtin_amdgcn_sched_barrier(0); }
#pragma unroll
    for (int ct = 0; ct < 8; ++ct) { u32x2 wv; wv.x = cvt_pk_bf16(oa[ct][0] * inv_l, oa[ct][1] * inv_l); wv.y = cvt_pk_bf16(oa[ct][2] * inv_l, oa[ct][3] * inv_l);
        *(u32x2*)(orow + 16 * ct) = wv; }
    if (lsep != nullptr && fq == 0) *lsep = (mx + __builtin_amdgcn_logf(l)) * LN2;
}
struct QoDesc { const bf16_t* qbase; long row0, rstep; bf16_t* obase; float* lsebase; int banded, dil, head; };

struct GateRegs { u32x4 v[2][6]; f32x4 wq[8]; f32x4 vs[3]; float gvl; };
__device__ __forceinline__ void gate_issue(int tid, int b, int chunk, int g, const bf16_t* Z, const float* VSS, const float* w_s, const float* g_v, GateRegs& R) {
    const int lane = tid & 63, w = __builtin_amdgcn_readfirstlane(tid >> 6), fr = lane & 15, fq = lane >> 4;
    const int tok0 = b * SEQ + chunk * 128;
    {
        const int r0 = tid >> 3, c0 = tid & 7; const bf16_t* gp = Z + (size_t)(tok0 + r0) * ZP + MIXW + g * 384 + c0 * 8;
#pragma unroll
        for (int i2 = 0; i2 < 2; ++i2)
#pragma unroll
            for (int i = 0; i < 6; ++i) R.v[i2][i] = *(const u32x4*)(gp + (size_t)i2 * 64 * ZP + 64 * i); }
    { const float* wp = w_s + (size_t)g * 16384 + (16 * w + fr) * 128 + 8 * fq;
#pragma unroll
      for (int kk = 0; kk < 4; ++kk) { R.wq[2 * kk] = *(const f32x4*)(wp + 32 * kk); R.wq[2 * kk + 1] = *(const f32x4*)(wp + 32 * kk + 4); } }
    { const float* p = VSS + (size_t)(tok0 + (tid & 127)) * 24 + 12 * ((tid >> 7) & 1);
#pragma unroll
      for (int i = 0; i < 3; ++i) R.vs[i] = *(const f32x4*)(p + 4 * i); }
    R.gvl = g_v[g * 384 + (tid < 384 ? tid : tid - 384)];
}
__device__ __forceinline__ void gate_run(LAS unsigned char* lds, int tid, int b, int chunk, int g, const GateRegs& R, const bf16_t* Z, const float* b_s, bf16_t* MIX) {
    const int lane = tid & 63, w = __builtin_amdgcn_readfirstlane(tid >> 6), fr = lane & 15, fq = lane >> 4;
    const int tok0 = b * SEQ + chunk * 128, i = 16 * w + fr;
    LAS float* rs = (LAS float*)(lds + LDS_TAB); LAS float* gvs = rs + 128;
    const size_t tokrow = (size_t)(tok0 + i);
    __syncthreads();
    const bf16_t* up = Z + tokrow * ZP + g * 384 + 4 * fq;
    u32x2 ucur[8];
    const float bs = b_s[g * 128 + i];
    {
        const int r0 = tid >> 3, c0 = tid & 7; const unsigned gsb0 = off_b(r0, c0), gsb1 = off_b(r0, c0 + 8);
#pragma unroll
        for (int i2 = 0; i2 < 2; ++i2)
#pragma unroll
            for (int k = 0; k < 6; ++k) *(LAS u32x4*)(lds + (k >> 1) * 32768 + ((k & 1) ? gsb1 : gsb0) + 16384 * i2) = R.v[i2][k]; }
    { float ssum = 0.f;
#pragma unroll
      for (int k = 0; k < 3; ++k) ssum += (R.vs[k][0] + R.vs[k][1]) + (R.vs[k][2] + R.vs[k][3]);
      if (tid < 256) rs[512 + tid] = ssum;
      if (tid < 384) gvs[tid] = R.gvl; }
    __syncthreads();
    if (tid < 128) rs[tid] = 1.0f / sqrtf((rs[512 + tid] + rs[512 + 128 + tid]) * (1.0f / MIXW) + EPS);
    __syncthreads();
    bf16x8 wf[4];
#pragma unroll
    for (int kk = 0; kk < 4; ++kk) { const int j0 = 32 * kk + 8 * fq;
        const f32x4 r0 = *(const LAS f32x4*)(rs + j0), r1 = *(const LAS f32x4*)(rs + j0 + 4);
        const f32x4 a = R.wq[2 * kk], c = R.wq[2 * kk + 1];
        float v[8] = {a[0] * r0[0], a[1] * r0[1], a[2] * r0[2], a[3] * r0[3], c[0] * r1[0], c[1] * r1[1], c[2] * r1[2], c[3] * r1[3]};
#pragma unroll
        for (int jj = 0; jj < 8; ++jj) v[jj] = (j0 + jj <= i) ? v[jj] : 0.f;
        u32x4 pk; pk.x = cvt_pk_bf16(v[0], v[1]); pk.y = cvt_pk_bf16(v[2], v[3]); pk.z = cvt_pk_bf16(v[4], v[5]); pk.w = cvt_pk_bf16(v[6], v[7]);
        wf[kk] = __builtin_bit_cast(bf16x8, pk); }
    unsigned vb[8][2];
#pragma unroll
    for (int c = 0; c < 8; ++c) { vb[c][0] = tr16_addr(lane, c, 0, 0); vb[c][1] = tr16_addr(lane, c, 0, 1); }
#pragma unroll
    for (int sub = 0; sub < 3; ++sub) { LAS unsigned char* img = lds + sub * 32768;
#pragma unroll
        for (int c = 0; c < 8; ++c) ucur[c] = *(const u32x2*)(up + sub * 128 + 16 * c);
#pragma unroll
        for (int c = 0; c < 8; ++c) { f32x4 a = (f32x4){0.f, 0.f, 0.f, 0.f};
#pragma unroll
            for (int kk = 0; kk < 4; ++kk) if (kk <= (w >> 1)) {
                const s16x4 lo = tr_read(img + vb[c][0] + 8192 * kk), hi = tr_read(img + vb[c][1] + 8192 * kk);
                const bf16x8 vf = (bf16x8){lo[0], lo[1], lo[2], lo[3], hi[0], hi[1], hi[2], hi[3]};
                a = __builtin_amdgcn_mfma_f32_16x16x32_bf16(vf, wf[kk], a, 0, 0, 0); }
            const int col = g * 384 + sub * 128 + 16 * c + 4 * fq;
            const f32x4 gv = *(const LAS f32x4*)(gvs + sub * 128 + 16 * c + 4 * fq);
            const u32x2 uw = ucur[c];
            const float o0 = bf_lo(uw.x) * (a[0] * gv[0] + bs), o1 = bf_hi(uw.x) * (a[1] * gv[1] + bs), o2 = bf_lo(uw.y) * (a[2] * gv[2] + bs), o3 = bf_hi(uw.y) * (a[3] * gv[3] + bs);
            u32x2 ov; ov.x = cvt_pk_bf16(o0, o1); ov.y = cvt_pk_bf16(o2, o3);
            *(u32x2*)(MIX + tokrow * DM + col) = ov; } }
}

template <int MODE, int K>
__device__ __forceinline__ void sample_gemv(LAS unsigned char* lds, const bf16_t* A, int a_pitch, const bf16_t* Wt, int N, int first, int stride,
                                            float* outf, bf16_t* outb, int ldb, float* win, const float* rs, const float* slse = nullptr) {
    int tid = threadIdx.x; asm volatile("" : "+v"(tid));
    const int lane = tid & 63, w = __builtin_amdgcn_readfirstlane(tid >> 6), fr = lane & 15, fq = lane >> 4;
    const int ntiles = (MODE == 2) ? N / 32 : N / 16;
    LAS float* red = (LAS float*)lds;
    constexpr int kw = K / 8;
    LAS float* atab = (LAS float*)(lds + LDS_TAB + 4096);
    if (slse != nullptr) {
        __syncthreads();
        if (tid < 128) { const int srow = tid >> 4, H = tid & 15; float al = 1.0f;
            if (H < 12) { const int hl = H & 3; const float l0 = slse[srow * 12 + hl], l1 = slse[srow * 12 + 4 + hl], l2 = slse[srow * 12 + 8 + hl], mm = fmaxf(l0, fmaxf(l1, l2));
                const float e0 = __expf(l0 - mm), e1 = __expf(l1 - mm), e2 = __expf(l2 - mm); al = (H < 4 ? e0 : (H < 8 ? e1 : e2)) / (e0 + e1 + e2); }
            atab[tid] = al; }
        __syncthreads();
    }
    for (int tile = first; tile < ntiles; tile += stride) {
        const int nrow0 = (MODE == 2) ? 256 * (tile >> 3) + 16 * (tile & 7) : 16 * tile;
        const bf16_t* ap = A + (size_t)(fr & 7) * a_pitch + w * kw + 8 * fq;
        const bf16_t* bp = Wt + (size_t)(nrow0 + fr) * K + w * kw + 8 * fq;
        f32x4 acc = (f32x4){0.f, 0.f, 0.f, 0.f}, acc2 = (f32x4){0.f, 0.f, 0.f, 0.f};
#pragma unroll
        for (int ks = 0; ks < kw / 32; ++ks) { bf16x8 a = *(const bf16x8*)(ap + 32 * ks); const bf16x8 b = *(const bf16x8*)(bp + 32 * ks);
            if (MODE == 1 && slse != nullptr) { const float al = atab[(fr & 7) * 16 + ((w * kw + 32 * ks + 8 * fq) >> 7)]; const u32x4 aw = __builtin_bit_cast(u32x4, a); u32x4 o;
                o.x = cvt_pk_bf16(bf_lo(aw.x) * al, bf_hi(aw.x) * al); o.y = cvt_pk_bf16(bf_lo(aw.y) * al, bf_hi(aw.y) * al);
                o.z = cvt_pk_bf16(bf_lo(aw.z) * al, bf_hi(aw.z) * al); o.w = cvt_pk_bf16(bf_lo(aw.w) * al, bf_hi(aw.w) * al); a = __builtin_bit_cast(bf16x8, o); }
            acc = __builtin_amdgcn_mfma_f32_16x16x32_bf16(b, a, acc, 0, 0, 0);
            if (MODE == 2) { const bf16x8 b2 = *(const bf16x8*)(bp + (size_t)128 * K + 32 * ks); acc2 = __builtin_amdgcn_mfma_f32_16x16x32_bf16(b2, a, acc2, 0, 0, 0); } }
        __syncthreads();
        *(LAS f32x4*)(red + (w * 16 + fr) * 16 + 4 * fq) = acc;
        if (MODE == 2) *(LAS f32x4*)(red + 2048 + (w * 16 + fr) * 16 + 4 * fq) = acc2;
        __syncthreads();
        if (tid < 128) { const int s = tid >> 4, c = tid & 15; float v = 0.f, v2 = 0.f;
#pragma unroll
            for (int ww = 0; ww < 8; ++ww) { v += red[(ww * 16 + s) * 16 + c]; if (MODE == 2) v2 += red[2048 + (ww * 16 + s) * 16 + c]; }
            if (rs != nullptr) { const float rsr = rs[s]; v *= rsr; v2 *= rsr; }
            if (MODE == 0) { const int n = nrow0 + c; outf[(size_t)s * ZP + n] = v;
                if (win != nullptr && n >= 1536 && n < 4608) { const int kv = n >= 3072 ? 1 : 0, cc = n - 1536 - 1536 * kv, grp = cc >> 9;
                    win[(size_t)grp * 8192 + (size_t)(s * 2 + kv) * 512 + (cc & 511)] = v; } }
            else if (MODE == 1) { outb[(size_t)s * ldb + nrow0 + c] = (bf16_t)f2bf(v); }
            else { outb[(size_t)s * ldb + 128 * (tile >> 3) + 16 * (tile & 7) + c] = (bf16_t)f2bf(silu_f(v) * v2); } }
    }
}

template <class KF, class VF>
__device__ __forceinline__ float sample_attend(LAS float* scr, const float* qv, int nkeys, KF kf, VF vf, const LAS float* btab, LAS float* o_out) {
    int tid = threadIdx.x; asm volatile("" : "+v"(tid));
    const int lane = tid & 63, w = __builtin_amdgcn_readfirstlane(tid >> 6);
    LAS float* sc = scr; LAS float* part = scr + 320; LAS float* stat = scr + 320 + 2048;
    {
        const int key = tid >> 1, half = tid & 1; float d = 0.f;
        if (key < nkeys) { const float* kp = kf(key) + 64 * half; const float* qp = qv + 64 * half; f32x4 k4[16];
#pragma unroll
            for (int i = 0; i < 16; ++i) k4[i] = *(const f32x4*)(kp + 4 * i);
#pragma unroll
            for (int i = 0; i < 16; ++i) { const f32x4 q4 = *(const f32x4*)(qp + 4 * i); d += (k4[i][0] * q4[0] + k4[i][1] * q4[1]) + (k4[i][2] * q4[2] + k4[i][3] * q4[3]); } }
        d += __shfl_xor(d, 1);
        if (half == 0 && key < nkeys) sc[key] = d * QSCALE + (btab != nullptr ? btab[key] : 0.f);
    }
    __syncthreads();
    if (w == 0) { float m = -1e30f; for (int j = lane; j < nkeys; j += 64) m = fmaxf(m, sc[j]); m = wave_max(m);
        float l = 0.f; for (int j = lane; j < nkeys; j += 64) { const float p = __builtin_amdgcn_exp2f(sc[j] - m); sc[j] = p; l += p; } l = wave_sum(l);
        if (lane == 0) { stat[0] = m; stat[1] = l; } }
    __syncthreads();
    {
        const int kg = tid >> 5, d4 = 4 * (tid & 31); f32x4 v4[16]; f32x4 a = (f32x4){0.f, 0.f, 0.f, 0.f};
#pragma unroll
        for (int i = 0; i < 16; ++i) { const int j = kg + 16 * i; v4[i] = (f32x4){0.f, 0.f, 0.f, 0.f}; if (j < nkeys) v4[i] = *(const f32x4*)(vf(j) + d4); }
#pragma unroll
        for (int i = 0; i < 16; ++i) { const int j = kg + 16 * i; const float pj = j < nkeys ? sc[j] : 0.f; a = a + v4[i] * pj; }
        *(LAS f32x4*)(part + kg * 128 + d4) = a; }
    __syncthreads();
    const float m = stat[0], l = stat[1];
    if (tid < 128) { float a = 0.f;
#pragma unroll
        for (int g = 0; g < 16; ++g) a += part[g * 128 + tid];
        o_out[tid] = a / l; }
    __syncthreads();
    return (m + __builtin_amdgcn_logf(l)) * LN2;
}

#define XB_TMO      128
#define XB_XCNT(j)  (256  + 64 * (j))
#define XB_XSUB(j)  (1280 + 64 * (j))
#define XB_XGEN(j)  (2304 + 64 * (j))
#define XB_TOP      3328
#define XB_TOPGEN   3392
#define XCD_BAR_WORDS 3456
#define XB_SPIN_CAP (1u << 18)
__device__ __forceinline__ unsigned xb_ld(unsigned* p)              { return __hip_atomic_load(p, __ATOMIC_RELAXED, __HIP_MEMORY_SCOPE_AGENT); }
__device__ __forceinline__ unsigned xb_add(unsigned* p, unsigned v) { return __hip_atomic_fetch_add(p, v, __ATOMIC_RELAXED, __HIP_MEMORY_SCOPE_AGENT); }
__device__ __forceinline__ unsigned xb_xcc_id() { return (unsigned)__builtin_amdgcn_s_getreg((3 << 11) | 20) & 0xFu; }
#define XB_SPIN(cond, bar) do { unsigned _sp = 0; while (cond) { __builtin_amdgcn_s_sleep(1); \
    if ((++_sp & 255u) == 0u) { if (xb_ld(&(bar)[XB_TMO])) break; if (_sp > XB_SPIN_CAP) { atomicAdd(&(bar)[XB_TMO], 1u); break; } } } } while (0)
struct XcdBarrier { unsigned* bar; unsigned x; volatile LAS unsigned* st; };
__device__ __forceinline__ XcdBarrier xcd_barrier_post(unsigned* bar, volatile LAS unsigned* st) {
    XcdBarrier b; b.bar = bar; b.x = xb_xcc_id(); b.st = st;
    if (threadIdx.x == 0) (void)xb_add(&bar[XB_XCNT(b.x)], 1u);
    return b;
}
__device__ __forceinline__ void xcd_barrier_complete(unsigned* bar, unsigned x, unsigned& nloc, unsigned& nx) {
    const unsigned G = gridDim.x * gridDim.y * gridDim.z;
    unsigned sum, cnt, mine, sp = 0u;
    for (;;) {
        sum = 0u; cnt = 0u; mine = 0u;
#pragma unroll
        for (unsigned j = 0; j < 16; ++j) { const unsigned c = xb_ld(&bar[XB_XCNT(j)]); sum += c; cnt += (c > 0u) ? 1u : 0u; mine = (j == x) ? c : mine; }
        if (sum == G) break;
        __builtin_amdgcn_s_sleep(1);
        if ((++sp & 255u) == 0u) { if (xb_ld(&bar[XB_TMO])) break; if (sp > XB_SPIN_CAP) { atomicAdd(&bar[XB_TMO], 1u); break; } }
    }
    nloc = mine > 0u ? mine : 1u; nx = cnt > 0u ? cnt : 1u;
}
__device__ __forceinline__ void xcd_barrier(const XcdBarrier& b) {
    asm volatile("s_waitcnt vmcnt(0)" ::: "memory");
    __syncthreads();
    if (threadIdx.x == 0) {
        unsigned* bar = b.bar;
        __builtin_amdgcn_s_waitcnt(0);
        unsigned nloc = b.st[0], nx = b.st[1];
        if (nloc == 0u) { xcd_barrier_complete(bar, b.x, nloc, nx); b.st[0] = nloc; b.st[1] = nx; }
        const unsigned old = xb_add(&bar[XB_XSUB(b.x)], 1u);
        const unsigned gen = old / nloc;
        if (old + 1u == (gen + 1u) * nloc) {
            __builtin_amdgcn_fence(__ATOMIC_RELEASE, "agent");
            asm volatile("s_waitcnt vmcnt(0)" ::: "memory");
            const unsigned og = xb_add(&bar[XB_TOP], 1u);
            const unsigned tg = og / nx;
            if (og + 1u == (tg + 1u) * nx) xb_add(&bar[XB_TOPGEN], 1u);
            else XB_SPIN(xb_ld(&bar[XB_TOPGEN]) == tg, bar);
            __builtin_amdgcn_fence(__ATOMIC_ACQUIRE, "agent");
            xb_add(&bar[XB_XGEN(b.x)], 1u);
            asm volatile("s_waitcnt vmcnt(0)" ::: "memory");
        } else {
            XB_SPIN(xb_ld(&bar[XB_XGEN(b.x)]) == gen, bar);
            __builtin_amdgcn_fence(__ATOMIC_ACQUIRE, "agent");
            asm volatile("s_waitcnt vmcnt(0)" ::: "memory");
        }
    }
    __syncthreads();
}

struct Args { const float* in[22]; float* out; unsigned char* ws; };
typedef const Args __attribute__((address_space(4)))* ArgsP;
__device__ __forceinline__ ArgsP args_ptr() { ArgsP p = (ArgsP)__builtin_amdgcn_kernarg_segment_ptr(); asm volatile("" : "+s"(p)); return p; }
#define WSP(T, off) ((T*)(A->ws + (off)))

constexpr int I_MKV = 32 * 16, I_INA = 32 * 56, I_INB = 32 * 80, I_OUT = 32 * 32, I_UP = 32 * 176, I_DN = 88 * 32, DN_P = 850, DN_A = 1170;
__device__ __forceinline__ int conv_count(int list) { return list == 0 ? 2 * I_MKV + I_INA + I_UP + DN_P : (list == 1 ? I_OUT + (DN_A - DN_P) : (list == 2 ? (I_DN - DN_A) + I_INB + I_OUT : (list == 3 ? I_UP : I_DN))); }
__device__ __forceinline__ TItem conv_item(ArgsP A, int list, int r) {
    const float* n_mix_pre = A->in[8]; const float* n_ffn_pre = A->in[10]; const float* n_mem = A->in[12]; const float* w_mem_kv = A->in[13]; const float* w_in_a = A->in[14];
    const float* w_in_b = A->in[18]; const float* w_out = A->in[19]; const float* w_up = A->in[20]; const float* w_dn = A->in[21];
    bf16_t* Wmkv = WSP(bf16_t, WS_WMKV); bf16_t* Wina = WSP(bf16_t, WS_WINA); bf16_t* Winb = WSP(bf16_t, WS_WINB); bf16_t* Wout = WSP(bf16_t, WS_WOUT);
    bf16_t* Wup = WSP(bf16_t, WS_WUP); bf16_t* Wdn = WSP(bf16_t, WS_WDN);
    if (list == 0) {
        if (r < 2 * I_MKV) { const int l = r / I_MKV; return t_make(w_mem_kv + (size_t)l * DM * NKV, DM, NKV, Wmkv + (size_t)l * NKV * DM, false, n_mem + l * DM, r % I_MKV); } r -= 2 * I_MKV;
        if (r < I_INA) return t_make(w_in_a, DM, NA, Wina, false, n_mix_pre, r); r -= I_INA;
        if (r < I_UP) return t_make(w_up, DM, NUP, Wup, true, n_ffn_pre, r); r -= I_UP;
        return t_make(w_dn, DFF, DM, Wdn, false, nullptr, r);
    } else if (list == 1) {
        if (r < I_OUT) return t_make(w_out, DM, DM, Wout, false, nullptr, r); r -= I_OUT;
        return t_make(w_dn, DFF, DM, Wdn, false, nullptr, DN_P + r);
    } else if (list == 2) {
        if (r < I_DN - DN_A) return t_make(w_dn, DFF, DM, Wdn, false, nullptr, DN_A + r); r -= I_DN - DN_A;
        if (r < I_INB) return t_make(w_in_b, DM, NB, Winb, false, n_mix_pre + DM, r); r -= I_INB;
        return t_make(w_out + (size_t)DM * DM, DM, DM, Wout + (size_t)DM * DM, false, nullptr, r);
    } else if (list == 3) {
        return t_make(w_up + (size_t)DM * NUP, DM, NUP, Wup + (size_t)NUP * DM, true, n_ffn_pre + DM, r);
    } else {
        return t_make(w_dn + (size_t)DFF * DM, DFF, DM, Wdn + (size_t)DM * DFF, false, nullptr, r);
    }
}
__device__ __forceinline__ void convert_list(LAS unsigned char* lds, ArgsP A, int list, int worker, int nworkers, int wave, int lane) {
    const int n = conv_count(list);
    LAS float* scr = (LAS float*)(lds + wave * 16384);
    int it = worker;
    if (it >= n) return;
    TItem cur = conv_item(A, list, it);
    f32x4 va[16], vb[16];
    t_load(cur, lane, va);
    for (;;) {
        const int itn = it + nworkers; const bool hn = itn < n;
        TItem nxt = cur;
        if (hn) { nxt = conv_item(A, list, itn); t_load(nxt, lane, vb); }
        t_store(cur, scr, lane, va);
        if (!hn) break;
#pragma unroll
        for (int i = 0; i < 16; ++i) va[i] = vb[i];
        cur = nxt; it = itn;
    }
}
__device__ __forceinline__ void convert_tail(LAS unsigned char* lds, ArgsP A, int list, int first_idle) {
    const int bid = blockIdx.x, G = gridDim.x;
    if (bid < first_idle || first_idle >= G) return;
    int tid = threadIdx.x; asm volatile("" : "+v"(tid));
    const int lane = tid & 63, wave = __builtin_amdgcn_readfirstlane(tid >> 6);
    __syncthreads();
    convert_list(lds, A, list, (bid - first_idle) * 8 + wave, (G - first_idle) * 8, wave, lane);
}
__device__ __forceinline__ void phase_prologue(LAS unsigned char* lds) {
    ArgsP A = args_ptr();
    int tid = threadIdx.x; asm volatile("" : "+v"(tid));
    const int lane = tid & 63, wave = __builtin_amdgcn_readfirstlane(tid >> 6), gw = blockIdx.x * 8 + wave, NGW = gridDim.x * 8;
    const float* x_prompt = A->in[0]; const float* x_sample = A->in[1]; const float* mem_prompt = A->in[2];
    bf16_t* YB = WSP(bf16_t, WS_HN); bf16_t* HM = WSP(bf16_t, WS_HM);
    float* RS = WSP(float, WS_RS); float* RSM = RS + 16384;
    convert_list(lds, A, 0, gw, NGW, wave, lane);
    if (gridDim.x != 256) { convert_list(lds, A, 1, gw, NGW, wave, lane); convert_list(lds, A, 2, gw, NGW, wave, lane); convert_list(lds, A, 3, gw, NGW, wave, lane); convert_list(lds, A, 4, gw, NGW, wave, lane); }
    for (int m = gw; m < 512 + TP + TSMP; m += NGW) {
        if (m < 512) norm_row<0>(mem_prompt + (size_t)m * DM, HM + (size_t)m * DM, nullptr, nullptr, RSM + m, nullptr, lane);
        else { const int r = m - 512; const float* xr = r < TP ? x_prompt + (size_t)r * DM : x_sample + (size_t)(r - TP) * DM;
            norm_row<0>(xr, YB + (size_t)r * DM, nullptr, nullptr, RS + r, nullptr, lane); }
    }
}

__device__ __forceinline__ void phase_in_a(LAS unsigned char* lds) {
    ArgsP A = args_ptr(); const int bid = blockIdx.x, G = gridDim.x;
    bf16_t* HN = WSP(bf16_t, WS_HN);
    { pg8::Gemm g{HN, WSP(bf16_t, WS_WINA), TP, NA, DM}; pg8::StaticOrder S; S.init(TP, NA, G, bid); pg8::EpiInA E{WSP(bf16_t, WS_Z), WSP(float, WS_VSS), WSP(float, WS_RS)};
      pg8::gemm_phase<pg8::EpiInA, true, true>(lds, g, S, E); }
#pragma unroll 1
    for (int l = 0; l < 2; ++l) { pg8::Gemm g{WSP(bf16_t, WS_HM), WSP(bf16_t, WS_WMKV) + (size_t)l * NKV * DM, 512, NKV, DM};
      pg8::StaticOrder S; S.init(512, NKV, G, (bid - 192 - 8 * l + 2 * G) % G);
      pg8::EpiMkv E{A->out + OUT_MKV + (size_t)l * 512 * NKV, WSP(bf16_t, WS_MKV) + (size_t)l * 512 * NKV, WSP(float, WS_RS) + 16384};
      pg8::gemm_phase<pg8::EpiMkv, true, true>(lds, g, S, E); }
    if (G == 256) { if (bid >= 208) sample_gemv<0, DM>(lds, HN + (size_t)TP * DM, DM, WSP(bf16_t, WS_WINA), NA, G - 1 - bid, 48, WSP(float, WS_ZS), nullptr, 0, nullptr, WSP(float, WS_RS) + TP); }
    else sample_gemv<0, DM>(lds, HN + (size_t)TP * DM, DM, WSP(bf16_t, WS_WINA), NA, G - 1 - bid, G, WSP(float, WS_ZS), nullptr, 0, nullptr, WSP(float, WS_RS) + TP);
    if (G == 256) convert_tail(lds, A, 1, 208);
}
__device__ __forceinline__ void phase_in_b(LAS unsigned char* lds) {
    ArgsP A = args_ptr(); const int bid = blockIdx.x, G = gridDim.x;
    bf16_t* HN = WSP(bf16_t, WS_HN); float* out = A->out;
    pg8::Gemm g{HN, WSP(bf16_t, WS_WINB), TP, NB, DM}; pg8::StaticOrder S; S.init(TP, NB, G, bid);
    pg8::EpiInB E{WSP(bf16_t, WS_Z), WSP(float, WS_RS)};
    pg8::gemm_phase<pg8::EpiInB, true, true>(lds, g, S, E);
    sample_gemv<0, DM>(lds, HN + (size_t)TP * DM, DM, WSP(bf16_t, WS_WINB), NB, G - 1 - bid, G, WSP(float, WS_ZS), nullptr, 0, out + OUT_W128S, WSP(float, WS_RS) + TP);
    if (G == 256) convert_tail(lds, A, 3, 128);
}
__device__ __forceinline__ void mem_unit_desc(ArgsP A, int v, int layer, KvDesc& kd, QoDesc& qd) {
    const int b = v >> 7, h = (v >> 5) & 3, qb = v & 31, qmoff = layer == 0 ? 3072 : 4608;
    const bf16_t* mkv = WSP(bf16_t, WS_MKV) + (size_t)layer * 512 * NKV + h * 128;
    kd.kbase = mkv; kd.vbase = mkv + 512; kd.row0 = (long)b * 256; kd.rstep = 1; kd.pitch = NKV; kd.key_lo = 0;
    qd.qbase = WSP(bf16_t, WS_Z) + qmoff + h * 128; qd.row0 = (long)b * SEQ + 128 * qb; qd.rstep = 1; qd.obase = WSP(bf16_t, WS_MIX) + MIXW + h * 128; qd.lsebase = nullptr;
    qd.banded = 0; qd.dil = 1; qd.head = 0;
}
__device__ __forceinline__ void swa_unit_desc(ArgsP A, int u, KvDesc& kd, QoDesc& qd) {
    const int b = u / 384, H = (u % 384) >> 5, idx = u & 31, g = H >> 2, dil = 1 << (2 * g), r = idx & (dil - 1), qb = idx >> (2 * g);
    const bf16_t* Z = WSP(bf16_t, WS_Z);
    kd.kbase = Z + MIXW + H * 128; kd.vbase = Z + 2 * MIXW + H * 128; kd.row0 = (long)b * SEQ + (long)(128 * qb - 128) * dil + r; kd.rstep = dil; kd.pitch = ZP; kd.key_lo = qb == 0 ? 128 : 0;
    qd.qbase = Z + H * 128; qd.row0 = (long)b * SEQ + (long)(128 * qb) * dil + r; qd.rstep = dil; qd.obase = WSP(bf16_t, WS_MIX) + H * 128; qd.lsebase = WSP(float, WS_LSE) + H;
    qd.banded = 1; qd.dil = dil; qd.head = H;
}
__device__ __forceinline__ void q_issue(const QoDesc& qd, int tid, bf16x8 (&qf)[4]) {
    const int lane = tid & 63, w = __builtin_amdgcn_readfirstlane(tid >> 6), fr = lane & 15, fq = lane >> 4;
    const long qrow = qd.row0 + (long)(16 * w + fr) * qd.rstep;
    const bf16_t* qp = qd.qbase + (size_t)qrow * ZP + 8 * fq;
#pragma unroll
    for (int k4 = 0; k4 < 4; ++k4) qf[k4] = *(const bf16x8*)(qp + 32 * k4);
}
__device__ __forceinline__ void build_bias_tables(LAS unsigned char* lds, int tid, const float* rel_bias) {
    LAS float* tab = (LAS float*)(lds + LDS_TAB); LAS float* rb = tab + 12 * 192;
    if (tid < 384) rb[tid] = rel_bias[tid] * LOG2E;
    __syncthreads();
    for (int i = tid; i < 12 * 192; i += 512) { const int H = i / 192, j = i % 192 - 32, dil = 1 << (2 * (H >> 2));
        tab[i] = (j >= 0 && j <= 128) ? rb[t5_bucket(j * dil) * 12 + H] : -1e30f; }
}
__device__ __forceinline__ void attn_unit_run(LAS unsigned char* lds, int tid, const QoDesc& qd, int key_lo, u32x4 (&kk)[8], u32x4 (&vv)[8], bf16x8 (&qf)[4],
                                              const bool has_next, const KvDesc nxt, const QoDesc nxtq) {
    const int lane = tid & 63, w = __builtin_amdgcn_readfirstlane(tid >> 6), fr = lane & 15, fq = lane >> 4;
    __syncthreads();
    kv_commit(lds, tid, key_lo, kk, vv);
    bf16x8 qc[4];
#pragma unroll
    for (int k4 = 0; k4 < 4; ++k4) qc[k4] = qf[k4];
    if (has_next) { kv_issue(nxt, tid, kk, vv); q_issue(nxtq, tid, qf); }
    __syncthreads();
    const long qrow = qd.row0 + (long)(16 * w + fr) * qd.rstep;
    bf16_t* orow = qd.obase + (size_t)qrow * DM + 4 * fq;
    float* lsep = qd.lsebase != nullptr ? qd.lsebase + (size_t)qrow * 12 : nullptr;
    if (qd.banded) attn_compute<true>(lds, lane, w, qc, key_lo, orow, lsep, (const LAS float*)(lds + LDS_TAB) + qd.head * 192);
    else attn_compute<false>(lds, lane, w, qc, key_lo, orow, lsep, (const LAS float*)(lds + LDS_TAB));
}
__device__ __forceinline__ void sample_mem_attn(LAS unsigned char* lds, int layer) {
    ArgsP A = args_ptr(); const int bid = blockIdx.x, G = gridDim.x;
    int tid = threadIdx.x; asm volatile("" : "+v"(tid));
    const int qmoff = layer == 0 ? 3072 : 4608;
    for (int it = G - 1 - 96 - bid; it >= 0 && it < 32; it += G) {
        const int s = it >> 2, h = it & 3;
        LAS float* scr = (LAS float*)lds; LAS float* og = scr + 2560;
        __syncthreads();
        const float* cm = A->in[3] + (size_t)(layer * 8 + s) * 256 * 1024;
        auto kf = [=](int j) -> const float* { return cm + (size_t)j * 1024 + h * 128; };
        auto vf = [=](int j) -> const float* { return cm + (size_t)j * 1024 + 512 + h * 128; };
        (void)sample_attend(scr, WSP(float, WS_ZS) + (size_t)s * ZP + qmoff + h * 128, 256, kf, vf, (const LAS float*)nullptr, og);
        if (tid < 128) WSP(bf16_t, WS_MIX)[(size_t)(TP + s) * DM + MIXW + h * 128 + tid] = (bf16_t)f2bf(og[tid]);
        __syncthreads();
    }
}
__device__ __forceinline__ void phase_mix_a(LAS unsigned char* lds) {
    ArgsP A = args_ptr(); const int bid = blockIdx.x, G = gridDim.x;
    int tid = threadIdx.x; asm volatile("" : "+v"(tid));
    const int lane = tid & 63, wave = __builtin_amdgcn_readfirstlane(tid >> 6);
    const float* ZS = WSP(float, WS_ZS); const float* n_v_a = A->in[15]; const float* w_sp = A->in[16]; const float* b_sp = A->in[17]; bf16_t* MIX = WSP(bf16_t, WS_MIX); float* out = A->out;
    for (int it = G - 1 - bid; it < TSMP; it += G) {
        LAS float* red = (LAS float*)lds; const int s = it;
        __syncthreads();
        float vv[3], uu[3], ss = 0.f;
#pragma unroll
        for (int i = 0; i < 3; ++i) { const int c = tid + 512 * i; uu[i] = gelu_tanh(ZS[(size_t)s * ZP + c]); vv[i] = gelu_tanh(ZS[(size_t)s * ZP + MIXW + c]); ss += vv[i] * vv[i]; }
        ss = wave_sum(ss); if (lane == 0) red[wave] = ss;
        __syncthreads();
        float tot = 0.f;
#pragma unroll
        for (int i = 0; i < 8; ++i) tot += red[i];
        const float rstd = 1.0f / sqrtf(tot * (1.0f / MIXW) + EPS);
#pragma unroll
        for (int i = 0; i < 3; ++i) { const int c = tid + 512 * i, g = c / 384; const float vn = vv[i] * rstd * n_v_a[c];
            out[OUT_CHV + (size_t)s * MIXW + c] = vn;
            const float sg = w_sp[(size_t)g * 16384] * vn + b_sp[g * 128];
            MIX[(size_t)(TP + s) * DM + c] = (bf16_t)f2bf(uu[i] * sg); }
    }
    sample_mem_attn(lds, 0);
    __syncthreads();
    for (int u = bid; u < 256; u += G) {
        KvDesc kd; QoDesc qd; mem_unit_desc(A, u, 0, kd, qd);
        u32x4 kk[8], vv[8]; bf16x8 qf[4]; GateRegs R;
        gate_issue(tid, u >> 7, (u >> 2) & 31, u & 3, WSP(bf16_t, WS_Z), WSP(float, WS_VSS), A->in[16], A->in[15], R);
        kv_issue(kd, tid, kk, vv); q_issue(qd, tid, qf);
        gate_run(lds, tid, u >> 7, (u >> 2) & 31, u & 3, R, WSP(bf16_t, WS_Z), A->in[17], WSP(bf16_t, WS_MIX));
        attn_unit_run(lds, tid, qd, kd.key_lo, kk, vv, qf, false, kd, qd);
    }
}
__device__ __forceinline__ void phase_mix_b1(LAS unsigned char* lds) {
    ArgsP A = args_ptr(); const int bid = blockIdx.x, G = gridDim.x;
    int tid = threadIdx.x; asm volatile("" : "+v"(tid));
    KvDesc kd{}, kn{}; QoDesc qd{}, qn{};
    u32x4 kk[8], vv[8]; bf16x8 qf[4];
    int u = bid;
    if (u < 1024) { if (u < 768) swa_unit_desc(A, u, kd, qd); else mem_unit_desc(A, u - 768, 1, kd, qd); kv_issue(kd, tid, kk, vv); q_issue(qd, tid, qf); }
    build_bias_tables(lds, tid, A->in[7]);
#pragma unroll 1
    for (; u < 1024; u += G) {
        const int un = u + G; const bool has_next = un < 1024;
        if (has_next) { if (un < 768) swa_unit_desc(A, un, kn, qn); else mem_unit_desc(A, un - 768, 1, kn, qn); }
        attn_unit_run(lds, tid, qd, kd.key_lo, kk, vv, qf, has_next, kn, qn);
        kd = kn; qd = qn;
    }
}
__device__ __forceinline__ void phase_mix_b2(LAS unsigned char* lds) {
    ArgsP A = args_ptr(); const int bid = blockIdx.x, G = gridDim.x;
    int tid = threadIdx.x; asm volatile("" : "+v"(tid));
    const int lane = tid & 63, wave = __builtin_amdgcn_readfirstlane(tid >> 6), gw = bid * 8 + wave, NGW = G * 8;
    bf16_t* MIX = WSP(bf16_t, WS_MIX); const float* LSE = WSP(float, WS_LSE);
    for (int row = gw; row < TP; row += NGW) {
        const float* lp = LSE + (size_t)row * 12;
#pragma unroll
        for (int i = 0; i < 3; ++i) { const int col = 8 * (lane + 64 * i), H = col >> 7, g = H >> 2, hl = H & 3;
            const float l0 = lp[hl], l1 = lp[4 + hl], l2 = lp[8 + hl], mm = fmaxf(l0, fmaxf(l1, l2));
            const float e0 = __expf(l0 - mm), e1 = __expf(l1 - mm), e2 = __expf(l2 - mm);
            const float al = (g == 0 ? e0 : (g == 1 ? e1 : e2)) / (e0 + e1 + e2);
            u32x4 wv = *(u32x4*)(MIX + (size_t)row * DM + col);
            wv.x = cvt_pk_bf16(bf_lo(wv.x) * al, bf_hi(wv.x) * al); wv.y = cvt_pk_bf16(bf_lo(wv.y) * al, bf_hi(wv.y) * al);
            wv.z = cvt_pk_bf16(bf_lo(wv.z) * al, bf_hi(wv.z) * al); wv.w = cvt_pk_bf16(bf_lo(wv.w) * al, bf_hi(wv.w) * al);
            *(u32x4*)(MIX + (size_t)row * DM + col) = wv; }
    }
    { const int nw = G > 128 ? G - 128 : G, wk = bid < nw ? bid : -1;
      if (wk >= 0) { const bf16_t* Z = WSP(bf16_t, WS_Z); float* o0 = A->out + OUT_W128P;
        for (int i = wk * 512 + tid; i < 688128; i += nw * 512) {
            const int g = i < 32768 ? 0 : (i < 163840 ? 1 : 2), ig = i - (g == 0 ? 0 : (g == 1 ? 32768 : 163840)), W = 128 << (2 * g);
            const int c8 = ig & 63, kv = (ig >> 6) & 1, tr = (ig >> 7) & (W - 1), b = (ig >> 7) / W;
            const u32x4 wv = *(const u32x4*)(Z + (size_t)(b * SEQ + (SEQ - W) + tr) * ZP + MIXW + kv * MIXW + g * 512 + c8 * 8);
            float* dst = o0 + (size_t)2048 * ((W - 128) / 3) + (size_t)ig * 8;
            *(f32x4*)dst = (f32x4){bf_lo(wv.x), bf_hi(wv.x), bf_lo(wv.y), bf_hi(wv.y)}; *(f32x4*)(dst + 4) = (f32x4){bf_lo(wv.z), bf_hi(wv.z), bf_lo(wv.w), bf_hi(wv.w)}; } } }
    const float* rel_bias = A->in[7]; const float* ZS = WSP(float, WS_ZS);
    for (int it = G - 1 - bid; it < 96; it += G) {
        const int s = it / 12, H = it % 12, g = H >> 2, hl = H & 3, dil = 1 << (2 * g), W = 128 << (2 * g);
        LAS float* scr = (LAS float*)lds; LAS float* btab = scr + 2400; LAS float* og = scr + 2560;
        __syncthreads();
        for (int j = tid; j <= 128; j += 512) btab[j] = rel_bias[t5_bucket(j * dil) * 12 + H] * LOG2E;
        __syncthreads();
        const float* cw = A->in[4 + g];
        const float* zrow = ZS + (size_t)s * ZP;
        auto kf = [=](int j) -> const float* { return j == 0 ? zrow + MIXW + H * 128 : cw + ((size_t)(s * W + (W - j * dil)) * 2 + 0) * 512 + hl * 128; };
        auto vf = [=](int j) -> const float* { return j == 0 ? zrow + 2 * MIXW + H * 128 : cw + ((size_t)(s * W + (W - j * dil)) * 2 + 1) * 512 + hl * 128; };
        const float lg = sample_attend(scr, zrow + H * 128, 129, kf, vf, btab, og);
        if (tid < 128) MIX[(size_t)(TP + s) * DM + H * 128 + tid] = (bf16_t)f2bf(og[tid]);
        if (tid == 0) WSP(float, WS_LSE)[(size_t)TP * 12 + s * 12 + H] = lg;
        __syncthreads();
    }
    sample_mem_attn(lds, 1);
}
__device__ __forceinline__ void phase_out(LAS unsigned char* lds, int layer) {
    ArgsP A = args_ptr(); const int bid = blockIdx.x, G = gridDim.x;
    bf16_t* MIX = WSP(bf16_t, WS_MIX); bf16_t* OB = WSP(bf16_t, WS_O); const bf16_t* W = WSP(bf16_t, WS_WOUT) + (size_t)layer * DM * DM;
    pg8::Gemm g{MIX, W, TP, DM, DM}; pg8::StaticOrder S; S.init(TP, DM, G, bid); pg8::EpiPlain E{OB, DM};
    pg8::gemm_phase<pg8::EpiPlain, false, true>(lds, g, S, E);
    sample_gemv<1, DM>(lds, MIX + (size_t)TP * DM, DM, W, DM, G - 1 - bid, G, nullptr, OB + (size_t)TP * DM, DM, nullptr, nullptr, layer == 1 ? WSP(float, WS_LSE) + (size_t)TP * 12 : nullptr);
}
__device__ __forceinline__ void phase_up(LAS unsigned char* lds, int layer) {
    ArgsP A = args_ptr(); const int bid = blockIdx.x, G = gridDim.x;
    bf16_t* HN = WSP(bf16_t, WS_HN); bf16_t* ACT = WSP(bf16_t, WS_ACT); const bf16_t* W = WSP(bf16_t, WS_WUP) + (size_t)layer * NUP * DM;
    pg8::Gemm g{HN, W, TP, NUP, DM}; pg8::StaticOrder S; S.init(TP, NUP, G, bid); pg8::EpiSwiglu E{ACT, WSP(float, WS_RS)};
    pg8::gemm_phase<pg8::EpiSwiglu, true, true>(lds, g, S, E);
    if (G == 256 && layer == 1) { if (bid >= 128) sample_gemv<2, DM>(lds, HN + (size_t)TP * DM, DM, W, NUP, G - 1 - bid, 128, nullptr, ACT + (size_t)TP * DFF, DFF, nullptr, WSP(float, WS_RS) + TP); }
    else sample_gemv<2, DM>(lds, HN + (size_t)TP * DM, DM, W, NUP, G - 1 - bid, G, nullptr, ACT + (size_t)TP * DFF, DFF, nullptr, WSP(float, WS_RS) + TP);
    if (G == 256) convert_tail(lds, A, layer == 0 ? 2 : 4, 128);
}
__device__ __forceinline__ void phase_down(LAS unsigned char* lds, int layer) {
    ArgsP A = args_ptr(); const int bid = blockIdx.x, G = gridDim.x;
    bf16_t* ACT = WSP(bf16_t, WS_ACT); bf16_t* OB = WSP(bf16_t, WS_O); const bf16_t* W = WSP(bf16_t, WS_WDN) + (size_t)layer * DM * DFF;
    pg8::Gemm g{ACT, W, TP, DM, DFF}; pg8::StaticOrder S; S.init(TP, DM, G, bid); pg8::EpiPlain E{OB, DM};
    pg8::gemm_phase<pg8::EpiPlain, false, true>(lds, g, S, E);
    sample_gemv<1, DFF>(lds, ACT + (size_t)TP * DFF, DFF, W, DM, G - 1 - bid, G, nullptr, OB + (size_t)TP * DM, DM, nullptr, nullptr);
}
__device__ __forceinline__ void phase_norm(int which) {
    ArgsP A = args_ptr();
    int tid = threadIdx.x; asm volatile("" : "+v"(tid));
    const int lane = tid & 63, wave = __builtin_amdgcn_readfirstlane(tid >> 6), gw = blockIdx.x * 8 + wave, NGW = gridDim.x * 8;
    const int layer = which >> 1;
    float* Y = A->out + OUT_Y; const bf16_t* OB = WSP(bf16_t, WS_O); bf16_t* YB = WSP(bf16_t, WS_HN); float* RS = WSP(float, WS_RS);
    const float* gpost = ((which & 1) ? A->in[11] : A->in[9]) + layer * DM;
    int r = gw;
    if (r >= TP + TSMP) return;
    NormRaw cur, nxt;
    norm_load(YB + (size_t)r * DM, OB + (size_t)r * DM, lane, cur);
    for (;;) {
        const int rn = r + NGW; const bool hn = rn < TP + TSMP;
        if (hn) norm_load(YB + (size_t)rn * DM, OB + (size_t)rn * DM, lane, nxt);
        if (which == 3) norm_finish<true>(cur, nullptr, gpost, nullptr, Y + (size_t)r * DM, lane);
        else norm_finish<false>(cur, YB + (size_t)r * DM, gpost, RS + r, nullptr, lane);
        if (!hn) break;
        cur = nxt; r = rn;
    }
}

__global__ void __launch_bounds__(512, 2) fwd_megakernel(Args args) {
    extern __shared__ __attribute__((aligned(16))) unsigned char lds_raw[];
    LAS unsigned char* lds = (LAS unsigned char*)lds_raw;
    volatile LAS unsigned* bst = (volatile LAS unsigned*)(lds + LDS_BYTES - 64);
    if (threadIdx.x < 16) bst[threadIdx.x] = 0u;
    __syncthreads();
    const XcdBarrier bar = xcd_barrier_post((unsigned*)args.ws, bst);
#define GRID_SYNC() xcd_barrier(bar)
    phase_prologue(lds);
    GRID_SYNC();
    phase_in_a(lds);
    GRID_SYNC();
    phase_mix_a(lds);
    GRID_SYNC();
    phase_out(lds, 0);
    GRID_SYNC();
    phase_norm(0);
    GRID_SYNC();
    phase_up(lds, 0);
    GRID_SYNC();
    phase_down(lds, 0);
    GRID_SYNC();
    phase_norm(1);
    GRID_SYNC();
    phase_in_b(lds);
    GRID_SYNC();
    phase_mix_b1(lds);
    GRID_SYNC();
    phase_mix_b2(lds);
    GRID_SYNC();
    phase_out(lds, 1);
    GRID_SYNC();
    phase_norm(2);
    GRID_SYNC();
    phase_up(lds, 1);
    GRID_SYNC();
    phase_down(lds, 1);
    GRID_SYNC();
    phase_norm(3);
#undef GRID_SYNC
}

extern "C" void kernel_launch(void* const* d_in, const int* in_sizes, int n_in, void* d_out, int out_size, void* d_ws, size_t ws_size, hipStream_t stream) {
    static int grid = 0;
    if (grid == 0) {
        if (n_in != 22 || (size_t)out_size != OUT_TOTAL || ws_size < WS_END) { fprintf(stderr, "kernel_launch: unexpected shapes (n_in %d, out %d, ws %zu)\n", n_in, out_size, ws_size); grid = -1; return; }
        int dev = 0, cus = 0, per_cu = 0;
        if (hipGetDevice(&dev) != hipSuccess || hipDeviceGetAttribute(&cus, hipDeviceAttributeMultiprocessorCount, dev) != hipSuccess) { grid = -1; return; }
        if (hipFuncSetAttribute((const void*)fwd_megakernel, hipFuncAttributeMaxDynamicSharedMemorySize, LDS_BYTES) != hipSuccess) { fprintf(stderr, "kernel_launch: hipFuncSetAttribute failed\n"); grid = -1; return; }
        if (hipOccupancyMaxActiveBlocksPerMultiprocessor(&per_cu, (const void*)fwd_megakernel, 512, LDS_BYTES) != hipSuccess || per_cu < 1) { fprintf(stderr, "kernel_launch: occupancy query says %d\n", per_cu); (void)hipGetLastError(); per_cu = 1; }
        grid = cus;
    }
    if (grid < 0) return;
    if (hipMemsetAsync(d_ws, 0, 16384, stream) != hipSuccess) { fprintf(stderr, "kernel_launch: memset of the barrier words failed\n"); return; }
    Args a{};
    for (int i = 0; i < 22; ++i) a.in[i] = (const float*)d_in[i];
    a.out = (float*)d_out; a.ws = (unsigned char*)d_ws;
    void* kargs[] = {&a};
    hipError_t e = hipLaunchCooperativeKernel((const void*)fwd_megakernel, dim3(grid), dim3(512), kargs, LDS_BYTES, stream);
    if (e != hipSuccess) fprintf(stderr, "kernel_launch: cooperative launch failed: %s (grid %d)\n", hipGetErrorString(e), grid);
}
```

```cpp
#include <hip/hip_runtime.h>
#include <cstdio>
#include <cstdint>

#define LAS __attribute__((address_space(3)))
typedef unsigned short bf16_t;
typedef short bf16x8 __attribute__((ext_vector_type(8)));
typedef short s16x4 __attribute__((ext_vector_type(4)));
typedef float f32x4 __attribute__((ext_vector_type(4)));
typedef float f32x2 __attribute__((ext_vector_type(2)));
typedef unsigned u32x4 __attribute__((ext_vector_type(4)));
typedef unsigned u32x2 __attribute__((ext_vector_type(2)));

constexpr int DM = 2048, TP = 8192, TSMP = 8, TROWS = TP + 16, SEQ = 4096;
constexpr int MIXW = 1536, NA = 3584, NB = 5120, DFF = 5632, NUP = 11264, NKV = 1024;
constexpr int ZP = 5120;
constexpr float EPS = 1e-6f;
constexpr float LOG2E = 1.4426950408889634f, LN2 = 0.6931471805599453f;
constexpr float QSCALE = 0.08838834764831845f * 1.4426950408889634f;

constexpr size_t MiB = 1u << 20;
constexpr size_t WS_WMKV = 1 * MiB;
constexpr size_t WS_WINA = 9 * MiB;
constexpr size_t WS_WINB = 23 * MiB;
constexpr size_t WS_WOUT = 43 * MiB;
constexpr size_t WS_WUP = 59 * MiB;
constexpr size_t WS_WDN = 147 * MiB;
constexpr size_t WS_HN = 191 * MiB;
constexpr size_t WS_HM = 224 * MiB;
constexpr size_t WS_MKV = 228 * MiB;
constexpr size_t WS_Z = 230 * MiB;
constexpr size_t WS_ZS = 310 * MiB;
constexpr size_t WS_VSS = 311 * MiB;
constexpr size_t WS_MIX = 312 * MiB;
constexpr size_t WS_LSE = 345 * MiB;
constexpr size_t WS_RS = 345 * MiB + 512 * 1024;
constexpr size_t WS_O = 346 * MiB;
constexpr size_t WS_ACT = 230 * MiB;
constexpr size_t WS_END = 468 * MiB;

constexpr size_t OUT_Y = 0;
constexpr size_t OUT_MKV = 16793600;
constexpr size_t OUT_CHV = OUT_MKV + 1048576;
constexpr size_t OUT_W128P = OUT_CHV + 12288;
constexpr size_t OUT_W512P = OUT_W128P + 262144;
constexpr size_t OUT_W2048P = OUT_W512P + 1048576;
constexpr size_t OUT_W128S = OUT_W2048P + 4194304;
constexpr size_t OUT_W512S = OUT_W128S + 8192;
constexpr size_t OUT_W2048S = OUT_W512S + 8192;
constexpr size_t OUT_TOTAL = OUT_W2048S + 8192;

constexpr int LDS_BYTES = 147456;
constexpr int LDS_TAB = 131072;

__device__ __forceinline__ unsigned cvt_pk_bf16(float lo, float hi) { unsigned r; asm volatile("v_cvt_pk_bf16_f32 %0, %1, %2" : "=v"(r) : "v"(lo), "v"(hi)); return r; }
__device__ __forceinline__ float bf_lo(unsigned w) { return __uint_as_float(w << 16); }
__device__ __forceinline__ float bf_hi(unsigned w) { return __uint_as_float(w & 0xffff0000u); }
__device__ __forceinline__ float wave_sum(float v) {
#pragma unroll
    for (int o = 1; o < 64; o <<= 1) v += __shfl_xor(v, o);
    return v;
}
__device__ __forceinline__ float wave_max(float v) {
#pragma unroll
    for (int o = 1; o < 64; o <<= 1) v = fmaxf(v, __shfl_xor(v, o));
    return v;
}
__device__ __forceinline__ float gelu_tanh(float x) {
    const float t = x * x;
    const float u2 = x * (1.5957691216057308f + 0.07135481627260024f * t);
    const float e = __builtin_amdgcn_exp2f(-LOG2E * u2);
    return x * __builtin_amdgcn_rcpf(1.0f + e);
}
__device__ __forceinline__ float silu_f(float x) {
    const float e = __builtin_amdgcn_exp2f(-LOG2E * x);
    return x * __builtin_amdgcn_rcpf(1.0f + e);
}
__device__ __forceinline__ int t5_bucket(int d) {
    if (d < 16) return d;
    int b = 16;
    b += (d >= 22); b += (d >= 30); b += (d >= 40); b += (d >= 54); b += (d >= 73); b += (d >= 99); b += (d >= 134); b += (d >= 182);
    b += (d >= 246); b += (d >= 332); b += (d >= 450); b += (d >= 609); b += (d >= 825); b += (d >= 1117); b += (d >= 1513);
    return b;
}
__device__ __forceinline__ unsigned off_b(unsigned row, unsigned ch) { return 256u * row + 16u * (ch ^ (((row & 3) << 2) | ((row >> 2) & 3))); }
__device__ __forceinline__ unsigned tr16_addr(unsigned lane, unsigned c, unsigned ks, unsigned t) {
    const unsigned g = lane >> 4, q = (lane & 15) >> 2, p = lane & 3;
    return off_b(32 * ks + 8 * g + 4 * t + q, 2 * c + (p >> 1)) + 8 * (p & 1);
}
typedef short v4i16_t __attribute__((ext_vector_type(4)));
__device__ __forceinline__ s16x4 tr_read(LAS unsigned char* p) { return __builtin_bit_cast(s16x4, __builtin_amdgcn_ds_read_tr16_b64_v4i16((LAS v4i16_t*)p)); }

namespace pg8 {
constexpr int BM = 256, BK = 64, HALF = 128, HTB = HALF * BK * 2, STAGE_BYTES = 8 * HTB, NXCD = 8, WGM = 4;
__host__ __device__ __forceinline__ int lds_byte(int r, int c) { const int st = (r >> 4) * 2 + (c >> 5), rr = r & 15, cc = c & 31, ob = rr * 64 + cc * 2; return st * 1024 + (ob ^ (((ob >> 9) & 1) << 5)); }
__host__ __device__ __forceinline__ void stage_rc(int b, int& R, int& C) { const int st = b / 1024, sb = b % 1024, swz = sb ^ (((sb >> 9) & 1) << 5); R = (st >> 1) * 16 + swz / 64; C = (st & 1) * 32 + (swz % 64) / 2; }
__host__ __device__ __forceinline__ int perm32(int rho) { const int n = rho >> 4, i = rho & 15; return 8 * (i >> 2) + 4 * n + (i & 3); }

struct Unit { int pm, pn; };
struct Gemm { const bf16_t* A; const bf16_t* Bt; int M, N, K; };

struct StaticOrder {
    int nM, nN, nwg, G, c;
    __host__ __device__ void init(int M, int N, int G_, int c_) { nM = M / BM; nN = N / BM; nwg = nM * nN; G = G_; c = c_; }
    __host__ __device__ bool next(int i, Unit& u) const {
        const long L = (long)i * G + c; if (L >= nwg) return false;
        int wgid = (int)L; { const int q = nwg / NXCD, r = nwg % NXCD, xcd = wgid % NXCD, off = wgid / NXCD; wgid = (xcd < r ? xcd * (q + 1) : r * (q + 1) + (xcd - r) * q) + off; }
        const int nig = WGM * nN, gid = wgid / nig, fm = gid * WGM, gsz = (nM - fm) < WGM ? (nM - fm) : WGM;
        u.pm = fm + ((wgid % nig) % gsz); u.pn = (wgid % nig) / gsz; return true;
    }
};

template <class Epi, bool ALIGN_EPI, bool SP2>
__device__ __forceinline__ void gemm_phase(LAS unsigned char* lds, const Gemm g, const StaticOrder& S, const Epi& E) {
    int tid = threadIdx.x; asm volatile("" : "+v"(tid));
    const int wid = __builtin_amdgcn_readfirstlane(tid >> 6), lane = tid & 63, wr = wid >> 2, wc = wid & 3, fr = lane & 15, fq = lane >> 4;
    const int K = g.K, nt = K / BK;
    unsigned voffA[2], voffB[2];
#pragma unroll
    for (int i = 0; i < 2; ++i) { int R, C; stage_rc(tid * 16 + i * 8192, R, C); const int Rb = (R & ~31) + perm32(R & 31);
        voffA[i] = (unsigned)(R * K + C) * 2u; voffB[i] = (unsigned)(Rb * K + C) * 2u; }
    const size_t kstep = (size_t)(BK * 2);
    const size_t hstep = (size_t)HALF * K * 2;
    const size_t tstep = 2 * hstep;
    const unsigned ldsw = (unsigned)wid * 1024u;
    const int aoff = lds_byte(wr * 64 + fr, fq * 8), boff = lds_byte(wc * 32 + fr, fq * 8);
#define PG8_SA(b, h) (((b) * 2 + (h)) * HTB)
#define PG8_SB(b, h) ((4 + (b) * 2 + (h)) * HTB)
#define PG8_STAGE(bufoff, gbase, voff) do { _Pragma("unroll") for (int _i = 0; _i < 2; ++_i) \
        __builtin_amdgcn_global_load_lds((const unsigned*)((const char*)(gbase) + (voff)[_i]), (LAS unsigned*)(lds + (bufoff) + ldsw + _i * 8192), 16, 0, 0); } while (0)
#define PG8_LDA(dst, b, h) do { _Pragma("unroll") for (int m = 0; m < 4; ++m) _Pragma("unroll") for (int k = 0; k < 2; ++k) dst[m][k] = *(const LAS bf16x8*)(lds + PG8_SA(b, h) + aoff + m * 2048 + k * 1024); } while (0)
#define PG8_LDB(dst, b, h) do { _Pragma("unroll") for (int n = 0; n < 2; ++n) _Pragma("unroll") for (int k = 0; k < 2; ++k) dst[n][k] = *(const LAS bf16x8*)(lds + PG8_SB(b, h) + boff + n * 2048 + k * 1024); } while (0)
#define PG8_MMA(ai, bj, At, Bt) do { __builtin_amdgcn_s_setprio(1); _Pragma("unroll") for (int m = 0; m < 4; ++m) _Pragma("unroll") for (int n = 0; n < 2; ++n) _Pragma("unroll") for (int k = 0; k < 2; ++k) \
        acc[ai][bj][m][n] = __builtin_amdgcn_mfma_f32_16x16x32_bf16(Bt[n][k], At[m][k], acc[ai][bj][m][n], 0, 0, 0); __builtin_amdgcn_s_setprio(0); } while (0)
#define PG8_WAIT_V(n) asm volatile("s_waitcnt vmcnt(" #n ")" ::: "memory")
#define PG8_WAIT_L(n) asm volatile("s_waitcnt lgkmcnt(" #n ")" ::: "memory")
#define PG8_BAR __builtin_amdgcn_s_barrier()
#define PG8_SCHED __builtin_amdgcn_sched_barrier(0)
    Unit cur, nxt; int ui = 0;
    if (!S.next(0, cur)) return;
    f32x4 acc[2][2][4][2];
#pragma unroll
    for (int a = 0; a < 2; ++a)
#pragma unroll
        for (int b = 0; b < 2; ++b)
#pragma unroll
            for (int m = 0; m < 4; ++m)
#pragma unroll
                for (int n = 0; n < 2; ++n) acc[a][b][m][n] = (f32x4){0.f, 0.f, 0.f, 0.f};
    bf16x8 At[4][2], B0[2][2], B1[2][2];
    const char* cA = (const char*)g.A + (size_t)cur.pm * tstep; const char* cB = (const char*)g.Bt + (size_t)cur.pn * tstep;
    if constexpr (SP2) {
        PG8_STAGE(PG8_SB(0, 0), cB, voffB); PG8_STAGE(PG8_SB(0, 1), cB + hstep, voffB); PG8_STAGE(PG8_SA(0, 0), cA, voffA); PG8_STAGE(PG8_SA(0, 1), cA + hstep, voffA);
        if (wr == 1) PG8_BAR;
        PG8_WAIT_V(2); PG8_BAR;
        PG8_STAGE(PG8_SB(1, 0), cB + kstep, voffB); PG8_STAGE(PG8_SA(1, 0), cA + kstep, voffA); PG8_STAGE(PG8_SB(1, 1), cB + hstep + kstep, voffB);
        PG8_WAIT_V(6); PG8_BAR;
    } else {
        PG8_STAGE(PG8_SB(0, 0), cB, voffB); PG8_STAGE(PG8_SA(0, 0), cA, voffA); PG8_STAGE(PG8_SB(0, 1), cB + hstep, voffB); PG8_STAGE(PG8_SA(0, 1), cA + hstep, voffA);
        if (wr == 1) PG8_BAR;
        PG8_WAIT_V(4); PG8_BAR;
        PG8_STAGE(PG8_SB(1, 0), cB + kstep, voffB); PG8_STAGE(PG8_SA(1, 0), cA + kstep, voffA); PG8_STAGE(PG8_SB(1, 1), cB + hstep + kstep, voffB);
        PG8_WAIT_V(6); PG8_BAR;
    }
    for (;;) {
        const typename Epi::Pre pre = E.prefetch(cur, wr, fr);
        const bool has_next = S.next(ui + 1, nxt);
        const char* nA = has_next ? (const char*)g.A + (size_t)nxt.pm * tstep : cA; const char* nB = has_next ? (const char*)g.Bt + (size_t)nxt.pn * tstep : cB;
        for (int t = 0; t < nt; t += 2) {
            const bool last = (t == nt - 2);
            const char* a1 = cA + (size_t)(t + 1) * kstep;
            const char* a2 = last ? nA : cA + (size_t)(t + 2) * kstep; const char* b2 = last ? nB : cB + (size_t)(t + 2) * kstep;
            const char* a3 = a2 + kstep; const char* b3 = b2 + kstep;
            if constexpr (SP2) {
            PG8_LDB(B0, 0, 0); PG8_LDB(B1, 0, 1); PG8_SCHED; PG8_LDA(At, 0, 0); PG8_STAGE(PG8_SA(1, 1), a1 + hstep, voffA);
            PG8_WAIT_V(8); PG8_WAIT_L(0); PG8_BAR; PG8_MMA(0, 0, At, B0); PG8_MMA(0, 1, At, B1); PG8_BAR; PG8_SCHED;
            PG8_LDA(At, 0, 1); PG8_STAGE(PG8_SB(0, 0), b2, voffB); PG8_STAGE(PG8_SB(0, 1), b2 + hstep, voffB); PG8_STAGE(PG8_SA(0, 0), a2, voffA);
            PG8_WAIT_V(8); PG8_WAIT_L(0); PG8_BAR; PG8_MMA(1, 0, At, B0); PG8_MMA(1, 1, At, B1); PG8_BAR; PG8_SCHED;
            PG8_LDB(B0, 1, 0); PG8_LDB(B1, 1, 1); PG8_SCHED; PG8_LDA(At, 1, 0); PG8_STAGE(PG8_SA(0, 1), a2 + hstep, voffA);
            PG8_WAIT_V(8); PG8_WAIT_L(0); PG8_BAR; PG8_MMA(0, 0, At, B0); PG8_MMA(0, 1, At, B1); PG8_BAR; PG8_SCHED;
            PG8_LDA(At, 1, 1); PG8_STAGE(PG8_SB(1, 0), b3, voffB); PG8_STAGE(PG8_SB(1, 1), b3 + hstep, voffB); PG8_STAGE(PG8_SA(1, 0), a3, voffA);
            PG8_WAIT_V(8); PG8_WAIT_L(0); PG8_BAR; PG8_MMA(1, 0, At, B0); PG8_MMA(1, 1, At, B1); PG8_BAR; PG8_SCHED;
            } else {
            PG8_LDB(B0, 0, 0); PG8_SCHED; PG8_LDA(At, 0, 0); PG8_STAGE(PG8_SA(1, 1), a1 + hstep, voffA);
            PG8_WAIT_L(8); PG8_BAR; PG8_WAIT_L(0); PG8_MMA(0, 0, At, B0); PG8_BAR; PG8_SCHED;
            PG8_LDB(B1, 0, 1); PG8_STAGE(PG8_SB(0, 0), b2, voffB);
            PG8_BAR; PG8_WAIT_L(0); PG8_MMA(0, 1, At, B1); PG8_BAR;
            PG8_LDA(At, 0, 1); PG8_STAGE(PG8_SA(0, 0), a2, voffA);
            PG8_BAR; PG8_WAIT_L(0); PG8_MMA(1, 0, At, B0); PG8_BAR; PG8_SCHED;
            PG8_STAGE(PG8_SB(0, 1), b2 + hstep, voffB);
            PG8_WAIT_V(6); PG8_BAR; PG8_MMA(1, 1, At, B1); PG8_BAR;
            PG8_LDB(B0, 1, 0); PG8_SCHED; PG8_LDA(At, 1, 0); PG8_STAGE(PG8_SA(0, 1), a2 + hstep, voffA);
            PG8_WAIT_L(8); PG8_BAR; PG8_WAIT_L(0); PG8_MMA(0, 0, At, B0); PG8_BAR; PG8_SCHED;
            PG8_LDB(B1, 1, 1); PG8_STAGE(PG8_SB(1, 0), b3, voffB);
            PG8_BAR; PG8_WAIT_L(0); PG8_MMA(0, 1, At, B1); PG8_BAR;
            PG8_LDA(At, 1, 1); PG8_STAGE(PG8_SA(1, 0), a3, voffA);
            PG8_BAR; PG8_WAIT_L(0); PG8_MMA(1, 0, At, B0); PG8_BAR; PG8_SCHED;
            PG8_STAGE(PG8_SB(1, 1), b3 + hstep, voffB);
            PG8_WAIT_V(6); PG8_BAR; PG8_MMA(1, 1, At, B1); PG8_BAR;
            }
        }
        if constexpr (ALIGN_EPI) { if (wr == 0) PG8_BAR; }
        E(acc, cur, wr, wc, fr, fq, pre);
        if (!has_next) break;
#pragma unroll
        for (int a = 0; a < 2; ++a)
#pragma unroll
            for (int b = 0; b < 2; ++b)
#pragma unroll
                for (int m = 0; m < 4; ++m)
#pragma unroll
                    for (int n = 0; n < 2; ++n) acc[a][b][m][n] = (f32x4){0.f, 0.f, 0.f, 0.f};
        cur = nxt; cA = nA; cB = nB; ++ui;
        if constexpr (ALIGN_EPI) { if (wr == 1) PG8_BAR; }
    }
    PG8_WAIT_V(0);
    if constexpr (!ALIGN_EPI) { if (wr == 0) PG8_BAR; }
    PG8_BAR;
#undef PG8_SA
#undef PG8_SB
#undef PG8_STAGE
#undef PG8_LDA
#undef PG8_LDB
#undef PG8_MMA
#undef PG8_WAIT_V
#undef PG8_WAIT_L
#undef PG8_BAR
#undef PG8_SCHED
}

typedef f32x4 Acc[2][2][4][2];
struct PreRs { float r[2][4]; };
struct PreNone { };
__device__ __forceinline__ PreRs load_rs(const float* rs, const Unit& u, int wr, int fr) { PreRs p; const int row0 = u.pm * BM + wr * 64 + fr;
#pragma unroll
    for (int ai = 0; ai < 2; ++ai)
#pragma unroll
        for (int m = 0; m < 4; ++m) p.r[ai][m] = rs[row0 + ai * HALF + m * 16];
    return p; }
__device__ __forceinline__ u32x4 pack8(const f32x4 a, const f32x4 b) { u32x4 w; w.x = cvt_pk_bf16(a[0], a[1]); w.y = cvt_pk_bf16(a[2], a[3]); w.z = cvt_pk_bf16(b[0], b[1]); w.w = cvt_pk_bf16(b[2], b[3]); return w; }

struct EpiInA {
    bf16_t* Z; float* VSS; const float* rs;
    typedef PreRs Pre; __device__ __forceinline__ Pre prefetch(const Unit& u, int wr, int fr) const { return load_rs(rs, u, wr, fr); }
    __device__ __forceinline__ void operator()(const Acc& acc, const Unit& u, int wr, int wc, int fr, int fq, const Pre& pre) const {
        const int row0 = u.pm * BM + wr * 64 + fr, col0 = u.pn * BM + wc * 32 + 8 * fq;
        const bool act = u.pn < 12, isv = (u.pn >= 6) && act;
#pragma unroll
        for (int ai = 0; ai < 2; ++ai)
#pragma unroll
            for (int m = 0; m < 4; ++m) {
                const int row = row0 + ai * HALF + m * 16; bf16_t* rowp = Z + (size_t)row * ZP + col0; float ss = 0.f; const float rsr = pre.r[ai][m];
#pragma unroll
                for (int bj = 0; bj < 2; ++bj) { f32x4 v0 = acc[ai][bj][m][0] * rsr, v1 = acc[ai][bj][m][1] * rsr;
                    if (act) {
#pragma unroll
                        for (int e = 0; e < 4; ++e) { v0[e] = gelu_tanh(v0[e]); v1[e] = gelu_tanh(v1[e]); ss += v0[e] * v0[e] + v1[e] * v1[e]; }
                    } else { v0 = v0 * QSCALE; v1 = v1 * QSCALE; }
                    *(u32x4*)(rowp + bj * HALF) = pack8(v0, v1); }
                if (isv) { ss += __shfl_xor(ss, 16); ss += __shfl_xor(ss, 32); if (fq == 0) VSS[(size_t)row * 24 + (u.pn - 6) * 4 + wc] = ss; }
            }
    }
};
struct EpiMkv {
    float* outf; bf16_t* outb; const float* rs;
    typedef PreRs Pre; __device__ __forceinline__ Pre prefetch(const Unit& u, int wr, int fr) const { return load_rs(rs, u, wr, fr); }
    __device__ __forceinline__ void operator()(const Acc& acc, const Unit& u, int wr, int wc, int fr, int fq, const Pre& pre) const {
        const int row0 = u.pm * BM + wr * 64 + fr, col0 = u.pn * BM + wc * 32 + 8 * fq;
#pragma unroll
        for (int ai = 0; ai < 2; ++ai)
#pragma unroll
            for (int m = 0; m < 4; ++m) { const size_t off = (size_t)(row0 + ai * HALF + m * 16) * NKV + col0; const float rsr = pre.r[ai][m];
#pragma unroll
                for (int bj = 0; bj < 2; ++bj) { const f32x4 v0 = acc[ai][bj][m][0] * rsr, v1 = acc[ai][bj][m][1] * rsr;
                    *(f32x4*)(outf + off + bj * HALF) = v0; *(f32x4*)(outf + off + bj * HALF + 4) = v1; *(u32x4*)(outb + off + bj * HALF) = pack8(v0, v1); } }
    }
};
struct EpiPlain {
    bf16_t* O; int ldc;
    typedef PreNone Pre; __device__ __forceinline__ Pre prefetch(const Unit&, int, int) const { return Pre{}; }
    __device__ __forceinline__ void operator()(const Acc& acc, const Unit& u, int wr, int wc, int fr, int fq, const Pre&) const {
        const int row0 = u.pm * BM + wr * 64 + fr, col0 = u.pn * BM + wc * 32 + 8 * fq;
#pragma unroll
        for (int ai = 0; ai < 2; ++ai)
#pragma unroll
            for (int m = 0; m < 4; ++m) { bf16_t* rowp = O + (size_t)(row0 + ai * HALF + m * 16) * ldc + col0;
#pragma unroll
                for (int bj = 0; bj < 2; ++bj) *(u32x4*)(rowp + bj * HALF) = pack8(acc[ai][bj][m][0], acc[ai][bj][m][1]); }
    }
};
struct EpiSwiglu {
    bf16_t* ACT; const float* rs;
    typedef PreRs Pre; __device__ __forceinline__ Pre prefetch(const Unit& u, int wr, int fr) const { return load_rs(rs, u, wr, fr); }
    __device__ __forceinline__ void operator()(const Acc& acc, const Unit& u, int wr, int wc, int fr, int fq, const Pre& pre) const {
        const int row0 = u.pm * BM + wr * 64 + fr, col0 = u.pn * HALF + wc * 32 + 8 * fq;
#pragma unroll
        for (int ai = 0; ai < 2; ++ai)
#pragma unroll
            for (int m = 0; m < 4; ++m) { f32x4 v0, v1; const float rsr = pre.r[ai][m];
#pragma unroll
                for (int e = 0; e < 4; ++e) { v0[e] = silu_f(acc[ai][0][m][0][e] * rsr) * (acc[ai][1][m][0][e] * rsr); v1[e] = silu_f(acc[ai][0][m][1][e] * rsr) * (acc[ai][1][m][1][e] * rsr); }
                *(u32x4*)(ACT + (size_t)(row0 + ai * HALF + m * 16) * DFF + col0) = pack8(v0, v1); }
    }
};
struct EpiInB {
    bf16_t* Z; const float* rs;
    typedef PreRs Pre; __device__ __forceinline__ Pre prefetch(const Unit& u, int wr, int fr) const { return load_rs(rs, u, wr, fr); }
    __device__ __forceinline__ void operator()(const Acc& acc, const Unit& u, int wr, int wc, int fr, int fq, const Pre& pre) const {
        const int row0 = u.pm * BM + wr * 64 + fr, col0 = u.pn * BM + wc * 32 + 8 * fq;
        const float qs = ((u.pn < 6) || (u.pn >= 18)) ? QSCALE : 1.0f;
#pragma unroll
        for (int ai = 0; ai < 2; ++ai)
#pragma unroll
            for (int m = 0; m < 4; ++m) {
                const int row = row0 + ai * HALF + m * 16; bf16_t* rowp = Z + (size_t)row * ZP + col0; const float rsr = pre.r[ai][m] * qs;
#pragma unroll
                for (int bj = 0; bj < 2; ++bj) *(u32x4*)(rowp + bj * HALF) = pack8(acc[ai][bj][m][0] * rsr, acc[ai][bj][m][1] * rsr);
            }
    }
};
}

__device__ __forceinline__ unsigned f2bf(float f) { unsigned u = __builtin_bit_cast(unsigned, f); return (u + 0x7fffu + ((u >> 16) & 1u)) >> 16; }
__device__ __forceinline__ unsigned pk2(float lo, float hi) { return f2bf(lo) | (f2bf(hi) << 16); }
struct TItem { const float* src; bf16_t* dst; const float* gain; int N, K; };
__device__ __forceinline__ TItem t_make(const float* W, int K, int N, bf16_t* WT, bool upperm, const float* gain, int item) {
    const int nblk = N / 64, kb = item / nblk, nb = item % nblk, k0 = 64 * kb, n0 = 64 * nb;
    int s0 = n0;
    if (upperm) { const int pn = n0 >> 8, j = n0 & 255; s0 = (j < 128) ? (128 * pn + j) : (DFF + 128 * pn + (j - 128)); }
    TItem t; t.src = W + (size_t)k0 * N + s0; t.dst = WT + (size_t)n0 * K + k0; t.gain = gain != nullptr ? gain + k0 : nullptr; t.N = N; t.K = K; return t;
}
__device__ __forceinline__ void t_load(const TItem& t, int lane, f32x4 (&v)[16]) {
    const float* src = t.src + (size_t)(lane >> 4) * t.N + 4 * (lane & 15);
#pragma unroll
    for (int i = 0; i < 16; ++i) v[i] = __builtin_nontemporal_load((const f32x4*)(src + (size_t)(4 * i) * t.N));
}
__device__ __forceinline__ void t_store(const TItem& t, LAS float* scr, int lane, const f32x4 (&v)[16]) {
    const int lr = lane >> 4, lc = lane & 15;
#pragma unroll
    for (int i = 0; i < 16; ++i) { const int k = 4 * i + lr; const float gk = t.gain != nullptr ? t.gain[k] : 1.0f;
        *(LAS f32x4*)(scr + k * 64 + ((4 * lc) ^ (4 * (k >> 3)))) = v[i] * gk; }
    asm volatile("s_waitcnt lgkmcnt(0)" ::: "memory");
    const int c = lane & 7;
#pragma unroll
    for (int j = 0; j < 8; ++j) { const int n = (lane >> 3) + 8 * j; const LAS float* sp = scr + (8 * c) * 64 + (n ^ (4 * c));
        u32x4 o; o.x = cvt_pk_bf16(sp[0 * 64], sp[1 * 64]); o.y = cvt_pk_bf16(sp[2 * 64], sp[3 * 64]); o.z = cvt_pk_bf16(sp[4 * 64], sp[5 * 64]); o.w = cvt_pk_bf16(sp[6 * 64], sp[7 * 64]);
        *(u32x4*)(t.dst + (size_t)n * t.K + 8 * c) = o; }
    asm volatile("s_waitcnt lgkmcnt(0)" ::: "memory");
}
template <int MODE>
__device__ __forceinline__ void norm_row(const float* basef, bf16_t* yb, const bf16_t* o, const float* gpost, float* rs_out, float* yout, int lane) {
    f32x4 y[8];
    if (MODE == 0 || MODE == 1) {
#pragma unroll
        for (int j = 0; j < 8; ++j) y[j] = __builtin_nontemporal_load((const f32x4*)(basef + 4 * (lane + 64 * j)));
    } else {
#pragma unroll
        for (int j = 0; j < 8; ++j) { const u32x2 w = *(const u32x2*)(yb + 4 * (lane + 64 * j)); y[j] = (f32x4){bf_lo(w.x), bf_hi(w.x), bf_lo(w.y), bf_hi(w.y)}; }
    }
    if (MODE != 0) {
        f32x4 ov[8]; float ss = 0.f;
#pragma unroll
        for (int j = 0; j < 8; ++j) { const u32x2 w = *(const u32x2*)(o + 4 * (lane + 64 * j)); ov[j] = (f32x4){bf_lo(w.x), bf_hi(w.x), bf_lo(w.y), bf_hi(w.y)};
            ss += (ov[j][0] * ov[j][0] + ov[j][1] * ov[j][1]) + (ov[j][2] * ov[j][2] + ov[j][3] * ov[j][3]); }
        const float rstd = 1.0f / sqrtf(wave_sum(ss) * (1.0f / DM) + EPS);
#pragma unroll
        for (int j = 0; j < 8; ++j) { const f32x4 g = *(const f32x4*)(gpost + 4 * (lane + 64 * j)); y[j] = y[j] + ov[j] * rstd * g; }
    }
    if (MODE == 3) {
#pragma unroll
        for (int j = 0; j < 8; ++j) *(f32x4*)(yout + 4 * (lane + 64 * j)) = y[j];
    } else {
        float ss = 0.f;
#pragma unroll
        for (int j = 0; j < 8; ++j) { ss += (y[j][0] * y[j][0] + y[j][1] * y[j][1]) + (y[j][2] * y[j][2] + y[j][3] * y[j][3]);
            u32x2 w; w.x = cvt_pk_bf16(y[j][0], y[j][1]); w.y = cvt_pk_bf16(y[j][2], y[j][3]); *(u32x2*)(yb + 4 * (lane + 64 * j)) = w; }
        ss = wave_sum(ss);
        if (lane == 0) *rs_out = 1.0f / sqrtf(ss * (1.0f / DM) + EPS);
    }
}

struct NormRaw { u32x2 yb[8]; u32x2 ob[8]; };
__device__ __forceinline__ void norm_load(const bf16_t* yb, const bf16_t* o, int lane, NormRaw& R) {
#pragma unroll
    for (int j = 0; j < 8; ++j) { R.yb[j] = *(const u32x2*)(yb + 4 * (lane + 64 * j)); R.ob[j] = *(const u32x2*)(o + 4 * (lane + 64 * j)); }
}
template <bool FINAL>
__device__ __forceinline__ void norm_finish(const NormRaw& R, bf16_t* yb, const float* gpost, float* rs_out, float* yout, int lane) {
    f32x4 y[8], ov[8]; float ss = 0.f;
#pragma unroll
    for (int j = 0; j < 8; ++j) { y[j] = (f32x4){bf_lo(R.yb[j].x), bf_hi(R.yb[j].x), bf_lo(R.yb[j].y), bf_hi(R.yb[j].y)}; ov[j] = (f32x4){bf_lo(R.ob[j].x), bf_hi(R.ob[j].x), bf_lo(R.ob[j].y), bf_hi(R.ob[j].y)};
        ss += (ov[j][0] * ov[j][0] + ov[j][1] * ov[j][1]) + (ov[j][2] * ov[j][2] + ov[j][3] * ov[j][3]); }
    const float rstd = 1.0f / sqrtf(wave_sum(ss) * (1.0f / DM) + EPS);
#pragma unroll
    for (int j = 0; j < 8; ++j) { const f32x4 g = *(const f32x4*)(gpost + 4 * (lane + 64 * j)); y[j] = y[j] + ov[j] * rstd * g; }
    if (FINAL) {
#pragma unroll
        for (int j = 0; j < 8; ++j) *(f32x4*)(yout + 4 * (lane + 64 * j)) = y[j];
    } else {
        float s2 = 0.f;
#pragma unroll
        for (int j = 0; j < 8; ++j) { s2 += (y[j][0] * y[j][0] + y[j][1] * y[j][1]) + (y[j][2] * y[j][2] + y[j][3] * y[j][3]);
            u32x2 w; w.x = cvt_pk_bf16(y[j][0], y[j][1]); w.y = cvt_pk_bf16(y[j][2], y[j][3]); *(u32x2*)(yb + 4 * (lane + 64 * j)) = w; }
        s2 = wave_sum(s2);
        if (lane == 0) *rs_out = 1.0f / sqrtf(s2 * (1.0f / DM) + EPS);
    }
}

struct KvDesc { const bf16_t* kbase; const bf16_t* vbase; long row0, rstep, pitch; int key_lo; };
__device__ __forceinline__ void kv_issue(const KvDesc& d, int tid, u32x4 (&kk)[8], u32x4 (&vv)[8]) {
    const int srow = tid >> 4, sch = tid & 15;
#pragma unroll
    for (int i = 0; i < 8; ++i) { const int row = srow + 32 * i, rowc = row < d.key_lo ? d.key_lo : row;
        const size_t e = (size_t)(d.row0 + (long)rowc * d.rstep) * d.pitch + sch * 8; kk[i] = *(const u32x4*)(d.kbase + e); vv[i] = *(const u32x4*)(d.vbase + e); }
}
__device__ __forceinline__ void kv_commit(LAS unsigned char* lds, int tid, int key_lo, const u32x4 (&kk)[8], const u32x4 (&vv)[8]) {
    const unsigned sb = off_b(tid >> 4, tid & 15); const int srow = tid >> 4; const u32x4 z = (u32x4){0u, 0u, 0u, 0u};
#pragma unroll
    for (int i = 0; i < 8; ++i) { const bool ok = (srow + 32 * i) >= key_lo; *(LAS u32x4*)(lds + sb + 8192 * i) = ok ? kk[i] : z; *(LAS u32x4*)(lds + 65536 + sb + 8192 * i) = ok ? vv[i] : z; }
}
template <bool BANDED>
__device__ __forceinline__ void attn_compute(LAS unsigned char* lds, int lane, int w, const bf16x8 (&qf)[4], int key_lo, bf16_t* orow, float* lsep, const LAS float* btab) {
    const int fr = lane & 15, fq = lane >> 4;
    LAS unsigned char* Kimg = lds; LAS unsigned char* Vimg = lds + 65536;
    constexpr int NBLK = BANDED ? 5 : 8;
    const int blk0 = BANDED ? (w >> 1) : 0;
    const int qi = 16 * w + fr;
    unsigned kb[2][4];
#pragma unroll
    for (int e = 0; e < 2; ++e)
#pragma unroll
        for (int kk = 0; kk < 4; ++kk) kb[e][kk] = off_b(8 * (fr >> 2) + 4 * e + (fr & 3), 4 * kk + fq);
    LAS unsigned char* Kb = Kimg + 8192 * blk0; LAS unsigned char* Vb = Vimg + 8192 * blk0;
    f32x4 s[2 * NBLK];
#pragma unroll
    for (int nt = 0; nt < 2 * NBLK; ++nt) s[nt] = (f32x4){0.f, 0.f, 0.f, 0.f};
    constexpr int TB = BANDED ? 2 * NBLK : NBLK;
#pragma unroll
    for (int t0 = 0; t0 < 2 * NBLK; t0 += TB)
#pragma unroll
        for (int kk = 0; kk < 4; ++kk) { bf16x8 kf[TB];
#pragma unroll
            for (int i = 0; i < TB; ++i) { const int nt = t0 + i; kf[i] = *(const LAS bf16x8*)(Kb + kb[nt & 1][kk] + 8192 * (nt >> 1)); }
            __builtin_amdgcn_sched_barrier(0);
#pragma unroll
            for (int i = 0; i < TB; ++i) s[t0 + i] = __builtin_amdgcn_mfma_f32_16x16x32_bf16(kf[i], qf[kk], s[t0 + i], 0, 0, 0);
            __builtin_amdgcn_sched_barrier(0); }
    float mx = -1e30f;
    const LAS float* bp = btab + (128 + 16 * (w & 1) + fr - 8 * fq + 32 - 135);
    const int cmin = BANDED ? (key_lo > 0 ? (128 + 16 * (w & 1) + fr - 8 * fq) - qi : -1000) : 0;
#pragma unroll
    for (int nt = 0; nt < 2 * NBLK; ++nt)
#pragma unroll
        for (int r = 0; r < 4; ++r) { float x = s[nt][r];
            if (BANDED) { const int c = 32 * (nt >> 1) + 4 * (nt & 1) + r; x = x + bp[135 - c]; x = (c >= cmin) ? x : -1e30f; s[nt][r] = x; }
            mx = fmaxf(mx, x); }
    mx = fmaxf(mx, __shfl_xor(mx, 16)); mx = fmaxf(mx, __shfl_xor(mx, 32));
    float l = 0.f;
#pragma unroll
    for (int nt = 0; nt < 2 * NBLK; ++nt)
#pragma unroll
        for (int r = 0; r < 4; ++r) { const float p = __builtin_amdgcn_exp2f(s[nt][r] - mx); s[nt][r] = p; l += p; }
    l += __shfl_xor(l, 16); l += __shfl_xor(l, 32);
    bf16x8 pf[NBLK];
#pragma unroll
    for (int ks = 0; ks < NBLK; ++ks) pf[ks] = __builtin_bit_cast(bf16x8, pg8::pack8(s[2 * ks], s[2 * ks + 1]));
    const float inv_l = 1.0f / l;
    unsigned vb[8][2];
#pragma unroll
    for (int ct = 0; ct < 8; ++ct) { vb[ct][0] = tr16_addr(lane, ct, 0, 0); vb[ct][1] = tr16_addr(lane, ct, 0, 1); }
    f32x4 oa[8];
#pragma unroll
    for (int ct = 0; ct < 8; ++ct) oa[ct] = (f32x4){0.f, 0.f, 0.f, 0.f};
#pragma unroll
    for (int ks = 0; ks < NBLK; ++ks) { s16x4 vlo[8], vhi[8];
#pragma unroll
        for (int ct = 0; ct < 8; ++ct) { vlo[ct] = tr_read(Vb + vb[ct][0] + 8192 * ks); vhi[ct] = tr_read(Vb + vb[ct][1] + 8192 * ks); }
        __builtin_amdgcn_sched_barrier(0);
#pragma unroll
        for (int ct = 0; ct < 8; ++ct) { const bf16x8 vf = (bf16x8){vlo[ct][0], vlo[ct][1], vlo[ct][2], vlo[ct][3], vhi[ct][0], vhi[ct][1], vhi[ct][2], vhi[ct][3]};
            oa[ct] = __builtin_amdgcn_mfma_f32_16x16x32_bf16(vf, pf[ks], oa[ct], 0, 0, 0); }
        __builtin_amdgcn_sched_barrier(0); }
#pragma unroll
    for (int ct = 0; ct < 8; ++ct) { u32x2 wv; wv.x = cvt_pk_bf16(oa[ct][0] * inv_l, oa[ct][1] * inv_l); wv.y = cvt_pk_bf16(oa[ct][2] * inv_l, oa[ct][3] * inv_l);
        *(u32x2*)(orow + 16 * ct) = wv; }
    if (lsep != nullptr && fq == 0) *lsep = (mx + __builtin_amdgcn_logf(l)) * LN2;
}
struct QoDesc { const bf16_t* qbase; long row0, rstep; bf16_t* obase; float* lsebase; int banded, dil, head; };

struct GateRegs { u32x4 v[2][6]; f32x4 wq[8]; f32x4 vs[3]; float gvl; };
__device__ __forceinline__ void gate_issue(int tid, int b, int chunk, int g, const bf16_t* Z, const float* VSS, const float* w_s, const float* g_v, GateRegs& R) {
    const int lane = tid & 63, w = __builtin_amdgcn_readfirstlane(tid >> 6), fr = lane & 15, fq = lane >> 4;
    const int tok0 = b * SEQ + chunk * 128;
    {
        const int r0 = tid >> 3, c0 = tid & 7; const bf16_t* gp = Z + (size_t)(tok0 + r0) * ZP + MIXW + g * 384 + c0 * 8;
#pragma unroll
        for (int i2 = 0; i2 < 2; ++i2)
#pragma unroll
            for (int i = 0; i < 6; ++i) R.v[i2][i] = *(const u32x4*)(gp + (size_t)i2 * 64 * ZP + 64 * i); }
    { const float* wp = w_s + (size_t)g * 16384 + (16 * w + fr) * 128 + 8 * fq;
#pragma unroll
      for (int kk = 0; kk < 4; ++kk) { R.wq[2 * kk] = *(const f32x4*)(wp + 32 * kk); R.wq[2 * kk + 1] = *(const f32x4*)(wp + 32 * kk + 4); } }
    { const float* p = VSS + (size_t)(tok0 + (tid & 127)) * 24 + 12 * ((tid >> 7) & 1);
#pragma unroll
      for (int i = 0; i < 3; ++i) R.vs[i] = *(const f32x4*)(p + 4 * i); }
    R.gvl = g_v[g * 384 + (tid < 384 ? tid : tid - 384)];
}
__device__ __forceinline__ void gate_run(LAS unsigned char* lds, int tid, int b, int chunk, int g, const GateRegs& R, const bf16_t* Z, const float* b_s, bf16_t* MIX) {
    const int lane = tid & 63, w = __builtin_amdgcn_readfirstlane(tid >> 6), fr = lane & 15, fq = lane >> 4;
    const int tok0 = b * SEQ + chunk * 128, i = 16 * w + fr;
    LAS float* rs = (LAS float*)(lds + LDS_TAB); LAS float* gvs = rs + 128;
    const size_t tokrow = (size_t)(tok0 + i);
    __syncthreads();
    const bf16_t* up = Z + tokrow * ZP + g * 384 + 4 * fq;
    u32x2 ucur[8];
    const float bs = b_s[g * 128 + i];
    {
        const int r0 = tid >> 3, c0 = tid & 7; const unsigned gsb0 = off_b(r0, c0), gsb1 = off_b(r0, c0 + 8);
#pragma unroll
        for (int i2 = 0; i2 < 2; ++i2)
#pragma unroll
            for (int k = 0; k < 6; ++k) *(LAS u32x4*)(lds + (k >> 1) * 32768 + ((k & 1) ? gsb1 : gsb0) + 16384 * i2) = R.v[i2][k]; }
    { float ssum = 0.f;
#pragma unroll
      for (int k = 0; k < 3; ++k) ssum += (R.vs[k][0] + R.vs[k][1]) + (R.vs[k][2] + R.vs[k][3]);
      if (tid < 256) rs[512 + tid] = ssum;
      if (tid < 384) gvs[tid] = R.gvl; }
    __syncthreads();
    if (tid < 128) rs[tid] = 1.0f / sqrtf((rs[512 + tid] + rs[512 + 128 + tid]) * (1.0f / MIXW) + EPS);
    __syncthreads();
    bf16x8 wf[4];
#pragma unroll
    for (int kk = 0; kk < 4; ++kk) { const int j0 = 32 * kk + 8 * fq;
        const f32x4 r0 = *(const LAS f32x4*)(rs + j0), r1 = *(const LAS f32x4*)(rs + j0 + 4);
        const f32x4 a = R.wq[2 * kk], c = R.wq[2 * kk + 1];
        float v[8] = {a[0] * r0[0], a[1] * r0[1], a[2] * r0[2], a[3] * r0[3], c[0] * r1[0], c[1] * r1[1], c[2] * r1[2], c[3] * r1[3]};
#pragma unroll
        for (int jj = 0; jj < 8; ++jj) v[jj] = (j0 + jj <= i) ? v[jj] : 0.f;
        u32x4 pk; pk.x = cvt_pk_bf16(v[0], v[1]); pk.y = cvt_pk_bf16(v[2], v[3]); pk.z = cvt_pk_bf16(v[4], v[5]); pk.w = cvt_pk_bf16(v[6], v[7]);
        wf[kk] = __builtin_bit_cast(bf16x8, pk); }
    unsigned vb[8][2];
#pragma unroll
    for (int c = 0; c < 8; ++c) { vb[c][0] = tr16_addr(lane, c, 0, 0); vb[c][1] = tr16_addr(lane, c, 0, 1); }
#pragma unroll
    for (int sub = 0; sub < 3; ++sub) { LAS unsigned char* img = lds + sub * 32768;
#pragma unroll
        for (int c = 0; c < 8; ++c) ucur[c] = *(const u32x2*)(up + sub * 128 + 16 * c);
#pragma unroll
        for (int c = 0; c < 8; ++c) { f32x4 a = (f32x4){0.f, 0.f, 0.f, 0.f};
#pragma unroll
            for (int kk = 0; kk < 4; ++kk) if (kk <= (w >> 1)) {
                const s16x4 lo = tr_read(img + vb[c][0] + 8192 * kk), hi = tr_read(img + vb[c][1] + 8192 * kk);
                const bf16x8 vf = (bf16x8){lo[0], lo[1], lo[2], lo[3], hi[0], hi[1], hi[2], hi[3]};
                a = __builtin_amdgcn_mfma_f32_16x16x32_bf16(vf, wf[kk], a, 0, 0, 0); }
            const int col = g * 384 + sub * 128 + 16 * c + 4 * fq;
            const f32x4 gv = *(const LAS f32x4*)(gvs + sub * 128 + 16 * c + 4 * fq);
            const u32x2 uw = ucur[c];
            const float o0 = bf_lo(uw.x) * (a[0] * gv[0] + bs), o1 = bf_hi(uw.x) * (a[1] * gv[1] + bs), o2 = bf_lo(uw.y) * (a[2] * gv[2] + bs), o3 = bf_hi(uw.y) * (a[3] * gv[3] + bs);
            u32x2 ov; ov.x = cvt_pk_bf16(o0, o1); ov.y = cvt_pk_bf16(o2, o3);
            *(u32x2*)(MIX + tokrow * DM + col) = ov; } }
}

template <int MODE, int K>
__device__ __forceinline__ void sample_gemv(LAS unsigned char* lds, const bf16_t* A, int a_pitch, const bf16_t* Wt, int N, int first, int stride,
                                            float* outf, bf16_t* outb, int ldb, float* win, const float* rs, const float* slse = nullptr) {
    int tid = threadIdx.x; asm volatile("" : "+v"(tid));
    const int lane = tid & 63, w = __builtin_amdgcn_readfirstlane(tid >> 6), fr = lane & 15, fq = lane >> 4;
    const int ntiles = (MODE == 2) ? N / 32 : N / 16;
    LAS float* red = (LAS float*)lds;
    constexpr int kw = K / 8;
    LAS float* atab = (LAS float*)(lds + LDS_TAB + 4096);
    if (slse != nullptr) {
        __syncthreads();
        if (tid < 128) { const int srow = tid >> 4, H = tid & 15; float al = 1.0f;
            if (H < 12) { const int hl = H & 3; const float l0 = slse[srow * 12 + hl], l1 = slse[srow * 12 + 4 + hl], l2 = slse[srow * 12 + 8 + hl], mm = fmaxf(l0, fmaxf(l1, l2));
                const float e0 = __expf(l0 - mm), e1 = __expf(l1 - mm), e2 = __expf(l2 - mm); al = (H < 4 ? e0 : (H < 8 ? e1 : e2)) / (e0 + e1 + e2); }
            atab[tid] = al; }
        __syncthreads();
    }
    for (int tile = first; tile < ntiles; tile += stride) {
        const int nrow0 = (MODE == 2) ? 256 * (tile >> 3) + 16 * (tile & 7) : 16 * tile;
        const bf16_t* ap = A + (size_t)(fr & 7) * a_pitch + w * kw + 8 * fq;
        const bf16_t* bp = Wt + (size_t)(nrow0 + fr) * K + w * kw + 8 * fq;
        f32x4 acc = (f32x4){0.f, 0.f, 0.f, 0.f}, acc2 = (f32x4){0.f, 0.f, 0.f, 0.f};
#pragma unroll
        for (int ks = 0; ks < kw / 32; ++ks) { bf16x8 a = *(const bf16x8*)(ap + 32 * ks); const bf16x8 b = *(const bf16x8*)(bp + 32 * ks);
            if (MODE == 1 && slse != nullptr) { const float al = atab[(fr & 7) * 16 + ((w * kw + 32 * ks + 8 * fq) >> 7)]; const u32x4 aw = __builtin_bit_cast(u32x4, a); u32x4 o;
                o.x = cvt_pk_bf16(bf_lo(aw.x) * al, bf_hi(aw.x) * al); o.y = cvt_pk_bf16(bf_lo(aw.y) * al, bf_hi(aw.y) * al);
                o.z = cvt_pk_bf16(bf_lo(aw.z) * al, bf_hi(aw.z) * al); o.w = cvt_pk_bf16(bf_lo(aw.w) * al, bf_hi(aw.w) * al); a = __builtin_bit_cast(bf16x8, o); }
            acc = __builtin_amdgcn_mfma_f32_16x16x32_bf16(b, a, acc, 0, 0, 0);
            if (MODE == 2) { const bf16x8 b2 = *(const bf16x8*)(bp + (size_t)128 * K + 32 * ks); acc2 = __builtin_amdgcn_mfma_f32_16x16x32_bf16(b2, a, acc2, 0, 0, 0); } }
        __syncthreads();
        *(LAS f32x4*)(red + (w * 16 + fr) * 16 + 4 * fq) = acc;
        if (MODE == 2) *(LAS f32x4*)(red + 2048 + (w * 16 + fr) * 16 + 4 * fq) = acc2;
        __syncthreads();
        if (tid < 128) { const int s = tid >> 4, c = tid & 15; float v = 0.f, v2 = 0.f;
#pragma unroll
            for (int ww = 0; ww < 8; ++ww) { v += red[(ww * 16 + s) * 16 + c]; if (MODE == 2) v2 += red[2048 + (ww * 16 + s) * 16 + c]; }
            if (rs != nullptr) { const float rsr = rs[s]; v *= rsr; v2 *= rsr; }
            if (MODE == 0) { const int n = nrow0 + c; outf[(size_t)s * ZP + n] = v;
                if (win != nullptr && n >= 1536 && n < 4608) { const int kv = n >= 3072 ? 1 : 0, cc = n - 1536 - 1536 * kv, grp = cc >> 9;
                    win[(size_t)grp * 8192 + (size_t)(s * 2 + kv) * 512 + (cc & 511)] = v; } }
            else if (MODE == 1) { outb[(size_t)s * ldb + nrow0 + c] = (bf16_t)f2bf(v); }
            else { outb[(size_t)s * ldb + 128 * (tile >> 3) + 16 * (tile & 7) + c] = (bf16_t)f2bf(silu_f(v) * v2); } }
    }
}

template <class KF, class VF>
__device__ __forceinline__ float sample_attend(LAS float* scr, const float* qv, int nkeys, KF kf, VF vf, const LAS float* btab, LAS float* o_out) {
    int tid = threadIdx.x; asm volatile("" : "+v"(tid));
    const int lane = tid & 63, w = __builtin_amdgcn_readfirstlane(tid >> 6);
    LAS float* sc = scr; LAS float* part = scr + 320; LAS float* stat = scr + 320 + 2048;
    {
        const int key = tid >> 1, half = tid & 1; float d = 0.f;
        if (key < nkeys) { const float* kp = kf(key) + 64 * half; const float* qp = qv + 64 * half; f32x4 k4[16];
#pragma unroll
            for (int i = 0; i < 16; ++i) k4[i] = *(const f32x4*)(kp + 4 * i);
#pragma unroll
            for (int i = 0; i < 16; ++i) { const f32x4 q4 = *(const f32x4*)(qp + 4 * i); d += (k4[i][0] * q4[0] + k4[i][1] * q4[1]) + (k4[i][2] * q4[2] + k4[i][3] * q4[3]); } }
        d += __shfl_xor(d, 1);
        if (half == 0 && key < nkeys) sc[key] = d * QSCALE + (btab != nullptr ? btab[key] : 0.f);
    }
    __syncthreads();
    if (w == 0) { float m = -1e30f; for (int j = lane; j < nkeys; j += 64) m = fmaxf(m, sc[j]); m = wave_max(m);
        float l = 0.f; for (int j = lane; j < nkeys; j += 64) { const float p = __builtin_amdgcn_exp2f(sc[j] - m); sc[j] = p; l += p; } l = wave_sum(l);
        if (lane == 0) { stat[0] = m; stat[1] = l; } }
    __syncthreads();
    {
        const int kg = tid >> 5, d4 = 4 * (tid & 31); f32x4 v4[16]; f32x4 a = (f32x4){0.f, 0.f, 0.f, 0.f};
#pragma unroll
        for (int i = 0; i < 16; ++i) { const int j = kg + 16 * i; v4[i] = (f32x4){0.f, 0.f, 0.f, 0.f}; if (j < nkeys) v4[i] = *(const f32x4*)(vf(j) + d4); }
#pragma unroll
        for (int i = 0; i < 16; ++i) { const int j = kg + 16 * i; const float pj = j < nkeys ? sc[j] : 0.f; a = a + v4[i] * pj; }
        *(LAS f32x4*)(part + kg * 128 + d4) = a; }
    __syncthreads();
    const float m = stat[0], l = stat[1];
    if (tid < 128) { float a = 0.f;
#pragma unroll
        for (int g = 0; g < 16; ++g) a += part[g * 128 + tid];
        o_out[tid] = a / l; }
    __syncthreads();
    return (m + __builtin_amdgcn_logf(l)) * LN2;
}

#define XB_TMO      128
#define XB_XCNT(j)  (256  + 64 * (j))
#define XB_XSUB(j)  (1280 + 64 * (j))
#define XB_XGEN(j)  (2304 + 64 * (j))
#define XB_TOP      3328
#define XB_TOPGEN   3392
#define XCD_BAR_WORDS 3456
#define XB_SPIN_CAP (1u << 18)
__device__ __forceinline__ unsigned xb_ld(unsigned* p)              { return __hip_atomic_load(p, __ATOMIC_RELAXED, __HIP_MEMORY_SCOPE_AGENT); }
__device__ __forceinline__ unsigned xb_add(unsigned* p, unsigned v) { return __hip_atomic_fetch_add(p, v, __ATOMIC_RELAXED, __HIP_MEMORY_SCOPE_AGENT); }
__device__ __forceinline__ unsigned xb_xcc_id() { return (unsigned)__builtin_amdgcn_s_getreg((3 << 11) | 20) & 0xFu; }
#define XB_SPIN(cond, bar) do { unsigned _sp = 0; while (cond) { __builtin_amdgcn_s_sleep(1); \
    if ((++_sp & 255u) == 0u) { if (xb_ld(&(bar)[XB_TMO])) break; if (_sp > XB_SPIN_CAP) { atomicAdd(&(bar)[XB_TMO], 1u); break; } } } } while (0)
struct XcdBarrier { unsigned* bar; unsigned x; volatile LAS unsigned* st; };
__device__ __forceinline__ XcdBarrier xcd_barrier_post(unsigned* bar, volatile LAS unsigned* st) {
    XcdBarrier b; b.bar = bar; b.x = xb_xcc_id(); b.st = st;
    if (threadIdx.x == 0) (void)xb_add(&bar[XB_XCNT(b.x)], 1u);
    return b;
}
__device__ __forceinline__ void xcd_barrier_complete(unsigned* bar, unsigned x, unsigned& nloc, unsigned& nx) {
    const unsigned G = gridDim.x * gridDim.y * gridDim.z;
    unsigned sum, cnt, mine, sp = 0u;
    for (;;) {
        sum = 0u; cnt = 0u; mine = 0u;
#pragma unroll
        for (unsigned j = 0; j < 16; ++j) { const unsigned c = xb_ld(&bar[XB_XCNT(j)]); sum += c; cnt += (c > 0u) ? 1u : 0u; mine = (j == x) ? c : mine; }
        if (sum == G) break;
        __builtin_amdgcn_s_sleep(1);
        if ((++sp & 255u) == 0u) { if (xb_ld(&bar[XB_TMO])) break; if (sp > XB_SPIN_CAP) { atomicAdd(&bar[XB_TMO], 1u); break; } }
    }
    nloc = mine > 0u ? mine : 1u; nx = cnt > 0u ? cnt : 1u;
}
__device__ __forceinline__ void xcd_barrier(const XcdBarrier& b) {
    asm volatile("s_waitcnt vmcnt(0)" ::: "memory");
    __syncthreads();
    if (threadIdx.x == 0) {
        unsigned* bar = b.bar;
        __builtin_amdgcn_s_waitcnt(0);
        unsigned nloc = b.st[0], nx = b.st[1];
        if (nloc == 0u) { xcd_barrier_complete(bar, b.x, nloc, nx); b.st[0] = nloc; b.st[1] = nx; }
        const unsigned old = xb_add(&bar[XB_XSUB(b.x)], 1u);
        const unsigned gen = old / nloc;
        if (old + 1u == (gen + 1u) * nloc) {
            __builtin_amdgcn_fence(__ATOMIC_RELEASE, "agent");
            asm volatile("s_waitcnt vmcnt(0)" ::: "memory");
            const unsigned og = xb_add(&bar[XB_TOP], 1u);
            const unsigned tg = og / nx;
            if (og + 1u == (tg + 1u) * nx) xb_add(&bar[XB_TOPGEN], 1u);
            else XB_SPIN(xb_ld(&bar[XB_TOPGEN]) == tg, bar);
            __builtin_amdgcn_fence(__ATOMIC_ACQUIRE, "agent");
            xb_add(&bar[XB_XGEN(b.x)], 1u);
            asm volatile("s_waitcnt vmcnt(0)" ::: "memory");
        } else {
            XB_SPIN(xb_ld(&bar[XB_XGEN(b.x)]) == gen, bar);
            __builtin_amdgcn_fence(__ATOMIC_ACQUIRE, "agent");
            asm volatile("s_waitcnt vmcnt(0)" ::: "memory");
        }
    }
    __syncthreads();
}

struct Args { const float* in[22]; float* out; unsigned char* ws; };
typedef const Args __attribute__((address_space(4)))* ArgsP;
__device__ __forceinline__ ArgsP args_ptr() { ArgsP p = (ArgsP)__builtin_amdgcn_kernarg_segment_ptr(); asm volatile("" : "+s"(p)); return p; }
#define WSP(T, off) ((T*)(A->ws + (off)))

constexpr int I_MKV = 32 * 16, I_INA = 32 * 56, I_INB = 32 * 80, I_OUT = 32 * 32, I_UP = 32 * 176, I_DN = 88 * 32, DN_P = 850, DN_A = 1170;
__device__ __forceinline__ int conv_count(int list) { return list == 0 ? 2 * I_MKV + I_INA + I_UP + DN_P : (list == 1 ? I_OUT + (DN_A - DN_P) : (list == 2 ? (I_DN - DN_A) + I_INB + I_OUT : (list == 3 ? I_UP : I_DN))); }
__device__ __forceinline__ TItem conv_item(ArgsP A, int list, int r) {
    const float* n_mix_pre = A->in[8]; const float* n_ffn_pre = A->in[10]; const float* n_mem = A->in[12]; const float* w_mem_kv = A->in[13]; const float* w_in_a = A->in[14];
    const float* w_in_b = A->in[18]; const float* w_out = A->in[19]; const float* w_up = A->in[20]; const float* w_dn = A->in[21];
    bf16_t* Wmkv = WSP(bf16_t, WS_WMKV); bf16_t* Wina = WSP(bf16_t, WS_WINA); bf16_t* Winb = WSP(bf16_t, WS_WINB); bf16_t* Wout = WSP(bf16_t, WS_WOUT);
    bf16_t* Wup = WSP(bf16_t, WS_WUP); bf16_t* Wdn = WSP(bf16_t, WS_WDN);
    if (list == 0) {
        if (r < 2 * I_MKV) { const int l = r / I_MKV; return t_make(w_mem_kv + (size_t)l * DM * NKV, DM, NKV, Wmkv + (size_t)l * NKV * DM, false, n_mem + l * DM, r % I_MKV); } r -= 2 * I_MKV;
        if (r < I_INA) return t_make(w_in_a, DM, NA, Wina, false, n_mix_pre, r); r -= I_INA;
        if (r < I_UP) return t_make(w_up, DM, NUP, Wup, true, n_ffn_pre, r); r -= I_UP;
        return t_make(w_dn, DFF, DM, Wdn, false, nullptr, r);
    } else if (list == 1) {
        if (r < I_OUT) return t_make(w_out, DM, DM, Wout, false, nullptr, r); r -= I_OUT;
        return t_make(w_dn, DFF, DM, Wdn, false, nullptr, DN_P + r);
    } else if (list == 2) {
        if (r < I_DN - DN_A) return t_make(w_dn, DFF, DM, Wdn, false, nullptr, DN_A + r); r -= I_DN - DN_A;
        if (r < I_INB) return t_make(w_in_b, DM, NB, Winb, false, n_mix_pre + DM, r); r -= I_INB;
        return t_make(w_out + (size_t)DM * DM, DM, DM, Wout + (size_t)DM * DM, false, nullptr, r);
    } else if (list == 3) {
        return t_make(w_up + (size_t)DM * NUP, DM, NUP, Wup + (size_t)NUP * DM, true, n_ffn_pre + DM, r);
    } else {
        return t_make(w_dn + (size_t)DFF * DM, DFF, DM, Wdn + (size_t)DM * DFF, false, nullptr, r);
    }
}
__device__ __forceinline__ void convert_list(LAS unsigned char* lds, ArgsP A, int list, int worker, int nworkers, int wave, int lane) {
    const int n = conv_count(list);
    LAS float* scr = (LAS float*)(lds + wave * 16384);
    int it = worker;
    if (it >= n) return;
    TItem cur = conv_item(A, list, it);
    f32x4 va[16], vb[16];
    t_load(cur, lane, va);
    for (;;) {
        const int itn = it + nworkers; const bool hn = itn < n;
        TItem nxt = cur;
        if (hn) { nxt = conv_item(A, list, itn); t_load(nxt, lane, vb); }
        t_store(cur, scr, lane, va);
        if (!hn) break;
#pragma unroll
        for (int i = 0; i < 16; ++i) va[i] = vb[i];
        cur = nxt; it = itn;
    }
}
__device__ __forceinline__ void convert_tail(LAS unsigned char* lds, ArgsP A, int list, int first_idle) {
    const int bid = blockIdx.x, G = gridDim.x;
    if (bid < first_idle || first_idle >= G) return;
    int tid = threadIdx.x; asm volatile("" : "+v"(tid));
    const int lane = tid & 63, wave = __builtin_amdgcn_readfirstlane(tid >> 6);
    __syncthreads();
    convert_list(lds, A, list, (bid - first_idle) * 8 + wave, (G - first_idle) * 8, wave, lane);
}
__device__ __forceinline__ void phase_prologue(LAS unsigned char* lds) {
    ArgsP A = args_ptr();
    int tid = threadIdx.x; asm volatile("" : "+v"(tid));
    const int lane = tid & 63, wave = __builtin_amdgcn_readfirstlane(tid >> 6), gw = blockIdx.x * 8 + wave, NGW = gridDim.x * 8;
    const float* x_prompt = A->in[0]; const float* x_sample = A->in[1]; const float* mem_prompt = A->in[2];
    bf16_t* YB = WSP(bf16_t, WS_HN); bf16_t* HM = WSP(bf16_t, WS_HM);
    float* RS = WSP(float, WS_RS); float* RSM = RS + 16384;
    convert_list(lds, A, 0, gw, NGW, wave, lane);
    if (gridDim.x != 256) { convert_list(lds, A, 1, gw, NGW, wave, lane); convert_list(lds, A, 2, gw, NGW, wave, lane); convert_list(lds, A, 3, gw, NGW, wave, lane); convert_list(lds, A, 4, gw, NGW, wave, lane); }
    for (int m = gw; m < 512 + TP + TSMP; m += NGW) {
        if (m < 512) norm_row<0>(mem_prompt + (size_t)m * DM, HM + (size_t)m * DM, nullptr, nullptr, RSM + m, nullptr, lane);
        else { const int r = m - 512; const float* xr = r < TP ? x_prompt + (size_t)r * DM : x_sample + (size_t)(r - TP) * DM;
            norm_row<0>(xr, YB + (size_t)r * DM, nullptr, nullptr, RS + r, nullptr, lane); }
    }
}

__device__ __forceinline__ void phase_in_a(LAS unsigned char* lds) {
    ArgsP A = args_ptr(); const int bid = blockIdx.x, G = gridDim.x;
    bf16_t* HN = WSP(bf16_t, WS_HN);
    { pg8::Gemm g{HN, WSP(bf16_t, WS_WINA), TP, NA, DM}; pg8::StaticOrder S; S.init(TP, NA, G, bid); pg8::EpiInA E{WSP(bf16_t, WS_Z), WSP(float, WS_VSS), WSP(float, WS_RS)};
      pg8::gemm_phase<pg8::EpiInA, true, true>(lds, g, S, E); }
#pragma unroll 1
    for (int l = 0; l < 2; ++l) { pg8::Gemm g{WSP(bf16_t, WS_HM), WSP(bf16_t, WS_WMKV) + (size_t)l * NKV * DM, 512, NKV, DM};
      pg8::StaticOrder S; S.init(512, NKV, G, (bid - 192 - 8 * l + 2 * G) % G);
      pg8::EpiMkv E{A->out + OUT_MKV + (size_t)l * 512 * NKV, WSP(bf16_t, WS_MKV) + (size_t)l * 512 * NKV, WSP(float, WS_RS) + 16384};
      pg8::gemm_phase<pg8::EpiMkv, true, true>(lds, g, S, E); }
    if (G == 256) { if (bid >= 208) sample_gemv<0, DM>(lds, HN + (size_t)TP * DM, DM, WSP(bf16_t, WS_WINA), NA, G - 1 - bid, 48, WSP(float, WS_ZS), nullptr, 0, nullptr, WSP(float, WS_RS) + TP); }
    else sample_gemv<0, DM>(lds, HN + (size_t)TP * DM, DM, WSP(bf16_t, WS_WINA), NA, G - 1 - bid, G, WSP(float, WS_ZS), nullptr, 0, nullptr, WSP(float, WS_RS) + TP);
    if (G == 256) convert_tail(lds, A, 1, 208);
}
__device__ __forceinline__ void phase_in_b(LAS unsigned char* lds) {
    ArgsP A = args_ptr(); const int bid = blockIdx.x, G = gridDim.x;
    bf16_t* HN = WSP(bf16_t, WS_HN); float* out = A->out;
    pg8::Gemm g{HN, WSP(bf16_t, WS_WINB), TP, NB, DM}; pg8::StaticOrder S; S.init(TP, NB, G, bid);
    pg8::EpiInB E{WSP(bf16_t, WS_Z), WSP(float, WS_RS)};
    pg8::gemm_phase<pg8::EpiInB, true, true>(lds, g, S, E);
    sample_gemv<0, DM>(lds, HN + (size_t)TP * DM, DM, WSP(bf16_t, WS_WINB), NB, G - 1 - bid, G, WSP(float, WS_ZS), nullptr, 0, out + OUT_W128S, WSP(float, WS_RS) + TP);
    if (G == 256) convert_tail(lds, A, 3, 128);
}
__device__ __forceinline__ void mem_unit_desc(ArgsP A, int v, int layer, KvDesc& kd, QoDesc& qd) {
    const int b = v >> 7, h = (v >> 5) & 3, qb = v & 31, qmoff = layer == 0 ? 3072 : 4608;
    const bf16_t* mkv = WSP(bf16_t, WS_MKV) + (size_t)layer * 512 * NKV + h * 128;
    kd.kbase = mkv; kd.vbase = mkv + 512; kd.row0 = (long)b * 256; kd.rstep = 1; kd.pitch = NKV; kd.key_lo = 0;
    qd.qbase = WSP(bf16_t, WS_Z) + qmoff + h * 128; qd.row0 = (long)b * SEQ + 128 * qb; qd.rstep = 1; qd.obase = WSP(bf16_t, WS_MIX) + MIXW + h * 128; qd.lsebase = nullptr;
    qd.banded = 0; qd.dil = 1; qd.head = 0;
}
__device__ __forceinline__ void swa_unit_desc(ArgsP A, int u, KvDesc& kd, QoDesc& qd) {
    const int b = u / 384, H = (u % 384) >> 5, idx = u & 31, g = H >> 2, dil = 1 << (2 * g), r = idx & (dil - 1), qb = idx >> (2 * g);
    const bf16_t* Z = WSP(bf16_t, WS_Z);
    kd.kbase = Z + MIXW + H * 128; kd.vbase = Z + 2 * MIXW + H * 128; kd.row0 = (long)b * SEQ + (long)(128 * qb - 128) * dil + r; kd.rstep = dil; kd.pitch = ZP; kd.key_lo = qb == 0 ? 128 : 0;
    qd.qbase = Z + H * 128; qd.row0 = (long)b * SEQ + (long)(128 * qb) * dil + r; qd.rstep = dil; qd.obase = WSP(bf16_t, WS_MIX) + H * 128; qd.lsebase = WSP(float, WS_LSE) + H;
    qd.banded = 1; qd.dil = dil; qd.head = H;
}
__device__ __forceinline__ void q_issue(const QoDesc& qd, int tid, bf16x8 (&qf)[4]) {
    const int lane = tid & 63, w = __builtin_amdgcn_readfirstlane(tid >> 6), fr = lane & 15, fq = lane >> 4;
    const long qrow = qd.row0 + (long)(16 * w + fr) * qd.rstep;
    const bf16_t* qp = qd.qbase + (size_t)qrow * ZP + 8 * fq;
#pragma unroll
    for (int k4 = 0; k4 < 4; ++k4) qf[k4] = *(const bf16x8*)(qp + 32 * k4);
}
__device__ __forceinline__ void build_bias_tables(LAS unsigned char* lds, int tid, const float* rel_bias) {
    LAS float* tab = (LAS float*)(lds + LDS_TAB); LAS float* rb = tab + 12 * 192;
    if (tid < 384) rb[tid] = rel_bias[tid] * LOG2E;
    __syncthreads();
    for (int i = tid; i < 12 * 192; i += 512) { const int H = i / 192, j = i % 192 - 32, dil = 1 << (2 * (H >> 2));
        tab[i] = (j >= 0 && j <= 128) ? rb[t5_bucket(j * dil) * 12 + H] : -1e30f; }
}
__device__ __forceinline__ void attn_unit_run(LAS unsigned char* lds, int tid, const QoDesc& qd, int key_lo, u32x4 (&kk)[8], u32x4 (&vv)[8], bf16x8 (&qf)[4],
                                              const bool has_next, const KvDesc nxt, const QoDesc nxtq) {
    const int lane = tid & 63, w = __builtin_amdgcn_readfirstlane(tid >> 6), fr = lane & 15, fq = lane >> 4;
    __syncthreads();
    kv_commit(lds, tid, key_lo, kk, vv);
    bf16x8 qc[4];
#pragma unroll
    for (int k4 = 0; k4 < 4; ++k4) qc[k4] = qf[k4];
    if (has_next) { kv_issue(nxt, tid, kk, vv); q_issue(nxtq, tid, qf); }
    __syncthreads();
    const long qrow = qd.row0 + (long)(16 * w + fr) * qd.rstep;
    bf16_t* orow = qd.obase + (size_t)qrow * DM + 4 * fq;
    float* lsep = qd.lsebase != nullptr ? qd.lsebase + (size_t)qrow * 12 : nullptr;
    if (qd.banded) attn_compute<true>(lds, lane, w, qc, key_lo, orow, lsep, (const LAS float*)(lds + LDS_TAB) + qd.head * 192);
    else attn_compute<false>(lds, lane, w, qc, key_lo, orow, lsep, (const LAS float*)(lds + LDS_TAB));
}
__device__ __forceinline__ void sample_mem_attn(LAS unsigned char* lds, int layer) {
    ArgsP A = args_ptr(); const int bid = blockIdx.x, G = gridDim.x;
    int tid = threadIdx.x; asm volatile("" : "+v"(tid));
    const int qmoff = layer == 0 ? 3072 : 4608;
    for (int it = G - 1 - 96 - bid; it >= 0 && it < 32; it += G) {
        const int s = it >> 2, h = it & 3;
        LAS float* scr = (LAS float*)lds; LAS float* og = scr + 2560;
        __syncthreads();
        const float* cm = A->in[3] + (size_t)(layer * 8 + s) * 256 * 1024;
        auto kf = [=](int j) -> const float* { return cm + (size_t)j * 1024 + h * 128; };
        auto vf = [=](int j) -> const float* { return cm + (size_t)j * 1024 + 512 + h * 128; };
        (void)sample_attend(scr, WSP(float, WS_ZS) + (size_t)s * ZP + qmoff + h * 128, 256, kf, vf, (const LAS float*)nullptr, og);
        if (tid < 128) WSP(bf16_t, WS_MIX)[(size_t)(TP + s) * DM + MIXW + h * 128 + tid] = (bf16_t)f2bf(og[tid]);
        __syncthreads();
    }
}
__device__ __forceinline__ void phase_mix_a(LAS unsigned char* lds) {
    ArgsP A = args_ptr(); const int bid = blockIdx.x, G = gridDim.x;
    int tid = threadIdx.x; asm volatile("" : "+v"(tid));
    const int lane = tid & 63, wave = __builtin_amdgcn_readfirstlane(tid >> 6);
    const float* ZS = WSP(float, WS_ZS); const float* n_v_a = A->in[15]; const float* w_sp = A->in[16]; const float* b_sp = A->in[17]; bf16_t* MIX = WSP(bf16_t, WS_MIX); float* out = A->out;
    for (int it = G - 1 - bid; it < TSMP; it += G) {
        LAS float* red = (LAS float*)lds; const int s = it;
        __syncthreads();
        float vv[3], uu[3], ss = 0.f;
#pragma unroll
        for (int i = 0; i < 3; ++i) { const int c = tid + 512 * i; uu[i] = gelu_tanh(ZS[(size_t)s * ZP + c]); vv[i] = gelu_tanh(ZS[(size_t)s * ZP + MIXW + c]); ss += vv[i] * vv[i]; }
        ss = wave_sum(ss); if (lane == 0) red[wave] = ss;
        __syncthreads();
        float tot = 0.f;
#pragma unroll
        for (int i = 0; i < 8; ++i) tot += red[i];
        const float rstd = 1.0f / sqrtf(tot * (1.0f / MIXW) + EPS);
#pragma unroll
        for (int i = 0; i < 3; ++i) { const int c = tid + 512 * i, g = c / 384; const float vn = vv[i] * rstd * n_v_a[c];
            out[OUT_CHV + (size_t)s * MIXW + c] = vn;
            const float sg = w_sp[(size_t)g * 16384] * vn + b_sp[g * 128];
            MIX[(size_t)(TP + s) * DM + c] = (bf16_t)f2bf(uu[i] * sg); }
    }
    sample_mem_attn(lds, 0);
    __syncthreads();
    for (int u = bid; u < 256; u += G) {
        KvDesc kd; QoDesc qd; mem_unit_desc(A, u, 0, kd, qd);
        u32x4 kk[8], vv[8]; bf16x8 qf[4]; GateRegs R;
        gate_issue(tid, u >> 7, (u >> 2) & 31, u & 3, WSP(bf16_t, WS_Z), WSP(float, WS_VSS), A->in[16], A->in[15], R);
        kv_issue(kd, tid, kk, vv); q_issue(qd, tid, qf);
        gate_run(lds, tid, u >> 7, (u >> 2) & 31, u & 3, R, WSP(bf16_t, WS_Z), A->in[17], WSP(bf16_t, WS_MIX));
        attn_unit_run(lds, tid, qd, kd.key_lo, kk, vv, qf, false, kd, qd);
    }
}
__device__ __forceinline__ void phase_mix_b1(LAS unsigned char* lds) {
    ArgsP A = args_ptr(); const int bid = blockIdx.x, G = gridDim.x;
    int tid = threadIdx.x; asm volatile("" : "+v"(tid));
    KvDesc kd{}, kn{}; QoDesc qd{}, qn{};
    u32x4 kk[8], vv[8]; bf16x8 qf[4];
    int u = bid;
    if (u < 1024) { if (u < 768) swa_unit_desc(A, u, kd, qd); else mem_unit_desc(A, u - 768, 1, kd, qd); kv_issue(kd, tid, kk, vv); q_issue(qd, tid, qf); }
    build_bias_tables(lds, tid, A->in[7]);
#pragma unroll 1
    for (; u < 1024; u += G) {
        const int un = u + G; const bool has_next = un < 1024;
        if (has_next) { if (un < 768) swa_unit_desc(A, un, kn, qn); else mem_unit_desc(A, un - 768, 1, kn, qn); }
        attn_unit_run(lds, tid, qd, kd.key_lo, kk, vv, qf, has_next, kn, qn);
        kd = kn; qd = qn;
    }
}
__device__ __forceinline__ void phase_mix_b2(LAS unsigned char* lds) {
    ArgsP A = args_ptr(); const int bid = blockIdx.x, G = gridDim.x;
    int tid = threadIdx.x; asm volatile("" : "+v"(tid));
    const int lane = tid & 63, wave = __builtin_amdgcn_readfirstlane(tid >> 6), gw = bid * 8 + wave, NGW = G * 8;
    bf16_t* MIX = WSP(bf16_t, WS_MIX); const float* LSE = WSP(float, WS_LSE);
    for (int row = gw; row < TP; row += NGW) {
        const float* lp = LSE + (size_t)row * 12;
#pragma unroll
        for (int i = 0; i < 3; ++i) { const int col = 8 * (lane + 64 * i), H = col >> 7, g = H >> 2, hl = H & 3;
            const float l0 = lp[hl], l1 = lp[4 + hl], l2 = lp[8 + hl], mm = fmaxf(l0, fmaxf(l1, l2));
            const float e0 = __expf(l0 - mm), e1 = __expf(l1 - mm), e2 = __expf(l2 - mm);
            const float al = (g == 0 ? e0 : (g == 1 ? e1 : e2)) / (e0 + e1 + e2);
            u32x4 wv = *(u32x4*)(MIX + (size_t)row * DM + col);
            wv.x = cvt_pk_bf16(bf_lo(wv.x) * al, bf_hi(wv.x) * al); wv.y = cvt_pk_bf16(bf_lo(wv.y) * al, bf_hi(wv.y) * al);
            wv.z = cvt_pk_bf16(bf_lo(wv.z) * al, bf_hi(wv.z) * al); wv.w = cvt_pk_bf16(bf_lo(wv.w) * al, bf_hi(wv.w) * al);
            *(u32x4*)(MIX + (size_t)row * DM + col) = wv; }
    }
    { const int nw = G > 128 ? G - 128 : G, wk = bid < nw ? bid : -1;
      if (wk >= 0) { const bf16_t* Z = WSP(bf16_t, WS_Z); float* o0 = A->out + OUT_W128P;
        for (int i = wk * 512 + tid; i < 688128; i += nw * 512) {
            const int g = i < 32768 ? 0 : (i < 163840 ? 1 : 2), ig = i - (g == 0 ? 0 : (g == 1 ? 32768 : 163840)), W = 128 << (2 * g);
            const int c8 = ig & 63, kv = (ig >> 6) & 1, tr = (ig >> 7) & (W - 1), b = (ig >> 7) / W;
            const u32x4 wv = *(const u32x4*)(Z + (size_t)(b * SEQ + (SEQ - W) + tr) * ZP + MIXW + kv * MIXW + g * 512 + c8 * 8);
            float* dst = o0 + (size_t)2048 * ((W - 128) / 3) + (size_t)ig * 8;
            *(f32x4*)dst = (f32x4){bf_lo(wv.x), bf_hi(wv.x), bf_lo(wv.y), bf_hi(wv.y)}; *(f32x4*)(dst + 4) = (f32x4){bf_lo(wv.z), bf_hi(wv.z), bf_lo(wv.w), bf_hi(wv.w)}; } } }
    const float* rel_bias = A->in[7]; const float* ZS = WSP(float, WS_ZS);
    for (int it = G - 1 - bid; it < 96; it += G) {
        const int s = it / 12, H = it % 12, g = H >> 2, hl = H & 3, dil = 1 << (2 * g), W = 128 << (2 * g);
        LAS float* scr = (LAS float*)lds; LAS float* btab = scr + 2400; LAS float* og = scr + 2560;
        __syncthreads();
        for (int j = tid; j <= 128; j += 512) btab[j] = rel_bias[t5_bucket(j * dil) * 12 + H] * LOG2E;
        __syncthreads();
        const float* cw = A->in[4 + g];
        const float* zrow = ZS + (size_t)s * ZP;
        auto kf = [=](int j) -> const float* { return j == 0 ? zrow + MIXW + H * 128 : cw + ((size_t)(s * W + (W - j * dil)) * 2 + 0) * 512 + hl * 128; };
        auto vf = [=](int j) -> const float* { return j == 0 ? zrow + 2 * MIXW + H * 128 : cw + ((size_t)(s * W + (W - j * dil)) * 2 + 1) * 512 + hl * 128; };
        const float lg = sample_attend(scr, zrow + H * 128, 129, kf, vf, btab, og);
        if (tid < 128) MIX[(size_t)(TP + s) * DM + H * 128 + tid] = (bf16_t)f2bf(og[tid]);
        if (tid == 0) WSP(float, WS_LSE)[(size_t)TP * 12 + s * 12 + H] = lg;
        __syncthreads();
    }
    sample_mem_attn(lds, 1);
}
__device__ __forceinline__ void phase_out(LAS unsigned char* lds, int layer) {
    ArgsP A = args_ptr(); const int bid = blockIdx.x, G = gridDim.x;
    bf16_t* MIX = WSP(bf16_t, WS_MIX); bf16_t* OB = WSP(bf16_t, WS_O); const bf16_t* W = WSP(bf16_t, WS_WOUT) + (size_t)layer * DM * DM;
    pg8::Gemm g{MIX, W, TP, DM, DM}; pg8::StaticOrder S; S.init(TP, DM, G, bid); pg8::EpiPlain E{OB, DM};
    pg8::gemm_phase<pg8::EpiPlain, false, true>(lds, g, S, E);
    sample_gemv<1, DM>(lds, MIX + (size_t)TP * DM, DM, W, DM, G - 1 - bid, G, nullptr, OB + (size_t)TP * DM, DM, nullptr, nullptr, layer == 1 ? WSP(float, WS_LSE) + (size_t)TP * 12 : nullptr);
}
__device__ __forceinline__ void phase_up(LAS unsigned char* lds, int layer) {
    ArgsP A = args_ptr(); const int bid = blockIdx.x, G = gridDim.x;
    bf16_t* HN = WSP(bf16_t, WS_HN); bf16_t* ACT = WSP(bf16_t, WS_ACT); const bf16_t* W = WSP(bf16_t, WS_WUP) + (size_t)layer * NUP * DM;
    pg8::Gemm g{HN, W, TP, NUP, DM}; pg8::StaticOrder S; S.init(TP, NUP, G, bid); pg8::EpiSwiglu E{ACT, WSP(float, WS_RS)};
    pg8::gemm_phase<pg8::EpiSwiglu, true, true>(lds, g, S, E);
    if (G == 256 && layer == 1) { if (bid >= 128) sample_gemv<2, DM>(lds, HN + (size_t)TP * DM, DM, W, NUP, G - 1 - bid, 128, nullptr, ACT + (size_t)TP * DFF, DFF, nullptr, WSP(float, WS_RS) + TP); }
    else sample_gemv<2, DM>(lds, HN + (size_t)TP * DM, DM, W, NUP, G - 1 - bid, G, nullptr, ACT + (size_t)TP * DFF, DFF, nullptr, WSP(float, WS_RS) + TP);
    if (G == 256) convert_tail(lds, A, layer == 0 ? 2 : 4, 128);
}
__device__ __forceinline__ void phase_down(LAS unsigned char* lds, int layer) {
    ArgsP A = args_ptr(); const int bid = blockIdx.x, G = gridDim.x;
    bf16_t* ACT = WSP(bf16_t, WS_ACT); bf16_t* OB = WSP(bf16_t, WS_O); const bf16_t* W = WSP(bf16_t, WS_WDN) + (size_t)layer * DM * DFF;
    pg8::Gemm g{ACT, W, TP, DM, DFF}; pg8::StaticOrder S; S.init(TP, DM, G, bid); pg8::EpiPlain E{OB, DM};
    pg8::gemm_phase<pg8::EpiPlain, false, true>(lds, g, S, E);
    sample_gemv<1, DFF>(lds, ACT + (size_t)TP * DFF, DFF, W, DM, G - 1 - bid, G, nullptr, OB + (size_t)TP * DM, DM, nullptr, nullptr);
}
__device__ __forceinline__ void phase_norm(int which) {
    ArgsP A = args_ptr();
    int tid = threadIdx.x; asm volatile("" : "+v"(tid));
    const int lane = tid & 63, wave = __builtin_amdgcn_readfirstlane(tid >> 6), gw = blockIdx.x * 8 + wave, NGW = gridDim.x * 8;
    const int layer = which >> 1;
    float* Y = A->out + OUT_Y; const bf16_t* OB = WSP(bf16_t, WS_O); bf16_t* YB = WSP(bf16_t, WS_HN); float* RS = WSP(float, WS_RS);
    const float* gpost = ((which & 1) ? A->in[11] : A->in[9]) + layer * DM;
    int r = gw;
    if (r >= TP + TSMP) return;
    NormRaw cur, nxt;
    norm_load(YB + (size_t)r * DM, OB + (size_t)r * DM, lane, cur);
    for (;;) {
        const int rn = r + NGW; const bool hn = rn < TP + TSMP;
        if (hn) norm_load(YB + (size_t)rn * DM, OB + (size_t)rn * DM, lane, nxt);
        if (which == 3) norm_finish<true>(cur, nullptr, gpost, nullptr, Y + (size_t)r * DM, lane);
        else norm_finish<false>(cur, YB + (size_t)r * DM, gpost, RS + r, nullptr, lane);
        if (!hn) break;
        cur = nxt; r = rn;
    }
}

__global__ void __launch_bounds__(512, 2) fwd_megakernel(Args args) {
    extern __shared__ __attribute__((aligned(16))) unsigned char lds_raw[];
    LAS unsigned char* lds = (LAS unsigned char*)lds_raw;
    volatile LAS unsigned* bst = (volatile LAS unsigned*)(lds + LDS_BYTES - 64);
    if (threadIdx.x < 16) bst[threadIdx.x] = 0u;
    __syncthreads();
    const XcdBarrier bar = xcd_barrier_post((unsigned*)args.ws, bst);
#define GRID_SYNC() xcd_barrier(bar)
    phase_prologue(lds);
    GRID_SYNC();
    phase_in_a(lds);
    GRID_SYNC();
    phase_mix_a(lds);
    GRID_SYNC();
    phase_out(lds, 0);
    GRID_SYNC();
    phase_norm(0);
    GRID_SYNC();
    phase_up(lds, 0);
    GRID_SYNC();
    phase_down(lds, 0);
    GRID_SYNC();
    phase_norm(1);
    GRID_SYNC();
    phase_in_b(lds);
    GRID_SYNC();
    phase_mix_b1(lds);
    GRID_SYNC();
    phase_mix_b2(lds);
    GRID_SYNC();
    phase_out(lds, 1);
    GRID_SYNC();
    phase_norm(2);
    GRID_SYNC();
    phase_up(lds, 1);
    GRID_SYNC();
    phase_down(lds, 1);
    GRID_SYNC();
    phase_norm(3);
#undef GRID_SYNC
}

extern "C" void kernel_launch(void* const* d_in, const int* in_sizes, int n_in, void* d_out, int out_size, void* d_ws, size_t ws_size, hipStream_t stream) {
    static int grid = 0;
    if (grid == 0) {
        if (n_in != 22 || (size_t)out_size != OUT_TOTAL || ws_size < WS_END) { fprintf(stderr, "kernel_launch: unexpected shapes (n_in %d, out %d, ws %zu)\n", n_in, out_size, ws_size); grid = -1; return; }
        int dev = 0, cus = 0, per_cu = 0;
        if (hipGetDevice(&dev) != hipSuccess || hipDeviceGetAttribute(&cus, hipDeviceAttributeMultiprocessorCount, dev) != hipSuccess) { grid = -1; return; }
        if (hipFuncSetAttribute((const void*)fwd_megakernel, hipFuncAttributeMaxDynamicSharedMemorySize, LDS_BYTES) != hipSuccess) { fprintf(stderr, "kernel_launch: hipFuncSetAttribute failed\n"); grid = -1; return; }
        if (hipOccupancyMaxActiveBlocksPerMultiprocessor(&per_cu, (const void*)fwd_megakernel, 512, LDS_BYTES) != hipSuccess || per_cu < 1) { fprintf(stderr, "kernel_launch: occupancy query says %d\n", per_cu); (void)hipGetLastError(); per_cu = 1; }
        grid = cus;
    }
    if (grid < 0) return;
    if (hipMemsetAsync(d_ws, 0, 16384, stream) != hipSuccess) { fprintf(stderr, "kernel_launch: memset of the barrier words failed\n"); return; }
    Args a{};
    for (int i = 0; i < 22; ++i) a.in[i] = (const float*)d_in[i];
    a.out = (float*)d_out; a.ws = (unsigned char*)d_ws;
    void* kargs[] = {&a};
    hipError_t e = hipLaunchCooperativeKernel((const void*)fwd_megakernel, dim3(grid), dim3(512), kargs, LDS_BYTES, stream);
    if (e != hipSuccess) fprintf(stderr, "kernel_launch: cooperative launch failed: %s (grid %d)\n", hipGetErrorString(e), grid);
}
```

```cpp
#include <hip/hip_runtime.h>
#include <cstdio>
#include <cstdint>

#define LAS __attribute__((address_space(3)))
typedef unsigned short bf16_t;
typedef short bf16x8 __attribute__((ext_vector_type(8)));
typedef short s16x4 __attribute__((ext_vector_type(4)));
typedef float f32x4 __attribute__((ext_vector_type(4)));
typedef float f32x2 __attribute__((ext_vector_type(2)));
typedef unsigned u32x4 __attribute__((ext_vector_type(4)));
typedef unsigned u32x2 __attribute__((ext_vector_type(2)));

constexpr int DM = 2048, TP = 8192, TSMP = 8, TROWS = TP + 16, SEQ = 4096;
constexpr int MIXW = 1536, NA = 3584, NB = 5120, DFF = 5632, NUP = 11264, NKV = 1024;
constexpr int ZP = 5120;
constexpr float EPS = 1e-6f;
constexpr float LOG2E = 1.4426950408889634f, LN2 = 0.6931471805599453f;
constexpr float QSCALE = 0.08838834764831845f * 1.4426950408889634f;

constexpr size_t MiB = 1u << 20;
constexpr size_t WS_WMKV = 1 * MiB;
constexpr size_t WS_WINA = 9 * MiB;
constexpr size_t WS_WINB = 23 * MiB;
constexpr size_t WS_WOUT = 43 * MiB;
constexpr size_t WS_WUP = 59 * MiB;
constexpr size_t WS_WDN = 147 * MiB;
constexpr size_t WS_HN = 191 * MiB;
constexpr size_t WS_HM = 224 * MiB;
constexpr size_t WS_MKV = 228 * MiB;
constexpr size_t WS_Z = 230 * MiB;
constexpr size_t WS_ZS = 310 * MiB;
constexpr size_t WS_VSS = 311 * MiB;
constexpr size_t WS_MIX = 312 * MiB;
constexpr size_t WS_LSE = 345 * MiB;
constexpr size_t WS_RS = 345 * MiB + 512 * 1024;
constexpr size_t WS_O = 346 * MiB;
constexpr size_t WS_ACT = 230 * MiB;
constexpr size_t WS_END = 468 * MiB;

constexpr size_t OUT_Y = 0;
constexpr size_t OUT_MKV = 16793600;
constexpr size_t OUT_CHV = OUT_MKV + 1048576;
constexpr size_t OUT_W128P = OUT_CHV + 12288;
constexpr size_t OUT_W512P = OUT_W128P + 262144;
constexpr size_t OUT_W2048P = OUT_W512P + 1048576;
constexpr size_t OUT_W128S = OUT_W2048P + 4194304;
constexpr size_t OUT_W512S = OUT_W128S + 8192;
constexpr size_t OUT_W2048S = OUT_W512S + 8192;
constexpr size_t OUT_TOTAL = OUT_W2048S + 8192;

constexpr int LDS_BYTES = 147456;
constexpr int LDS_TAB = 131072;

__device__ __forceinline__ unsigned cvt_pk_bf16(float lo, float hi) { unsigned r; asm volatile("v_cvt_pk_bf16_f32 %0, %1, %2" : "=v"(r) : "v"(lo), "v"(hi)); return r; }
__device__ __forceinline__ float bf_lo(unsigned w) { return __uint_as_float(w << 16); }
__device__ __forceinline__ float bf_hi(unsigned w) { return __uint_as_float(w & 0xffff0000u); }
__device__ __forceinline__ float wave_sum(float v) {
#pragma unroll
    for (int o = 1; o < 64; o <<= 1) v += __shfl_xor(v, o);
    return v;
}
__device__ __forceinline__ float wave_max(float v) {
#pragma unroll
    for (int o = 1; o < 64; o <<= 1) v = fmaxf(v, __shfl_xor(v, o));
    return v;
}
__device__ __forceinline__ float gelu_tanh(float x) {
    const float t = x * x;
    const float u2 = x * (1.5957691216057308f + 0.07135481627260024f * t);
    const float e = __builtin_amdgcn_exp2f(-LOG2E * u2);
    return x * __builtin_amdgcn_rcpf(1.0f + e);
}
__device__ __forceinline__ float silu_f(float x) {
    const float e = __builtin_amdgcn_exp2f(-LOG2E * x);
    return x * __builtin_amdgcn_rcpf(1.0f + e);
}
__device__ __forceinline__ int t5_bucket(int d) {
    if (d < 16) return d;
    int b = 16;
    b += (d >= 22); b += (d >= 30); b += (d >= 40); b += (d >= 54); b += (d >= 73); b += (d >= 99); b += (d >= 134); b += (d >= 182);
    b += (d >= 246); b += (d >= 332); b += (d >= 450); b += (d >= 609); b += (d >= 825); b += (d >= 1117); b += (d >= 1513);
    return b;
}
__device__ __forceinline__ unsigned off_b(unsigned row, unsigned ch) { return 256u * row + 16u * (ch ^ (((row & 3) << 2) | ((row >> 2) & 3))); }
__device__ __forceinline__ unsigned tr16_addr(unsigned lane, unsigned c, unsigned ks, unsigned t) {
    const unsigned g = lane >> 4, q = (lane & 15) >> 2, p = lane & 3;
    return off_b(32 * ks + 8 * g + 4 * t + q, 2 * c + (p >> 1)) + 8 * (p & 1);
}
typedef short v4i16_t __attribute__((ext_vector_type(4)));
__device__ __forceinline__ s16x4 tr_read(LAS unsigned char* p) { return __builtin_bit_cast(s16x4, __builtin_amdgcn_ds_read_tr16_b64_v4i16((LAS v4i16_t*)p)); }

namespace pg8 {
constexpr int BM = 256, BK = 64, HALF = 128, HTB = HALF * BK * 2, STAGE_BYTES = 8 * HTB, NXCD = 8, WGM = 4;
__host__ __device__ __forceinline__ int lds_byte(int r, int c) { const int st = (r >> 4) * 2 + (c >> 5), rr = r & 15, cc = c & 31, ob = rr * 64 + cc * 2; return st * 1024 + (ob ^ (((ob >> 9) & 1) << 5)); }
__host__ __device__ __forceinline__ void stage_rc(int b, int& R, int& C) { const int st = b / 1024, sb = b % 1024, swz = sb ^ (((sb >> 9) & 1) << 5); R = (st >> 1) * 16 + swz / 64; C = (st & 1) * 32 + (swz % 64) / 2; }
__host__ __device__ __forceinline__ int perm32(int rho) { const int n = rho >> 4, i = rho & 15; return 8 * (i >> 2) + 4 * n + (i & 3); }

struct Unit { int pm, pn; };
struct Gemm { const bf16_t* A; const bf16_t* Bt; int M, N, K; };

struct StaticOrder {
    int nM, nN, nwg, G, c;
    __host__ __device__ void init(int M, int N, int G_, int c_) { nM = M / BM; nN = N / BM; nwg = nM * nN; G = G_; c = c_; }
    __host__ __device__ bool next(int i, Unit& u) const {
        const long L = (long)i * G + c; if (L >= nwg) return false;
        int wgid = (int)L; { const int q = nwg / NXCD, r = nwg % NXCD, xcd = wgid % NXCD, off = wgid / NXCD; wgid = (xcd < r ? xcd * (q + 1) : r * (q + 1) + (xcd - r) * q) + off; }
        const int nig = WGM * nN, gid = wgid / nig, fm = gid * WGM, gsz = (nM - fm) < WGM ? (nM - fm) : WGM;
        u.pm = fm + ((wgid % nig) % gsz); u.pn = (wgid % nig) / gsz; return true;
    }
};

template <class Epi, bool ALIGN_EPI, bool SP2>
__device__ __forceinline__ void gemm_phase(LAS unsigned char* lds, const Gemm g, const StaticOrder& S, const Epi& E) {
    int tid = threadIdx.x; asm volatile("" : "+v"(tid));
    const int wid = __builtin_amdgcn_readfirstlane(tid >> 6), lane = tid & 63, wr = wid >> 2, wc = wid & 3, fr = lane & 15, fq = lane >> 4;
    const int K = g.K, nt = K / BK;
    unsigned voffA[2], voffB[2];
#pragma unroll
    for (int i = 0; i < 2; ++i) { int R, C; stage_rc(tid * 16 + i * 8192, R, C); const int Rb = (R & ~31) + perm32(R & 31);
        voffA[i] = (unsigned)(R * K + C) * 2u; voffB[i] = (unsigned)(Rb * K + C) * 2u; }
    const size_t kstep = (size_t)(BK * 2);
    const size_t hstep = (size_t)HALF * K * 2;
    const size_t tstep = 2 * hstep;
    const unsigned ldsw = (unsigned)wid * 1024u;
    const int aoff = lds_byte(wr * 64 + fr, fq * 8), boff = lds_byte(wc * 32 + fr, fq * 8);
#define PG8_SA(b, h) (((b) * 2 + (h)) * HTB)
#define PG8_SB(b, h) ((4 + (b) * 2 + (h)) * HTB)
#define PG8_STAGE(bufoff, gbase, voff) do { _Pragma("unroll") for (int _i = 0; _i < 2; ++_i) \
        __builtin_amdgcn_global_load_lds((const unsigned*)((const char*)(gbase) + (voff)[_i]), (LAS unsigned*)(lds + (bufoff) + ldsw + _i * 8192), 16, 0, 0); } while (0)
#define PG8_LDA(dst, b, h) do { _Pragma("unroll") for (int m = 0; m < 4; ++m) _Pragma("unroll") for (int k = 0; k < 2; ++k) dst[m][k] = *(const LAS bf16x8*)(lds + PG8_SA(b, h) + aoff + m * 2048 + k * 1024); } while (0)
#define PG8_LDB(dst, b, h) do { _Pragma("unroll") for (int n = 0; n < 2; ++n) _Pragma("unroll") for (int k = 0; k < 2; ++k) dst[n][k] = *(const LAS bf16x8*)(lds + PG8_SB(b, h) + boff + n * 2048 + k * 1024); } while (0)
#define PG8_MMA(ai, bj, At, Bt) do { __builtin_amdgcn_s_setprio(1); _Pragma("unroll") for (int m = 0; m < 4; ++m) _Pragma("unroll") for (int n = 0; n < 2; ++n) _Pragma("unroll") for (int k = 0; k < 2; ++k) \
        acc[ai][bj][m][n] = __builtin_amdgcn_mfma_f32_16x16x32_bf16(Bt[n][k], At[m][k], acc[ai][bj][m][n], 0, 0, 0); __builtin_amdgcn_s_setprio(0); } while (0)
#define PG8_WAIT_V(n) asm volatile("s_waitcnt vmcnt(" #n ")" ::: "memory")
#define PG8_WAIT_L(n) asm volatile("s_waitcnt lgkmcnt(" #n ")" ::: "memory")
#define PG8_BAR __builtin_amdgcn_s_barrier()
#define PG8_SCHED __builtin_amdgcn_sched_barrier(0)
    Unit cur, nxt; int ui = 0;
    if (!S.next(0, cur)) return;
    f32x4 acc[2][2][4][2];
#pragma unroll
    for (int a = 0; a < 2; ++a)
#pragma unroll
        for (int b = 0; b < 2; ++b)
#pragma unroll
            for (int m = 0; m < 4; ++m)
#pragma unroll
                for (int n = 0; n < 2; ++n) acc[a][b][m][n] = (f32x4){0.f, 0.f, 0.f, 0.f};
    bf16x8 At[4][2], B0[2][2], B1[2][2];
    const char* cA = (const char*)g.A + (size_t)cur.pm * tstep; const char* cB = (const char*)g.Bt + (size_t)cur.pn * tstep;
    if constexpr (SP2) {
        PG8_STAGE(PG8_SB(0, 0), cB, voffB); PG8_STAGE(PG8_SB(0, 1), cB + hstep, voffB); PG8_STAGE(PG8_SA(0, 0), cA, voffA); PG8_STAGE(PG8_SA(0, 1), cA + hstep, voffA);
        if (wr == 1) PG8_BAR;
        PG8_WAIT_V(2); PG8_BAR;
        PG8_STAGE(PG8_SB(1, 0), cB + kstep, voffB); PG8_STAGE(PG8_SA(1, 0), cA + kstep, voffA); PG8_STAGE(PG8_SB(1, 1), cB + hstep + kstep, voffB);
        PG8_WAIT_V(6); PG8_BAR;
    } else {
        PG8_STAGE(PG8_SB(0, 0), cB, voffB); PG8_STAGE(PG8_SA(0, 0), cA, voffA); PG8_STAGE(PG8_SB(0, 1), cB + hstep, voffB); PG8_STAGE(PG8_SA(0, 1), cA + hstep, voffA);
        if (wr == 1) PG8_BAR;
        PG8_WAIT_V(4); PG8_BAR;
        PG8_STAGE(PG8_SB(1, 0), cB + kstep, voffB); PG8_STAGE(PG8_SA(1, 0), cA + kstep, voffA); PG8_STAGE(PG8_SB(1, 1), cB + hstep + kstep, voffB);
        PG8_WAIT_V(6); PG8_BAR;
    }
    for (;;) {
        const typename Epi::Pre pre = E.prefetch(cur, wr, fr);
        const bool has_next = S.next(ui + 1, nxt);
        const char* nA = has_next ? (const char*)g.A + (size_t)nxt.pm * tstep : cA; const char* nB = has_next ? (const char*)g.Bt + (size_t)nxt.pn * tstep : cB;
        for (int t = 0; t < nt; t += 2) {
            const bool last = (t == nt - 2);
            const char* a1 = cA + (size_t)(t + 1) * kstep;
            const char* a2 = last ? nA : cA + (size_t)(t + 2) * kstep; const char* b2 = last ? nB : cB + (size_t)(t + 2) * kstep;
            const char* a3 = a2 + kstep; const char* b3 = b2 + kstep;
            if constexpr (SP2) {
            PG8_LDB(B0, 0, 0); PG8_LDB(B1, 0, 1); PG8_SCHED; PG8_LDA(At, 0, 0); PG8_STAGE(PG8_SA(1, 1), a1 + hstep, voffA);
            PG8_WAIT_V(8); PG8_WAIT_L(0); PG8_BAR; PG8_MMA(0, 0, At, B0); PG8_MMA(0, 1, At, B1); PG8_BAR; PG8_SCHED;
            PG8_LDA(At, 0, 1); PG8_STAGE(PG8_SB(0, 0), b2, voffB); PG8_STAGE(PG8_SB(0, 1), b2 + hstep, voffB); PG8_STAGE(PG8_SA(0, 0), a2, voffA);
            PG8_WAIT_V(8); PG8_WAIT_L(0); PG8_BAR; PG8_MMA(1, 0, At, B0); PG8_MMA(1, 1, At, B1); PG8_BAR; PG8_SCHED;
            PG8_LDB(B0, 1, 0); PG8_LDB(B1, 1, 1); PG8_SCHED; PG8_LDA(At, 1, 0); PG8_STAGE(PG8_SA(0, 1), a2 + hstep, voffA);
            PG8_WAIT_V(8); PG8_WAIT_L(0); PG8_BAR; PG8_MMA(0, 0, At, B0); PG8_MMA(0, 1, At, B1); PG8_BAR; PG8_SCHED;
            PG8_LDA(At, 1, 1); PG8_STAGE(PG8_SB(1, 0), b3, voffB); PG8_STAGE(PG8_SB(1, 1), b3 + hstep, voffB); PG8_STAGE(PG8_SA(1, 0), a3, voffA);
            PG8_WAIT_V(8); PG8_WAIT_L(0); PG8_BAR; PG8_MMA(1, 0, At, B0); PG8_MMA(1, 1, At, B1); PG8_BAR; PG8_SCHED;
            } else {
            PG8_LDB(B0, 0, 0); PG8_SCHED; PG8_LDA(At, 0, 0); PG8_STAGE(PG8_SA(1, 1), a1 + hstep, voffA);
            PG8_WAIT_L(8); PG8_BAR; PG8_WAIT_L(0); PG8_MMA(0, 0, At, B0); PG8_BAR; PG8_SCHED;
            PG8_LDB(B1, 0, 1); PG8_STAGE(PG8_SB(0, 0), b2, voffB);
            PG8_BAR; PG8_WAIT_L(0); PG8_MMA(0, 1, At, B1); PG8_BAR;
            PG8_LDA(At, 0, 1); PG8_STAGE(PG8_SA(0, 0), a2, voffA);
            PG8_BAR; PG8_WAIT_L(0); PG8_MMA(1, 0, At, B0); PG8_BAR; PG8_SCHED;
            PG8_STAGE(PG8_SB(0, 1), b2 + hstep, voffB);
            PG8_WAIT_V(6); PG8_BAR; PG8_MMA(1, 1, At, B1); PG8_BAR;
            PG8_LDB(B0, 1, 0); PG8_SCHED; PG8_LDA(At, 1, 0); PG8_STAGE(PG8_SA(0, 1), a2 + hstep, voffA);
            PG8_WAIT_L(8); PG8_BAR; PG8_WAIT_L(0); PG8_MMA(0, 0, At, B0); PG8_BAR; PG8_SCHED;
            PG8_LDB(B1, 1, 1); PG8_STAGE(PG8_SB(1, 0), b3, voffB);
            PG8_BAR; PG8_WAIT_L(0); PG8_MMA(0, 1, At, B1); PG8_BAR;
            PG8_LDA(At, 1, 1); PG8_STAGE(PG8_SA(1, 0), a3, voffA);
            PG8_BAR; PG8_WAIT_L(0); PG8_MMA(1, 0, At, B0); PG8_BAR; PG8_SCHED;
            PG8_STAGE(PG8_SB(1, 1), b3 + hstep, voffB);
            PG8_WAIT_V(6); PG8_BAR; PG8_MMA(1, 1, At, B1); PG8_BAR;
            }
        }
        if constexpr (ALIGN_EPI) { if (wr == 0) PG8_BAR; }
        E(acc, cur, wr, wc, fr, fq, pre);
        if (!has_next) break;
#pragma unroll
        for (int a = 0; a < 2; ++a)
#pragma unroll
            for (int b = 0; b < 2; ++b)
#pragma unroll
                for (int m = 0; m < 4; ++m)
#pragma unroll
                    for (int n = 0; n < 2; ++n) acc[a][b][m][n] = (f32x4){0.f, 0.f, 0.f, 0.f};
        cur = nxt; cA = nA; cB = nB; ++ui;
        if constexpr (ALIGN_EPI) { if (wr == 1) PG8_BAR; }
    }
    PG8_WAIT_V(0);
    if constexpr (!ALIGN_EPI) { if (wr == 0) PG8_BAR; }
    PG8_BAR;
#undef PG8_SA
#undef PG8_SB
#undef PG8_STAGE
#undef PG8_LDA
#undef PG8_LDB
#undef PG8_MMA
#undef PG8_WAIT_V
#undef PG8_WAIT_L
#undef PG8_BAR
#undef PG8_SCHED
}

typedef f32x4 Acc[2][2][4][2];
struct PreRs { float r[2][4]; };
struct PreNone { };
__device__ __forceinline__ PreRs load_rs(const float* rs, const Unit& u, int wr, int fr) { PreRs p; const int row0 = u.pm * BM + wr * 64 + fr;
#pragma unroll
    for (int ai = 0; ai < 2; ++ai)
#pragma unroll
        for (int m = 0; m < 4; ++m) p.r[ai][m] = rs[row0 + ai * HALF + m * 16];
    return p; }
__device__ __forceinline__ u32x4 pack8(const f32x4 a, const f32x4 b) { u32x4 w; w.x = cvt_pk_bf16(a[0], a[1]); w.y = cvt_pk_bf16(a[2], a[3]); w.z = cvt_pk_bf16(b[0], b[1]); w.w = cvt_pk_bf16(b[2], b[3]); return w; }

struct EpiInA {
    bf16_t* Z; float* VSS; const float* rs;
    typedef PreRs Pre; __device__ __forceinline__ Pre prefetch(const Unit& u, int wr, int fr) const { return load_rs(rs, u, wr, fr); }
    __device__ __forceinline__ void operator()(const Acc& acc, const Unit& u, int wr, int wc, int fr, int fq, const Pre& pre) const {
        const int row0 = u.pm * BM + wr * 64 + fr, col0 = u.pn * BM + wc * 32 + 8 * fq;
        const bool act = u.pn < 12, isv = (u.pn >= 6) && act;
#pragma unroll
        for (int ai = 0; ai < 2; ++ai)
#pragma unroll
            for (int m = 0; m < 4; ++m) {
                const int row = row0 + ai * HALF + m * 16; bf16_t* rowp = Z + (size_t)row * ZP + col0; float ss = 0.f; const float rsr = pre.r[ai][m];
#pragma unroll
                for (int bj = 0; bj < 2; ++bj) { f32x4 v0 = acc[ai][bj][m][0] * rsr, v1 = acc[ai][bj][m][1] * rsr;
                    if (act) {
#pragma unroll
                        for (int e = 0; e < 4; ++e) { v0[e] = gelu_tanh(v0[e]); v1[e] = gelu_tanh(v1[e]); ss += v0[e] * v0[e] + v1[e] * v1[e]; }
                    } else { v0 = v0 * QSCALE; v1 = v1 * QSCALE; }
                    *(u32x4*)(rowp + bj * HALF) = pack8(v0, v1); }
                if (isv) { ss += __shfl_xor(ss, 16); ss += __shfl_xor(ss, 32); if (fq == 0) VSS[(size_t)row * 24 + (u.pn - 6) * 4 + wc] = ss; }
            }
    }
};
struct EpiMkv {
    float* outf; bf16_t* outb; const float* rs;
    typedef PreRs Pre; __device__ __forceinline__ Pre prefetch(const Unit& u, int wr, int fr) const { return load_rs(rs, u, wr, fr); }
    __device__ __forceinline__ void operator()(const Acc& acc, const Unit& u, int wr, int wc, int fr, int fq, const Pre& pre) const {
        const int row0 = u.pm * BM + wr * 64 + fr, col0 = u.pn * BM + wc * 32 + 8 * fq;
#pragma unroll
        for (int ai = 0; ai < 2; ++ai)
#pragma unroll
            for (int m = 0; m < 4; ++m) { const size_t off = (size_t)(row0 + ai * HALF + m * 16) * NKV + col0; const float rsr = pre.r[ai][m];
#pragma unroll
                for (int bj = 0; bj < 2; ++bj) { const f32x4 v0 = acc[ai][bj][m][0] * rsr, v1 = acc[ai][bj][m][1] * rsr;
                    *(f32x4*)(outf + off + bj * HALF) = v0; *(f32x4*)(outf + off + bj * HALF + 4) = v1; *(u32x4*)(outb + off + bj * HALF) = pack8(v0, v1); } }
    }
};
struct EpiPlain {
    bf16_t* O; int ldc;
    typedef PreNone Pre; __device__ __forceinline__ Pre prefetch(const Unit&, int, int) const { return Pre{}; }
    __device__ __forceinline__ void operator()(const Acc& acc, const Unit& u, int wr, int wc, int fr, int fq, const Pre&) const {
        const int row0 = u.pm * BM + wr * 64 + fr, col0 = u.pn * BM + wc * 32 + 8 * fq;
#pragma unroll
        for (int ai = 0; ai < 2; ++ai)
#pragma unroll
            for (int m = 0; m < 4; ++m) { bf16_t* rowp = O + (size_t)(row0 + ai * HALF + m * 16) * ldc + col0;
#pragma unroll
                for (int bj = 0; bj < 2; ++bj) *(u32x4*)(rowp + bj * HALF) = pack8(acc[ai][bj][m][0], acc[ai][bj][m][1]); }
    }
};
struct EpiSwiglu {
    bf16_t* ACT; const float* rs;
    typedef PreRs Pre; __device__ __forceinline__ Pre prefetch(const Unit& u, int wr, int fr) const { return load_rs(rs, u, wr, fr); }
    __device__ __forceinline__ void operator()(const Acc& acc, const Unit& u, int wr, int wc, int fr, int fq, const Pre& pre) const {
        const int row0 = u.pm * BM + wr * 64 + fr, col0 = u.pn * HALF + wc * 32 + 8 * fq;
#pragma unroll
        for (int ai = 0; ai < 2; ++ai)
#pragma unroll
            for (int m = 0; m < 4; ++m) { f32x4 v0, v1; const float rsr = pre.r[ai][m];
#pragma unroll
                for (int e = 0; e < 4; ++e) { v0[e] = silu_f(acc[ai][0][m][0][e] * rsr) * (acc[ai][1][m][0][e] * rsr); v1[e] = silu_f(acc[ai][0][m][1][e] * rsr) * (acc[ai][1][m][1][e] * rsr); }
                *(u32x4*)(ACT + (size_t)(row0 + ai * HALF + m * 16) * DFF + col0) = pack8(v0, v1); }
    }
};
struct EpiInB {
    bf16_t* Z; const float* rs;
    typedef PreRs Pre; __device__ __forceinline__ Pre prefetch(const Unit& u, int wr, int fr) const { return load_rs(rs, u, wr, fr); }
    __device__ __forceinline__ void operator()(const Acc& acc, const Unit& u, int wr, int wc, int fr, int fq, const Pre& pre) const {
        const int row0 = u.pm * BM + wr * 64 + fr, col0 = u.pn * BM + wc * 32 + 8 * fq;
        const float qs = ((u.pn < 6) || (u.pn >= 18)) ? QSCALE : 1.0f;
#pragma unroll
        for (int ai = 0; ai < 2; ++ai)
#pragma unroll
            for (int m = 0; m < 4; ++m) {
                const int row = row0 + ai * HALF + m * 16; bf16_t* rowp = Z + (size_t)row * ZP + col0; const float rsr = pre.r[ai][m] * qs;
#pragma unroll
                for (int bj = 0; bj < 2; ++bj) *(u32x4*)(rowp + bj * HALF) = pack8(acc[ai][bj][m][0] * rsr, acc[ai][bj][m][1] * rsr);
            }
    }
};
}

__device__ __forceinline__ unsigned f2bf(float f) { unsigned u = __builtin_bit_cast(unsigned, f); return (u + 0x7fffu + ((u >> 16) & 1u)) >> 16; }
__device__ __forceinline__ unsigned pk2(float lo, float hi) { return f2bf(lo) | (f2bf(hi) << 16); }
struct TItem { const float* src; bf16_t* dst; const float* gain; int N, K; };
__device__ __forceinline__ TItem t_make(const float* W, int K, int N, bf16_t* WT, bool upperm, const float* gain, int item) {
    const int nblk = N / 64, kb = item / nblk, nb = item % nblk, k0 = 64 * kb, n0 = 64 * nb;
    int s0 = n0;
    if (upperm) { const int pn = n0 >> 8, j = n0 & 255; s0 = (j < 128) ? (128 * pn + j) : (DFF + 128 * pn + (j - 128)); }
    TItem t; t.src = W + (size_t)k0 * N + s0; t.dst = WT + (size_t)n0 * K + k0; t.gain = gain != nullptr ? gain + k0 : nullptr; t.N = N; t.K = K; return t;
}
__device__ __forceinline__ void t_load(const TItem& t, int lane, f32x4 (&v)[16]) {
    const float* src = t.src + (size_t)(lane >> 4) * t.N + 4 * (lane & 15);
#pragma unroll
    for (int i = 0; i < 16; ++i) v[i] = __builtin_nontemporal_load((const f32x4*)(src + (size_t)(4 * i) * t.N));
}
__device__ __forceinline__ void t_store(const TItem& t, LAS float* scr, int lane, const f32x4 (&v)[16]) {
    const int lr = lane >> 4, lc = lane & 15;
#pragma unroll
    for (int i = 0; i < 16; ++i) { const int k = 4 * i + lr; const float gk = t.gain != nullptr ? t.gain[k] : 1.0f;
        *(LAS f32x4*)(scr + k * 64 + ((4 * lc) ^ (4 * (k >> 3)))) = v[i] * gk; }
    asm volatile("s_waitcnt lgkmcnt(0)" ::: "memory");
    const int c = lane & 7;
#pragma unroll
    for (int j = 0; j < 8; ++j) { const int n = (lane >> 3) + 8 * j; const LAS float* sp = scr + (8 * c) * 64 + (n ^ (4 * c));
        u32x4 o; o.x = cvt_pk_bf16(sp[0 * 64], sp[1 * 64]); o.y = cvt_pk_bf16(sp[2 * 64], sp[3 * 64]); o.z = cvt_pk_bf16(sp[4 * 64], sp[5 * 64]); o.w = cvt_pk_bf16(sp[6 * 64], sp[7 * 64]);
        *(u32x4*)(t.dst + (size_t)n * t.K + 8 * c) = o; }
    asm volatile("s_waitcnt lgkmcnt(0)" ::: "memory");
}
template <int MODE>
__device__ __forceinline__ void norm_row(const float* basef, bf16_t* yb, const bf16_t* o, const float* gpost, float* rs_out, float* yout, int lane) {
    f32x4 y[8];
    if (MODE == 0 || MODE == 1) {
#pragma unroll
        for (int j = 0; j < 8; ++j) y[j] = __builtin_nontemporal_load((const f32x4*)(basef + 4 * (lane + 64 * j)));
    } else {
#pragma unroll
        for (int j = 0; j < 8; ++j) { const u32x2 w = *(const u32x2*)(yb + 4 * (lane + 64 * j)); y[j] = (f32x4){bf_lo(w.x), bf_hi(w.x), bf_lo(w.y), bf_hi(w.y)}; }
    }
    if (MODE != 0) {
        f32x4 ov[8]; float ss = 0.f;
#pragma unroll
        for (int j = 0; j < 8; ++j) { const u32x2 w = *(const u32x2*)(o + 4 * (lane + 64 * j)); ov[j] = (f32x4){bf_lo(w.x), bf_hi(w.x), bf_lo(w.y), bf_hi(w.y)};
            ss += (ov[j][0] * ov[j][0] + ov[j][1] * ov[j][1]) + (ov[j][2] * ov[j][2] + ov[j][3] * ov[j][3]); }
        const float rstd = 1.0f / sqrtf(wave_sum(ss) * (1.0f / DM) + EPS);
#pragma unroll
        for (int j = 0; j < 8; ++j) { const f32x4 g = *(const f32x4*)(gpost + 4 * (lane + 64 * j)); y[j] = y[j] + ov[j] * rstd * g; }
    }
    if (MODE == 3) {
#pragma unroll
        for (int j = 0; j < 8; ++j) *(f32x4*)(yout + 4 * (lane + 64 * j)) = y[j];
    } else {
        float ss = 0.f;
#pragma unroll
        for (int j = 0; j < 8; ++j) { ss += (y[j][0] * y[j][0] + y[j][1] * y[j][1]) + (y[j][2] * y[j][2] + y[j][3] * y[j][3]);
            u32x2 w; w.x = cvt_pk_bf16(y[j][0], y[j][1]); w.y = cvt_pk_bf16(y[j][2], y[j][3]); *(u32x2*)(yb + 4 * (lane + 64 * j)) = w; }
        ss = wave_sum(ss);
        if (lane == 0) *rs_out = 1.0f / sqrtf(ss * (1.0f / DM) + EPS);
    }
}

struct NormRaw { u32x2 yb[8]; u32x2 ob[8]; };
__device__ __forceinline__ void norm_load(const bf16_t* yb, const bf16_t* o, int lane, NormRaw& R) {
#pragma unroll
    for (int j = 0; j < 8; ++j) { R.yb[j] = *(const u32x2*)(yb + 4 * (lane + 64 * j)); R.ob[j] = __builtin_nontemporal_load((const u32x2*)(o + 4 * (lane + 64 * j))); }
}
template <bool FINAL>
__device__ __forceinline__ void norm_finish(const NormRaw& R, bf16_t* yb, const float* gpost, float* rs_out, float* yout, int lane) {
    f32x4 y[8], ov[8]; float ss = 0.f;
#pragma unroll
    for (int j = 0; j < 8; ++j) { y[j] = (f32x4){bf_lo(R.yb[j].x), bf_hi(R.yb[j].x), bf_lo(R.yb[j].y), bf_hi(R.yb[j].y)}; ov[j] = (f32x4){bf_lo(R.ob[j].x), bf_hi(R.ob[j].x), bf_lo(R.ob[j].y), bf_hi(R.ob[j].y)};
        ss += (ov[j][0] * ov[j][0] + ov[j][1] * ov[j][1]) + (ov[j][2] * ov[j][2] + ov[j][3] * ov[j][3]); }
    const float rstd = 1.0f / sqrtf(wave_sum(ss) * (1.0f / DM) + EPS);
#pragma unroll
    for (int j = 0; j < 8; ++j) { const f32x4 g = *(const f32x4*)(gpost + 4 * (lane + 64 * j)); y[j] = y[j] + ov[j] * rstd * g; }
    if (FINAL) {
#pragma unroll
        for (int j = 0; j < 8; ++j) __builtin_nontemporal_store(y[j], (f32x4*)(yout + 4 * (lane + 64 * j)));
    } else {
        float s2 = 0.f;
#pragma unroll
        for (int j = 0; j < 8; ++j) { s2 += (y[j][0] * y[j][0] + y[j][1] * y[j][1]) + (y[j][2] * y[j][2] + y[j][3] * y[j][3]);
            u32x2 w; w.x = cvt_pk_bf16(y[j][0], y[j][1]); w.y = cvt_pk_bf16(y[j][2], y[j][3]); *(u32x2*)(yb + 4 * (lane + 64 * j)) = w; }
        s2 = wave_sum(s2);
        if (lane == 0) *rs_out = 1.0f / sqrtf(s2 * (1.0f / DM) + EPS);
    }
}

struct KvDesc { const bf16_t* kbase; const bf16_t* vbase; long row0, rstep, pitch; int key_lo; };
__device__ __forceinline__ void kv_issue(const KvDesc& d, int tid, u32x4 (&kk)[8], u32x4 (&vv)[8]) {
    const int srow = tid >> 4, sch = tid & 15;
#pragma unroll
    for (int i = 0; i < 8; ++i) { const int row = srow + 32 * i, rowc = row < d.key_lo ? d.key_lo : row;
        const size_t e = (size_t)(d.row0 + (long)rowc * d.rstep) * d.pitch + sch * 8; kk[i] = *(const u32x4*)(d.kbase + e); vv[i] = *(const u32x4*)(d.vbase + e); }
}
__device__ __forceinline__ void kv_commit(LAS unsigned char* lds, int tid, int key_lo, const u32x4 (&kk)[8], const u32x4 (&vv)[8]) {
    const unsigned sb = off_b(tid >> 4, tid & 15); const int srow = tid >> 4; const u32x4 z = (u32x4){0u, 0u, 0u, 0u};
#pragma unroll
    for (int i = 0; i < 8; ++i) { const bool ok = (srow + 32 * i) >= key_lo; *(LAS u32x4*)(lds + sb + 8192 * i) = ok ? kk[i] : z; *(LAS u32x4*)(lds + 65536 + sb + 8192 * i) = ok ? vv[i] : z; }
}
template <bool BANDED>
__device__ __forceinline__ void attn_compute(LAS unsigned char* lds, int lane, int w, const bf16x8 (&qf)[4], int key_lo, bf16_t* orow, float* lsep, const LAS float* btab) {
    const int fr = lane & 15, fq = lane >> 4;
    LAS unsigned char* Kimg = lds; LAS unsigned char* Vimg = lds + 65536;
    constexpr int NBLK = BANDED ? 5 : 8;
    const int blk0 = BANDED ? (w >> 1) : 0;
    const int qi = 16 * w + fr;
    unsigned kb[2][4];
#pragma unroll
    for (int e = 0; e < 2; ++e)
#pragma unroll
        for (int kk = 0; kk < 4; ++kk) kb[e][kk] = off_b(8 * (fr >> 2) + 4 * e + (fr & 3), 4 * kk + fq);
    LAS unsigned char* Kb = Kimg + 8192 * blk0; LAS unsigned char* Vb = Vimg + 8192 * blk0;
    f32x4 s[2 * NBLK];
#pragma unroll
    for (int nt = 0; nt < 2 * NBLK; ++nt) s[nt] = (f32x4){0.f, 0.f, 0.f, 0.f};
    constexpr int TB = BANDED ? 2 * NBLK : NBLK;
#pragma unroll
    for (int t0 = 0; t0 < 2 * NBLK; t0 += TB)
#pragma unroll
        for (int kk = 0; kk < 4; ++kk) { bf16x8 kf[TB];
#pragma unroll
            for (int i = 0; i < TB; ++i) { const int nt = t0 + i; kf[i] = *(const LAS bf16x8*)(Kb + kb[nt & 1][kk] + 8192 * (nt >> 1)); }
            __builtin_amdgcn_sched_barrier(0);
#pragma unroll
            for (int i = 0; i < TB; ++i) s[t0 + i] = __builtin_amdgcn_mfma_f32_16x16x32_bf16(kf[i], qf[kk], s[t0 + i], 0, 0, 0);
            __builtin_amdgcn_sched_barrier(0); }
    float mx = -1e30f;
    const LAS float* bp = btab + (128 + 16 * (w & 1) + fr - 8 * fq + 32 - 135);
    const int cmin = BANDED ? (key_lo > 0 ? (128 + 16 * (w & 1) + fr - 8 * fq) - qi : -1000) : 0;
#pragma unroll
    for (int nt = 0; nt < 2 * NBLK; ++nt)
#pragma unroll
        for (int r = 0; r < 4; ++r) { float x = s[nt][r];
            if (BANDED) { const int c = 32 * (nt >> 1) + 4 * (nt & 1) + r; x = x + bp[135 - c]; x = (c >= cmin) ? x : -1e30f; s[nt][r] = x; }
            mx = fmaxf(mx, x); }
    mx = fmaxf(mx, __shfl_xor(mx, 16)); mx = fmaxf(mx, __shfl_xor(mx, 32));
    float l = 0.f;
#pragma unroll
    for (int nt = 0; nt < 2 * NBLK; ++nt)
#pragma unroll
        for (int r = 0; r < 4; ++r) { const float p = __builtin_amdgcn_exp2f(s[nt][r] - mx); s[nt][r] = p; l += p; }
    l += __shfl_xor(l, 16); l += __shfl_xor(l, 32);
    bf16x8 pf[NBLK];
#pragma unroll
    for (int ks = 0; ks < NBLK; ++ks) pf[ks] = __builtin_bit_cast(bf16x8, pg8::pack8(s[2 * ks], s[2 * ks + 1]));
    const float inv_l = 1.0f / l;
    unsigned vb[8][2];
#pragma unroll
    for (int ct = 0; ct < 8; ++ct) { vb[ct][0] = tr16_addr(lane, ct, 0, 0); vb[ct][1] = tr16_addr(lane, ct, 0, 1); }
    f32x4 oa[8];
#pragma unroll
    for (int ct = 0; ct < 8; ++ct) oa[ct] = (f32x4){0.f, 0.f, 0.f, 0.f};
#pragma unroll
    for (int ks = 0; ks < NBLK; ++ks) { s16x4 vlo[8], vhi[8];
#pragma unroll
        for (int ct = 0; ct < 8; ++ct) { vlo[ct] = tr_read(Vb + vb[ct][0] + 8192 * ks); vhi[ct] = tr_read(Vb + vb[ct][1] + 8192 * ks); }
        __builtin_amdgcn_sched_barrier(0);
#pragma unroll
        for (int ct = 0; ct < 8; ++ct) { const bf16x8 vf = (bf16x8){vlo[ct][0], vlo[ct][1], vlo[ct][2], vlo[ct][3], vhi[ct][0], vhi[ct][1], vhi[ct][2], vhi[ct][3]};
            oa[ct] = __builtin_amdgcn_mfma_f32_16x16x32_bf16(vf, pf[ks], oa[ct], 0, 0, 0); }
        __builtin_amdgcn_sched_barrier(0); }
#pragma unroll
    for (int ct = 0; ct < 8; ++ct) { u32x2 wv; wv.x = cvt_pk_bf16(oa[ct][0] * inv_l, oa[ct][1] * inv_l); wv.y = cvt_pk_bf16(oa[ct][2] * inv_l, oa[ct][3] * inv_l);
        *(u32x2*)(orow + 16 * ct) = wv; }
    if (lsep != nullptr && fq == 0) *lsep = (mx + __builtin_amdgcn_logf(l)) * LN2;
}
struct QoDesc { const bf16_t* qbase; long row0, rstep; bf16_t* obase; float* lsebase; int banded, dil, head; };

struct GateRegs { u32x4 v[2][6]; f32x4 wq[8]; f32x4 vs[3]; float gvl; };
__device__ __forceinline__ void gate_issue(int tid, int b, int chunk, int g, const bf16_t* Z, const float* VSS, const float* w_s, const float* g_v, GateRegs& R) {
    const int lane = tid & 63, w = __builtin_amdgcn_readfirstlane(tid >> 6), fr = lane & 15, fq = lane >> 4;
    const int tok0 = b * SEQ + chunk * 128;
    {
        const int r0 = tid >> 3, c0 = tid & 7; const bf16_t* gp = Z + (size_t)(tok0 + r0) * ZP + MIXW + g * 384 + c0 * 8;
#pragma unroll
        for (int i2 = 0; i2 < 2; ++i2)
#pragma unroll
            for (int i = 0; i < 6; ++i) R.v[i2][i] = *(const u32x4*)(gp + (size_t)i2 * 64 * ZP + 64 * i); }
    { const float* wp = w_s + (size_t)g * 16384 + (16 * w + fr) * 128 + 8 * fq;
#pragma unroll
      for (int kk = 0; kk < 4; ++kk) { R.wq[2 * kk] = *(const f32x4*)(wp + 32 * kk); R.wq[2 * kk + 1] = *(const f32x4*)(wp + 32 * kk + 4); } }
    { const float* p = VSS + (size_t)(tok0 + (tid & 127)) * 24 + 12 * ((tid >> 7) & 1);
#pragma unroll
      for (int i = 0; i < 3; ++i) R.vs[i] = *(const f32x4*)(p + 4 * i); }
    R.gvl = g_v[g * 384 + (tid < 384 ? tid : tid - 384)];
}
__device__ __forceinline__ void gate_run(LAS unsigned char* lds, int tid, int b, int chunk, int g, const GateRegs& R, const bf16_t* Z, const float* b_s, bf16_t* MIX) {
    const int lane = tid & 63, w = __builtin_amdgcn_readfirstlane(tid >> 6), fr = lane & 15, fq = lane >> 4;
    const int tok0 = b * SEQ + chunk * 128, i = 16 * w + fr;
    LAS float* rs = (LAS float*)(lds + LDS_TAB); LAS float* gvs = rs + 128;
    const size_t tokrow = (size_t)(tok0 + i);
    __syncthreads();
    const bf16_t* up = Z + tokrow * ZP + g * 384 + 4 * fq;
    u32x2 ucur[8];
    const float bs = b_s[g * 128 + i];
    {
        const int r0 = tid >> 3, c0 = tid & 7; const unsigned gsb0 = off_b(r0, c0), gsb1 = off_b(r0, c0 + 8);
#pragma unroll
        for (int i2 = 0; i2 < 2; ++i2)
#pragma unroll
            for (int k = 0; k < 6; ++k) *(LAS u32x4*)(lds + (k >> 1) * 32768 + ((k & 1) ? gsb1 : gsb0) + 16384 * i2) = R.v[i2][k]; }
    { float ssum = 0.f;
#pragma unroll
      for (int k = 0; k < 3; ++k) ssum += (R.vs[k][0] + R.vs[k][1]) + (R.vs[k][2] + R.vs[k][3]);
      if (tid < 256) rs[512 + tid] = ssum;
      if (tid < 384) gvs[tid] = R.gvl; }
    __syncthreads();
    if (tid < 128) rs[tid] = 1.0f / sqrtf((rs[512 + tid] + rs[512 + 128 + tid]) * (1.0f / MIXW) + EPS);
    __syncthreads();
    bf16x8 wf[4];
#pragma unroll
    for (int kk = 0; kk < 4; ++kk) { const int j0 = 32 * kk + 8 * fq;
        const f32x4 r0 = *(const LAS f32x4*)(rs + j0), r1 = *(const LAS f32x4*)(rs + j0 + 4);
        const f32x4 a = R.wq[2 * kk], c = R.wq[2 * kk + 1];
        float v[8] = {a[0] * r0[0], a[1] * r0[1], a[2] * r0[2], a[3] * r0[3], c[0] * r1[0], c[1] * r1[1], c[2] * r1[2], c[3] * r1[3]};
#pragma unroll
        for (int jj = 0; jj < 8; ++jj) v[jj] = (j0 + jj <= i) ? v[jj] : 0.f;
        u32x4 pk; pk.x = cvt_pk_bf16(v[0], v[1]); pk.y = cvt_pk_bf16(v[2], v[3]); pk.z = cvt_pk_bf16(v[4], v[5]); pk.w = cvt_pk_bf16(v[6], v[7]);
        wf[kk] = __builtin_bit_cast(bf16x8, pk); }
    unsigned vb[8][2];
#pragma unroll
    for (int c = 0; c < 8; ++c) { vb[c][0] = tr16_addr(lane, c, 0, 0); vb[c][1] = tr16_addr(lane, c, 0, 1); }
#pragma unroll
    for (int sub = 0; sub < 3; ++sub) { LAS unsigned char* img = lds + sub * 32768;
#pragma unroll
        for (int c = 0; c < 8; ++c) ucur[c] = *(const u32x2*)(up + sub * 128 + 16 * c);
#pragma unroll
        for (int c = 0; c < 8; ++c) { f32x4 a = (f32x4){0.f, 0.f, 0.f, 0.f};
#pragma unroll
            for (int kk = 0; kk < 4; ++kk) if (kk <= (w >> 1)) {
                const s16x4 lo = tr_read(img + vb[c][0] + 8192 * kk), hi = tr_read(img + vb[c][1] + 8192 * kk);
                const bf16x8 vf = (bf16x8){lo[0], lo[1], lo[2], lo[3], hi[0], hi[1], hi[2], hi[3]};
                a = __builtin_amdgcn_mfma_f32_16x16x32_bf16(vf, wf[kk], a, 0, 0, 0); }
            const int col = g * 384 + sub * 128 + 16 * c + 4 * fq;
            const f32x4 gv = *(const LAS f32x4*)(gvs + sub * 128 + 16 * c + 4 * fq);
            const u32x2 uw = ucur[c];
            const float o0 = bf_lo(uw.x) * (a[0] * gv[0] + bs), o1 = bf_hi(uw.x) * (a[1] * gv[1] + bs), o2 = bf_lo(uw.y) * (a[2] * gv[2] + bs), o3 = bf_hi(uw.y) * (a[3] * gv[3] + bs);
            u32x2 ov; ov.x = cvt_pk_bf16(o0, o1); ov.y = cvt_pk_bf16(o2, o3);
            *(u32x2*)(MIX + tokrow * DM + col) = ov; } }
}

template <int MODE, int K>
__device__ __forceinline__ void sample_gemv(LAS unsigned char* lds, const bf16_t* A, int a_pitch, const bf16_t* Wt, int N, int first, int stride,
                                            float* outf, bf16_t* outb, int ldb, float* win, const float* rs, const float* slse = nullptr) {
    int tid = threadIdx.x; asm volatile("" : "+v"(tid));
    const int lane = tid & 63, w = __builtin_amdgcn_readfirstlane(tid >> 6), fr = lane & 15, fq = lane >> 4;
    const int ntiles = (MODE == 2) ? N / 32 : N / 16;
    LAS float* red = (LAS float*)lds;
    constexpr int kw = K / 8;
    LAS float* atab = (LAS float*)(lds + LDS_TAB + 4096);
    if (slse != nullptr) {
        __syncthreads();
        if (tid < 128) { const int srow = tid >> 4, H = tid & 15; float al = 1.0f;
            if (H < 12) { const int hl = H & 3; const float l0 = slse[srow * 12 + hl], l1 = slse[srow * 12 + 4 + hl], l2 = slse[srow * 12 + 8 + hl], mm = fmaxf(l0, fmaxf(l1, l2));
                const float e0 = __expf(l0 - mm), e1 = __expf(l1 - mm), e2 = __expf(l2 - mm); al = (H < 4 ? e0 : (H < 8 ? e1 : e2)) / (e0 + e1 + e2); }
            atab[tid] = al; }
        __syncthreads();
    }
    for (int tile = first; tile < ntiles; tile += stride) {
        const int nrow0 = (MODE == 2) ? 256 * (tile >> 3) + 16 * (tile & 7) : 16 * tile;
        const bf16_t* ap = A + (size_t)(fr & 7) * a_pitch + w * kw + 8 * fq;
        const bf16_t* bp = Wt + (size_t)(nrow0 + fr) * K + w * kw + 8 * fq;
        f32x4 acc = (f32x4){0.f, 0.f, 0.f, 0.f}, acc2 = (f32x4){0.f, 0.f, 0.f, 0.f};
#pragma unroll
        for (int ks = 0; ks < kw / 32; ++ks) { bf16x8 a = *(const bf16x8*)(ap + 32 * ks); const bf16x8 b = *(const bf16x8*)(bp + 32 * ks);
            if (MODE == 1 && slse != nullptr) { const float al = atab[(fr & 7) * 16 + ((w * kw + 32 * ks + 8 * fq) >> 7)]; const u32x4 aw = __builtin_bit_cast(u32x4, a); u32x4 o;
                o.x = cvt_pk_bf16(bf_lo(aw.x) * al, bf_hi(aw.x) * al); o.y = cvt_pk_bf16(bf_lo(aw.y) * al, bf_hi(aw.y) * al);
                o.z = cvt_pk_bf16(bf_lo(aw.z) * al, bf_hi(aw.z) * al); o.w = cvt_pk_bf16(bf_lo(aw.w) * al, bf_hi(aw.w) * al); a = __builtin_bit_cast(bf16x8, o); }
            acc = __builtin_amdgcn_mfma_f32_16x16x32_bf16(b, a, acc, 0, 0, 0);
            if (MODE == 2) { const bf16x8 b2 = *(const bf16x8*)(bp + (size_t)128 * K + 32 * ks); acc2 = __builtin_amdgcn_mfma_f32_16x16x32_bf16(b2, a, acc2, 0, 0, 0); } }
        __syncthreads();
        *(LAS f32x4*)(red + (w * 16 + fr) * 16 + 4 * fq) = acc;
        if (MODE == 2) *(LAS f32x4*)(red + 2048 + (w * 16 + fr) * 16 + 4 * fq) = acc2;
        __syncthreads();
        if (tid < 128) { const int s = tid >> 4, c = tid & 15; float v = 0.f, v2 = 0.f;
#pragma unroll
            for (int ww = 0; ww < 8; ++ww) { v += red[(ww * 16 + s) * 16 + c]; if (MODE == 2) v2 += red[2048 + (ww * 16 + s) * 16 + c]; }
            if (rs != nullptr) { const float rsr = rs[s]; v *= rsr; v2 *= rsr; }
            if (MODE == 0) { const int n = nrow0 + c; outf[(size_t)s * ZP + n] = v;
                if (win != nullptr && n >= 1536 && n < 4608) { const int kv = n >= 3072 ? 1 : 0, cc = n - 1536 - 1536 * kv, grp = cc >> 9;
                    win[(size_t)grp * 8192 + (size_t)(s * 2 + kv) * 512 + (cc & 511)] = v; } }
            else if (MODE == 1) { outb[(size_t)s * ldb + nrow0 + c] = (bf16_t)f2bf(v); }
            else { outb[(size_t)s * ldb + 128 * (tile >> 3) + 16 * (tile & 7) + c] = (bf16_t)f2bf(silu_f(v) * v2); } }
    }
}

template <class KF, class VF>
__device__ __forceinline__ float sample_attend(LAS float* scr, const float* qv, int nkeys, KF kf, VF vf, const LAS float* btab, LAS float* o_out) {
    int tid = threadIdx.x; asm volatile("" : "+v"(tid));
    const int lane = tid & 63, w = __builtin_amdgcn_readfirstlane(tid >> 6);
    LAS float* sc = scr; LAS float* part = scr + 320; LAS float* stat = scr + 320 + 2048;
    {
        const int key = tid >> 1, half = tid & 1; float d = 0.f;
        if (key < nkeys) { const float* kp = kf(key) + 64 * half; const float* qp = qv + 64 * half; f32x4 k4[16];
#pragma unroll
            for (int i = 0; i < 16; ++i) k4[i] = *(const f32x4*)(kp + 4 * i);
#pragma unroll
            for (int i = 0; i < 16; ++i) { const f32x4 q4 = *(const f32x4*)(qp + 4 * i); d += (k4[i][0] * q4[0] + k4[i][1] * q4[1]) + (k4[i][2] * q4[2] + k4[i][3] * q4[3]); } }
        d += __shfl_xor(d, 1);
        if (half == 0 && key < nkeys) sc[key] = d * QSCALE + (btab != nullptr ? btab[key] : 0.f);
    }
    __syncthreads();
    if (w == 0) { float m = -1e30f; for (int j = lane; j < nkeys; j += 64) m = fmaxf(m, sc[j]); m = wave_max(m);
        float l = 0.f; for (int j = lane; j < nkeys; j += 64) { const float p = __builtin_amdgcn_exp2f(sc[j] - m); sc[j] = p; l += p; } l = wave_sum(l);
        if (lane == 0) { stat[0] = m; stat[1] = l; } }
    __syncthreads();
    {
        const int kg = tid >> 5, d4 = 4 * (tid & 31); f32x4 v4[16]; f32x4 a = (f32x4){0.f, 0.f, 0.f, 0.f};
#pragma unroll
        for (int i = 0; i < 16; ++i) { const int j = kg + 16 * i; v4[i] = (f32x4){0.f, 0.f, 0.f, 0.f}; if (j < nkeys) v4[i] = *(const f32x4*)(vf(j) + d4); }
#pragma unroll
        for (int i = 0; i < 16; ++i) { const int j = kg + 16 * i; const float pj = j < nkeys ? sc[j] : 0.f; a = a + v4[i] * pj; }
        *(LAS f32x4*)(part + kg * 128 + d4) = a; }
    __syncthreads();
    const float m = stat[0], l = stat[1];
    if (tid < 128) { float a = 0.f;
#pragma unroll
        for (int g = 0; g < 16; ++g) a += part[g * 128 + tid];
        o_out[tid] = a / l; }
    __syncthreads();
    return (m + __builtin_amdgcn_logf(l)) * LN2;
}

#define XB_TMO      128
#define XB_XCNT(j)  (256  + 64 * (j))
#define XB_XSUB(j)  (1280 + 64 * (j))
#define XB_XGEN(j)  (2304 + 64 * (j))
#define XB_TOP      3328
#define XB_TOPGEN   3392
#define XCD_BAR_WORDS 3456
#define XB_SPIN_CAP (1u << 18)
__device__ __forceinline__ unsigned xb_ld(unsigned* p)              { return __hip_atomic_load(p, __ATOMIC_RELAXED, __HIP_MEMORY_SCOPE_AGENT); }
__device__ __forceinline__ unsigned xb_add(unsigned* p, unsigned v) { return __hip_atomic_fetch_add(p, v, __ATOMIC_RELAXED, __HIP_MEMORY_SCOPE_AGENT); }
__device__ __forceinline__ unsigned xb_xcc_id() { return (unsigned)__builtin_amdgcn_s_getreg((3 << 11) | 20) & 0xFu; }
#define XB_SPIN(cond, bar) do { unsigned _sp = 0; while (cond) { __builtin_amdgcn_s_sleep(1); \
    if ((++_sp & 255u) == 0u) { if (xb_ld(&(bar)[XB_TMO])) break; if (_sp > XB_SPIN_CAP) { atomicAdd(&(bar)[XB_TMO], 1u); break; } } } } while (0)
struct XcdBarrier { unsigned* bar; unsigned x; volatile LAS unsigned* st; };
__device__ __forceinline__ XcdBarrier xcd_barrier_post(unsigned* bar, volatile LAS unsigned* st) {
    XcdBarrier b; b.bar = bar; b.x = xb_xcc_id(); b.st = st;
    if (threadIdx.x == 0) (void)xb_add(&bar[XB_XCNT(b.x)], 1u);
    return b;
}
__device__ __forceinline__ void xcd_barrier_complete(unsigned* bar, unsigned x, unsigned& nloc, unsigned& nx) {
    const unsigned G = gridDim.x * gridDim.y * gridDim.z;
    unsigned sum, cnt, mine, sp = 0u;
    for (;;) {
        sum = 0u; cnt = 0u; mine = 0u;
#pragma unroll
        for (unsigned j = 0; j < 16; ++j) { const unsigned c = xb_ld(&bar[XB_XCNT(j)]); sum += c; cnt += (c > 0u) ? 1u : 0u; mine = (j == x) ? c : mine; }
        if (sum == G) break;
        __builtin_amdgcn_s_sleep(1);
        if ((++sp & 255u) == 0u) { if (xb_ld(&bar[XB_TMO])) break; if (sp > XB_SPIN_CAP) { atomicAdd(&bar[XB_TMO], 1u); break; } }
    }
    nloc = mine > 0u ? mine : 1u; nx = cnt > 0u ? cnt : 1u;
}
__device__ __forceinline__ void xcd_barrier(const XcdBarrier& b) {
    asm volatile("s_waitcnt vmcnt(0)" ::: "memory");
    __syncthreads();
    if (threadIdx.x == 0) {
        unsigned* bar = b.bar;
        __builtin_amdgcn_s_waitcnt(0);
        unsigned nloc = b.st[0], nx = b.st[1];
        if (nloc == 0u) { xcd_barrier_complete(bar, b.x, nloc, nx); b.st[0] = nloc; b.st[1] = nx; }
        const unsigned old = xb_add(&bar[XB_XSUB(b.x)], 1u);
        const unsigned gen = old / nloc;
        if (old + 1u == (gen + 1u) * nloc) {
            __builtin_amdgcn_fence(__ATOMIC_RELEASE, "agent");
            asm volatile("s_waitcnt vmcnt(0)" ::: "memory");
            const unsigned og = xb_add(&bar[XB_TOP], 1u);
            const unsigned tg = og / nx;
            if (og + 1u == (tg + 1u) * nx) xb_add(&bar[XB_TOPGEN], 1u);
            else XB_SPIN(xb_ld(&bar[XB_TOPGEN]) == tg, bar);
            __builtin_amdgcn_fence(__ATOMIC_ACQUIRE, "agent");
            xb_add(&bar[XB_XGEN(b.x)], 1u);
            asm volatile("s_waitcnt vmcnt(0)" ::: "memory");
        } else {
            XB_SPIN(xb_ld(&bar[XB_XGEN(b.x)]) == gen, bar);
            __builtin_amdgcn_fence(__ATOMIC_ACQUIRE, "agent");
            asm volatile("s_waitcnt vmcnt(0)" ::: "memory");
        }
    }
    __syncthreads();
}

struct Args { const float* in[22]; float* out; unsigned char* ws; };
typedef const Args __attribute__((address_space(4)))* ArgsP;
__device__ __forceinline__ ArgsP args_ptr() { ArgsP p = (ArgsP)__builtin_amdgcn_kernarg_segment_ptr(); asm volatile("" : "+s"(p)); return p; }
#define WSP(T, off) ((T*)(A->ws + (off)))

constexpr int I_MKV = 32 * 16, I_INA = 32 * 56, I_INB = 32 * 80, I_OUT = 32 * 32, I_UP = 32 * 176, I_DN = 88 * 32, DN_P = 850, DN_A = 1170;
__device__ __forceinline__ int conv_count(int list) { return list == 0 ? 2 * I_MKV + I_INA + I_UP + DN_P : (list == 1 ? I_OUT + (DN_A - DN_P) : (list == 2 ? (I_DN - DN_A) + I_INB + I_OUT : (list == 3 ? I_UP : I_DN))); }
__device__ __forceinline__ TItem conv_item(ArgsP A, int list, int r) {
    const float* n_mix_pre = A->in[8]; const float* n_ffn_pre = A->in[10]; const float* n_mem = A->in[12]; const float* w_mem_kv = A->in[13]; const float* w_in_a = A->in[14];
    const float* w_in_b = A->in[18]; const float* w_out = A->in[19]; const float* w_up = A->in[20]; const float* w_dn = A->in[21];
    bf16_t* Wmkv = WSP(bf16_t, WS_WMKV); bf16_t* Wina = WSP(bf16_t, WS_WINA); bf16_t* Winb = WSP(bf16_t, WS_WINB); bf16_t* Wout = WSP(bf16_t, WS_WOUT);
    bf16_t* Wup = WSP(bf16_t, WS_WUP); bf16_t* Wdn = WSP(bf16_t, WS_WDN);
    if (list == 0) {
        if (r < 2 * I_MKV) { const int l = r / I_MKV; return t_make(w_mem_kv + (size_t)l * DM * NKV, DM, NKV, Wmkv + (size_t)l * NKV * DM, false, n_mem + l * DM, r % I_MKV); } r -= 2 * I_MKV;
        if (r < I_INA) return t_make(w_in_a, DM, NA, Wina, false, n_mix_pre, r); r -= I_INA;
        if (r < I_UP) return t_make(w_up, DM, NUP, Wup, true, n_ffn_pre, r); r -= I_UP;
        return t_make(w_dn, DFF, DM, Wdn, false, nullptr, r);
    } else if (list == 1) {
        if (r < I_OUT) return t_make(w_out, DM, DM, Wout, false, nullptr, r); r -= I_OUT;
        return t_make(w_dn, DFF, DM, Wdn, false, nullptr, DN_P + r);
    } else if (list == 2) {
        if (r < I_DN - DN_A) return t_make(w_dn, DFF, DM, Wdn, false, nullptr, DN_A + r); r -= I_DN - DN_A;
        if (r < I_INB) return t_make(w_in_b, DM, NB, Winb, false, n_mix_pre + DM, r); r -= I_INB;
        return t_make(w_out + (size_t)DM * DM, DM, DM, Wout + (size_t)DM * DM, false, nullptr, r);
    } else if (list == 3) {
        return t_make(w_up + (size_t)DM * NUP, DM, NUP, Wup + (size_t)NUP * DM, true, n_ffn_pre + DM, r);
    } else {
        return t_make(w_dn + (size_t)DFF * DM, DFF, DM, Wdn + (size_t)DM * DFF, false, nullptr, r);
    }
}
__device__ __forceinline__ void convert_list(LAS unsigned char* lds, ArgsP A, int list, int worker, int nworkers, int wave, int lane) {
    const int n = conv_count(list);
    LAS float* scr = (LAS float*)(lds + wave * 16384);
    int it = worker;
    if (it >= n) return;
    TItem cur = conv_item(A, list, it);
    f32x4 va[16], vb[16];
    t_load(cur, lane, va);
    for (;;) {
        const int itn = it + nworkers; const bool hn = itn < n;
        TItem nxt = cur;
        if (hn) { nxt = conv_item(A, list, itn); t_load(nxt, lane, vb); }
        t_store(cur, scr, lane, va);
        if (!hn) break;
#pragma unroll
        for (int i = 0; i < 16; ++i) va[i] = vb[i];
        cur = nxt; it = itn;
    }
}
__device__ __forceinline__ void convert_tail(LAS unsigned char* lds, ArgsP A, int list, int first_idle) {
    const int bid = blockIdx.x, G = gridDim.x;
    if (bid < first_idle || first_idle >= G) return;
    int tid = threadIdx.x; asm volatile("" : "+v"(tid));
    const int lane = tid & 63, wave = __builtin_amdgcn_readfirstlane(tid >> 6);
    __syncthreads();
    convert_list(lds, A, list, (bid - first_idle) * 8 + wave, (G - first_idle) * 8, wave, lane);
}
__device__ __forceinline__ void phase_prologue(LAS unsigned char* lds) {
    ArgsP A = args_ptr();
    int tid = threadIdx.x; asm volatile("" : "+v"(tid));
    const int lane = tid & 63, wave = __builtin_amdgcn_readfirstlane(tid >> 6), gw = blockIdx.x * 8 + wave, NGW = gridDim.x * 8;
    const float* x_prompt = A->in[0]; const float* x_sample = A->in[1]; const float* mem_prompt = A->in[2];
    bf16_t* YB = WSP(bf16_t, WS_HN); bf16_t* HM = WSP(bf16_t, WS_HM);
    float* RS = WSP(float, WS_RS); float* RSM = RS + 16384;
    convert_list(lds, A, 0, gw, NGW, wave, lane);
    if (gridDim.x != 256) { convert_list(lds, A, 1, gw, NGW, wave, lane); convert_list(lds, A, 2, gw, NGW, wave, lane); convert_list(lds, A, 3, gw, NGW, wave, lane); convert_list(lds, A, 4, gw, NGW, wave, lane); }
    for (int m = gw; m < 512 + TP + TSMP; m += NGW) {
        if (m < 512) norm_row<0>(mem_prompt + (size_t)m * DM, HM + (size_t)m * DM, nullptr, nullptr, RSM + m, nullptr, lane);
        else { const int r = m - 512; const float* xr = r < TP ? x_prompt + (size_t)r * DM : x_sample + (size_t)(r - TP) * DM;
            norm_row<0>(xr, YB + (size_t)r * DM, nullptr, nullptr, RS + r, nullptr, lane); }
    }
}

__device__ __forceinline__ void phase_in_a(LAS unsigned char* lds) {
    ArgsP A = args_ptr(); const int bid = blockIdx.x, G = gridDim.x;
    bf16_t* HN = WSP(bf16_t, WS_HN);
    { pg8::Gemm g{HN, WSP(bf16_t, WS_WINA), TP, NA, DM}; pg8::StaticOrder S; S.init(TP, NA, G, bid); pg8::EpiInA E{WSP(bf16_t, WS_Z), WSP(float, WS_VSS), WSP(float, WS_RS)};
      pg8::gemm_phase<pg8::EpiInA, true, true>(lds, g, S, E); }
#pragma unroll 1
    for (int l = 0; l < 2; ++l) { pg8::Gemm g{WSP(bf16_t, WS_HM), WSP(bf16_t, WS_WMKV) + (size_t)l * NKV * DM, 512, NKV, DM};
      pg8::StaticOrder S; S.init(512, NKV, G, (bid - 192 - 8 * l + 2 * G) % G);
      pg8::EpiMkv E{A->out + OUT_MKV + (size_t)l * 512 * NKV, WSP(bf16_t, WS_MKV) + (size_t)l * 512 * NKV, WSP(float, WS_RS) + 16384};
      pg8::gemm_phase<pg8::EpiMkv, true, true>(lds, g, S, E); }
    if (G == 256) { if (bid >= 208) sample_gemv<0, DM>(lds, HN + (size_t)TP * DM, DM, WSP(bf16_t, WS_WINA), NA, G - 1 - bid, 48, WSP(float, WS_ZS), nullptr, 0, nullptr, WSP(float, WS_RS) + TP); }
    else sample_gemv<0, DM>(lds, HN + (size_t)TP * DM, DM, WSP(bf16_t, WS_WINA), NA, G - 1 - bid, G, WSP(float, WS_ZS), nullptr, 0, nullptr, WSP(float, WS_RS) + TP);
    if (G == 256) convert_tail(lds, A, 1, 208);
}
__device__ __forceinline__ void phase_in_b(LAS unsigned char* lds) {
    ArgsP A = args_ptr(); const int bid = blockIdx.x, G = gridDim.x;
    bf16_t* HN = WSP(bf16_t, WS_HN); float* out = A->out;
    pg8::Gemm g{HN, WSP(bf16_t, WS_WINB), TP, NB, DM}; pg8::StaticOrder S; S.init(TP, NB, G, bid);
    pg8::EpiInB E{WSP(bf16_t, WS_Z), WSP(float, WS_RS)};
    pg8::gemm_phase<pg8::EpiInB, true, true>(lds, g, S, E);
    sample_gemv<0, DM>(lds, HN + (size_t)TP * DM, DM, WSP(bf16_t, WS_WINB), NB, G - 1 - bid, G, WSP(float, WS_ZS), nullptr, 0, out + OUT_W128S, WSP(float, WS_RS) + TP);
    if (G == 256) convert_tail(lds, A, 3, 128);
}
__device__ __forceinline__ void mem_unit_desc(ArgsP A, int v, int layer, KvDesc& kd, QoDesc& qd) {
    const int b = v >> 7, h = (v >> 5) & 3, qb = v & 31, qmoff = layer == 0 ? 3072 : 4608;
    const bf16_t* mkv = WSP(bf16_t, WS_MKV) + (size_t)layer * 512 * NKV + h * 128;
    kd.kbase = mkv; kd.vbase = mkv + 512; kd.row0 = (long)b * 256; kd.rstep = 1; kd.pitch = NKV; kd.key_lo = 0;
    qd.qbase = WSP(bf16_t, WS_Z) + qmoff + h * 128; qd.row0 = (long)b * SEQ + 128 * qb; qd.rstep = 1; qd.obase = WSP(bf16_t, WS_MIX) + MIXW + h * 128; qd.lsebase = nullptr;
    qd.banded = 0; qd.dil = 1; qd.head = 0;
}
__device__ __forceinline__ void swa_unit_desc(ArgsP A, int u, KvDesc& kd, QoDesc& qd) {
    const int b = u / 384, H = (u % 384) >> 5, idx = u & 31, g = H >> 2, dil = 1 << (2 * g), r = idx & (dil - 1), qb = idx >> (2 * g);
    const bf16_t* Z = WSP(bf16_t, WS_Z);
    kd.kbase = Z + MIXW + H * 128; kd.vbase = Z + 2 * MIXW + H * 128; kd.row0 = (long)b * SEQ + (long)(128 * qb - 128) * dil + r; kd.rstep = dil; kd.pitch = ZP; kd.key_lo = qb == 0 ? 128 : 0;
    qd.qbase = Z + H * 128; qd.row0 = (long)b * SEQ + (long)(128 * qb) * dil + r; qd.rstep = dil; qd.obase = WSP(bf16_t, WS_MIX) + H * 128; qd.lsebase = WSP(float, WS_LSE) + H;
    qd.banded = 1; qd.dil = dil; qd.head = H;
}
__device__ __forceinline__ void q_issue(const QoDesc& qd, int tid, bf16x8 (&qf)[4]) {
    const int lane = tid & 63, w = __builtin_amdgcn_readfirstlane(tid >> 6), fr = lane & 15, fq = lane >> 4;
    const long qrow = qd.row0 + (long)(16 * w + fr) * qd.rstep;
    const bf16_t* qp = qd.qbase + (size_t)qrow * ZP + 8 * fq;
#pragma unroll
    for (int k4 = 0; k4 < 4; ++k4) qf[k4] = *(const bf16x8*)(qp + 32 * k4);
}
__device__ __forceinline__ void build_bias_tables(LAS unsigned char* lds, int tid, const float* rel_bias) {
    LAS float* tab = (LAS float*)(lds + LDS_TAB); LAS float* rb = tab + 12 * 192;
    if (tid < 384) rb[tid] = rel_bias[tid] * LOG2E;
    __syncthreads();
    for (int i = tid; i < 12 * 192; i += 512) { const int H = i / 192, j = i % 192 - 32, dil = 1 << (2 * (H >> 2));
        tab[i] = (j >= 0 && j <= 128) ? rb[t5_bucket(j * dil) * 12 + H] : -1e30f; }
}
__device__ __forceinline__ void attn_unit_run(LAS unsigned char* lds, int tid, const QoDesc& qd, int key_lo, u32x4 (&kk)[8], u32x4 (&vv)[8], bf16x8 (&qf)[4],
                                              const bool has_next, const KvDesc nxt, const QoDesc nxtq) {
    const int lane = tid & 63, w = __builtin_amdgcn_readfirstlane(tid >> 6), fr = lane & 15, fq = lane >> 4;
    __syncthreads();
    kv_commit(lds, tid, key_lo, kk, vv);
    bf16x8 qc[4];
#pragma unroll
    for (int k4 = 0; k4 < 4; ++k4) qc[k4] = qf[k4];
    if (has_next) { kv_issue(nxt, tid, kk, vv); q_issue(nxtq, tid, qf); }
    __syncthreads();
    const long qrow = qd.row0 + (long)(16 * w + fr) * qd.rstep;
    bf16_t* orow = qd.obase + (size_t)qrow * DM + 4 * fq;
    float* lsep = qd.lsebase != nullptr ? qd.lsebase + (size_t)qrow * 12 : nullptr;
    if (qd.banded) attn_compute<true>(lds, lane, w, qc, key_lo, orow, lsep, (const LAS float*)(lds + LDS_TAB) + qd.head * 192);
    else attn_compute<false>(lds, lane, w, qc, key_lo, orow, lsep, (const LAS float*)(lds + LDS_TAB));
}
__device__ __forceinline__ void sample_mem_attn(LAS unsigned char* lds, int layer) {
    ArgsP A = args_ptr(); const int bid = blockIdx.x, G = gridDim.x;
    int tid = threadIdx.x; asm volatile("" : "+v"(tid));
    const int qmoff = layer == 0 ? 3072 : 4608;
    for (int it = G - 1 - 96 - bid; it >= 0 && it < 32; it += G) {
        const int s = it >> 2, h = it & 3;
        LAS float* scr = (LAS float*)lds; LAS float* og = scr + 2560;
        __syncthreads();
        const float* cm = A->in[3] + (size_t)(layer * 8 + s) * 256 * 1024;
        auto kf = [=](int j) -> const float* { return cm + (size_t)j * 1024 + h * 128; };
        auto vf = [=](int j) -> const float* { return cm + (size_t)j * 1024 + 512 + h * 128; };
        (void)sample_attend(scr, WSP(float, WS_ZS) + (size_t)s * ZP + qmoff + h * 128, 256, kf, vf, (const LAS float*)nullptr, og);
        if (tid < 128) WSP(bf16_t, WS_MIX)[(size_t)(TP + s) * DM + MIXW + h * 128 + tid] = (bf16_t)f2bf(og[tid]);
        __syncthreads();
    }
}
__device__ __forceinline__ void phase_mix_a(LAS unsigned char* lds) {
    ArgsP A = args_ptr(); const int bid = blockIdx.x, G = gridDim.x;
    int tid = threadIdx.x; asm volatile("" : "+v"(tid));
    const int lane = tid & 63, wave = __builtin_amdgcn_readfirstlane(tid >> 6);
    const float* ZS = WSP(float, WS_ZS); const float* n_v_a = A->in[15]; const float* w_sp = A->in[16]; const float* b_sp = A->in[17]; bf16_t* MIX = WSP(bf16_t, WS_MIX); float* out = A->out;
    for (int it = G - 1 - bid; it < TSMP; it += G) {
        LAS float* red = (LAS float*)lds; const int s = it;
        __syncthreads();
        float vv[3], uu[3], ss = 0.f;
#pragma unroll
        for (int i = 0; i < 3; ++i) { const int c = tid + 512 * i; uu[i] = gelu_tanh(ZS[(size_t)s * ZP + c]); vv[i] = gelu_tanh(ZS[(size_t)s * ZP + MIXW + c]); ss += vv[i] * vv[i]; }
        ss = wave_sum(ss); if (lane == 0) red[wave] = ss;
        __syncthreads();
        float tot = 0.f;
#pragma unroll
        for (int i = 0; i < 8; ++i) tot += red[i];
        const float rstd = 1.0f / sqrtf(tot * (1.0f / MIXW) + EPS);
#pragma unroll
        for (int i = 0; i < 3; ++i) { const int c = tid + 512 * i, g = c / 384; const float vn = vv[i] * rstd * n_v_a[c];
            out[OUT_CHV + (size_t)s * MIXW + c] = vn;
            const float sg = w_sp[(size_t)g * 16384] * vn + b_sp[g * 128];
            MIX[(size_t)(TP + s) * DM + c] = (bf16_t)f2bf(uu[i] * sg); }
    }
    sample_mem_attn(lds, 0);
    __syncthreads();
    for (int u = bid; u < 256; u += G) {
        KvDesc kd; QoDesc qd; mem_unit_desc(A, u, 0, kd, qd);
        u32x4 kk[8], vv[8]; bf16x8 qf[4]; GateRegs R;
        gate_issue(tid, u >> 7, (u >> 2) & 31, u & 3, WSP(bf16_t, WS_Z), WSP(float, WS_VSS), A->in[16], A->in[15], R);
        kv_issue(kd, tid, kk, vv); q_issue(qd, tid, qf);
        gate_run(lds, tid, u >> 7, (u >> 2) & 31, u & 3, R, WSP(bf16_t, WS_Z), A->in[17], WSP(bf16_t, WS_MIX));
        attn_unit_run(lds, tid, qd, kd.key_lo, kk, vv, qf, false, kd, qd);
    }
}
__device__ __forceinline__ void phase_mix_b1(LAS unsigned char* lds) {
    ArgsP A = args_ptr(); const int bid = blockIdx.x, G = gridDim.x;
    int tid = threadIdx.x; asm volatile("" : "+v"(tid));
    KvDesc kd{}, kn{}; QoDesc qd{}, qn{};
    u32x4 kk[8], vv[8]; bf16x8 qf[4];
    int u = bid;
    if (u < 1024) { if (u < 768) swa_unit_desc(A, u, kd, qd); else mem_unit_desc(A, u - 768, 1, kd, qd); kv_issue(kd, tid, kk, vv); q_issue(qd, tid, qf); }
    build_bias_tables(lds, tid, A->in[7]);
#pragma unroll 1
    for (; u < 1024; u += G) {
        const int un = u + G; const bool has_next = un < 1024;
        if (has_next) { if (un < 768) swa_unit_desc(A, un, kn, qn); else mem_unit_desc(A, un - 768, 1, kn, qn); }
        attn_unit_run(lds, tid, qd, kd.key_lo, kk, vv, qf, has_next, kn, qn);
        kd = kn; qd = qn;
    }
}
__device__ __forceinline__ void phase_mix_b2(LAS unsigned char* lds) {
    ArgsP A = args_ptr(); const int bid = blockIdx.x, G = gridDim.x;
    int tid = threadIdx.x; asm volatile("" : "+v"(tid));
    const int lane = tid & 63, wave = __builtin_amdgcn_readfirstlane(tid >> 6), gw = bid * 8 + wave, NGW = G * 8;
    bf16_t* MIX = WSP(bf16_t, WS_MIX); const float* LSE = WSP(float, WS_LSE);
    for (int row = gw; row < TP; row += NGW) {
        const float* lp = LSE + (size_t)row * 12;
#pragma unroll
        for (int i = 0; i < 3; ++i) { const int col = 8 * (lane + 64 * i), H = col >> 7, g = H >> 2, hl = H & 3;
            const float l0 = lp[hl], l1 = lp[4 + hl], l2 = lp[8 + hl], mm = fmaxf(l0, fmaxf(l1, l2));
            const float e0 = __expf(l0 - mm), e1 = __expf(l1 - mm), e2 = __expf(l2 - mm);
            const float al = (g == 0 ? e0 : (g == 1 ? e1 : e2)) / (e0 + e1 + e2);
            u32x4 wv = *(u32x4*)(MIX + (size_t)row * DM + col);
            wv.x = cvt_pk_bf16(bf_lo(wv.x) * al, bf_hi(wv.x) * al); wv.y = cvt_pk_bf16(bf_lo(wv.y) * al, bf_hi(wv.y) * al);
            wv.z = cvt_pk_bf16(bf_lo(wv.z) * al, bf_hi(wv.z) * al); wv.w = cvt_pk_bf16(bf_lo(wv.w) * al, bf_hi(wv.w) * al);
            *(u32x4*)(MIX + (size_t)row * DM + col) = wv; }
    }
    { const int nw = G > 128 ? G - 128 : G, wk = bid < nw ? bid : -1;
      if (wk >= 0) { const bf16_t* Z = WSP(bf16_t, WS_Z); float* o0 = A->out + OUT_W128P;
        for (int i = wk * 512 + tid; i < 688128; i += nw * 512) {
            const int g = i < 32768 ? 0 : (i < 163840 ? 1 : 2), ig = i - (g == 0 ? 0 : (g == 1 ? 32768 : 163840)), W = 128 << (2 * g);
            const int c8 = ig & 63, kv = (ig >> 6) & 1, tr = (ig >> 7) & (W - 1), b = (ig >> 7) / W;
            const u32x4 wv = __builtin_nontemporal_load((const u32x4*)(Z + (size_t)(b * SEQ + (SEQ - W) + tr) * ZP + MIXW + kv * MIXW + g * 512 + c8 * 8));
            float* dst = o0 + (size_t)2048 * ((W - 128) / 3) + (size_t)ig * 8;
            __builtin_nontemporal_store((f32x4){bf_lo(wv.x), bf_hi(wv.x), bf_lo(wv.y), bf_hi(wv.y)}, (f32x4*)dst); __builtin_nontemporal_store((f32x4){bf_lo(wv.z), bf_hi(wv.z), bf_lo(wv.w), bf_hi(wv.w)}, (f32x4*)(dst + 4)); } } }
    const float* rel_bias = A->in[7]; const float* ZS = WSP(float, WS_ZS);
    for (int it = G - 1 - bid; it < 96; it += G) {
        const int s = it / 12, H = it % 12, g = H >> 2, hl = H & 3, dil = 1 << (2 * g), W = 128 << (2 * g);
        LAS float* scr = (LAS float*)lds; LAS float* btab = scr + 2400; LAS float* og = scr + 2560;
        __syncthreads();
        for (int j = tid; j <= 128; j += 512) btab[j] = rel_bias[t5_bucket(j * dil) * 12 + H] * LOG2E;
        __syncthreads();
        const float* cw = A->in[4 + g];
        const float* zrow = ZS + (size_t)s * ZP;
        auto kf = [=](int j) -> const float* { return j == 0 ? zrow + MIXW + H * 128 : cw + ((size_t)(s * W + (W - j * dil)) * 2 + 0) * 512 + hl * 128; };
        auto vf = [=](int j) -> const float* { return j == 0 ? zrow + 2 * MIXW + H * 128 : cw + ((size_t)(s * W + (W - j * dil)) * 2 + 1) * 512 + hl * 128; };
        const float lg = sample_attend(scr, zrow + H * 128, 129, kf, vf, btab, og);
        if (tid < 128) MIX[(size_t)(TP + s) * DM + H * 128 + tid] = (bf16_t)f2bf(og[tid]);
        if (tid == 0) WSP(float, WS_LSE)[(size_t)TP * 12 + s * 12 + H] = lg;
        __syncthreads();
    }
    sample_mem_attn(lds, 1);
}
__device__ __forceinline__ void phase_out(LAS unsigned char* lds, int layer) {
    ArgsP A = args_ptr(); const int bid = blockIdx.x, G = gridDim.x;
    bf16_t* MIX = WSP(bf16_t, WS_MIX); bf16_t* OB = WSP(bf16_t, WS_O); const bf16_t* W = WSP(bf16_t, WS_WOUT) + (size_t)layer * DM * DM;
    pg8::Gemm g{MIX, W, TP, DM, DM}; pg8::StaticOrder S; S.init(TP, DM, G, bid); pg8::EpiPlain E{OB, DM};
    pg8::gemm_phase<pg8::EpiPlain, false, true>(lds, g, S, E);
    sample_gemv<1, DM>(lds, MIX + (size_t)TP * DM, DM, W, DM, G - 1 - bid, G, nullptr, OB + (size_t)TP * DM, DM, nullptr, nullptr, layer == 1 ? WSP(float, WS_LSE) + (size_t)TP * 12 : nullptr);
}
__device__ __forceinline__ void phase_up(LAS unsigned char* lds, int layer) {
    ArgsP A = args_ptr(); const int bid = blockIdx.x, G = gridDim.x;
    bf16_t* HN = WSP(bf16_t, WS_HN); bf16_t* ACT = WSP(bf16_t, WS_ACT); const bf16_t* W = WSP(bf16_t, WS_WUP) + (size_t)layer * NUP * DM;
    pg8::Gemm g{HN, W, TP, NUP, DM}; pg8::StaticOrder S; S.init(TP, NUP, G, bid); pg8::EpiSwiglu E{ACT, WSP(float, WS_RS)};
    pg8::gemm_phase<pg8::EpiSwiglu, true, true>(lds, g, S, E);
    if (G == 256 && layer == 1) { if (bid >= 128) sample_gemv<2, DM>(lds, HN + (size_t)TP * DM, DM, W, NUP, G - 1 - bid, 128, nullptr, ACT + (size_t)TP * DFF, DFF, nullptr, WSP(float, WS_RS) + TP); }
    else sample_gemv<2, DM>(lds, HN + (size_t)TP * DM, DM, W, NUP, G - 1 - bid, G, nullptr, ACT + (size_t)TP * DFF, DFF, nullptr, WSP(float, WS_RS) + TP);
    if (G == 256) convert_tail(lds, A, layer == 0 ? 2 : 4, 128);
}
__device__ __forceinline__ void phase_down(LAS unsigned char* lds, int layer) {
    ArgsP A = args_ptr(); const int bid = blockIdx.x, G = gridDim.x;
    bf16_t* ACT = WSP(bf16_t, WS_ACT); bf16_t* OB = WSP(bf16_t, WS_O); const bf16_t* W = WSP(bf16_t, WS_WDN) + (size_t)layer * DM * DFF;
    pg8::Gemm g{ACT, W, TP, DM, DFF}; pg8::StaticOrder S; S.init(TP, DM, G, bid); pg8::EpiPlain E{OB, DM};
    pg8::gemm_phase<pg8::EpiPlain, false, true>(lds, g, S, E);
    sample_gemv<1, DFF>(lds, ACT + (size_t)TP * DFF, DFF, W, DM, G - 1 - bid, G, nullptr, OB + (size_t)TP * DM, DM, nullptr, nullptr);
}
__device__ __forceinline__ void phase_norm(int which) {
    ArgsP A = args_ptr();
    int tid = threadIdx.x; asm volatile("" : "+v"(tid));
    const int lane = tid & 63, wave = __builtin_amdgcn_readfirstlane(tid >> 6), gw = blockIdx.x * 8 + wave, NGW = gridDim.x * 8;
    const int layer = which >> 1;
    float* Y = A->out + OUT_Y; const bf16_t* OB = WSP(bf16_t, WS_O); bf16_t* YB = WSP(bf16_t, WS_HN); float* RS = WSP(float, WS_RS);
    const float* gpost = ((which & 1) ? A->in[11] : A->in[9]) + layer * DM;
    int r = gw;
    if (r >= TP + TSMP) return;
    NormRaw cur, nxt;
    norm_load(YB + (size_t)r * DM, OB + (size_t)r * DM, lane, cur);
    for (;;) {
        const int rn = r + NGW; const bool hn = rn < TP + TSMP;
        if (hn) norm_load(YB + (size_t)rn * DM, OB + (size_t)rn * DM, lane, nxt);
        if (which == 3) norm_finish<true>(cur, nullptr, gpost, nullptr, Y + (size_t)r * DM, lane);
        else norm_finish<false>(cur, YB + (size_t)r * DM, gpost, RS + r, nullptr, lane);
        if (!hn) break;
        cur = nxt; r = rn;
    }
}

__global__ void __launch_bounds__(512, 2) fwd_megakernel(Args args) {
    extern __shared__ __attribute__((aligned(16))) unsigned char lds_raw[];
    LAS unsigned char* lds = (LAS unsigned char*)lds_raw;
    volatile LAS unsigned* bst = (volatile LAS unsigned*)(lds + LDS_BYTES - 64);
    if (threadIdx.x < 16) bst[threadIdx.x] = 0u;
    __syncthreads();
    const XcdBarrier bar = xcd_barrier_post((unsigned*)args.ws, bst);
#define GRID_SYNC() xcd_barrier(bar)
    phase_prologue(lds);
    GRID_SYNC();
    phase_in_a(lds);
    GRID_SYNC();
    phase_mix_a(lds);
    GRID_SYNC();
    phase_out(lds, 0);
    GRID_SYNC();
    phase_norm(0);
    GRID_SYNC();
    phase_up(lds, 0);
    GRID_SYNC();
    phase_down(lds, 0);
    GRID_SYNC();
    phase_norm(1);
    GRID_SYNC();
    phase_in_b(lds);
    GRID_SYNC();
    phase_mix_b1(lds);
    GRID_SYNC();
    phase_mix_b2(lds);
    GRID_SYNC();
    phase_out(lds, 1);
    GRID_SYNC();
    phase_norm(2);
    GRID_SYNC();
    phase_up(lds, 1);
    GRID_SYNC();
    phase_down(lds, 1);
    GRID_SYNC();
    phase_norm(3);
#undef GRID_SYNC
}

extern "C" void kernel_launch(void* const* d_in, const int* in_sizes, int n_in, void* d_out, int out_size, void* d_ws, size_t ws_size, hipStream_t stream) {
    static int grid = 0;
    if (grid == 0) {
        if (n_in != 22 || (size_t)out_size != OUT_TOTAL || ws_size < WS_END) { fprintf(stderr, "kernel_launch: unexpected shapes (n_in %d, out %d, ws %zu)\n", n_in, out_size, ws_size); grid = -1; return; }
        int dev = 0, cus = 0, per_cu = 0;
        if (hipGetDevice(&dev) != hipSuccess || hipDeviceGetAttribute(&cus, hipDeviceAttributeMultiprocessorCount, dev) != hipSuccess) { grid = -1; return; }
        if (hipFuncSetAttribute((const void*)fwd_megakernel, hipFuncAttributeMaxDynamicSharedMemorySize, LDS_BYTES) != hipSuccess) { fprintf(stderr, "kernel_launch: hipFuncSetAttribute failed\n"); grid = -1; return; }
        if (hipOccupancyMaxActiveBlocksPerMultiprocessor(&per_cu, (const void*)fwd_megakernel, 512, LDS_BYTES) != hipSuccess || per_cu < 1) { fprintf(stderr, "kernel_launch: occupancy query says %d\n", per_cu); (void)hipGetLastError(); per_cu = 1; }
        grid = cus;
    }
    if (grid < 0) return;
    if (hipMemsetAsync(d_ws, 0, 16384, stream) != hipSuccess) { fprintf(stderr, "kernel_launch: memset of the barrier words failed\n"); return; }
    Args a{};
    for (int i = 0; i < 22; ++i) a.in[i] = (const float*)d_in[i];
    a.out = (float*)d_out; a.ws = (unsigned char*)d_ws;
    void* kargs[] = {&a};
    hipError_t e = hipLaunchCooperativeKernel((const void*)fwd_megakernel, dim3(grid), dim3(512), kargs, LDS_BYTES, stream);
    if (e != hipSuccess) fprintf(stderr, "kernel_launch: cooperative launch failed: %s (grid %d)\n", hipGetErrorString(e), grid);
}
```
